# Optimizing an MI355X kernel written in HIP

```python
import math
import jax
import jax.numpy as jnp
from jax import lax
import numpy as np


D_MODEL = 1024
BATCH = 8
SEQ = 4096
DEPTH = 2

GRID_W = 64
CTX_LEN = 256
HEAD_DIM = 64
ATTN_W = D_MODEL // 2
N_Q_HEADS = ATTN_W // HEAD_DIM
N_KV_HEADS = max(1, N_Q_HEADS // 4)
GQA_GROUP = N_Q_HEADS // N_KV_HEADS
KV_W = N_KV_HEADS * HEAD_DIM
ROPE_AXIS_DIM = HEAD_DIM // 2
ROPE_THETA = 10000.0
Q_BLOCK = 128
FOURIER_W = D_MODEL // 4
FOURIER_GROUPS = 4
FOURIER_GROUP_DIM = FOURIER_W // FOURIER_GROUPS
HYENA_W = D_MODEL - ATTN_W - FOURIER_W
HYENA_BANDS = 16
HYENA_EMB = 1 + 2 * HYENA_BANDS
HYENA_FILTER_W = 64
HYENA_FAST_DECAY = 0.3
HYENA_SLOW_DECAY = 1.5
HYENA_TARGET = 1e-2
MIX_W = ATTN_W + FOURIER_W + HYENA_W
Q0 = 0
K0 = ATTN_W
V0 = K0 + KV_W
F0 = V0 + KV_W
H0 = F0 + FOURIER_W
IN_W = H0 + 3 * HYENA_W
D_FF = int(math.ceil(8 * D_MODEL / 3 / 128)) * 128
NORM_EPS = 1e-6

kernel_name = 'hybrid_attn_fourier_hyena_dit'


def rmsnorm(x, g):
    xf = x.astype(jnp.float32)
    y = xf * lax.rsqrt(jnp.mean(xf * xf, axis=-1, keepdims=True) + NORM_EPS)
    return (y * g.astype(jnp.float32)).astype(x.dtype)


def dwconv3(u, w, b):
    up = jnp.pad(u, ((0, 0), (1, 1), (0, 0)))
    return up[:, :-2] * w[0] + up[:, 1:-1] * w[1] + up[:, 2:] * w[2] + b


def rope2d(x, ang_r, ang_c):
    def rot(xa, ang):
        cos = jnp.cos(ang)[:, None, :].astype(xa.dtype)
        sin = jnp.sin(ang)[:, None, :].astype(xa.dtype)
        x1, x2 = jnp.split(xa, 2, axis=-1)
        return jnp.concatenate([x1 * cos - x2 * sin, x2 * cos + x1 * sin], axis=-1)
    xr, xc = jnp.split(x, 2, axis=-1)
    return jnp.concatenate([rot(xr, ang_r), rot(xc, ang_c)], axis=-1)


def attend(q, k, v):
    s = jnp.einsum('bqhgd,bkhd->bhgqk', q, k).astype(jnp.float32) * (HEAD_DIM ** -0.5)
    p = jax.nn.softmax(s, axis=-1).astype(v.dtype)
    return jnp.einsum('bhgqk,bkhd->bqhgd', p, v)


def blocked_attention(q, k, v):
    B, L = q.shape[0], q.shape[1]
    nb = L // Q_BLOCK
    qb = q.reshape(B, nb, Q_BLOCK, N_KV_HEADS, GQA_GROUP, HEAD_DIM).swapaxes(0, 1)
    ob = lax.map(lambda qq: attend(qq, k, v), qb)
    return ob.swapaxes(0, 1).reshape(B, L, ATTN_W)


def fourier_mix(f, w):
    B, L, _ = f.shape
    fg = f.astype(jnp.float32).reshape(B, L, FOURIER_GROUPS, FOURIER_GROUP_DIM)
    y = jnp.fft.fft2(fg, axes=(1, 3), norm='ortho').real.astype(f.dtype)
    return y.reshape(B, L, FOURIER_W) @ w


def hyena_filter(L, w1, b1, fr1, w2, b2, fr2, w3):
    f32 = jnp.float32
    t = jnp.linspace(0.0, 1.0, L, dtype=f32)[:, None]
    bands = jnp.linspace(1e-4, HYENA_BANDS - 1, HYENA_BANDS, dtype=f32)
    ang = (2.0 * math.pi) * jnp.arange(L, dtype=f32)[:, None] / L * bands[None, :]
    z = jnp.concatenate([t, jnp.cos(ang), -jnp.sin(ang)], axis=-1)
    h = jnp.sin(fr1.astype(f32) * (z @ w1.astype(f32) + b1.astype(f32)))
    h = jnp.sin(fr2.astype(f32) * (h @ w2.astype(f32) + b2.astype(f32)))
    h = h @ w3.astype(f32)
    deltas = jnp.abs(jnp.linspace(math.log(HYENA_TARGET) / HYENA_SLOW_DECAY,
                                  math.log(HYENA_TARGET) / HYENA_FAST_DECAY, HYENA_W, dtype=f32))
    decay = jnp.exp(-t * deltas[None, :])
    h_fwd = h[:, :HYENA_W] * decay
    h_bwd = h[:, HYENA_W:] * decay
    two = jnp.concatenate([h_fwd, jnp.zeros((1, HYENA_W), f32), h_bwd[:0:-1]], axis=0)
    return two / jnp.sum(jnp.abs(two), axis=0, keepdims=True)


def hyena_longconv(u, filt, bias):
    L = u.shape[1]
    n = 2 * L
    uf = jnp.fft.rfft(u.astype(jnp.float32), n=n, axis=1)
    kf = jnp.fft.rfft(filt, n=n, axis=0)
    y = jnp.fft.irfft(uf * kf[None], n=n, axis=1)[:, :L]
    return (y + u.astype(jnp.float32) * bias.astype(jnp.float32)).astype(u.dtype)


def hyena_mix(p, conv_w, conv_b, filt, bias):
    uc = dwconv3(p, conv_w, conv_b)
    x0, x1, v = jnp.split(uc, 3, axis=-1)
    return x0 * hyena_longconv(x1 * v, filt, bias)


def conv_ffn(h, w_up, w_c, b_c, w_down):
    u = dwconv3(h @ w_up, w_c, b_c)
    gate, val = jnp.split(u, 2, axis=-1)
    return (jax.nn.silu(gate) * val) @ w_down


def setup_inputs(seed: int = 0) -> dict:
    key = jax.random.key(seed)
    ks = jax.random.split(key, 32)
    f32 = jnp.float32

    def nrm(k, shape, scale):
        return jax.random.normal(k, shape, f32) * scale

    def gain(k, shape):
        return 1.0 + 0.05 * jax.random.normal(k, shape, f32)

    return {
        'x': nrm(ks[0], (BATCH, SEQ, D_MODEL), 1.0),
        'c': nrm(ks[1], (BATCH, D_MODEL), 1.0),
        'ctx': nrm(ks[2], (BATCH, CTX_LEN, D_MODEL), 1.0),
        'c_ctx': nrm(ks[3], (D_MODEL,), 1.0),
        'w_mod': nrm(ks[4], (DEPTH, D_MODEL, 6 * D_MODEL), 0.5 * D_MODEL ** -0.5),
        'b_mod': nrm(ks[5], (DEPTH, 6 * D_MODEL), 0.02),
        'g_pre_mix': gain(ks[6], (DEPTH, D_MODEL)),
        'g_post_mix': gain(ks[7], (DEPTH, D_MODEL)),
        'g_pre_ffn': gain(ks[8], (DEPTH, D_MODEL)),
        'g_post_ffn': gain(ks[9], (DEPTH, D_MODEL)),
        'w_in': nrm(ks[10], (DEPTH, D_MODEL, IN_W), D_MODEL ** -0.5),
        'g_q': gain(ks[11], (DEPTH, HEAD_DIM)),
        'g_k': gain(ks[12], (DEPTH, HEAD_DIM)),
        'w_fourier': nrm(ks[13], (DEPTH, FOURIER_W, FOURIER_W), FOURIER_W ** -0.5),
        'w_hy_conv': nrm(ks[14], (DEPTH, 3, 3 * HYENA_W), 3 ** -0.5),
        'b_hy_conv': nrm(ks[15], (DEPTH, 3 * HYENA_W), 0.02),
        'hy_w1': nrm(ks[16], (DEPTH, HYENA_EMB, HYENA_FILTER_W), HYENA_EMB ** -0.5),
        'hy_b1': nrm(ks[17], (DEPTH, HYENA_FILTER_W), 0.1),
        'hy_fr1': gain(ks[18], (DEPTH, HYENA_FILTER_W)),
        'hy_w2': nrm(ks[19], (DEPTH, HYENA_FILTER_W, HYENA_FILTER_W), HYENA_FILTER_W ** -0.5),
        'hy_b2': nrm(ks[20], (DEPTH, HYENA_FILTER_W), 0.1),
        'hy_fr2': gain(ks[21], (DEPTH, HYENA_FILTER_W)),
        'hy_w3': nrm(ks[22], (DEPTH, HYENA_FILTER_W, 2 * HYENA_W), HYENA_FILTER_W ** -0.5),
        'hy_bias': nrm(ks[23], (DEPTH, HYENA_W), 0.1),
        'w_out': nrm(ks[24], (DEPTH, MIX_W, D_MODEL), MIX_W ** -0.5),
        'w_up': nrm(ks[25], (DEPTH, D_MODEL, 2 * D_FF), D_MODEL ** -0.5),
        'w_ffn_conv': nrm(ks[26], (DEPTH, 3, 2 * D_FF), 3 ** -0.5),
        'b_ffn_conv': nrm(ks[27], (DEPTH, 2 * D_FF), 0.02),
        'w_down': nrm(ks[28], (DEPTH, D_FF, D_MODEL), D_FF ** -0.5),
    }


def reference(x, c, ctx, c_ctx, w_mod, b_mod, g_pre_mix, g_post_mix, g_pre_ffn, g_post_ffn,
              w_in, g_q, g_k, w_fourier, w_hy_conv, b_hy_conv, hy_w1, hy_b1, hy_fr1,
              hy_w2, hy_b2, hy_fr2, hy_w3, hy_bias, w_out, w_up, w_ffn_conv, b_ffn_conv, w_down):
    B, L, _ = x.shape
    C = ctx.shape[1]
    ROWS = L // GRID_W
    row = jnp.repeat(jnp.arange(ROWS, dtype=jnp.float32), GRID_W)
    col = jnp.tile(jnp.arange(GRID_W, dtype=jnp.float32), ROWS)
    inv = ROPE_THETA ** (-jnp.arange(0, ROPE_AXIS_DIM, 2, dtype=jnp.float32) / ROPE_AXIS_DIM)
    ang_r = row[:, None] * inv[None, :]
    ang_c = col[:, None] * inv[None, :]

    for i in range(DEPTH):
        last = i == DEPTH - 1
        mod_x = (jax.nn.silu(c) @ w_mod[i] + b_mod[i])[:, None, :]
        mod_c = (jax.nn.silu(c_ctx) @ w_mod[i] + b_mod[i])[None, None, :]
        sh1, sc1, ga1, sh2, sc2, ga2 = jnp.split(mod_x, 6, axis=-1)
        csh1, csc1, cga1, csh2, csc2, cga2 = jnp.split(mod_c, 6, axis=-1)
        hy_params = (hy_w1[i], hy_b1[i], hy_fr1[i], hy_w2[i], hy_b2[i], hy_fr2[i], hy_w3[i])

        hx = rmsnorm(x, g_pre_mix[i]) * (1.0 + sc1) + sh1
        hc = rmsnorm(ctx, g_pre_mix[i]) * (1.0 + csc1) + csh1
        px = hx @ w_in[i]
        pc = hc @ (w_in[i][:, K0:F0] if last else w_in[i])
        pc_kv = pc if last else pc[..., K0:F0]

        kc = rmsnorm(pc_kv[..., :KV_W].reshape(B, C, N_KV_HEADS, HEAD_DIM), g_k[i])
        vc = pc_kv[..., KV_W:].reshape(B, C, N_KV_HEADS, HEAD_DIM)
        q = rope2d(rmsnorm(px[..., Q0:K0].reshape(B, L, N_Q_HEADS, HEAD_DIM), g_q[i]), ang_r, ang_c)
        k = rope2d(rmsnorm(px[..., K0:V0].reshape(B, L, N_KV_HEADS, HEAD_DIM), g_k[i]), ang_r, ang_c)
        v = px[..., V0:F0].reshape(B, L, N_KV_HEADS, HEAD_DIM)
        k_all = jnp.concatenate([kc, k], axis=1)
        v_all = jnp.concatenate([vc, v], axis=1)
        attn_x = blocked_attention(q.reshape(B, L, N_KV_HEADS, GQA_GROUP, HEAD_DIM), k_all, v_all)
        four_x = fourier_mix(px[..., F0:H0], w_fourier[i])
        hy_x = hyena_mix(px[..., H0:], w_hy_conv[i], b_hy_conv[i], hyena_filter(L, *hy_params), hy_bias[i])
        mix_x = jnp.concatenate([attn_x, four_x, hy_x], axis=-1) @ w_out[i]
        x = x + ga1 * rmsnorm(mix_x, g_post_mix[i])

        if not last:
            qc = rmsnorm(pc[..., Q0:K0].reshape(B, C, N_Q_HEADS, HEAD_DIM), g_q[i])
            attn_c = attend(qc.reshape(B, C, N_KV_HEADS, GQA_GROUP, HEAD_DIM), kc, vc).reshape(B, C, ATTN_W)
            four_c = fourier_mix(pc[..., F0:H0], w_fourier[i])
            hy_c = hyena_mix(pc[..., H0:], w_hy_conv[i], b_hy_conv[i], hyena_filter(C, *hy_params), hy_bias[i])
            mix_c = jnp.concatenate([attn_c, four_c, hy_c], axis=-1) @ w_out[i]
            ctx = ctx + cga1 * rmsnorm(mix_c, g_post_mix[i])

        fx = rmsnorm(x, g_pre_ffn[i]) * (1.0 + sc2) + sh2
        yx = conv_ffn(fx, w_up[i], w_ffn_conv[i], b_ffn_conv[i], w_down[i])
        x = x + ga2 * rmsnorm(yx, g_post_ffn[i])
        if not last:
            fc = rmsnorm(ctx, g_pre_ffn[i]) * (1.0 + csc2) + csh2
            yc = conv_ffn(fc, w_up[i], w_ffn_conv[i], b_ffn_conv[i], w_down[i])
            ctx = ctx + cga2 * rmsnorm(yc, g_post_ffn[i])

    return x
```

```cpp
#include <hip/hip_runtime.h>
#include <hip/hip_cooperative_groups.h>
#include <hip/hip_bf16.h>
#include <cstdio>
#include <cstdint>
#include <cmath>
namespace cg = cooperative_groups;
__device__ __forceinline__ int mk_tid() { int t = threadIdx.x; asm volatile("" : "+v"(t)); return t; }
namespace pg8 {
#define PG8_LAS __attribute__((address_space(3)))
typedef unsigned short bf16_t;
typedef short bf16x8 __attribute__((ext_vector_type(8)));
typedef float f32x4 __attribute__((ext_vector_type(4)));
typedef unsigned u32x4 __attribute__((ext_vector_type(4)));
constexpr int BM = 256, BK = 64, HALF = 128, HTB = HALF * BK * 2  , STAGE_BYTES = 8 * HTB, NXCD = 8, WGM = 8;

__host__ __device__ __forceinline__ int lds_byte(int r, int c) { const int st = (r >> 4) * 2 + (c >> 5), rr = r & 15, cc = c & 31, ob = rr * 64 + cc * 2; return st * 1024 + (ob ^ (((ob >> 9) & 1) << 5)); }
__host__ __device__ __forceinline__ void stage_rc(int b, int& R, int& C) { const int st = b / 1024, sb = b % 1024, swz = sb ^ (((sb >> 9) & 1) << 5); R = (st >> 1) * 16 + swz / 64; C = (st & 1) * 32 + (swz % 64) / 2; }
__host__ __device__ __forceinline__ int perm32(int rho) { const int n = rho >> 4, i = rho & 15; return 8 * (i >> 2) + 4 * n + (i & 3); }

struct Unit { int pm, pn; };
struct Gemm { const bf16_t* A; const bf16_t* Bt; int M, N, K; };

struct StaticOrder {
    int nM, nN, nwg, G, c;
    __host__ __device__ void init(int M, int N, int G_, int c_) { nM = M / BM; nN = N / BM; nwg = nM * nN; G = G_; c = c_; }
    __host__ __device__ bool next(int i, Unit& u) const {
        const long L = (long)i * G + c; if (L >= nwg) return false;
        int wgid = (int)L; { const int q = nwg / NXCD, r = nwg % NXCD, xcd = wgid % NXCD, off = wgid / NXCD; wgid = (xcd < r ? xcd * (q + 1) : r * (q + 1) + (xcd - r) * q) + off; }
        const int nig = WGM * nN, gid = wgid / nig, fm = gid * WGM, gsz = (nM - fm) < WGM ? (nM - fm) : WGM;
        u.pm = fm + ((wgid % nig) % gsz); u.pn = (wgid % nig) / gsz; return true;
    }
    __device__ __forceinline__ void a_ready(const Unit&) const {}
    __device__ __forceinline__ void done(const Unit&) const {}
};
__device__ __forceinline__ unsigned cvt_pk_bf16(float lo, float hi) { unsigned r; asm volatile("v_cvt_pk_bf16_f32 %0, %1, %2" : "=v"(r) : "v"(lo), "v"(hi)); return r; }
typedef float f32x2 __attribute__((ext_vector_type(2)));
template <class Epi, class Sched, bool ALIGN_EPI = false, bool SP2 = false>
__device__ __forceinline__ void gemm_phase(PG8_LAS unsigned char* lds, const Gemm g, const Sched& S, const Epi& E) {
    const int tid = mk_tid(), wid = __builtin_amdgcn_readfirstlane(tid >> 6), lane = tid & 63, wr = wid >> 2, wc = wid & 3, fr = lane & 15, fq = lane >> 4;
    const int K = g.K, nt = K / BK;
    unsigned voffA[2], voffB[2];
#pragma unroll
    for (int i = 0; i < 2; ++i) { int R, C; stage_rc(tid * 16 + i * 8192, R, C); const int Rb = Epi::PERM ? ((R & ~31) + perm32(R & 31)) : R;
        voffA[i] = (unsigned)(R * K + C) * 2u; voffB[i] = (unsigned)(Rb * K + C) * 2u; }
    const size_t kstep = (size_t)(BK * 2);
    const size_t hstep = (size_t)HALF * K * 2;
    const size_t tstep = 2 * hstep;
    const unsigned ldsw = (unsigned)wid * 1024u;
    const int aoff = lds_byte(wr * 64 + fr, fq * 8), boff = lds_byte(wc * 32 + fr, fq * 8);
#define PG8_SA(b, h) (((b) * 2 + (h)) * HTB)
#define PG8_SB(b, h) ((4 + (b) * 2 + (h)) * HTB)
#define PG8_STAGE(bufoff, gbase, voff) do { _Pragma("unroll") for (int _i = 0; _i < 2; ++_i) \
        __builtin_amdgcn_global_load_lds((const unsigned*)((const char*)(gbase) + (voff)[_i]), (PG8_LAS unsigned*)(lds + (bufoff) + ldsw + _i * 8192), 16, 0, 0); } while (0)
#define PG8_LDA(dst, b, h) do { _Pragma("unroll") for (int m = 0; m < 4; ++m) _Pragma("unroll") for (int k = 0; k < 2; ++k) dst[m][k] = *(const PG8_LAS bf16x8*)(lds + PG8_SA(b, h) + aoff + m * 2048 + k * 1024); } while (0)
#define PG8_LDB(dst, b, h) do { _Pragma("unroll") for (int n = 0; n < 2; ++n) _Pragma("unroll") for (int k = 0; k < 2; ++k) dst[n][k] = *(const PG8_LAS bf16x8*)(lds + PG8_SB(b, h) + boff + n * 2048 + k * 1024); } while (0)
#define PG8_MMA(ai, bj, At, Bt) do { __builtin_amdgcn_s_setprio(1); _Pragma("unroll") for (int m = 0; m < 4; ++m) _Pragma("unroll") for (int n = 0; n < 2; ++n) _Pragma("unroll") for (int k = 0; k < 2; ++k) \
        acc[ai][bj][m][n] = __builtin_amdgcn_mfma_f32_16x16x32_bf16(Bt[n][k], At[m][k], acc[ai][bj][m][n], 0, 0, 0); __builtin_amdgcn_s_setprio(0); } while (0)
#define PG8_WAIT_V(n) asm volatile("s_waitcnt vmcnt(" #n ")" ::: "memory")
#define PG8_WAIT_L(n) asm volatile("s_waitcnt lgkmcnt(" #n ")" ::: "memory")
#define PG8_BAR __builtin_amdgcn_s_barrier()
#define PG8_SCHED __builtin_amdgcn_sched_barrier(0)
    Unit cur, nxt; int ui = 0;
    if (!S.next(0, cur)) return;
    f32x4 acc[2][2][4][2];
#pragma unroll
    for (int a = 0; a < 2; ++a)
#pragma unroll
        for (int b = 0; b < 2; ++b)
#pragma unroll
            for (int m = 0; m < 4; ++m)
#pragma unroll
                for (int n = 0; n < 2; ++n) acc[a][b][m][n] = (f32x4){0.f, 0.f, 0.f, 0.f};
    bf16x8 At[4][2], B0[2][2], B1[2][2];
    const char* cA = (const char*)g.A + (size_t)cur.pm * tstep; const char* cB = (const char*)g.Bt + (size_t)cur.pn * tstep;
    S.a_ready(cur);
    if constexpr (SP2) {
        PG8_STAGE(PG8_SB(0, 0), cB, voffB); PG8_STAGE(PG8_SB(0, 1), cB + hstep, voffB); PG8_STAGE(PG8_SA(0, 0), cA, voffA); PG8_STAGE(PG8_SA(0, 1), cA + hstep, voffA);
        if (wr == 1) PG8_BAR;
        PG8_WAIT_V(2); PG8_BAR;
        PG8_STAGE(PG8_SB(1, 0), cB + kstep, voffB); PG8_STAGE(PG8_SA(1, 0), cA + kstep, voffA); PG8_STAGE(PG8_SB(1, 1), cB + hstep + kstep, voffB);
        PG8_WAIT_V(6); PG8_BAR;
    } else {
        PG8_STAGE(PG8_SB(0, 0), cB, voffB); PG8_STAGE(PG8_SA(0, 0), cA, voffA); PG8_STAGE(PG8_SB(0, 1), cB + hstep, voffB); PG8_STAGE(PG8_SA(0, 1), cA + hstep, voffA);
        if (wr == 1) PG8_BAR;
        PG8_WAIT_V(4); PG8_BAR;
        PG8_STAGE(PG8_SB(1, 0), cB + kstep, voffB); PG8_STAGE(PG8_SA(1, 0), cA + kstep, voffA); PG8_STAGE(PG8_SB(1, 1), cB + hstep + kstep, voffB);
        PG8_WAIT_V(6); PG8_BAR;
    }
    for (;;) {
        const bool has_next = S.next(ui + 1, nxt);
        const char* nA = has_next ? (const char*)g.A + (size_t)nxt.pm * tstep : cA; const char* nB = has_next ? (const char*)g.Bt + (size_t)nxt.pn * tstep : cB;
        for (int t = 0; t < nt; t += 2) {
            const bool last = (t == nt - 2);
            const char* a1 = cA + (size_t)(t + 1) * kstep;
            const char* a2 = last ? nA : cA + (size_t)(t + 2) * kstep; const char* b2 = last ? nB : cB + (size_t)(t + 2) * kstep;
            const char* a3 = a2 + kstep; const char* b3 = b2 + kstep;
            if (last && has_next) S.a_ready(nxt);
            if constexpr (SP2) {
            PG8_LDB(B0, 0, 0); PG8_LDB(B1, 0, 1); PG8_SCHED; PG8_LDA(At, 0, 0); PG8_STAGE(PG8_SA(1, 1), a1 + hstep, voffA);
            PG8_WAIT_V(8); PG8_WAIT_L(0); PG8_BAR; PG8_MMA(0, 0, At, B0); PG8_MMA(0, 1, At, B1); PG8_BAR; PG8_SCHED;
            PG8_LDA(At, 0, 1); PG8_STAGE(PG8_SB(0, 0), b2, voffB); PG8_STAGE(PG8_SB(0, 1), b2 + hstep, voffB); PG8_STAGE(PG8_SA(0, 0), a2, voffA);
            PG8_WAIT_V(8); PG8_WAIT_L(0); PG8_BAR; PG8_MMA(1, 0, At, B0); PG8_MMA(1, 1, At, B1); PG8_BAR; PG8_SCHED;
            PG8_LDB(B0, 1, 0); PG8_LDB(B1, 1, 1); PG8_SCHED; PG8_LDA(At, 1, 0); PG8_STAGE(PG8_SA(0, 1), a2 + hstep, voffA);
            PG8_WAIT_V(8); PG8_WAIT_L(0); PG8_BAR; PG8_MMA(0, 0, At, B0); PG8_MMA(0, 1, At, B1); PG8_BAR; PG8_SCHED;
            PG8_LDA(At, 1, 1); PG8_STAGE(PG8_SB(1, 0), b3, voffB); PG8_STAGE(PG8_SB(1, 1), b3 + hstep, voffB); PG8_STAGE(PG8_SA(1, 0), a3, voffA);
            PG8_WAIT_V(8); PG8_WAIT_L(0); PG8_BAR; PG8_MMA(1, 0, At, B0); PG8_MMA(1, 1, At, B1); PG8_BAR; PG8_SCHED;
            } else {
            PG8_LDB(B0, 0, 0); PG8_SCHED; PG8_LDA(At, 0, 0); PG8_STAGE(PG8_SA(1, 1), a1 + hstep, voffA);
            PG8_WAIT_L(8); PG8_BAR; PG8_WAIT_L(0); PG8_MMA(0, 0, At, B0); PG8_BAR; PG8_SCHED;
            PG8_LDB(B1, 0, 1); PG8_STAGE(PG8_SB(0, 0), b2, voffB);
            PG8_BAR; PG8_WAIT_L(0); PG8_MMA(0, 1, At, B1); PG8_BAR;
            PG8_LDA(At, 0, 1); PG8_STAGE(PG8_SA(0, 0), a2, voffA);
            PG8_BAR; PG8_WAIT_L(0); PG8_MMA(1, 0, At, B0); PG8_BAR; PG8_SCHED;
            PG8_STAGE(PG8_SB(0, 1), b2 + hstep, voffB);
            PG8_WAIT_V(6); PG8_BAR; PG8_MMA(1, 1, At, B1); PG8_BAR;
            PG8_LDB(B0, 1, 0); PG8_SCHED; PG8_LDA(At, 1, 0); PG8_STAGE(PG8_SA(0, 1), a2 + hstep, voffA);
            PG8_WAIT_L(8); PG8_BAR; PG8_WAIT_L(0); PG8_MMA(0, 0, At, B0); PG8_BAR; PG8_SCHED;
            PG8_LDB(B1, 1, 1); PG8_STAGE(PG8_SB(1, 0), b3, voffB);
            PG8_BAR; PG8_WAIT_L(0); PG8_MMA(0, 1, At, B1); PG8_BAR;
            PG8_LDA(At, 1, 1); PG8_STAGE(PG8_SA(1, 0), a3, voffA);
            PG8_BAR; PG8_WAIT_L(0); PG8_MMA(1, 0, At, B0); PG8_BAR; PG8_SCHED;
            PG8_STAGE(PG8_SB(1, 1), b3 + hstep, voffB);
            PG8_WAIT_V(6); PG8_BAR; PG8_MMA(1, 1, At, B1); PG8_BAR;
            }
        }
        if constexpr (ALIGN_EPI) { if (wr == 0) PG8_BAR; }
        if constexpr (!Epi::AFTER_DRAIN) { E(acc, cur, wr, wc, fr, fq); S.done(cur); }
        if (!has_next) break;
#pragma unroll
        for (int a = 0; a < 2; ++a)
#pragma unroll
            for (int b = 0; b < 2; ++b)
#pragma unroll
                for (int m = 0; m < 4; ++m)
#pragma unroll
                    for (int n = 0; n < 2; ++n) acc[a][b][m][n] = (f32x4){0.f, 0.f, 0.f, 0.f};
        cur = nxt; cA = nA; cB = nB; ++ui;
        if constexpr (ALIGN_EPI) { if (wr == 1) PG8_BAR; }
    }
    PG8_WAIT_V(0);
    if constexpr (!ALIGN_EPI) { if (wr == 0) PG8_BAR; }
    PG8_BAR;
    if constexpr (Epi::AFTER_DRAIN) { E.fused(acc, cur, wr, wc, fr, fq, lds, wid, lane); S.done(cur); }
#undef PG8_SA
#undef PG8_SB
#undef PG8_STAGE
#undef PG8_LDA
#undef PG8_LDB
#undef PG8_MMA
#undef PG8_WAIT_V
#undef PG8_WAIT_L
#undef PG8_BAR
#undef PG8_SCHED
}
}
namespace attn_body {
using bf16=__hip_bfloat16;
using bf16x8=__attribute__((ext_vector_type(8)))short;
using s16x4=__attribute__((ext_vector_type(4)))short;
using f32x16=__attribute__((ext_vector_type(16)))float;
using u32x4=__attribute__((ext_vector_type(4)))unsigned;
__device__ __forceinline__ int crow(int r,int hi){return (r&3)+8*(r>>2)+4*hi;}
#define SBAR() __builtin_amdgcn_sched_barrier(0)
__device__ __forceinline__ void glds16(const void*gsrc,unsigned lds_dst){unsigned keep;
  asm volatile("s_mov_b32 %0, m0\n\ts_mov_b32 m0, %2\n\ts_nop 0\n\tglobal_load_lds_dwordx4 %1, off\n\ts_mov_b32 m0, %0":"=&s"(keep):"v"(gsrc),"s"(lds_dst):"memory");}
typedef float f32x2_t __attribute__((ext_vector_type(2))); typedef __bf16 bf16x2_t __attribute__((ext_vector_type(2)));
__device__ __forceinline__ unsigned cvtpk_s(float lo,float hi){f32x2_t v={lo,hi};bf16x2_t b=__builtin_convertvector(v,bf16x2_t);return __builtin_bit_cast(unsigned,b);}
#define WAIT_BAR(N) asm volatile("s_waitcnt vmcnt(" #N ") lgkmcnt(0)\n\ts_barrier":::"memory")
__device__ __forceinline__ void qkt(f32x16&p0,f32x16&p1,const char*Kslot,const bf16x8*qr,const f32x16&negm,int r32,int hi){
  const char*kb=Kslot+hi*1024+r32*16;
  #pragma unroll
  for(int d0=0;d0<4;++d0){
    const bf16x8 b0=*reinterpret_cast<const bf16x8*>(kb+d0*2048);
    const bf16x8 b1=*reinterpret_cast<const bf16x8*>(kb+d0*2048+512);
    if(d0==0){p0=__builtin_amdgcn_mfma_f32_32x32x16_bf16(b0,qr[0],negm,0,0,0);p1=__builtin_amdgcn_mfma_f32_32x32x16_bf16(b1,qr[0],negm,0,0,0);}
    else{p0=__builtin_amdgcn_mfma_f32_32x32x16_bf16(b0,qr[d0],p0,0,0,0);p1=__builtin_amdgcn_mfma_f32_32x32x16_bf16(b1,qr[d0],p1,0,0,0);}}
}
__device__ __forceinline__ void pv(f32x16*o,int vb,bf16x8 pa0,bf16x8 pa1,bf16x8 pa2,bf16x8 pa3){
  #pragma unroll
  for(int d0=0;d0<2;++d0){s16x4 lo[4],hi[4];
    #pragma unroll
    for(int ks=0;ks<4;++ks){
      asm volatile("ds_read_b64_tr_b16 %0,%1 offset:%c2":"=&v"(lo[ks]):"v"(vb),"i"(d0*4096+ks*1024):"memory");
      asm volatile("ds_read_b64_tr_b16 %0,%1 offset:%c2":"=&v"(hi[ks]):"v"(vb),"i"(d0*4096+ks*1024+512):"memory");}
    asm volatile("s_waitcnt lgkmcnt(0)":::"memory");SBAR();
    #define PK(k) (bf16x8){lo[k][0],lo[k][1],lo[k][2],lo[k][3],hi[k][0],hi[k][1],hi[k][2],hi[k][3]}
    o[d0]=__builtin_amdgcn_mfma_f32_32x32x16_bf16(pa0,PK(0),o[d0],0,0,0);
    o[d0]=__builtin_amdgcn_mfma_f32_32x32x16_bf16(pa1,PK(1),o[d0],0,0,0);
    o[d0]=__builtin_amdgcn_mfma_f32_32x32x16_bf16(pa2,PK(2),o[d0],0,0,0);
    o[d0]=__builtin_amdgcn_mfma_f32_32x32x16_bf16(pa3,PK(3),o[d0],0,0,0);
    #undef PK
  }
}
#undef SBAR
#undef WAIT_BAR
}

namespace mk {
using pg8::bf16_t; using pg8::f32x4; using pg8::Unit; using pg8::cvt_pk_bf16;
#define LAS __attribute__((address_space(3)))
typedef unsigned u32x2 __attribute__((ext_vector_type(2)));
typedef unsigned u32x4 __attribute__((ext_vector_type(4)));
typedef float f32x2 __attribute__((ext_vector_type(2)));
typedef short bf16x8 __attribute__((ext_vector_type(8)));
typedef float f32x16 __attribute__((ext_vector_type(16)));

constexpr int DM = 1024, NB = 8, SL = 4096, CL = 256, ML = NB * SL, MC = NB * CL, MT = ML + MC;
constexpr int INW = 1792, DFF = 2816, UPW = 5632, MIXK = 1280, KVP = 128, QP = 512, KVB = SL + CL;
constexpr int HALF_A = 16384;
constexpr float EPS = 1e-6f;
constexpr float QSCALE = 0.125f * 1.4426950408889634f;

constexpr size_t MiB = 1u << 20;
constexpr size_t WS_CTL = 0;
constexpr size_t WS_MODP = 1 * MiB;
constexpr size_t WS_MOD = 5 * MiB;
constexpr size_t WS_T = 6 * MiB;
constexpr size_t WS_TW = 7 * MiB;
constexpr size_t WS_W = 8 * MiB;
constexpr size_t W_LAYER = 24 * MiB;
constexpr size_t WS_ADFT = 56 * MiB;
constexpr size_t WS_ADFTC = 88 * MiB;
constexpr size_t WS_KF = 89 * MiB;
constexpr size_t WS_KFC = 121 * MiB;
constexpr size_t WS_CX = 122 * MiB;
constexpr size_t WS_XN = 130 * MiB;
constexpr size_t WS_TMP = 198 * MiB;
constexpr size_t WS_Q = WS_TMP;
constexpr size_t WS_K = WS_TMP + 34 * MiB;
constexpr size_t WS_V = WS_TMP + 43 * MiB;
constexpr size_t WS_FT = WS_TMP + 52 * MiB;
constexpr size_t WS_FTC = WS_TMP + 68 * MiB;
constexpr size_t WS_PT = WS_TMP + 69 * MiB;
constexpr size_t WS_PTC = WS_TMP + 117 * MiB;
constexpr size_t WS_MIX = WS_TMP + 120 * MiB;
constexpr size_t WS_HRAW = WS_TMP + 206 * MiB;
constexpr size_t WS_U = WS_TMP;
constexpr size_t WS_G = WS_TMP + 198 * MiB;
constexpr size_t WS_END = WS_TMP + 297 * MiB;

struct Params { const float* in[29]; float* out; unsigned char* ws; int ph_lo, ph_hi; };
enum { I_X = 0, I_C, I_CTX, I_CCTX, I_WMOD, I_BMOD, I_GPREMIX, I_GPOSTMIX, I_GPREFFN, I_GPOSTFFN, I_WIN, I_GQ, I_GK, I_WF, I_WHC, I_BHC,
       I_HW1, I_HB1, I_HFR1, I_HW2, I_HB2, I_HFR2, I_HW3, I_HBIAS, I_WOUT, I_WUP, I_WFC, I_BFC, I_WDOWN };

__device__ __forceinline__ unsigned f2bf(float f) { unsigned u = __builtin_bit_cast(unsigned, f); return (u + 0x7fffu + ((u >> 16) & 1u)) >> 16; }
__device__ __forceinline__ unsigned pk2(float lo, float hi) { return f2bf(lo) | (f2bf(hi) << 16); }
__device__ __forceinline__ float bflo(unsigned w) { return __uint_as_float(w << 16); }
__device__ __forceinline__ float bfhi(unsigned w) { return __uint_as_float(w & 0xffff0000u); }
__device__ __forceinline__ float bf2f(bf16_t h) { return __uint_as_float((unsigned)h << 16); }
__device__ __forceinline__ float wave_sum(float v) {
#pragma unroll
    for (int o = 1; o < 64; o <<= 1) v += __shfl_xor(v, o);
    return v;
}

struct EpiPlain {
    static constexpr bool PERM = true, AFTER_DRAIN = false;
    bf16_t* O; int ldc;
    __device__ __forceinline__ void operator()(const f32x4 (&acc)[2][2][4][2], const Unit& u, int wr, int wc, int fr, int fq) const {
        const int row0 = u.pm * 256 + wr * 64 + fr; const int col0 = u.pn * 256 + wc * 32 + 8 * fq;
#pragma unroll
        for (int ai = 0; ai < 2; ++ai)
#pragma unroll
            for (int m = 0; m < 4; ++m) { bf16_t* rowp = O + (size_t)(row0 + ai * 128 + m * 16) * ldc + col0;
#pragma unroll
                for (int bj = 0; bj < 2; ++bj) { const f32x4 v0 = acc[ai][bj][m][0], v1 = acc[ai][bj][m][1];
                    u32x4 w; w.x = cvt_pk_bf16(v0[0], v0[1]); w.y = cvt_pk_bf16(v0[2], v0[3]); w.z = cvt_pk_bf16(v1[0], v1[1]); w.w = cvt_pk_bf16(v1[2], v1[3]);
                    *(u32x4*)(rowp + bj * 128) = w; } }
    }
};

struct EpiFourier {
    static constexpr bool PERM = true, AFTER_DRAIN = false;
    bf16_t* MIXp; int Lh; int rowbase0; int rowstride;
    __device__ __forceinline__ void operator()(const f32x4 (&acc)[2][2][4][2], const Unit& u, int wr, int wc, int fr, int fq) const {
        asm volatile("" : "+v"(fr), "+v"(fq), "+s"(wr), "+s"(wc));
        const int b = u.pn; const int len = 2 * Lh; const int rb = rowbase0 + b * rowstride;
#pragma unroll
        for (int ai = 0; ai < 2; ++ai)
#pragma unroll
            for (int m = 0; m < 4; ++m) {
                const int r = u.pm * 256 + ai * 128 + wr * 64 + m * 16 + fr;
                const bool isS = r > Lh; const int k = isS ? r - Lh : r;
                const bool edge = (k == 0) || (k == Lh);
#pragma unroll
                for (int bj = 0; bj < 2; ++bj) { const f32x4 v0 = acc[ai][bj][m][0], v1 = acc[ai][bj][m][1];
                    const int ch = bj * 128 + wc * 32 + 8 * fq;
                    u32x4 w; w.x = cvt_pk_bf16(v0[0], v0[1]); w.y = cvt_pk_bf16(v0[2], v0[3]); w.z = cvt_pk_bf16(v1[0], v1[1]); w.w = cvt_pk_bf16(v1[2], v1[3]);
                    const int col = 512 + (isS ? 256 : 0) + ch;
                    *(u32x4*)(MIXp + (size_t)(rb + k) * MIXK + col) = w;
                    if (!edge) { u32x4 wm = w; if (isS) { wm.x ^= 0x80008000u; wm.y ^= 0x80008000u; wm.z ^= 0x80008000u; wm.w ^= 0x80008000u; }
                        *(u32x4*)(MIXp + (size_t)(rb + len - k) * MIXK + col) = wm; }
                    else if (!isS) { *(u32x4*)(MIXp + (size_t)(rb + k) * MIXK + col + 256) = (u32x4){0u, 0u, 0u, 0u}; }
                }
            }
    }
};

struct EpiInProj {
    static constexpr bool PERM = false, AFTER_DRAIN = false;
    bf16_t *Q, *K, *V, *fT, *fTc, *PT, *PTc; const float *gq, *gk, *rope; LAS float* xch;
    __device__ __forceinline__ void operator()(const f32x4 (&acc)[2][2][4][2], const Unit& u, int wr, int wc, int fr, int fq) const {
        asm volatile("" : "+v"(fr), "+v"(fq), "+s"(wr), "+s"(wc));
        const int pn = u.pn, pm = u.pm; const bool isctx = pm >= 128;
        const int b = isctx ? pm - 128 : pm >> 4;
        const int tbase = isctx ? 0 : (pm & 15) * 256;
#ifdef T_NOQK
        if (false) {
#else
        if (pn <= 2) {
#endif
#pragma unroll
            for (int ai = 0; ai < 2; ++ai)
#pragma unroll
                for (int m = 0; m < 4; ++m)
#pragma unroll
                    for (int bj = 0; bj < 2; ++bj) {
                        float s = 0.f;
#pragma unroll
                        for (int n = 0; n < 2; ++n) { const f32x4 x = acc[ai][bj][m][n]; s += (x[0] * x[0] + x[1] * x[1]) + (x[2] * x[2] + x[3] * x[3]); }
                        s += __shfl_xor(s, 16); s += __shfl_xor(s, 32);
                        if (fq == 0) xch[((ai * 128 + wr * 64 + m * 16 + fr) * 2 + bj) * 4 + wc] = s;
                    }
            asm volatile("s_waitcnt lgkmcnt(0)\n\ts_barrier" ::: "memory");
            const float* gg = (pn == 2) ? gk : gq;
            const int dbase = (wc & 1) * 32 + 4 * fq;
            const f32x4 g1 = *(const f32x4*)(gg + dbase), g2 = *(const f32x4*)(gg + dbase + 16);
            const float osc = (pn == 2) ? 1.0f : QSCALE;
#pragma unroll
            for (int ai = 0; ai < 2; ++ai)
#pragma unroll
                for (int m = 0; m < 4; ++m) {
                    const int rl = ai * 128 + wr * 64 + m * 16 + fr; const int t = tbase + rl;
                    const int p = (wc & 1) ? (t & 63) : (t >> 6);
                    f32x4 cs = (f32x4){1.f, 1.f, 1.f, 1.f}, sn = (f32x4){0.f, 0.f, 0.f, 0.f};
                    if (!isctx) { cs = *(const f32x4*)(rope + p * 16 + 4 * fq); sn = *(const f32x4*)(rope + 1024 + p * 16 + 4 * fq); }
                    const size_t qrow = (size_t)pm * 256 + rl;
                    const size_t kvrow = isctx ? (size_t)b * KVB + rl : (size_t)b * KVB + CL + t;
#pragma unroll
                    for (int bj = 0; bj < 2; ++bj) {
                        if (pn == 2 && bj == 1) {
#pragma unroll
                            for (int n = 0; n < 2; ++n) { const f32x4 x = acc[ai][bj][m][n]; u32x2 w; w.x = cvt_pk_bf16(x[0], x[1]); w.y = cvt_pk_bf16(x[2], x[3]);
                                *(u32x2*)(V + kvrow * KVP + wc * 32 + 16 * n + 4 * fq) = w; }
                        } else {
                            const float ssq = xch[(rl * 2 + bj) * 4 + wc] + xch[(rl * 2 + bj) * 4 + (wc ^ 1)];
                            const float rstd = rsqrtf(ssq * (1.0f / 64.0f) + EPS) * osc;
                            const f32x4 y1 = acc[ai][bj][m][0] * rstd * g1, y2 = acc[ai][bj][m][1] * rstd * g2;
                            const f32x4 o1 = y1 * cs - y2 * sn, o2 = y2 * cs + y1 * sn;
                            u32x2 w1, w2; w1.x = cvt_pk_bf16(o1[0], o1[1]); w1.y = cvt_pk_bf16(o1[2], o1[3]); w2.x = cvt_pk_bf16(o2[0], o2[1]); w2.y = cvt_pk_bf16(o2[2], o2[3]);
                            bf16_t* dst = (pn == 2) ? (K + kvrow * KVP + wc * 32 + 4 * fq) : (Q + qrow * QP + pn * 256 + bj * 128 + wc * 32 + 4 * fq);
                            *(u32x2*)dst = w1; *(u32x2*)(dst + 16) = w2;
                        }
                    }
                    asm volatile("" ::: "memory"); __builtin_amdgcn_sched_barrier(0);
                }
        }
#ifndef T_NOTR
        else {
            const int NC = (pn == 3) ? 256 : 768; const int cb = (pn == 3) ? 0 : (pn - 4) * 256;
            bf16_t* base; int tl;
            if (isctx) { base = ((pn == 3) ? fTc : PTc) + (size_t)b * NC * CL; tl = CL; }
            else { base = ((pn == 3) ? fT : PT) + (size_t)b * NC * SL + tbase; tl = SL; }
            const int lane = fq * 16 + fr;
            LAS bf16_t* stg = (LAS bf16_t*)((LAS unsigned char*)xch + 8192) + (wr * 4 + wc) * 1152;
#pragma unroll
            for (int ai = 0; ai < 2; ++ai)
#pragma unroll
                for (int bj = 0; bj < 2; ++bj)
#pragma unroll
                    for (int n = 0; n < 2; ++n) {
#pragma unroll
                        for (int m = 0; m < 4; ++m) { const f32x4 x = acc[ai][bj][m][n];
#pragma unroll
                            for (int j = 0; j < 4; ++j) stg[(4 * fq + j) * 72 + m * 16 + fr] = (bf16_t)f2bf(x[j]); }
                        asm volatile("s_waitcnt lgkmcnt(0)" ::: "memory");
                        bf16_t* dst = base + (size_t)(cb + bj * 128 + wc * 32 + 16 * n) * tl + ai * 128 + wr * 64;
#pragma unroll
                        for (int i = 0; i < 2; ++i) { const int v = lane + 64 * i, col = v >> 3, k = v & 7;
                            const u32x4 w = *(const LAS u32x4*)(stg + col * 72 + k * 8);
                            *(u32x4*)(dst + (size_t)col * tl + 8 * k) = w; }
                        asm volatile("s_waitcnt lgkmcnt(0)" ::: "memory");
                    }
        }
#endif
    }
};

struct OneUnit { int pm, pn;
    __device__ __forceinline__ bool next(int i, Unit& u) const { if (i > 0) return false; u.pm = pm; u.pn = pn; return true; }
    __device__ __forceinline__ void a_ready(const Unit&) const {}
    __device__ __forceinline__ void done(const Unit&) const {}
};

constexpr int AT_K = 0, AT_V = 16384, AT_WS = 32768, AT_OST = 32768 + 2048;
__device__ __forceinline__ void attn_unit(const bf16_t* Qu, const bf16_t* Kh, const bf16_t* Vh, bf16_t* Ou, int NT, char* shm) {
    using namespace attn_body;
    const int tid = mk_tid(), lane = tid & 63, r32 = lane & 31, hi = lane >> 5; const int wid = __builtin_amdgcn_readfirstlane(tid >> 6);
    const unsigned lds0 = (unsigned)(uintptr_t)shm;
    float* wsf = (float*)(shm + AT_WS) + wid * 64;
    const bf16_t* ksrc = Kh + (size_t)lane * KVP + wid * 8;
    const bf16_t* vsrc = Vh + (size_t)(16 * (wid & 3) + (lane >> 2)) * KVP + (wid >> 2) * 32 + (lane & 3) * 8;
    const unsigned kdst = lds0 + AT_K + wid * 1024, vdst = lds0 + AT_V + wid * 1024;
#define DMA_K(t, slot) glds16(ksrc + (size_t)(t) * 64 * KVP, (unsigned)__builtin_amdgcn_readfirstlane(kdst + (slot)))
#define DMA_V(t, slot) glds16(vsrc + (size_t)(t) * 64 * KVP, (unsigned)__builtin_amdgcn_readfirstlane(vdst + (slot)))
    const int vb0 = (int)(lds0 + AT_V) + ((lane >> 4) & 1) * 32 + (lane & 3) * 8 + (4 * hi + ((lane & 15) >> 2)) * 64;
    DMA_K(0, 0); DMA_V(0, 0);
    const bf16_t* Qw = Qu + (size_t)(wid * 32) * QP;
    bf16x8 qr[4];
#pragma unroll
    for (int d0 = 0; d0 < 4; ++d0) qr[d0] = *reinterpret_cast<const bf16x8*>(&Qw[(size_t)r32 * QP + d0 * 16 + hi * 8]);
    float mrun = -INFINITY, l_reg = 0.f; f32x16 o[2]; o[0] = f32x16{}; o[1] = f32x16{};
    f32x16 zero16 = f32x16{};
    for (int t = 0; t < NT; ++t) {
        const int buf = (t & 1) * 8192;
        if (t + 1 < NT) { DMA_K(t + 1, buf ^ 8192); DMA_V(t + 1, buf ^ 8192); asm volatile("s_waitcnt vmcnt(2)\n\ts_barrier" ::: "memory"); }
        else { asm volatile("s_waitcnt vmcnt(0)\n\ts_barrier" ::: "memory"); }
        f32x16 p0, p1;
        qkt(p0, p1, shm + AT_K + buf, qr, zero16, r32, hi);
        float rm = p0[0];
#pragma unroll
        for (int r = 1; r < 16; ++r) rm = fmaxf(rm, p0[r]);
#pragma unroll
        for (int r = 0; r < 16; ++r) rm = fmaxf(rm, p1[r]);
        rm = fmaxf(rm, __shfl_xor(rm, 32));
        const float mnew = fmaxf(mrun, rm);
        const float f = __builtin_amdgcn_exp2f(mrun - mnew);
        mrun = mnew;
        float sacc = 0.f;
#pragma unroll
        for (int r = 0; r < 16; ++r) { p0[r] = __builtin_amdgcn_exp2f(p0[r] - mnew); p1[r] = __builtin_amdgcn_exp2f(p1[r] - mnew); sacc += p0[r] + p1[r]; }
        l_reg = l_reg * f + sacc;
        if (hi == 0) wsf[r32] = f;
        asm volatile("s_waitcnt lgkmcnt(0)" ::: "memory");
#pragma unroll
        for (int r = 0; r < 16; ++r) { const float fr_ = wsf[crow(r, hi)]; o[0][r] *= fr_; o[1][r] *= fr_; }
        u32x4 pw0, pw1, pw2, pw3;
        pw0 = (u32x4){cvtpk_s(p0[0], p0[1]), cvtpk_s(p0[2], p0[3]), cvtpk_s(p0[4], p0[5]), cvtpk_s(p0[6], p0[7])};
        pw1 = (u32x4){cvtpk_s(p0[8], p0[9]), cvtpk_s(p0[10], p0[11]), cvtpk_s(p0[12], p0[13]), cvtpk_s(p0[14], p0[15])};
        pw2 = (u32x4){cvtpk_s(p1[0], p1[1]), cvtpk_s(p1[2], p1[3]), cvtpk_s(p1[4], p1[5]), cvtpk_s(p1[6], p1[7])};
        pw3 = (u32x4){cvtpk_s(p1[8], p1[9]), cvtpk_s(p1[10], p1[11]), cvtpk_s(p1[12], p1[13]), cvtpk_s(p1[14], p1[15])};
        pv(o, vb0 + buf, __builtin_bit_cast(bf16x8, pw0), __builtin_bit_cast(bf16x8, pw1), __builtin_bit_cast(bf16x8, pw2), __builtin_bit_cast(bf16x8, pw3));
        asm volatile("s_waitcnt lgkmcnt(0)\n\ts_barrier" ::: "memory");
    }
    l_reg += __shfl_xor(l_reg, 32);
    if (hi == 0) wsf[32 + r32] = l_reg;
    asm volatile("s_waitcnt lgkmcnt(0)" ::: "memory");
    float rli[16];
#pragma unroll
    for (int r = 0; r < 16; ++r) rli[r] = 1.0f / wsf[32 + crow(r, hi)];
    bf16_t* Ow = Ou + (size_t)(wid * 32) * MIXK;
    { bf16_t* stg = (bf16_t*)(shm + AT_OST) + wid * 2048;
#pragma unroll
      for (int r = 0; r < 16; ++r) { const int orow = crow(r, hi);
#pragma unroll
        for (int d0 = 0; d0 < 2; ++d0) stg[orow * 64 + d0 * 32 + r32] = (bf16_t)f2bf(o[d0][r] * rli[r]); }
      asm volatile("s_waitcnt lgkmcnt(0)" ::: "memory");
#pragma unroll
      for (int i = 0; i < 4; ++i) { const int row = i * 8 + (lane >> 3), ch = lane & 7; const u32x4 v = *(const u32x4*)(stg + row * 64 + ch * 8); *(u32x4*)(Ow + (size_t)row * MIXK + ch * 8) = v; } }
    asm volatile("s_waitcnt vmcnt(0) lgkmcnt(0)\n\ts_barrier" ::: "memory");
#undef DMA_K
#undef DMA_V
}

template <int LOGN, int R, bool INV>
__device__ __forceinline__ void fft_pass(LAS f32x2* d, const LAS f32x2* tw, int s, int tid) {
    constexpr int N = 1 << LOGN, RR = 1 << R;
    const int lgs = LOGN - s - R; const int stride = 1 << lgs;
    for (int g = tid; g < (N >> R); g += 512) {
        const int lo = g & (stride - 1), hi = g >> lgs; const int base = (hi << (lgs + R)) + lo;
        f32x2 v[RR];
#pragma unroll
        for (int e = 0; e < RR; ++e) v[e] = d[base + e * stride];
#pragma unroll
        for (int jj = 0; jj < R; ++jj) {
            const int j = INV ? (R - 1 - jj) : jj;
            const int he = 1 << (R - 1 - j);
#pragma unroll
            for (int e = 0; e < RR; ++e) if ((e & he) == 0) {
                const int mi = (((e & (he - 1)) << lgs) + lo) << (s + j);
                const f32x2 w = tw[mi];
                const f32x2 a = v[e], b = v[e + he];
                if (!INV) { const f32x2 dl = a - b; v[e] = a + b; v[e + he] = (f32x2){dl.x * w.x - dl.y * w.y, dl.x * w.y + dl.y * w.x}; }
                else { const f32x2 bw = (f32x2){b.x * w.x + b.y * w.y, b.y * w.x - b.x * w.y}; v[e] = a + bw; v[e + he] = a - bw; }
            }
        }
#pragma unroll
        for (int e = 0; e < RR; ++e) d[base + e * stride] = v[e];
    }
    __syncthreads();
}
template <int LOGN> __device__ __forceinline__ void fft_fwd(LAS f32x2* d, const LAS f32x2* tw, int tid) {
    if constexpr (LOGN == 13) { fft_pass<13, 4, false>(d, tw, 0, tid); fft_pass<13, 4, false>(d, tw, 4, tid); fft_pass<13, 4, false>(d, tw, 8, tid); fft_pass<13, 1, false>(d, tw, 12, tid); }
    else { fft_pass<9, 4, false>(d, tw, 0, tid); fft_pass<9, 4, false>(d, tw, 4, tid); fft_pass<9, 1, false>(d, tw, 8, tid); }
}
template <int LOGN> __device__ __forceinline__ void fft_inv(LAS f32x2* d, const LAS f32x2* tw, int tid) {
    if constexpr (LOGN == 13) { fft_pass<13, 1, true>(d, tw, 12, tid); fft_pass<13, 4, true>(d, tw, 8, tid); fft_pass<13, 4, true>(d, tw, 4, tid); fft_pass<13, 4, true>(d, tw, 0, tid); }
    else { fft_pass<9, 1, true>(d, tw, 8, tid); fft_pass<9, 4, true>(d, tw, 4, tid); fft_pass<9, 4, true>(d, tw, 0, tid); }
}
template <int LOGN> __device__ __forceinline__ void load_tw(LAS f32x2* tw, const f32x2* g, int tid) {
    for (int i = tid; i < (1 << (LOGN - 1)); i += 512) tw[i] = g[i];
}

template <int LOGN> __device__ __forceinline__ void kf_job(LAS unsigned char* lds, const float* hrawT, const f32x2* twg, f32x2* kf, int ch, int tid) {
    constexpr int N = 1 << LOGN, T = N / 2;
    LAS f32x2* d = (LAS f32x2*)lds; LAS f32x2* tw = (LAS f32x2*)(lds + 65536); LAS float* red = (LAS float*)(lds + 65536 + 32768);
    load_tw<LOGN>(tw, twg, tid);
    float s = 0.f;
    for (int n = tid; n < N; n += 512) {
        float v;
        if (n < T) v = hrawT[(size_t)ch * T + n]; else if (n == T) v = 0.f; else v = hrawT[(size_t)(256 + ch) * T + (N - n)];
        d[n] = (f32x2){v, 0.f}; s += fabsf(v);
    }
    s = wave_sum(s);
    if ((tid & 63) == 0) red[tid >> 6] = s;
    __syncthreads();
    float tot = 0.f;
#pragma unroll
    for (int i = 0; i < 8; ++i) tot += red[i];
    const float inv = 1.0f / tot;
    for (int n = tid; n < N; n += 512) { f32x2 v = d[n]; v.x *= inv; d[n] = v; }
    __syncthreads();
    fft_fwd<LOGN>(d, tw, tid);
    for (int n = tid; n < N; n += 512) kf[(size_t)ch * N + n] = d[n];
    __syncthreads();
}

template <int LOGN> __device__ __forceinline__ void hyena_job(LAS unsigned char* lds, const bf16_t* PTall, const f32x2* twg, const f32x2* kf, const float* wc, const float* bc, const float* hbias,
                                                            bf16_t* MIXp, int rowbase, int bp, int ch, int tid) {
    constexpr int N = 1 << LOGN, T = N / 2, PER = (T + 511) / 512;
    LAS f32x2* d = (LAS f32x2*)lds; LAS f32x2* tw = (LAS f32x2*)(lds + 65536);
    load_tw<LOGN>(tw, twg, tid);
    const float w10 = wc[256 + ch], w11 = wc[768 + 256 + ch], w12 = wc[1536 + 256 + ch], b1 = bc[256 + ch];
    const float w20 = wc[512 + ch], w21 = wc[768 + 512 + ch], w22 = wc[1536 + 512 + ch], b2 = bc[512 + ch];
    const float w00 = wc[ch], w01 = wc[768 + ch], w02 = wc[1536 + ch], b0 = bc[ch];
    const float hb = hbias[ch];
    f32x2 ukeep[PER];
#pragma unroll
    for (int i = 0; i < PER; ++i) {
        const int t = tid + 512 * i;
        f32x2 u = (f32x2){0.f, 0.f};
        if (t < T) {
#pragma unroll
            for (int bb = 0; bb < 2; ++bb) {
                const bf16_t* p1 = PTall + ((size_t)(2 * bp + bb) * 768 + 256 + ch) * T; const bf16_t* p2 = PTall + ((size_t)(2 * bp + bb) * 768 + 512 + ch) * T;
                const float a_m = t > 0 ? bf2f(p1[t - 1]) : 0.f, a_0 = bf2f(p1[t]), a_p = t < T - 1 ? bf2f(p1[t + 1]) : 0.f;
                const float c_m = t > 0 ? bf2f(p2[t - 1]) : 0.f, c_0 = bf2f(p2[t]), c_p = t < T - 1 ? bf2f(p2[t + 1]) : 0.f;
                const float x1 = a_m * w10 + a_0 * w11 + a_p * w12 + b1, vv = c_m * w20 + c_0 * w21 + c_p * w22 + b2;
                if (bb == 0) u.x = x1 * vv; else u.y = x1 * vv;
            }
            d[t] = u; d[t + T] = (f32x2){0.f, 0.f};
        }
        ukeep[i] = u;
    }
    __syncthreads();
    fft_fwd<LOGN>(d, tw, tid);
    for (int n = tid; n < N; n += 512) { const f32x2 a = d[n], k = kf[(size_t)ch * N + n]; d[n] = (f32x2){a.x * k.x - a.y * k.y, a.x * k.y + a.y * k.x}; }
    __syncthreads();
    fft_inv<LOGN>(d, tw, tid);
    const float sc = 1.0f / (float)N;
#pragma unroll
    for (int i = 0; i < PER; ++i) {
        const int t = tid + 512 * i;
        if (t < T) {
            const f32x2 y = d[t] * sc; const f32x2 u = ukeep[i];
#pragma unroll
            for (int bb = 0; bb < 2; ++bb) {
                const bf16_t* p0 = PTall + ((size_t)(2 * bp + bb) * 768 + ch) * T;
                const float a_m = t > 0 ? bf2f(p0[t - 1]) : 0.f, a_0 = bf2f(p0[t]), a_p = t < T - 1 ? bf2f(p0[t + 1]) : 0.f;
                const float x0 = a_m * w00 + a_0 * w01 + a_p * w02 + b0;
                const float yy = bb == 0 ? y.x : y.y, uu = bb == 0 ? u.x : u.y;
                MIXp[(size_t)(rowbase + (2 * bp + bb) * T + t) * MIXK + 1024 + ch] = (bf16_t)f2bf(x0 * (yy + uu * hb));
            }
        }
    }
    __syncthreads();
}

__device__ __forceinline__ void norm_rows(int gw, int NGW, int lane, int nrows, const float* xl_in, const float* xc_in, float* xl_out, float* xc_out,
                                          const bf16_t* Y, const float* gpost, const float* modA, int ga_off,
                                          bf16_t* XN, const float* gpre, const float* modB, int sc_off, int sh_off) {
    for (int row = gw; row < nrows; row += NGW) {
        const bool isctx = row >= ML; const int mb = isctx ? 8 : (row >> 12);
        const float* xin = isctx ? xc_in + (size_t)(row - ML) * DM : xl_in + (size_t)row * DM;
        f32x4 v[4];
#pragma unroll
        for (int j = 0; j < 4; ++j) v[j] = *(const f32x4*)(xin + 4 * lane + 256 * j);
        if (Y) {
            f32x4 y[4]; float s = 0.f;
#pragma unroll
            for (int j = 0; j < 4; ++j) { const u32x2 w = *(const u32x2*)(Y + (size_t)row * DM + 4 * lane + 256 * j); y[j] = (f32x4){bflo(w.x), bfhi(w.x), bflo(w.y), bfhi(w.y)};
                s += (y[j].x * y[j].x + y[j].y * y[j].y) + (y[j].z * y[j].z + y[j].w * y[j].w); }
            const float rstd = rsqrtf(wave_sum(s) * (1.0f / DM) + EPS);
            float* xo = isctx ? xc_out + (size_t)(row - ML) * DM : xl_out + (size_t)row * DM;
#pragma unroll
            for (int j = 0; j < 4; ++j) { const f32x4 g = *(const f32x4*)(gpost + 4 * lane + 256 * j); const f32x4 ga = *(const f32x4*)(modA + (size_t)mb * 6144 + ga_off + 4 * lane + 256 * j);
                v[j] = v[j] + ga * (y[j] * rstd * g); *(f32x4*)(xo + 4 * lane + 256 * j) = v[j]; }
        }
        if (XN) {
            float s = 0.f;
#pragma unroll
            for (int j = 0; j < 4; ++j) s += (v[j].x * v[j].x + v[j].y * v[j].y) + (v[j].z * v[j].z + v[j].w * v[j].w);
            const float rstd = rsqrtf(wave_sum(s) * (1.0f / DM) + EPS);
#pragma unroll
            for (int j = 0; j < 4; ++j) { const f32x4 g = *(const f32x4*)(gpre + 4 * lane + 256 * j); const f32x4 sc = *(const f32x4*)(modB + (size_t)mb * 6144 + sc_off + 4 * lane + 256 * j);
                const f32x4 sh = *(const f32x4*)(modB + (size_t)mb * 6144 + sh_off + 4 * lane + 256 * j);
                const f32x4 o = (v[j] * rstd * g) * (1.0f + sc) + sh; u32x2 w; w.x = pk2(o.x, o.y); w.y = pk2(o.z, o.w);
                *(u32x2*)(XN + (size_t)row * DM + 4 * lane + 256 * j) = w; }
        }
    }
}

__device__ __forceinline__ void glu_pass(int blk, int nblk, int tid, int r0, int nrows, const bf16_t* U, bf16_t* G, const float* wc, const float* bc) {
    const int nitems = nrows / 8;
    for (int it = blk; it < nitems; it += nblk) {
        for (int p = tid; p < 8 * 352; p += 512) {
            const int rl = it * 8 + p / 352, vc = p % 352, j0 = vc * 8; const int r = r0 + rl;
            int t, len; if (r >= ML) { t = (r - ML) & (CL - 1); len = CL; } else { t = r & (SL - 1); len = SL; }
            const bool hm = t > 0, hp = t < len - 1;
            const bf16_t* ur = U + (size_t)rl * UPW + j0;
            const u32x4 z4 = (u32x4){0u, 0u, 0u, 0u};
            const u32x4 g0 = *(const u32x4*)ur, gm = hm ? *(const u32x4*)(ur - UPW) : z4, gp = hp ? *(const u32x4*)(ur + UPW) : z4;
            const u32x4 v0 = *(const u32x4*)(ur + DFF), vm = hm ? *(const u32x4*)(ur + DFF - UPW) : z4, vp = hp ? *(const u32x4*)(ur + DFF + UPW) : z4;
            unsigned outw[4];
#pragma unroll
            for (int q = 0; q < 4; ++q) {
                float res[2];
#pragma unroll
                for (int h = 0; h < 2; ++h) {
                    const int j = j0 + 2 * q + h;
                    const float a_m = h ? bfhi(gm[q]) : bflo(gm[q]), a_0 = h ? bfhi(g0[q]) : bflo(g0[q]), a_p = h ? bfhi(gp[q]) : bflo(gp[q]);
                    const float c_m = h ? bfhi(vm[q]) : bflo(vm[q]), c_0 = h ? bfhi(v0[q]) : bflo(v0[q]), c_p = h ? bfhi(vp[q]) : bflo(vp[q]);
                    const float cg = a_m * wc[j] + a_0 * wc[UPW + j] + a_p * wc[2 * UPW + j] + bc[j];
                    const float cv = c_m * wc[DFF + j] + c_0 * wc[UPW + DFF + j] + c_p * wc[2 * UPW + DFF + j] + bc[DFF + j];
                    const float sg = cg / (1.0f + __expf(-cg));
                    res[h] = sg * cv;
                }
                outw[q] = pk2(res[0], res[1]);
            }
            *(u32x4*)(G + (size_t)rl * DFF + j0) = (u32x4){outw[0], outw[1], outw[2], outw[3]};
        }
    }
}

__device__ __forceinline__ void transpose_item(const float* W, int ldw, bf16_t* WT, int ldt, int nblk, int item, LAS float* scr, int lane) {
    const int kb = item / nblk, nb = item % nblk, k0 = 64 * kb, n0 = 32 * nb;
#pragma unroll 8
    for (int i = 0; i < 32; ++i) { const int kk = 2 * i + (lane >> 5); scr[kk * 33 + (lane & 31)] = W[(size_t)(k0 + kk) * ldw + n0 + (lane & 31)]; }
    asm volatile("s_waitcnt lgkmcnt(0)" ::: "memory");
    const int c = lane & 7;
#pragma unroll
    for (int j = 0; j < 4; ++j) { const int n = (lane >> 3) + 8 * j; const LAS float* s = scr + (8 * c) * 33 + n;
        u32x4 o; o.x = pk2(s[0 * 33], s[1 * 33]); o.y = pk2(s[2 * 33], s[3 * 33]); o.z = pk2(s[4 * 33], s[5 * 33]); o.w = pk2(s[6 * 33], s[7 * 33]);
        *(u32x4*)(WT + (size_t)(n0 + n) * ldt + k0 + 8 * c) = o; }
    asm volatile("s_waitcnt lgkmcnt(0)" ::: "memory");
}
}

using namespace mk;
typedef const __attribute__((address_space(4))) Params* KP;
__device__ __forceinline__ KP kp_get() { KP p = (KP)__builtin_amdgcn_kernarg_segment_ptr(); asm volatile("" : "+s"(p)); return p; }
#ifndef MK_EN
#define MK_EN 0xffff
#endif
#define EN(k) if constexpr ((MK_EN >> (k)) & 1)
constexpr int LDS_BYTES = 159744;
constexpr int XCH_OFF = 131072;
constexpr int MISC_OFF = 131072 + 8192 + 18432;

__device__ __forceinline__ bf16_t* wlayer(unsigned char* ws, int l, size_t off) { return (bf16_t*)(ws + WS_W + (size_t)l * W_LAYER + off); }
constexpr size_t OFF_WIN = 0, OFF_WOUT = 4 * MiB, OFF_WUP = 7 * MiB, OFF_WDOWN = 18 * MiB;

__device__ __forceinline__ void setup0(KP pp, LAS unsigned char* lds, int tid, int lane, int wave) {
    unsigned char* ws = pp->ws;
    {
        LAS float* scr = (LAS float*)(lds + wave * 16384);
        const int gw = blockIdx.x * 8 + wave, NGW = gridDim.x * 8;
        constexpr int I_IN = 16 * 56, I_UP = 16 * 176, I_DN = 44 * 32, I_OA = 8 * 32, I_OH = 4 * 32, I_L = I_IN + I_UP + I_DN + I_OA + I_OH;
        for (int it = gw; it < 2 * I_L; it += NGW) {
            const int l = it / I_L; int r = it % I_L;
            if (r < I_IN) { transpose_item(pp->in[I_WIN] + (size_t)l * DM * INW, INW, wlayer(ws, l, OFF_WIN), DM, 56, r, scr, lane); continue; } r -= I_IN;
            if (r < I_UP) { transpose_item(pp->in[I_WUP] + (size_t)l * DM * UPW, UPW, wlayer(ws, l, OFF_WUP), DM, 176, r, scr, lane); continue; } r -= I_UP;
            if (r < I_DN) { transpose_item(pp->in[I_WDOWN] + (size_t)l * DFF * DM, DM, wlayer(ws, l, OFF_WDOWN), DFF, 32, r, scr, lane); continue; } r -= I_DN;
            if (r < I_OA) { transpose_item(pp->in[I_WOUT] + (size_t)l * DM * DM, DM, wlayer(ws, l, OFF_WOUT), MIXK, 32, r, scr, lane); continue; } r -= I_OA;
            transpose_item(pp->in[I_WOUT] + (size_t)l * DM * DM + (size_t)768 * DM, DM, wlayer(ws, l, OFF_WOUT) + 1024, MIXK, 32, r, scr, lane);
        }
    }
    __syncthreads();
    constexpr int N_MOD = 192, N_MLP = 512 + 32 + 512, N_DFT = 4096 + 256, N_T = 1024, N_TAB = 1;
    constexpr int NIT = N_MOD + N_MLP + N_DFT + N_T + N_TAB;
    LAS float* fl = (LAS float*)lds;
    for (int it = blockIdx.x; it < NIT; it += gridDim.x) {
        int r = it;
        if (r < N_MOD) {
            const int l = r / 96, cb = (r % 96) / 8, kc = r % 8;
            for (int idx = tid; idx < 9 * 128; idx += 512) { const int rr = idx / 128, k = idx % 128; const float cv = rr < 8 ? pp->in[I_C][rr * DM + kc * 128 + k] : pp->in[I_CCTX][kc * 128 + k];
                fl[idx] = cv / (1.0f + __expf(-cv)); }
            __syncthreads();
            const int j = cb * 512 + tid; float acc[9];
#pragma unroll
            for (int rr = 0; rr < 9; ++rr) acc[rr] = 0.f;
            const float* wm = pp->in[I_WMOD] + (size_t)l * DM * 6144 + (size_t)(kc * 128) * 6144 + j;
            for (int k = 0; k < 128; ++k) { const float w = wm[(size_t)k * 6144];
#pragma unroll
                for (int rr = 0; rr < 9; ++rr) acc[rr] += fl[rr * 128 + k] * w; }
            float* mp = (float*)(ws + WS_MODP) + ((size_t)(l * 8 + kc) * 9) * 6144 + j;
#pragma unroll
            for (int rr = 0; rr < 9; ++rr) mp[(size_t)rr * 6144] = acc[rr];
            __syncthreads();
            continue;
        }
        r -= N_MOD;
        if (r < N_MLP) {
            int l, which, t0;
            if (r < 512) { l = 0; which = 0; t0 = r * 8; } else if (r < 544) { l = 0; which = 1; t0 = (r - 512) * 8; } else { l = 1; which = 0; t0 = (r - 544) * 8; }
            const int T = which ? CL : SL;
            LAS float* Z = fl; LAS float* H1 = fl + 8 * 36; LAS float* H2 = H1 + 512;
            if (tid < 128) { const int p = tid >> 4, i = tid & 15; const int t = t0 + p; const float band = 1e-4f + (float)i * ((15.0f - 1e-4f) / 15.0f);
                const float ang = ((6.2831855f * (float)t) / (float)T) * band; Z[p * 36 + 1 + i] = cosf(ang); Z[p * 36 + 17 + i] = -sinf(ang);
                if (i == 0) Z[p * 36] = (float)t / (float)(T - 1); }
            __syncthreads();
            { const int p = tid >> 6, j = tid & 63; const float* w1 = pp->in[I_HW1] + (size_t)l * 33 * 64; float s = pp->in[I_HB1][l * 64 + j];
              for (int i = 0; i < 33; ++i) s += Z[p * 36 + i] * w1[i * 64 + j];
              H1[p * 64 + j] = sinf(pp->in[I_HFR1][l * 64 + j] * s); }
            __syncthreads();
            { const int p = tid >> 6, j = tid & 63; const float* w2 = pp->in[I_HW2] + (size_t)l * 64 * 64; float s = pp->in[I_HB2][l * 64 + j];
              for (int i = 0; i < 64; ++i) s += H1[p * 64 + i] * w2[i * 64 + j];
              H2[p * 64 + j] = sinf(pp->in[I_HFR2][l * 64 + j] * s); }
            __syncthreads();
            { const int j = tid; const float* w3 = pp->in[I_HW3] + (size_t)l * 64 * 512 + j; float acc[8];
#pragma unroll
              for (int p = 0; p < 8; ++p) acc[p] = 0.f;
              for (int i = 0; i < 64; ++i) { const float w = w3[(size_t)i * 512];
#pragma unroll
                  for (int p = 0; p < 8; ++p) acc[p] += H2[p * 64 + i] * w; }
              const float da = -3.0701134573253944f, db = -15.350567286626972f;
              const float delta = fabsf(da + (float)(j & 255) * ((db - da) / 255.0f));
              float* hr = (float*)(ws + WS_HRAW) + (which ? (size_t)2 * 512 * SL : (size_t)l * 512 * SL) + (size_t)j * T + t0;
#pragma unroll
              for (int p = 0; p < 8; ++p) hr[p] = acc[p] * expf(-Z[p * 36] * delta); }
            __syncthreads();
            continue;
        }
        r -= N_MLP;
        if (r < N_DFT) {
            if (r < 4096) { bf16_t* row = (bf16_t*)(ws + WS_ADFT) + (size_t)r * 4096; const bool isS = r > 2048; const int k = isS ? r - 2048 : r;
                for (int t = tid; t < 4096; t += 512) { const int idx = (k * t) & 4095; const float x = (float)idx * (1.0f / 2048.0f); const float v = (isS ? sinpif(x) : cospif(x)) * (1.0f / 512.0f); row[t] = (bf16_t)f2bf(v); } }
            else { const int rr = r - 4096; bf16_t* row = (bf16_t*)(ws + WS_ADFTC) + (size_t)rr * 256; const bool isS = rr > 128; const int k = isS ? rr - 128 : rr;
                if (tid < 256) { const int idx = (k * tid) & 255; const float x = (float)idx * (1.0f / 128.0f); const float v = (isS ? sinpif(x) : cospif(x)) * (1.0f / 128.0f); row[tid] = (bf16_t)f2bf(v); } }
            continue;
        }
        r -= N_DFT;
        if (r < N_T) {
            const int l = r >> 9, kk = r & 511; const bool isS = kk >= 256; const int gc = kk & 255, g = gc >> 6, c = gc & 63;
            if (tid < 256) { const float* wf = pp->in[I_WF] + (size_t)l * 256 * 256 + (size_t)(g * 64) * 256 + tid; float s = 0.f;
                for (int m = 0; m < 64; ++m) { const float x = (float)((m * c) & 63) * (1.0f / 32.0f); const float tr = isS ? -sinpif(x) : cospif(x); s += tr * wf[(size_t)m * 256]; }
                ((float*)(ws + WS_T))[((size_t)l * 512 + kk) * 256 + tid] = s; }
            continue;
        }
        { f32x2* tw = (f32x2*)(ws + WS_TW);
          for (int i = tid; i < 4096; i += 512) { const float x = (float)i * (1.0f / 4096.0f); tw[i] = (f32x2){cospif(x), -sinpif(x)}; }
          f32x2* tw2 = (f32x2*)(ws + WS_TW + 65536);
          if (tid < 256) { const float x = (float)tid * (1.0f / 256.0f); tw2[tid] = (f32x2){cospif(x), -sinpif(x)}; }
          float* rope = (float*)(ws + WS_TW + 131072);
          for (int i = tid; i < 1024; i += 512) { const int p = i >> 4, q = i & 15; const float inv = powf(10000.0f, -(float)q / 16.0f); const float a = (float)p * inv; rope[i] = cosf(a); rope[1024 + i] = sinf(a); } }
    }
}

__device__ __forceinline__ void setup1(KP pp, LAS unsigned char* lds, int tid) {
    unsigned char* ws = pp->ws;
    { const int gt = blockIdx.x * 512 + tid, NGT = gridDim.x * 512;
      for (int idx = gt; idx < 2 * 9 * 6144; idx += NGT) { const int l = idx / (9 * 6144), rj = idx % (9 * 6144), j = rj % 6144; float s = pp->in[I_BMOD][l * 6144 + j];
#pragma unroll
          for (int kc = 0; kc < 8; ++kc) s += ((const float*)(ws + WS_MODP))[((size_t)(l * 8 + kc) * 9) * 6144 + rj];
          ((float*)(ws + WS_MOD))[idx] = s; } }
    constexpr int N_KF = 768, N_W2 = 2048;
    LAS float* fl = (LAS float*)lds;
    for (int it = blockIdx.x; it < N_KF + N_W2; it += gridDim.x) {
        if (it < N_KF) {
            if (it < 512) { const int l = it >> 8, ch = it & 255;
                kf_job<13>(lds, (const float*)(ws + WS_HRAW) + (size_t)l * 512 * SL, (const f32x2*)(ws + WS_TW), (f32x2*)(ws + WS_KF) + (size_t)l * 256 * 8192, ch, tid); }
            else { const int ch = it - 512;
                kf_job<9>(lds, (const float*)(ws + WS_HRAW) + (size_t)2 * 512 * SL, (const f32x2*)(ws + WS_TW + 65536), (f32x2*)(ws + WS_KFC), ch, tid); }
            continue;
        }
        const int r = it - N_KF; const int l = r >> 10, kk = (r >> 1) & 511, nh = r & 1;
        if (tid < 256) fl[tid] = ((const float*)(ws + WS_T))[((size_t)l * 512 + kk) * 256 + tid];
        __syncthreads();
        { const int n = nh * 512 + tid; const float* wo = pp->in[I_WOUT] + (size_t)l * DM * DM + (size_t)512 * DM + n; float s = 0.f;
          for (int j = 0; j < 256; ++j) s += fl[j] * wo[(size_t)j * DM];
          wlayer(ws, l, OFF_WOUT)[(size_t)n * MIXK + 512 + kk] = (bf16_t)f2bf(s); }
        __syncthreads();
    }
}

__global__ void __launch_bounds__(512, 2) mega_fwd(Params P) {
    extern __shared__ __attribute__((aligned(16))) unsigned char lds_raw[];
    LAS unsigned char* lds = (LAS unsigned char*)lds_raw;
    int ph = 0;
#define PH_BEGIN { KP pp = kp_get(); const int lo = pp->ph_lo, hi = pp->ph_hi; if (ph >= lo && ph < hi) { unsigned char* ws = pp->ws; const int tid = mk_tid(), lane = tid & 63, wave = __builtin_amdgcn_readfirstlane(tid >> 6); const int G = gridDim.x, gw = blockIdx.x * 8 + wave, NGW = G * 8; (void)lane; (void)gw; (void)NGW; PTRS
#define PH_END   if (ph + 1 < hi) cg::this_grid().sync(); } } ++ph;
#define PTRS \
    bf16_t* XN = (bf16_t*)(ws + WS_XN); bf16_t* Qb = (bf16_t*)(ws + WS_Q); bf16_t* Kb = (bf16_t*)(ws + WS_K); bf16_t* Vb = (bf16_t*)(ws + WS_V); \
    bf16_t* fT = (bf16_t*)(ws + WS_FT); bf16_t* fTc = (bf16_t*)(ws + WS_FTC); bf16_t* PT = (bf16_t*)(ws + WS_PT); bf16_t* PTc = (bf16_t*)(ws + WS_PTC); \
    bf16_t* MIXb = (bf16_t*)(ws + WS_MIX); bf16_t* Ub = (bf16_t*)(ws + WS_U); bf16_t* Gb = (bf16_t*)(ws + WS_G); \
    float* CX = (float*)(ws + WS_CX); const float* MOD = (const float*)(ws + WS_MOD); \
    const float* rope = (const float*)(ws + WS_TW + 131072); \
    volatile LAS int* misc = (volatile LAS int*)(lds + MISC_OFF); \
    (void)XN; (void)Qb; (void)Kb; (void)Vb; (void)fT; (void)fTc; (void)PT; (void)PTc; (void)MIXb; (void)Ub; (void)Gb; (void)CX; (void)MOD; (void)rope; (void)misc;

    PH_BEGIN EN(0) setup0(pp, lds, tid, lane, wave); PH_END
    PH_BEGIN EN(1) setup1(pp, lds, tid); PH_END
    PH_BEGIN EN(2) norm_rows(gw, NGW, lane, MT, pp->in[I_X], pp->in[I_CTX], nullptr, nullptr, nullptr, nullptr, nullptr, 0, XN, pp->in[I_GPREMIX], MOD, 1024, 0); PH_END

    for (int l = 0; l < 2; ++l) {
        const bool last = (l == 1);
        const int MR = last ? ML : MT;
        PH_BEGIN {
            pg8::Gemm g{XN, wlayer(ws, l, OFF_WIN), MT, INW, DM}; pg8::StaticOrder S; S.init(MT, INW, G, (int)blockIdx.x);
            EpiInProj E{Qb, Kb, Vb, fT, fTc, PT, PTc, pp->in[I_GQ] + l * 64, pp->in[I_GK] + l * 64, rope, (LAS float*)(lds + XCH_OFF)};
            EN(3) pg8::gemm_phase<EpiInProj, pg8::StaticOrder, true, true>(lds, g, S, E);
        } PH_END
        PH_BEGIN {
            const int nF = last ? 128 : 136, nA = last ? 1024 : 1088, nH = last ? 1024 : 2048;
            for (;;) {
                KP pq = kp_get(); unsigned char* wq = pq->ws; const int tq = mk_tid();
                if (tq == 0) misc[0] = (int)atomicAdd((unsigned*)(wq + WS_CTL) + 64 * (1 + l), 1u);
                __syncthreads();
                int it = misc[0];
                __syncthreads();
                if (it >= nF + nA + nH) break;
                bf16_t* MIXq = (bf16_t*)(wq + WS_MIX);
                if (it < nF) {
                    if (it < 128) { pg8::Gemm g{(const bf16_t*)(wq + WS_ADFT), (const bf16_t*)(wq + WS_FT), 4096, 2048, 4096}; OneUnit S{it >> 3, it & 7}; EpiFourier E{MIXq, 2048, 0, SL};
                        EN(4) pg8::gemm_phase<EpiFourier, OneUnit, false, true>(lds, g, S, E); }
                    else { pg8::Gemm g{(const bf16_t*)(wq + WS_ADFTC), (const bf16_t*)(wq + WS_FTC), 256, 2048, 256}; OneUnit S{0, it - 128}; EpiFourier E{MIXq, 128, ML, CL};
                        EN(4) pg8::gemm_phase<EpiFourier, OneUnit, false, true>(lds, g, S, E); }
                    continue;
                }
                it -= nF;
                if (it < nA) {
                    const bf16_t* Qq = (const bf16_t*)(wq + WS_Q); const bf16_t* Kq = (const bf16_t*)(wq + WS_K); const bf16_t* Vq = (const bf16_t*)(wq + WS_V);
                    int b, h, NT; size_t qrow;
                    if (it < 1024) { b = it >> 7; h = (it >> 4) & 7; qrow = (size_t)b * SL + (it & 15) * 256; NT = KVB / 64; }
                    else { const int r = it - 1024; b = r >> 3; h = r & 7; qrow = (size_t)ML + b * CL; NT = CL / 64; }
                    const size_t kv0 = (size_t)b * KVB;
                    EN(5) attn_unit(Qq + qrow * QP + h * 64, Kq + kv0 * KVP + (h >> 2) * 64, Vq + kv0 * KVP + (h >> 2) * 64, MIXq + qrow * MIXK + h * 64, NT, (char*)lds_raw);
                    continue;
                }
                it -= nA;
                const float* wc = pq->in[I_WHC] + (size_t)l * 3 * 768; const float* bc = pq->in[I_BHC] + (size_t)l * 768; const float* hb = pq->in[I_HBIAS] + (size_t)l * 256;
                EN(6) { if (it < 1024) hyena_job<13>(lds, (const bf16_t*)(wq + WS_PT), (const f32x2*)(wq + WS_TW), (const f32x2*)(wq + WS_KF) + (size_t)l * 256 * 8192, wc, bc, hb, MIXq, 0, it >> 8, it & 255, tq);
                else { const int r = it - 1024; hyena_job<9>(lds, (const bf16_t*)(wq + WS_PTC), (const f32x2*)(wq + WS_TW + 65536), (const f32x2*)(wq + WS_KFC), wc, bc, hb, MIXq, ML, r >> 8, r & 255, tq); } }
            }
        } PH_END
        PH_BEGIN {
            pg8::Gemm g{MIXb, wlayer(ws, l, OFF_WOUT), MR, DM, MIXK}; pg8::StaticOrder S; S.init(MR, DM, G, (int)blockIdx.x);
            EpiPlain E{XN, DM};
            EN(7) pg8::gemm_phase<EpiPlain, pg8::StaticOrder, true, true>(lds, g, S, E);
        } PH_END
        PH_BEGIN EN(2) norm_rows(gw, NGW, lane, MR, l == 0 ? pp->in[I_X] : pp->out, l == 0 ? pp->in[I_CTX] : CX, pp->out, CX, XN, pp->in[I_GPOSTMIX] + l * DM, (MOD + (size_t)l * 9 * 6144), 2048,
                           XN, pp->in[I_GPREFFN] + l * DM, (MOD + (size_t)l * 9 * 6144), 4096, 3072); PH_END
        for (int hf = 0; hf < 2; ++hf) {
            const int r0 = hf ? HALF_A : 0, nr = hf ? (MR - HALF_A) : HALF_A;
            PH_BEGIN {
                pg8::Gemm g{XN + (size_t)r0 * DM, wlayer(ws, l, OFF_WUP), nr, UPW, DM}; pg8::StaticOrder S; S.init(nr, UPW, G, (int)blockIdx.x);
                EpiPlain E{Ub, UPW};
                EN(8) pg8::gemm_phase<EpiPlain, pg8::StaticOrder, true, true>(lds, g, S, E);
            } PH_END
            PH_BEGIN EN(9) glu_pass((int)blockIdx.x, G, tid, r0, nr, Ub, Gb, pp->in[I_WFC] + (size_t)l * 3 * UPW, pp->in[I_BFC] + (size_t)l * UPW); PH_END
            PH_BEGIN {
                pg8::Gemm g{Gb, wlayer(ws, l, OFF_WDOWN), nr, DM, DFF}; pg8::StaticOrder S; S.init(nr, DM, G, (int)blockIdx.x);
                EpiPlain E{XN + (size_t)r0 * DM, DM};
                EN(10) pg8::gemm_phase<EpiPlain, pg8::StaticOrder, true, true>(lds, g, S, E);
            } PH_END
        }
        PH_BEGIN EN(2) norm_rows(gw, NGW, lane, MR, pp->out, CX, pp->out, CX, XN, pp->in[I_GPOSTFFN] + l * DM, (MOD + (size_t)l * 9 * 6144), 5120,
                           last ? nullptr : XN, pp->in[I_GPREMIX] + (last ? 0 : (l + 1) * DM), MOD + (size_t)(last ? 0 : (l + 1)) * 9 * 6144, 1024, 0); PH_END
    }
}

constexpr int N_PHASES = 3 + 2 * 11;
#ifndef MK_MULTI
#define MK_MULTI 0
#endif
extern "C" void kernel_launch(void* const* d_in, const int* in_sizes, int n_in, void* d_out, int out_size, void* d_ws, size_t ws_size, hipStream_t stream) {
    static int grid = 0;
    if (grid == 0) {
        if (n_in != 29 || ws_size < WS_END) { fprintf(stderr, "kernel_launch: bad args n_in %d ws %zu (need %zu)\n", n_in, ws_size, (size_t)WS_END); grid = -1; return; }
        int dev = 0, cus = 0, per_cu = 0;
        hipGetDevice(&dev); hipDeviceGetAttribute(&cus, hipDeviceAttributeMultiprocessorCount, dev);
        if (hipFuncSetAttribute((const void*)mega_fwd, hipFuncAttributeMaxDynamicSharedMemorySize, LDS_BYTES) != hipSuccess) { fprintf(stderr, "hipFuncSetAttribute failed\n"); grid = -1; return; }
        if (hipOccupancyMaxActiveBlocksPerMultiprocessor(&per_cu, (const void*)mega_fwd, 512, LDS_BYTES) != hipSuccess || per_cu < 1) { fprintf(stderr, "occupancy query: %d\n", per_cu); per_cu = 1; }
        (void)hipGetLastError();
        grid = cus * 1;
    }
    if (grid < 0) return;
    hipMemsetAsync((char*)d_ws + WS_CTL, 0, 1 * MiB, stream);
    Params p{};
    for (int i = 0; i < 29; ++i) p.in[i] = (const float*)d_in[i];
    p.out = (float*)d_out; p.ws = (unsigned char*)d_ws;
#if MK_MULTI
    for (int k = 0; k < N_PHASES; ++k) { p.ph_lo = k; p.ph_hi = k + 1; hipLaunchKernelGGL(mega_fwd, dim3(grid), dim3(512), LDS_BYTES, stream, p); }
#else
    p.ph_lo = 0; p.ph_hi = N_PHASES;
    void* args[] = {&p};
    hipError_t e = hipLaunchCooperativeKernel((const void*)mega_fwd, dim3(grid), dim3(512), args, LDS_BYTES, stream);
    if (e != hipSuccess) fprintf(stderr, "cooperative launch failed: %s (grid %d)\n", hipGetErrorString(e), grid);
#endif
}
```

```cpp
#define MK_REP 0
#include <hip/hip_runtime.h>
#include <hip/hip_cooperative_groups.h>
#include <hip/hip_bf16.h>
#include <cstdio>
#include <cstdint>
#include <cmath>
namespace cg = cooperative_groups;
__device__ __forceinline__ int mk_tid() { int t = threadIdx.x; asm volatile("" : "+v"(t)); return t; }
namespace pg8 {
#define PG8_LAS __attribute__((address_space(3)))
typedef unsigned short bf16_t;
typedef short bf16x8 __attribute__((ext_vector_type(8)));
typedef float f32x4 __attribute__((ext_vector_type(4)));
typedef unsigned u32x4 __attribute__((ext_vector_type(4)));
constexpr int BM = 256, BK = 64, HALF = 128, HTB = HALF * BK * 2  , STAGE_BYTES = 8 * HTB, NXCD = 8, WGM = 8;

__host__ __device__ __forceinline__ int lds_byte(int r, int c) { const int st = (r >> 4) * 2 + (c >> 5), rr = r & 15, cc = c & 31, ob = rr * 64 + cc * 2; return st * 1024 + (ob ^ (((ob >> 9) & 1) << 5)); }
__host__ __device__ __forceinline__ void stage_rc(int b, int& R, int& C) { const int st = b / 1024, sb = b % 1024, swz = sb ^ (((sb >> 9) & 1) << 5); R = (st >> 1) * 16 + swz / 64; C = (st & 1) * 32 + (swz % 64) / 2; }
__host__ __device__ __forceinline__ int perm32(int rho) { const int n = rho >> 4, i = rho & 15; return 8 * (i >> 2) + 4 * n + (i & 3); }

struct Unit { int pm, pn; };
struct Gemm { const bf16_t* A; const bf16_t* Bt; int M, N, K; };

struct StaticOrder {
    int nM, nN, nwg, G, c;
    __host__ __device__ void init(int M, int N, int G_, int c_) { nM = M / BM; nN = N / BM; nwg = nM * nN; G = G_; c = c_; }
    __host__ __device__ bool next(int i, Unit& u) const {
        const long L = (long)i * G + c; if (L >= nwg) return false;
        int wgid = (int)L; { const int q = nwg / NXCD, r = nwg % NXCD, xcd = wgid % NXCD, off = wgid / NXCD; wgid = (xcd < r ? xcd * (q + 1) : r * (q + 1) + (xcd - r) * q) + off; }
        const int nig = WGM * nN, gid = wgid / nig, fm = gid * WGM, gsz = (nM - fm) < WGM ? (nM - fm) : WGM;
        u.pm = fm + ((wgid % nig) % gsz); u.pn = (wgid % nig) / gsz; return true;
    }
    __device__ __forceinline__ void a_ready(const Unit&) const {}
    __device__ __forceinline__ void done(const Unit&) const {}
};
__device__ __forceinline__ unsigned cvt_pk_bf16(float lo, float hi) { unsigned r; asm volatile("v_cvt_pk_bf16_f32 %0, %1, %2" : "=v"(r) : "v"(lo), "v"(hi)); return r; }
typedef float f32x2 __attribute__((ext_vector_type(2)));
template <class Epi, class Sched, bool ALIGN_EPI = false, bool SP2 = false>
__device__ __forceinline__ void gemm_phase(PG8_LAS unsigned char* lds, const Gemm g, const Sched& S, const Epi& E) {
    const int tid = mk_tid(), wid = __builtin_amdgcn_readfirstlane(tid >> 6), lane = tid & 63, wr = wid >> 2, wc = wid & 3, fr = lane & 15, fq = lane >> 4;
    const int K = g.K, nt = K / BK;
    unsigned voffA[2], voffB[2];
#pragma unroll
    for (int i = 0; i < 2; ++i) { int R, C; stage_rc(tid * 16 + i * 8192, R, C); const int Rb = Epi::PERM ? ((R & ~31) + perm32(R & 31)) : R;
        voffA[i] = (unsigned)(R * K + C) * 2u; voffB[i] = (unsigned)(Rb * K + C) * 2u; }
    const size_t kstep = (size_t)(BK * 2);
    const size_t hstep = (size_t)HALF * K * 2;
    const size_t tstep = 2 * hstep;
    const unsigned ldsw = (unsigned)wid * 1024u;
    const int aoff = lds_byte(wr * 64 + fr, fq * 8), boff = lds_byte(wc * 32 + fr, fq * 8);
#define PG8_SA(b, h) (((b) * 2 + (h)) * HTB)
#define PG8_SB(b, h) ((4 + (b) * 2 + (h)) * HTB)
#define PG8_STAGE(bufoff, gbase, voff) do { _Pragma("unroll") for (int _i = 0; _i < 2; ++_i) \
        __builtin_amdgcn_global_load_lds((const unsigned*)((const char*)(gbase) + (voff)[_i]), (PG8_LAS unsigned*)(lds + (bufoff) + ldsw + _i * 8192), 16, 0, 0); } while (0)
#define PG8_LDA(dst, b, h) do { _Pragma("unroll") for (int m = 0; m < 4; ++m) _Pragma("unroll") for (int k = 0; k < 2; ++k) dst[m][k] = *(const PG8_LAS bf16x8*)(lds + PG8_SA(b, h) + aoff + m * 2048 + k * 1024); } while (0)
#define PG8_LDB(dst, b, h) do { _Pragma("unroll") for (int n = 0; n < 2; ++n) _Pragma("unroll") for (int k = 0; k < 2; ++k) dst[n][k] = *(const PG8_LAS bf16x8*)(lds + PG8_SB(b, h) + boff + n * 2048 + k * 1024); } while (0)
#define PG8_MMA(ai, bj, At, Bt) do { __builtin_amdgcn_s_setprio(1); _Pragma("unroll") for (int m = 0; m < 4; ++m) _Pragma("unroll") for (int n = 0; n < 2; ++n) _Pragma("unroll") for (int k = 0; k < 2; ++k) \
        acc[ai][bj][m][n] = __builtin_amdgcn_mfma_f32_16x16x32_bf16(Bt[n][k], At[m][k], acc[ai][bj][m][n], 0, 0, 0); __builtin_amdgcn_s_setprio(0); } while (0)
#define PG8_WAIT_V(n) asm volatile("s_waitcnt vmcnt(" #n ")" ::: "memory")
#define PG8_WAIT_L(n) asm volatile("s_waitcnt lgkmcnt(" #n ")" ::: "memory")
#define PG8_BAR __builtin_amdgcn_s_barrier()
#define PG8_SCHED __builtin_amdgcn_sched_barrier(0)
    Unit cur, nxt; int ui = 0;
    if (!S.next(0, cur)) return;
    f32x4 acc[2][2][4][2];
#pragma unroll
    for (int a = 0; a < 2; ++a)
#pragma unroll
        for (int b = 0; b < 2; ++b)
#pragma unroll
            for (int m = 0; m < 4; ++m)
#pragma unroll
                for (int n = 0; n < 2; ++n) acc[a][b][m][n] = (f32x4){0.f, 0.f, 0.f, 0.f};
    bf16x8 At[4][2], B0[2][2], B1[2][2];
    const char* cA = (const char*)g.A + (size_t)cur.pm * tstep; const char* cB = (const char*)g.Bt + (size_t)cur.pn * tstep;
    S.a_ready(cur);
    if constexpr (SP2) {
        PG8_STAGE(PG8_SB(0, 0), cB, voffB); PG8_STAGE(PG8_SB(0, 1), cB + hstep, voffB); PG8_STAGE(PG8_SA(0, 0), cA, voffA); PG8_STAGE(PG8_SA(0, 1), cA + hstep, voffA);
        if (wr == 1) PG8_BAR;
        PG8_WAIT_V(2); PG8_BAR;
        PG8_STAGE(PG8_SB(1, 0), cB + kstep, voffB); PG8_STAGE(PG8_SA(1, 0), cA + kstep, voffA); PG8_STAGE(PG8_SB(1, 1), cB + hstep + kstep, voffB);
        PG8_WAIT_V(6); PG8_BAR;
    } else {
        PG8_STAGE(PG8_SB(0, 0), cB, voffB); PG8_STAGE(PG8_SA(0, 0), cA, voffA); PG8_STAGE(PG8_SB(0, 1), cB + hstep, voffB); PG8_STAGE(PG8_SA(0, 1), cA + hstep, voffA);
        if (wr == 1) PG8_BAR;
        PG8_WAIT_V(4); PG8_BAR;
        PG8_STAGE(PG8_SB(1, 0), cB + kstep, voffB); PG8_STAGE(PG8_SA(1, 0), cA + kstep, voffA); PG8_STAGE(PG8_SB(1, 1), cB + hstep + kstep, voffB);
        PG8_WAIT_V(6); PG8_BAR;
    }
    for (;;) {
        const bool has_next = S.next(ui + 1, nxt);
        const char* nA = has_next ? (const char*)g.A + (size_t)nxt.pm * tstep : cA; const char* nB = has_next ? (const char*)g.Bt + (size_t)nxt.pn * tstep : cB;
        for (int t = 0; t < nt; t += 2) {
            const bool last = (t == nt - 2);
            const char* a1 = cA + (size_t)(t + 1) * kstep;
            const char* a2 = last ? nA : cA + (size_t)(t + 2) * kstep; const char* b2 = last ? nB : cB + (size_t)(t + 2) * kstep;
            const char* a3 = a2 + kstep; const char* b3 = b2 + kstep;
            if (last && has_next) S.a_ready(nxt);
            if constexpr (SP2) {
            PG8_LDB(B0, 0, 0); PG8_LDB(B1, 0, 1); PG8_SCHED; PG8_LDA(At, 0, 0); PG8_STAGE(PG8_SA(1, 1), a1 + hstep, voffA);
            PG8_WAIT_V(8); PG8_WAIT_L(0); PG8_BAR; PG8_MMA(0, 0, At, B0); PG8_MMA(0, 1, At, B1); PG8_BAR; PG8_SCHED;
            PG8_LDA(At, 0, 1); PG8_STAGE(PG8_SB(0, 0), b2, voffB); PG8_STAGE(PG8_SB(0, 1), b2 + hstep, voffB); PG8_STAGE(PG8_SA(0, 0), a2, voffA);
            PG8_WAIT_V(8); PG8_WAIT_L(0); PG8_BAR; PG8_MMA(1, 0, At, B0); PG8_MMA(1, 1, At, B1); PG8_BAR; PG8_SCHED;
            PG8_LDB(B0, 1, 0); PG8_LDB(B1, 1, 1); PG8_SCHED; PG8_LDA(At, 1, 0); PG8_STAGE(PG8_SA(0, 1), a2 + hstep, voffA);
            PG8_WAIT_V(8); PG8_WAIT_L(0); PG8_BAR; PG8_MMA(0, 0, At, B0); PG8_MMA(0, 1, At, B1); PG8_BAR; PG8_SCHED;
            PG8_LDA(At, 1, 1); PG8_STAGE(PG8_SB(1, 0), b3, voffB); PG8_STAGE(PG8_SB(1, 1), b3 + hstep, voffB); PG8_STAGE(PG8_SA(1, 0), a3, voffA);
            PG8_WAIT_V(8); PG8_WAIT_L(0); PG8_BAR; PG8_MMA(1, 0, At, B0); PG8_MMA(1, 1, At, B1); PG8_BAR; PG8_SCHED;
            } else {
            PG8_LDB(B0, 0, 0); PG8_SCHED; PG8_LDA(At, 0, 0); PG8_STAGE(PG8_SA(1, 1), a1 + hstep, voffA);
            PG8_WAIT_L(8); PG8_BAR; PG8_WAIT_L(0); PG8_MMA(0, 0, At, B0); PG8_BAR; PG8_SCHED;
            PG8_LDB(B1, 0, 1); PG8_STAGE(PG8_SB(0, 0), b2, voffB);
            PG8_BAR; PG8_WAIT_L(0); PG8_MMA(0, 1, At, B1); PG8_BAR;
            PG8_LDA(At, 0, 1); PG8_STAGE(PG8_SA(0, 0), a2, voffA);
            PG8_BAR; PG8_WAIT_L(0); PG8_MMA(1, 0, At, B0); PG8_BAR; PG8_SCHED;
            PG8_STAGE(PG8_SB(0, 1), b2 + hstep, voffB);
            PG8_WAIT_V(6); PG8_BAR; PG8_MMA(1, 1, At, B1); PG8_BAR;
            PG8_LDB(B0, 1, 0); PG8_SCHED; PG8_LDA(At, 1, 0); PG8_STAGE(PG8_SA(0, 1), a2 + hstep, voffA);
            PG8_WAIT_L(8); PG8_BAR; PG8_WAIT_L(0); PG8_MMA(0, 0, At, B0); PG8_BAR; PG8_SCHED;
            PG8_LDB(B1, 1, 1); PG8_STAGE(PG8_SB(1, 0), b3, voffB);
            PG8_BAR; PG8_WAIT_L(0); PG8_MMA(0, 1, At, B1); PG8_BAR;
            PG8_LDA(At, 1, 1); PG8_STAGE(PG8_SA(1, 0), a3, voffA);
            PG8_BAR; PG8_WAIT_L(0); PG8_MMA(1, 0, At, B0); PG8_BAR; PG8_SCHED;
            PG8_STAGE(PG8_SB(1, 1), b3 + hstep, voffB);
            PG8_WAIT_V(6); PG8_BAR; PG8_MMA(1, 1, At, B1); PG8_BAR;
            }
        }
        if constexpr (ALIGN_EPI) { if (wr == 0) PG8_BAR; }
        if constexpr (!Epi::AFTER_DRAIN) { E(acc, cur, wr, wc, fr, fq); S.done(cur); }
        if (!has_next) break;
#pragma unroll
        for (int a = 0; a < 2; ++a)
#pragma unroll
            for (int b = 0; b < 2; ++b)
#pragma unroll
                for (int m = 0; m < 4; ++m)
#pragma unroll
                    for (int n = 0; n < 2; ++n) acc[a][b][m][n] = (f32x4){0.f, 0.f, 0.f, 0.f};
        cur = nxt; cA = nA; cB = nB; ++ui;
        if constexpr (ALIGN_EPI) { if (wr == 1) PG8_BAR; }
    }
    PG8_WAIT_V(0);
    if constexpr (!ALIGN_EPI) { if (wr == 0) PG8_BAR; }
    PG8_BAR;
    if constexpr (Epi::AFTER_DRAIN) { E.fused(acc, cur, wr, wc, fr, fq, lds, wid, lane); S.done(cur); }
#undef PG8_SA
#undef PG8_SB
#undef PG8_STAGE
#undef PG8_LDA
#undef PG8_LDB
#undef PG8_MMA
#undef PG8_WAIT_V
#undef PG8_WAIT_L
#undef PG8_BAR
#undef PG8_SCHED
}
}
namespace attn_body {
using bf16=__hip_bfloat16;
using bf16x8=__attribute__((ext_vector_type(8)))short;
using s16x4=__attribute__((ext_vector_type(4)))short;
using f32x16=__attribute__((ext_vector_type(16)))float;
using u32x4=__attribute__((ext_vector_type(4)))unsigned;
__device__ __forceinline__ int crow(int r,int hi){return (r&3)+8*(r>>2)+4*hi;}
#define SBAR() __builtin_amdgcn_sched_barrier(0)
__device__ __forceinline__ void glds16(const void*gsrc,unsigned lds_dst){unsigned keep;
  asm volatile("s_mov_b32 %0, m0\n\ts_mov_b32 m0, %2\n\ts_nop 0\n\tglobal_load_lds_dwordx4 %1, off\n\ts_mov_b32 m0, %0":"=&s"(keep):"v"(gsrc),"s"(lds_dst):"memory");}
typedef float f32x2_t __attribute__((ext_vector_type(2))); typedef __bf16 bf16x2_t __attribute__((ext_vector_type(2)));
__device__ __forceinline__ unsigned cvtpk_s(float lo,float hi){f32x2_t v={lo,hi};bf16x2_t b=__builtin_convertvector(v,bf16x2_t);return __builtin_bit_cast(unsigned,b);}
#define WAIT_BAR(N) asm volatile("s_waitcnt vmcnt(" #N ") lgkmcnt(0)\n\ts_barrier":::"memory")
__device__ __forceinline__ void qkt(f32x16&p0,f32x16&p1,const char*Kslot,const bf16x8*qr,const f32x16&negm,int r32,int hi){
  const char*kb=Kslot+hi*1024+r32*16;
  #pragma unroll
  for(int d0=0;d0<4;++d0){
    const bf16x8 b0=*reinterpret_cast<const bf16x8*>(kb+d0*2048);
    const bf16x8 b1=*reinterpret_cast<const bf16x8*>(kb+d0*2048+512);
    if(d0==0){p0=__builtin_amdgcn_mfma_f32_32x32x16_bf16(b0,qr[0],negm,0,0,0);p1=__builtin_amdgcn_mfma_f32_32x32x16_bf16(b1,qr[0],negm,0,0,0);}
    else{p0=__builtin_amdgcn_mfma_f32_32x32x16_bf16(b0,qr[d0],p0,0,0,0);p1=__builtin_amdgcn_mfma_f32_32x32x16_bf16(b1,qr[d0],p1,0,0,0);}}
}
__device__ __forceinline__ void pv(f32x16*o,int vb,bf16x8 pa0,bf16x8 pa1,bf16x8 pa2,bf16x8 pa3){
  #pragma unroll
  for(int d0=0;d0<2;++d0){s16x4 lo[4],hi[4];
    #pragma unroll
    for(int ks=0;ks<4;++ks){
      asm volatile("ds_read_b64_tr_b16 %0,%1 offset:%c2":"=&v"(lo[ks]):"v"(vb),"i"(d0*4096+ks*1024):"memory");
      asm volatile("ds_read_b64_tr_b16 %0,%1 offset:%c2":"=&v"(hi[ks]):"v"(vb),"i"(d0*4096+ks*1024+512):"memory");}
    asm volatile("s_waitcnt lgkmcnt(0)":::"memory");SBAR();
    #define PK(k) (bf16x8){lo[k][0],lo[k][1],lo[k][2],lo[k][3],hi[k][0],hi[k][1],hi[k][2],hi[k][3]}
    o[d0]=__builtin_amdgcn_mfma_f32_32x32x16_bf16(pa0,PK(0),o[d0],0,0,0);
    o[d0]=__builtin_amdgcn_mfma_f32_32x32x16_bf16(pa1,PK(1),o[d0],0,0,0);
    o[d0]=__builtin_amdgcn_mfma_f32_32x32x16_bf16(pa2,PK(2),o[d0],0,0,0);
    o[d0]=__builtin_amdgcn_mfma_f32_32x32x16_bf16(pa3,PK(3),o[d0],0,0,0);
    #undef PK
  }
}
#undef SBAR
#undef WAIT_BAR
}

namespace mk {
using pg8::bf16_t; using pg8::f32x4; using pg8::Unit; using pg8::cvt_pk_bf16;
#define LAS __attribute__((address_space(3)))
typedef unsigned u32x2 __attribute__((ext_vector_type(2)));
typedef unsigned u32x4 __attribute__((ext_vector_type(4)));
typedef float f32x2 __attribute__((ext_vector_type(2)));
typedef short bf16x8 __attribute__((ext_vector_type(8)));
typedef float f32x16 __attribute__((ext_vector_type(16)));

constexpr int DM = 1024, NB = 8, SL = 4096, CL = 256, ML = NB * SL, MC = NB * CL, MT = ML + MC;
constexpr int INW = 1792, DFF = 2816, UPW = 5632, MIXK = 1280, KVP = 128, QP = 512, KVB = SL + CL;
constexpr int HALF_A = 16384;
constexpr float EPS = 1e-6f;
constexpr float QSCALE = 0.125f * 1.4426950408889634f;

constexpr size_t MiB = 1u << 20;
constexpr size_t WS_CTL = 0;
constexpr size_t WS_MODP = 1 * MiB;
constexpr size_t WS_MOD = 5 * MiB;
constexpr size_t WS_T = 6 * MiB;
constexpr size_t WS_TW = 7 * MiB;
constexpr size_t WS_W = 8 * MiB;
constexpr size_t W_LAYER = 24 * MiB;
constexpr size_t WS_ADFT = 56 * MiB;
constexpr size_t WS_ADFTC = 88 * MiB;
constexpr size_t WS_KF = 89 * MiB;
constexpr size_t WS_KFC = 121 * MiB;
constexpr size_t WS_CX = 122 * MiB;
constexpr size_t WS_XN = 130 * MiB;
constexpr size_t WS_TMP = 198 * MiB;
constexpr size_t WS_Q = WS_TMP;
constexpr size_t WS_K = WS_TMP + 34 * MiB;
constexpr size_t WS_V = WS_TMP + 43 * MiB;
constexpr size_t WS_FT = WS_TMP + 52 * MiB;
constexpr size_t WS_FTC = WS_TMP + 68 * MiB;
constexpr size_t WS_PT = WS_TMP + 69 * MiB;
constexpr size_t WS_PTC = WS_TMP + 117 * MiB;
constexpr size_t WS_MIX = WS_TMP + 120 * MiB;
constexpr size_t WS_HRAW = WS_TMP + 206 * MiB;
constexpr size_t WS_U = WS_TMP;
constexpr size_t WS_G = WS_TMP + 198 * MiB;
constexpr size_t WS_END = WS_TMP + 297 * MiB;

struct Params { const float* in[29]; float* out; unsigned char* ws; int ph_lo, ph_hi; };
enum { I_X = 0, I_C, I_CTX, I_CCTX, I_WMOD, I_BMOD, I_GPREMIX, I_GPOSTMIX, I_GPREFFN, I_GPOSTFFN, I_WIN, I_GQ, I_GK, I_WF, I_WHC, I_BHC,
       I_HW1, I_HB1, I_HFR1, I_HW2, I_HB2, I_HFR2, I_HW3, I_HBIAS, I_WOUT, I_WUP, I_WFC, I_BFC, I_WDOWN };

__device__ __forceinline__ unsigned f2bf(float f) { unsigned u = __builtin_bit_cast(unsigned, f); return (u + 0x7fffu + ((u >> 16) & 1u)) >> 16; }
__device__ __forceinline__ unsigned pk2(float lo, float hi) { return f2bf(lo) | (f2bf(hi) << 16); }
__device__ __forceinline__ float bflo(unsigned w) { return __uint_as_float(w << 16); }
__device__ __forceinline__ float bfhi(unsigned w) { return __uint_as_float(w & 0xffff0000u); }
__device__ __forceinline__ float bf2f(bf16_t h) { return __uint_as_float((unsigned)h << 16); }
__device__ __forceinline__ float wave_sum(float v) {
#pragma unroll
    for (int o = 1; o < 64; o <<= 1) v += __shfl_xor(v, o);
    return v;
}

struct EpiPlain {
    static constexpr bool PERM = true, AFTER_DRAIN = false;
    bf16_t* O; int ldc;
    __device__ __forceinline__ void operator()(const f32x4 (&acc)[2][2][4][2], const Unit& u, int wr, int wc, int fr, int fq) const {
        const int row0 = u.pm * 256 + wr * 64 + fr; const int col0 = u.pn * 256 + wc * 32 + 8 * fq;
#pragma unroll
        for (int ai = 0; ai < 2; ++ai)
#pragma unroll
            for (int m = 0; m < 4; ++m) { bf16_t* rowp = O + (size_t)(row0 + ai * 128 + m * 16) * ldc + col0;
#pragma unroll
                for (int bj = 0; bj < 2; ++bj) { const f32x4 v0 = acc[ai][bj][m][0], v1 = acc[ai][bj][m][1];
                    u32x4 w; w.x = cvt_pk_bf16(v0[0], v0[1]); w.y = cvt_pk_bf16(v0[2], v0[3]); w.z = cvt_pk_bf16(v1[0], v1[1]); w.w = cvt_pk_bf16(v1[2], v1[3]);
                    *(u32x4*)(rowp + bj * 128) = w; } }
    }
};

struct EpiFourier {
    static constexpr bool PERM = true, AFTER_DRAIN = false;
    bf16_t* MIXp; int Lh; int rowbase0; int rowstride;
    __device__ __forceinline__ void operator()(const f32x4 (&acc)[2][2][4][2], const Unit& u, int wr, int wc, int fr, int fq) const {
        asm volatile("" : "+v"(fr), "+v"(fq), "+s"(wr), "+s"(wc));
        const int b = u.pn; const int len = 2 * Lh; const int rb = rowbase0 + b * rowstride;
#pragma unroll
        for (int ai = 0; ai < 2; ++ai)
#pragma unroll
            for (int m = 0; m < 4; ++m) {
                const int r = u.pm * 256 + ai * 128 + wr * 64 + m * 16 + fr;
                const bool isS = r > Lh; const int k = isS ? r - Lh : r;
                const bool edge = (k == 0) || (k == Lh);
#pragma unroll
                for (int bj = 0; bj < 2; ++bj) { const f32x4 v0 = acc[ai][bj][m][0], v1 = acc[ai][bj][m][1];
                    const int ch = bj * 128 + wc * 32 + 8 * fq;
                    u32x4 w; w.x = cvt_pk_bf16(v0[0], v0[1]); w.y = cvt_pk_bf16(v0[2], v0[3]); w.z = cvt_pk_bf16(v1[0], v1[1]); w.w = cvt_pk_bf16(v1[2], v1[3]);
                    const int col = 512 + (isS ? 256 : 0) + ch;
                    *(u32x4*)(MIXp + (size_t)(rb + k) * MIXK + col) = w;
                    if (!edge) { u32x4 wm = w; if (isS) { wm.x ^= 0x80008000u; wm.y ^= 0x80008000u; wm.z ^= 0x80008000u; wm.w ^= 0x80008000u; }
                        *(u32x4*)(MIXp + (size_t)(rb + len - k) * MIXK + col) = wm; }
                    else if (!isS) { *(u32x4*)(MIXp + (size_t)(rb + k) * MIXK + col + 256) = (u32x4){0u, 0u, 0u, 0u}; }
                }
            }
    }
};

struct EpiInProj {
    static constexpr bool PERM = false, AFTER_DRAIN = false;
    bf16_t *Q, *K, *V, *fT, *fTc, *PT, *PTc; const float *gq, *gk, *rope; LAS float* xch;
    __device__ __forceinline__ void operator()(const f32x4 (&acc)[2][2][4][2], const Unit& u, int wr, int wc, int fr, int fq) const {
        asm volatile("" : "+v"(fr), "+v"(fq), "+s"(wr), "+s"(wc));
        const int pn = u.pn, pm = u.pm; const bool isctx = pm >= 128;
        const int b = isctx ? pm - 128 : pm >> 4;
        const int tbase = isctx ? 0 : (pm & 15) * 256;
#ifdef T_NOQK
        if (false) {
#else
        if (pn <= 2) {
#endif
#pragma unroll
            for (int ai = 0; ai < 2; ++ai)
#pragma unroll
                for (int m = 0; m < 4; ++m)
#pragma unroll
                    for (int bj = 0; bj < 2; ++bj) {
                        float s = 0.f;
#pragma unroll
                        for (int n = 0; n < 2; ++n) { const f32x4 x = acc[ai][bj][m][n]; s += (x[0] * x[0] + x[1] * x[1]) + (x[2] * x[2] + x[3] * x[3]); }
                        s += __shfl_xor(s, 16); s += __shfl_xor(s, 32);
                        if (fq == 0) xch[((ai * 128 + wr * 64 + m * 16 + fr) * 2 + bj) * 4 + wc] = s;
                    }
            asm volatile("s_waitcnt lgkmcnt(0)\n\ts_barrier" ::: "memory");
            const float* gg = (pn == 2) ? gk : gq;
            const int dbase = (wc & 1) * 32 + 4 * fq;
            const f32x4 g1 = *(const f32x4*)(gg + dbase), g2 = *(const f32x4*)(gg + dbase + 16);
            const float osc = (pn == 2) ? 1.0f : QSCALE;
#pragma unroll
            for (int ai = 0; ai < 2; ++ai)
#pragma unroll
                for (int m = 0; m < 4; ++m) {
                    const int rl = ai * 128 + wr * 64 + m * 16 + fr; const int t = tbase + rl;
                    const int p = (wc & 1) ? (t & 63) : (t >> 6);
                    f32x4 cs = (f32x4){1.f, 1.f, 1.f, 1.f}, sn = (f32x4){0.f, 0.f, 0.f, 0.f};
                    if (!isctx) { cs = *(const f32x4*)(rope + p * 16 + 4 * fq); sn = *(const f32x4*)(rope + 1024 + p * 16 + 4 * fq); }
                    const size_t qrow = (size_t)pm * 256 + rl;
                    const size_t kvrow = isctx ? (size_t)b * KVB + rl : (size_t)b * KVB + CL + t;
#pragma unroll
                    for (int bj = 0; bj < 2; ++bj) {
                        if (pn == 2 && bj == 1) {
#pragma unroll
                            for (int n = 0; n < 2; ++n) { const f32x4 x = acc[ai][bj][m][n]; u32x2 w; w.x = cvt_pk_bf16(x[0], x[1]); w.y = cvt_pk_bf16(x[2], x[3]);
                                *(u32x2*)(V + kvrow * KVP + wc * 32 + 16 * n + 4 * fq) = w; }
                        } else {
                            const float ssq = xch[(rl * 2 + bj) * 4 + wc] + xch[(rl * 2 + bj) * 4 + (wc ^ 1)];
                            const float rstd = rsqrtf(ssq * (1.0f / 64.0f) + EPS) * osc;
                            const f32x4 y1 = acc[ai][bj][m][0] * rstd * g1, y2 = acc[ai][bj][m][1] * rstd * g2;
                            const f32x4 o1 = y1 * cs - y2 * sn, o2 = y2 * cs + y1 * sn;
                            u32x2 w1, w2; w1.x = cvt_pk_bf16(o1[0], o1[1]); w1.y = cvt_pk_bf16(o1[2], o1[3]); w2.x = cvt_pk_bf16(o2[0], o2[1]); w2.y = cvt_pk_bf16(o2[2], o2[3]);
                            bf16_t* dst = (pn == 2) ? (K + kvrow * KVP + wc * 32 + 4 * fq) : (Q + qrow * QP + pn * 256 + bj * 128 + wc * 32 + 4 * fq);
                            *(u32x2*)dst = w1; *(u32x2*)(dst + 16) = w2;
                        }
                    }
                    asm volatile("" ::: "memory"); __builtin_amdgcn_sched_barrier(0);
                }
        }
#ifndef T_NOTR
        else {
            const int NC = (pn == 3) ? 256 : 768; const int cb = (pn == 3) ? 0 : (pn - 4) * 256;
            bf16_t* base; int tl;
            if (isctx) { base = ((pn == 3) ? fTc : PTc) + (size_t)b * NC * CL; tl = CL; }
            else { base = ((pn == 3) ? fT : PT) + (size_t)b * NC * SL + tbase; tl = SL; }
            const int lane = fq * 16 + fr;
            LAS bf16_t* stg = (LAS bf16_t*)((LAS unsigned char*)xch + 8192) + (wr * 4 + wc) * 1152;
#pragma unroll
            for (int ai = 0; ai < 2; ++ai)
#pragma unroll
                for (int bj = 0; bj < 2; ++bj)
#pragma unroll
                    for (int n = 0; n < 2; ++n) {
#pragma unroll
                        for (int m = 0; m < 4; ++m) { const f32x4 x = acc[ai][bj][m][n];
#pragma unroll
                            for (int j = 0; j < 4; ++j) stg[(4 * fq + j) * 72 + m * 16 + fr] = (bf16_t)f2bf(x[j]); }
                        asm volatile("s_waitcnt lgkmcnt(0)" ::: "memory");
                        bf16_t* dst = base + (size_t)(cb + bj * 128 + wc * 32 + 16 * n) * tl + ai * 128 + wr * 64;
#pragma unroll
                        for (int i = 0; i < 2; ++i) { const int v = lane + 64 * i, col = v >> 3, k = v & 7;
                            const u32x4 w = *(const LAS u32x4*)(stg + col * 72 + k * 8);
                            *(u32x4*)(dst + (size_t)col * tl + 8 * k) = w; }
                        asm volatile("s_waitcnt lgkmcnt(0)" ::: "memory");
                    }
        }
#endif
    }
};

struct OneUnit { int pm, pn;
    __device__ __forceinline__ bool next(int i, Unit& u) const { if (i > 0) return false; u.pm = pm; u.pn = pn; return true; }
    __device__ __forceinline__ void a_ready(const Unit&) const {}
    __device__ __forceinline__ void done(const Unit&) const {}
};

constexpr int AT_K = 0, AT_V = 16384, AT_WS = 32768, AT_OST = 32768 + 2048;
__device__ __forceinline__ void attn_unit(const bf16_t* Qu, const bf16_t* Kh, const bf16_t* Vh, bf16_t* Ou, int NT, char* shm) {
    using namespace attn_body;
    const int tid = mk_tid(), lane = tid & 63, r32 = lane & 31, hi = lane >> 5; const int wid = __builtin_amdgcn_readfirstlane(tid >> 6);
    const unsigned lds0 = (unsigned)(uintptr_t)shm;
    float* wsf = (float*)(shm + AT_WS) + wid * 64;
    const bf16_t* ksrc = Kh + (size_t)lane * KVP + wid * 8;
    const bf16_t* vsrc = Vh + (size_t)(16 * (wid & 3) + (lane >> 2)) * KVP + (wid >> 2) * 32 + (lane & 3) * 8;
    const unsigned kdst = lds0 + AT_K + wid * 1024, vdst = lds0 + AT_V + wid * 1024;
#define DMA_K(t, slot) glds16(ksrc + (size_t)(t) * 64 * KVP, (unsigned)__builtin_amdgcn_readfirstlane(kdst + (slot)))
#define DMA_V(t, slot) glds16(vsrc + (size_t)(t) * 64 * KVP, (unsigned)__builtin_amdgcn_readfirstlane(vdst + (slot)))
    const int vb0 = (int)(lds0 + AT_V) + ((lane >> 4) & 1) * 32 + (lane & 3) * 8 + (4 * hi + ((lane & 15) >> 2)) * 64;
    DMA_K(0, 0); DMA_V(0, 0);
    const bf16_t* Qw = Qu + (size_t)(wid * 32) * QP;
    bf16x8 qr[4];
#pragma unroll
    for (int d0 = 0; d0 < 4; ++d0) qr[d0] = *reinterpret_cast<const bf16x8*>(&Qw[(size_t)r32 * QP + d0 * 16 + hi * 8]);
    float mrun = -INFINITY, l_reg = 0.f; f32x16 o[2]; o[0] = f32x16{}; o[1] = f32x16{};
    f32x16 zero16 = f32x16{};
    for (int t = 0; t < NT; ++t) {
        const int buf = (t & 1) * 8192;
        if (t + 1 < NT) { DMA_K(t + 1, buf ^ 8192); DMA_V(t + 1, buf ^ 8192); asm volatile("s_waitcnt vmcnt(2)\n\ts_barrier" ::: "memory"); }
        else { asm volatile("s_waitcnt vmcnt(0)\n\ts_barrier" ::: "memory"); }
        f32x16 p0, p1;
        qkt(p0, p1, shm + AT_K + buf, qr, zero16, r32, hi);
        float rm = p0[0];
#pragma unroll
        for (int r = 1; r < 16; ++r) rm = fmaxf(rm, p0[r]);
#pragma unroll
        for (int r = 0; r < 16; ++r) rm = fmaxf(rm, p1[r]);
        rm = fmaxf(rm, __shfl_xor(rm, 32));
        const float mnew = fmaxf(mrun, rm);
        const float f = __builtin_amdgcn_exp2f(mrun - mnew);
        mrun = mnew;
        float sacc = 0.f;
#pragma unroll
        for (int r = 0; r < 16; ++r) { p0[r] = __builtin_amdgcn_exp2f(p0[r] - mnew); p1[r] = __builtin_amdgcn_exp2f(p1[r] - mnew); sacc += p0[r] + p1[r]; }
        l_reg = l_reg * f + sacc;
        if (hi == 0) wsf[r32] = f;
        asm volatile("s_waitcnt lgkmcnt(0)" ::: "memory");
#pragma unroll
        for (int r = 0; r < 16; ++r) { const float fr_ = wsf[crow(r, hi)]; o[0][r] *= fr_; o[1][r] *= fr_; }
        u32x4 pw0, pw1, pw2, pw3;
        pw0 = (u32x4){cvtpk_s(p0[0], p0[1]), cvtpk_s(p0[2], p0[3]), cvtpk_s(p0[4], p0[5]), cvtpk_s(p0[6], p0[7])};
        pw1 = (u32x4){cvtpk_s(p0[8], p0[9]), cvtpk_s(p0[10], p0[11]), cvtpk_s(p0[12], p0[13]), cvtpk_s(p0[14], p0[15])};
        pw2 = (u32x4){cvtpk_s(p1[0], p1[1]), cvtpk_s(p1[2], p1[3]), cvtpk_s(p1[4], p1[5]), cvtpk_s(p1[6], p1[7])};
        pw3 = (u32x4){cvtpk_s(p1[8], p1[9]), cvtpk_s(p1[10], p1[11]), cvtpk_s(p1[12], p1[13]), cvtpk_s(p1[14], p1[15])};
        pv(o, vb0 + buf, __builtin_bit_cast(bf16x8, pw0), __builtin_bit_cast(bf16x8, pw1), __builtin_bit_cast(bf16x8, pw2), __builtin_bit_cast(bf16x8, pw3));
        asm volatile("s_waitcnt lgkmcnt(0)\n\ts_barrier" ::: "memory");
    }
    l_reg += __shfl_xor(l_reg, 32);
    if (hi == 0) wsf[32 + r32] = l_reg;
    asm volatile("s_waitcnt lgkmcnt(0)" ::: "memory");
    float rli[16];
#pragma unroll
    for (int r = 0; r < 16; ++r) rli[r] = 1.0f / wsf[32 + crow(r, hi)];
    bf16_t* Ow = Ou + (size_t)(wid * 32) * MIXK;
    { bf16_t* stg = (bf16_t*)(shm + AT_OST) + wid * 2048;
#pragma unroll
      for (int r = 0; r < 16; ++r) { const int orow = crow(r, hi);
#pragma unroll
        for (int d0 = 0; d0 < 2; ++d0) stg[orow * 64 + d0 * 32 + r32] = (bf16_t)f2bf(o[d0][r] * rli[r]); }
      asm volatile("s_waitcnt lgkmcnt(0)" ::: "memory");
#pragma unroll
      for (int i = 0; i < 4; ++i) { const int row = i * 8 + (lane >> 3), ch = lane & 7; const u32x4 v = *(const u32x4*)(stg + row * 64 + ch * 8); *(u32x4*)(Ow + (size_t)row * MIXK + ch * 8) = v; } }
    asm volatile("s_waitcnt vmcnt(0) lgkmcnt(0)\n\ts_barrier" ::: "memory");
#undef DMA_K
#undef DMA_V
}

__device__ __forceinline__ int PADI(int i) { return i + (i >> 5); }
constexpr int FFT_TW_OFF = 69632, FFT_RED_OFF = 69632 + 32768;
template <int LOGN, int R, bool INV>
__device__ __forceinline__ void fft_pass(LAS f32x2* d, const LAS f32x2* tw, int s, int tid) {
    constexpr int N = 1 << LOGN, RR = 1 << R;
    const int lgs = LOGN - s - R; const int stride = 1 << lgs;
    constexpr float C16[8] = {1.0f, 0.9238795325112867f, 0.7071067811865476f, 0.3826834323650898f, 0.0f, -0.3826834323650898f, -0.7071067811865476f, -0.9238795325112867f};
    constexpr float S16[8] = {0.0f, 0.3826834323650898f, 0.7071067811865476f, 0.9238795325112867f, 1.0f, 0.9238795325112867f, 0.7071067811865476f, 0.3826834323650898f};
    for (int g = tid; g < (N >> R); g += 512) {
        const int lo = g & (stride - 1), hi = g >> lgs; const int base = (hi << (lgs + R)) + lo;
        f32x2 v[RR];
#pragma unroll
        for (int e = 0; e < RR; ++e) v[e] = d[PADI(base + e * stride)];
        if constexpr (R == 1) { const f32x2 a = v[0], b = v[1]; v[0] = a + b; v[1] = a - b; }
        else {
            static_assert(R == 4 || R == 1, "radix");
            f32x2 Wb[4];
            Wb[0] = tw[lo << s];
#pragma unroll
            for (int j = 1; j < 4; ++j) Wb[j] = (f32x2){Wb[j - 1].x * Wb[j - 1].x - Wb[j - 1].y * Wb[j - 1].y, 2.0f * Wb[j - 1].x * Wb[j - 1].y};
#pragma unroll
            for (int jj = 0; jj < 4; ++jj) {
                const int j = INV ? (3 - jj) : jj;
                const int he = 8 >> j;
#pragma unroll
                for (int q = 0; q < 8; ++q) if (q < he) {
                    const int k = q << j;
                    const f32x2 w = (f32x2){Wb[j].x * C16[k] + Wb[j].y * S16[k], Wb[j].y * C16[k] - Wb[j].x * S16[k]};
#pragma unroll
                    for (int e = 0; e < 16; ++e) if ((e & he) == 0 && (e & (he - 1)) == q) {
                        const f32x2 a = v[e], b = v[e + he];
                        if (!INV) { const f32x2 dl = a - b; v[e] = a + b; v[e + he] = (f32x2){dl.x * w.x - dl.y * w.y, dl.x * w.y + dl.y * w.x}; }
                        else { const f32x2 bw = (f32x2){b.x * w.x + b.y * w.y, b.y * w.x - b.x * w.y}; v[e] = a + bw; v[e + he] = a - bw; }
                    }
                }
            }
        }
#pragma unroll
        for (int e = 0; e < RR; ++e) d[PADI(base + e * stride)] = v[e];
    }
    __syncthreads();
}
template <int LOGN> __device__ __forceinline__ void fft_fwd(LAS f32x2* d, const LAS f32x2* tw, int tid) {
    if constexpr (LOGN == 13) { fft_pass<13, 4, false>(d, tw, 0, tid); fft_pass<13, 4, false>(d, tw, 4, tid); fft_pass<13, 4, false>(d, tw, 8, tid); fft_pass<13, 1, false>(d, tw, 12, tid); }
    else { fft_pass<9, 4, false>(d, tw, 0, tid); fft_pass<9, 4, false>(d, tw, 4, tid); fft_pass<9, 1, false>(d, tw, 8, tid); }
}
template <int LOGN> __device__ __forceinline__ void fft_inv(LAS f32x2* d, const LAS f32x2* tw, int tid) {
    if constexpr (LOGN == 13) { fft_pass<13, 1, true>(d, tw, 12, tid); fft_pass<13, 4, true>(d, tw, 8, tid); fft_pass<13, 4, true>(d, tw, 4, tid); fft_pass<13, 4, true>(d, tw, 0, tid); }
    else { fft_pass<9, 1, true>(d, tw, 8, tid); fft_pass<9, 4, true>(d, tw, 4, tid); fft_pass<9, 4, true>(d, tw, 0, tid); }
}
template <int LOGN> __device__ __forceinline__ void load_tw(LAS f32x2* tw, const f32x2* g, int tid) {
    for (int i = tid; i < (1 << (LOGN - 1)); i += 512) tw[i] = g[i];
}

template <int LOGN> __device__ __forceinline__ void kf_job(LAS unsigned char* lds, const float* hrawT, const f32x2* twg, f32x2* kf, int ch, int tid) {
    constexpr int N = 1 << LOGN, T = N / 2;
    LAS f32x2* d = (LAS f32x2*)lds; LAS f32x2* tw = (LAS f32x2*)(lds + FFT_TW_OFF); LAS float* red = (LAS float*)(lds + FFT_RED_OFF);
    load_tw<LOGN>(tw, twg, tid);
    float s = 0.f;
    for (int n = tid; n < N; n += 512) {
        float v;
        if (n < T) v = hrawT[(size_t)ch * T + n]; else if (n == T) v = 0.f; else v = hrawT[(size_t)(256 + ch) * T + (N - n)];
        d[PADI(n)] = (f32x2){v, 0.f}; s += fabsf(v);
    }
    s = wave_sum(s);
    if ((tid & 63) == 0) red[tid >> 6] = s;
    __syncthreads();
    float tot = 0.f;
#pragma unroll
    for (int i = 0; i < 8; ++i) tot += red[i];
    const float inv = 1.0f / tot;
    for (int n = tid; n < N; n += 512) { f32x2 v = d[PADI(n)]; v.x *= inv; d[PADI(n)] = v; }
    __syncthreads();
    fft_fwd<LOGN>(d, tw, tid);
    for (int n = tid; n < N; n += 512) kf[(size_t)ch * N + n] = d[PADI(n)];
    __syncthreads();
}

template <int LOGN> __device__ __forceinline__ void hyena_job(LAS unsigned char* lds, const bf16_t* PTall, const f32x2* twg, const f32x2* kf, const float* wc, const float* bc, const float* hbias,
                                                            bf16_t* MIXp, int rowbase, int bp, int ch, int tid) {
    constexpr int N = 1 << LOGN, T = N / 2, PER = (T + 511) / 512;
    LAS f32x2* d = (LAS f32x2*)lds; LAS f32x2* tw = (LAS f32x2*)(lds + FFT_TW_OFF);
    load_tw<LOGN>(tw, twg, tid);
    const float w10 = wc[256 + ch], w11 = wc[768 + 256 + ch], w12 = wc[1536 + 256 + ch], b1 = bc[256 + ch];
    const float w20 = wc[512 + ch], w21 = wc[768 + 512 + ch], w22 = wc[1536 + 512 + ch], b2 = bc[512 + ch];
    const float w00 = wc[ch], w01 = wc[768 + ch], w02 = wc[1536 + ch], b0 = bc[ch];
    const float hb = hbias[ch];
    f32x2 ukeep[PER];
#pragma unroll
    for (int i = 0; i < PER; ++i) {
        const int t = tid + 512 * i;
        f32x2 u = (f32x2){0.f, 0.f};
        if (t < T) {
#pragma unroll
            for (int bb = 0; bb < 2; ++bb) {
                const bf16_t* p1 = PTall + ((size_t)(2 * bp + bb) * 768 + 256 + ch) * T; const bf16_t* p2 = PTall + ((size_t)(2 * bp + bb) * 768 + 512 + ch) * T;
                const float a_m = t > 0 ? bf2f(p1[t - 1]) : 0.f, a_0 = bf2f(p1[t]), a_p = t < T - 1 ? bf2f(p1[t + 1]) : 0.f;
                const float c_m = t > 0 ? bf2f(p2[t - 1]) : 0.f, c_0 = bf2f(p2[t]), c_p = t < T - 1 ? bf2f(p2[t + 1]) : 0.f;
                const float x1 = a_m * w10 + a_0 * w11 + a_p * w12 + b1, vv = c_m * w20 + c_0 * w21 + c_p * w22 + b2;
                if (bb == 0) u.x = x1 * vv; else u.y = x1 * vv;
            }
            d[PADI(t)] = u; d[PADI(t + T)] = (f32x2){0.f, 0.f};
        }
        ukeep[i] = u;
    }
    __syncthreads();
    fft_fwd<LOGN>(d, tw, tid);
    for (int n = tid; n < N; n += 512) { const f32x2 a = d[PADI(n)], k = kf[(size_t)ch * N + n]; d[PADI(n)] = (f32x2){a.x * k.x - a.y * k.y, a.x * k.y + a.y * k.x}; }
    __syncthreads();
    fft_inv<LOGN>(d, tw, tid);
    const float sc = 1.0f / (float)N;
#pragma unroll
    for (int i = 0; i < PER; ++i) {
        const int t = tid + 512 * i;
        if (t < T) {
            const f32x2 y = d[PADI(t)] * sc; const f32x2 u = ukeep[i];
#pragma unroll
            for (int bb = 0; bb < 2; ++bb) {
                const bf16_t* p0 = PTall + ((size_t)(2 * bp + bb) * 768 + ch) * T;
                const float a_m = t > 0 ? bf2f(p0[t - 1]) : 0.f, a_0 = bf2f(p0[t]), a_p = t < T - 1 ? bf2f(p0[t + 1]) : 0.f;
                const float x0 = a_m * w00 + a_0 * w01 + a_p * w02 + b0;
                const float yy = bb == 0 ? y.x : y.y, uu = bb == 0 ? u.x : u.y;
                MIXp[(size_t)(rowbase + (2 * bp + bb) * T + t) * MIXK + 1024 + ch] = (bf16_t)f2bf(x0 * (yy + uu * hb));
            }
        }
    }
    __syncthreads();
}

__device__ __forceinline__ void norm_rows(int gw, int NGW, int lane, int nrows, const float* xl_in, const float* xc_in, float* xl_out, float* xc_out,
                                          const bf16_t* Y, const float* gpost, const float* modA, int ga_off,
                                          bf16_t* XN, const float* gpre, const float* modB, int sc_off, int sh_off) {
    for (int row = gw; row < nrows; row += NGW) {
        const bool isctx = row >= ML; const int mb = isctx ? 8 : (row >> 12);
        const float* xin = isctx ? xc_in + (size_t)(row - ML) * DM : xl_in + (size_t)row * DM;
        f32x4 v[4];
#pragma unroll
        for (int j = 0; j < 4; ++j) v[j] = *(const f32x4*)(xin + 4 * lane + 256 * j);
        if (Y) {
            f32x4 y[4]; float s = 0.f;
#pragma unroll
            for (int j = 0; j < 4; ++j) { const u32x2 w = *(const u32x2*)(Y + (size_t)row * DM + 4 * lane + 256 * j); y[j] = (f32x4){bflo(w.x), bfhi(w.x), bflo(w.y), bfhi(w.y)};
                s += (y[j].x * y[j].x + y[j].y * y[j].y) + (y[j].z * y[j].z + y[j].w * y[j].w); }
            const float rstd = rsqrtf(wave_sum(s) * (1.0f / DM) + EPS);
            float* xo = isctx ? xc_out + (size_t)(row - ML) * DM : xl_out + (size_t)row * DM;
#pragma unroll
            for (int j = 0; j < 4; ++j) { const f32x4 g = *(const f32x4*)(gpost + 4 * lane + 256 * j); const f32x4 ga = *(const f32x4*)(modA + (size_t)mb * 6144 + ga_off + 4 * lane + 256 * j);
                v[j] = v[j] + ga * (y[j] * rstd * g); *(f32x4*)(xo + 4 * lane + 256 * j) = v[j]; }
        }
        if (XN) {
            float s = 0.f;
#pragma unroll
            for (int j = 0; j < 4; ++j) s += (v[j].x * v[j].x + v[j].y * v[j].y) + (v[j].z * v[j].z + v[j].w * v[j].w);
            const float rstd = rsqrtf(wave_sum(s) * (1.0f / DM) + EPS);
#pragma unroll
            for (int j = 0; j < 4; ++j) { const f32x4 g = *(const f32x4*)(gpre + 4 * lane + 256 * j); const f32x4 sc = *(const f32x4*)(modB + (size_t)mb * 6144 + sc_off + 4 * lane + 256 * j);
                const f32x4 sh = *(const f32x4*)(modB + (size_t)mb * 6144 + sh_off + 4 * lane + 256 * j);
                const f32x4 o = (v[j] * rstd * g) * (1.0f + sc) + sh; u32x2 w; w.x = pk2(o.x, o.y); w.y = pk2(o.z, o.w);
                *(u32x2*)(XN + (size_t)row * DM + 4 * lane + 256 * j) = w; }
        }
    }
}

__device__ __forceinline__ void glu_pass(int blk, int nblk, int tid, int r0, int nrows, const bf16_t* U, bf16_t* G, const float* wc, const float* bc) {
    const int nitems = nrows / 8;
    for (int it = blk; it < nitems; it += nblk) {
        for (int p = tid; p < 8 * 352; p += 512) {
            const int rl = it * 8 + p / 352, vc = p % 352, j0 = vc * 8; const int r = r0 + rl;
            int t, len; if (r >= ML) { t = (r - ML) & (CL - 1); len = CL; } else { t = r & (SL - 1); len = SL; }
            const bool hm = t > 0, hp = t < len - 1;
            const bf16_t* ur = U + (size_t)rl * UPW + j0;
            const u32x4 z4 = (u32x4){0u, 0u, 0u, 0u};
            const u32x4 g0 = *(const u32x4*)ur, gm = hm ? *(const u32x4*)(ur - UPW) : z4, gp = hp ? *(const u32x4*)(ur + UPW) : z4;
            const u32x4 v0 = *(const u32x4*)(ur + DFF), vm = hm ? *(const u32x4*)(ur + DFF - UPW) : z4, vp = hp ? *(const u32x4*)(ur + DFF + UPW) : z4;
            unsigned outw[4];
#pragma unroll
            for (int q = 0; q < 4; ++q) {
                float res[2];
#pragma unroll
                for (int h = 0; h < 2; ++h) {
                    const int j = j0 + 2 * q + h;
                    const float a_m = h ? bfhi(gm[q]) : bflo(gm[q]), a_0 = h ? bfhi(g0[q]) : bflo(g0[q]), a_p = h ? bfhi(gp[q]) : bflo(gp[q]);
                    const float c_m = h ? bfhi(vm[q]) : bflo(vm[q]), c_0 = h ? bfhi(v0[q]) : bflo(v0[q]), c_p = h ? bfhi(vp[q]) : bflo(vp[q]);
                    const float cg = a_m * wc[j] + a_0 * wc[UPW + j] + a_p * wc[2 * UPW + j] + bc[j];
                    const float cv = c_m * wc[DFF + j] + c_0 * wc[UPW + DFF + j] + c_p * wc[2 * UPW + DFF + j] + bc[DFF + j];
                    const float sg = cg / (1.0f + __expf(-cg));
                    res[h] = sg * cv;
                }
                outw[q] = pk2(res[0], res[1]);
            }
            *(u32x4*)(G + (size_t)rl * DFF + j0) = (u32x4){outw[0], outw[1], outw[2], outw[3]};
        }
    }
}

__device__ __forceinline__ void transpose_item(const float* W, int ldw, bf16_t* WT, int ldt, int nblk, int item, LAS float* scr, int lane) {
    const int kb = item / nblk, nb = item % nblk, k0 = 64 * kb, n0 = 32 * nb;
#pragma unroll 8
    for (int i = 0; i < 32; ++i) { const int kk = 2 * i + (lane >> 5); scr[kk * 33 + (lane & 31)] = W[(size_t)(k0 + kk) * ldw + n0 + (lane & 31)]; }
    asm volatile("s_waitcnt lgkmcnt(0)" ::: "memory");
    const int c = lane & 7;
#pragma unroll
    for (int j = 0; j < 4; ++j) { const int n = (lane >> 3) + 8 * j; const LAS float* s = scr + (8 * c) * 33 + n;
        u32x4 o; o.x = pk2(s[0 * 33], s[1 * 33]); o.y = pk2(s[2 * 33], s[3 * 33]); o.z = pk2(s[4 * 33], s[5 * 33]); o.w = pk2(s[6 * 33], s[7 * 33]);
        *(u32x4*)(WT + (size_t)(n0 + n) * ldt + k0 + 8 * c) = o; }
    asm volatile("s_waitcnt lgkmcnt(0)" ::: "memory");
}
}

using namespace mk;
typedef const __attribute__((address_space(4))) Params* KP;
__device__ __forceinline__ KP kp_get() { KP p = (KP)__builtin_amdgcn_kernarg_segment_ptr(); asm volatile("" : "+s"(p)); return p; }
#ifndef MK_REP
#define MK_REP 0
#endif
#define REP(k) for (int rep_ = 0; rep_ < 1 + ((MK_REP >> (k)) & 1); ++rep_)
#ifndef MK_EN
#define MK_EN 0xffff
#endif
#define EN(k) if constexpr ((MK_EN >> (k)) & 1)
constexpr int LDS_BYTES = 159744;
constexpr int XCH_OFF = 131072;
constexpr int MISC_OFF = 131072 + 8192 + 18432;

#define RLX_AGENT __ATOMIC_RELAXED, __HIP_MEMORY_SCOPE_AGENT
#define XB_TMO      128
#define XB_XCNT(j)  (256  + 64 * (j))
#define XB_XSUB(j)  (1280 + 64 * (j))
#define XB_XGEN(j)  (2304 + 64 * (j))
#define XB_TOP      3328
#define XB_TOPGEN   3392
#define XCD_BAR_WORDS 3456
#define XB_SPIN_CAP (1u << 18)

__device__ __forceinline__ unsigned xb_ld(unsigned* p)              { return __hip_atomic_load(p, __ATOMIC_RELAXED, __HIP_MEMORY_SCOPE_AGENT); }
__device__ __forceinline__ unsigned xb_add(unsigned* p, unsigned v) { return __hip_atomic_fetch_add(p, v, __ATOMIC_RELAXED, __HIP_MEMORY_SCOPE_AGENT); }
__device__ __forceinline__ unsigned xb_xcc_id() { return (unsigned)__builtin_amdgcn_s_getreg((3 << 11) | 20) & 0xFu; }
#define XB_SPIN(cond, bar) do { unsigned _sp = 0; while (cond) { __builtin_amdgcn_s_sleep(1); \
    if ((++_sp & 255u) == 0u) { if (xb_ld(&(bar)[XB_TMO])) break; if (_sp > XB_SPIN_CAP) { atomicAdd(&(bar)[XB_TMO], 1u); break; } } } } while (0)

struct XcdBarrier {
    unsigned* bar; unsigned x;
    volatile LAS unsigned* st;
};

__device__ __forceinline__ XcdBarrier xcd_barrier_post(unsigned* bar, volatile LAS unsigned* st) {
    XcdBarrier b; b.bar = bar; b.x = xb_xcc_id(); b.st = st;
    if (threadIdx.x == 0) (void)xb_add(&bar[XB_XCNT(b.x)], 1u);
    return b;
}
__device__ __forceinline__ void xcd_barrier_complete(unsigned* bar, unsigned x, unsigned& nloc, unsigned& nx) {
    const unsigned G = gridDim.x * gridDim.y * gridDim.z;
    unsigned sum, cnt, mine, sp = 0u;
    for (;;) {
        sum = 0u; cnt = 0u; mine = 0u;
#pragma unroll
        for (unsigned j = 0; j < 16; ++j) { const unsigned c = xb_ld(&bar[XB_XCNT(j)]); sum += c; cnt += (c > 0u) ? 1u : 0u; mine = (j == x) ? c : mine; }
        if (sum == G) break;
        __builtin_amdgcn_s_sleep(1);
        if ((++sp & 255u) == 0u) { if (xb_ld(&bar[XB_TMO])) break; if (sp > XB_SPIN_CAP) { atomicAdd(&bar[XB_TMO], 1u); break; } }
    }
    nloc = mine > 0u ? mine : 1u; nx = cnt > 0u ? cnt : 1u;
}

__device__ __forceinline__ void xcd_barrier(const XcdBarrier& b) {
    asm volatile("s_waitcnt vmcnt(0)" ::: "memory");
    __syncthreads();
    if (threadIdx.x == 0) {
        unsigned* bar = b.bar;
        __builtin_amdgcn_s_waitcnt(0);
        unsigned nloc = b.st[0], nx = b.st[1];
        if (nloc == 0u) { xcd_barrier_complete(bar, b.x, nloc, nx); b.st[0] = nloc; b.st[1] = nx; }
        const unsigned old = xb_add(&bar[XB_XSUB(b.x)], 1u);
        const unsigned gen = old / nloc;
        if (old + 1u == (gen + 1u) * nloc) {
            __builtin_amdgcn_fence(__ATOMIC_RELEASE, "agent");
            asm volatile("s_waitcnt vmcnt(0)" ::: "memory");
            const unsigned og = xb_add(&bar[XB_TOP], 1u);
            const unsigned tg = og / nx;
            if (og + 1u == (tg + 1u) * nx) xb_add(&bar[XB_TOPGEN], 1u);
            else XB_SPIN(xb_ld(&bar[XB_TOPGEN]) == tg, bar);
            __builtin_amdgcn_fence(__ATOMIC_ACQUIRE, "agent");
            xb_add(&bar[XB_XGEN(b.x)], 1u);
            asm volatile("s_waitcnt vmcnt(0)" ::: "memory");
        } else {
            XB_SPIN(xb_ld(&bar[XB_XGEN(b.x)]) == gen, bar);
            __builtin_amdgcn_fence(__ATOMIC_ACQUIRE, "agent");
            asm volatile("s_waitcnt vmcnt(0)" ::: "memory");
        }
    }
    __syncthreads();
}

__device__ __forceinline__ bf16_t* wlayer(unsigned char* ws, int l, size_t off) { return (bf16_t*)(ws + WS_W + (size_t)l * W_LAYER + off); }
constexpr size_t OFF_WIN = 0, OFF_WOUT = 4 * MiB, OFF_WUP = 7 * MiB, OFF_WDOWN = 18 * MiB;

__device__ __forceinline__ void setup0(KP pp, LAS unsigned char* lds, int tid, int lane, int wave) {
    unsigned char* ws = pp->ws;
    {
        LAS float* scr = (LAS float*)(lds + wave * 16384);
        const int gw = blockIdx.x * 8 + wave, NGW = gridDim.x * 8;
        constexpr int I_IN = 16 * 56, I_UP = 16 * 176, I_DN = 44 * 32, I_OA = 8 * 32, I_OH = 4 * 32, I_L = I_IN + I_UP + I_DN + I_OA + I_OH;
        for (int it = gw; it < 2 * I_L; it += NGW) {
            const int l = it / I_L; int r = it % I_L;
            if (r < I_IN) { transpose_item(pp->in[I_WIN] + (size_t)l * DM * INW, INW, wlayer(ws, l, OFF_WIN), DM, 56, r, scr, lane); continue; } r -= I_IN;
            if (r < I_UP) { transpose_item(pp->in[I_WUP] + (size_t)l * DM * UPW, UPW, wlayer(ws, l, OFF_WUP), DM, 176, r, scr, lane); continue; } r -= I_UP;
            if (r < I_DN) { transpose_item(pp->in[I_WDOWN] + (size_t)l * DFF * DM, DM, wlayer(ws, l, OFF_WDOWN), DFF, 32, r, scr, lane); continue; } r -= I_DN;
            if (r < I_OA) { transpose_item(pp->in[I_WOUT] + (size_t)l * DM * DM, DM, wlayer(ws, l, OFF_WOUT), MIXK, 32, r, scr, lane); continue; } r -= I_OA;
            transpose_item(pp->in[I_WOUT] + (size_t)l * DM * DM + (size_t)768 * DM, DM, wlayer(ws, l, OFF_WOUT) + 1024, MIXK, 32, r, scr, lane);
        }
    }
    __syncthreads();
    constexpr int N_MOD = 192, N_MLP = 512 + 32 + 512, N_DFT = 4096 + 256, N_T = 1024, N_TAB = 1;
    constexpr int NIT = N_MOD + N_MLP + N_DFT + N_T + N_TAB;
    LAS float* fl = (LAS float*)lds;
    for (int it = blockIdx.x; it < NIT; it += gridDim.x) {
        int r = it;
        if (r < N_MOD) {
            const int l = r / 96, cb = (r % 96) / 8, kc = r % 8;
            for (int idx = tid; idx < 9 * 128; idx += 512) { const int rr = idx / 128, k = idx % 128; const float cv = rr < 8 ? pp->in[I_C][rr * DM + kc * 128 + k] : pp->in[I_CCTX][kc * 128 + k];
                fl[idx] = cv / (1.0f + __expf(-cv)); }
            __syncthreads();
            const int j = cb * 512 + tid; float acc[9];
#pragma unroll
            for (int rr = 0; rr < 9; ++rr) acc[rr] = 0.f;
            const float* wm = pp->in[I_WMOD] + (size_t)l * DM * 6144 + (size_t)(kc * 128) * 6144 + j;
            for (int k = 0; k < 128; ++k) { const float w = wm[(size_t)k * 6144];
#pragma unroll
                for (int rr = 0; rr < 9; ++rr) acc[rr] += fl[rr * 128 + k] * w; }
            float* mp = (float*)(ws + WS_MODP) + ((size_t)(l * 8 + kc) * 9) * 6144 + j;
#pragma unroll
            for (int rr = 0; rr < 9; ++rr) mp[(size_t)rr * 6144] = acc[rr];
            __syncthreads();
            continue;
        }
        r -= N_MOD;
        if (r < N_MLP) {
            int l, which, t0;
            if (r < 512) { l = 0; which = 0; t0 = r * 8; } else if (r < 544) { l = 0; which = 1; t0 = (r - 512) * 8; } else { l = 1; which = 0; t0 = (r - 544) * 8; }
            const int T = which ? CL : SL;
            LAS float* Z = fl; LAS float* H1 = fl + 8 * 36; LAS float* H2 = H1 + 512;
            if (tid < 128) { const int p = tid >> 4, i = tid & 15; const int t = t0 + p; const float band = 1e-4f + (float)i * ((15.0f - 1e-4f) / 15.0f);
                const float ang = ((6.2831855f * (float)t) / (float)T) * band; Z[p * 36 + 1 + i] = cosf(ang); Z[p * 36 + 17 + i] = -sinf(ang);
                if (i == 0) Z[p * 36] = (float)t / (float)(T - 1); }
            __syncthreads();
            { const int p = tid >> 6, j = tid & 63; const float* w1 = pp->in[I_HW1] + (size_t)l * 33 * 64; float s = pp->in[I_HB1][l * 64 + j];
              for (int i = 0; i < 33; ++i) s += Z[p * 36 + i] * w1[i * 64 + j];
              H1[p * 64 + j] = sinf(pp->in[I_HFR1][l * 64 + j] * s); }
            __syncthreads();
            { const int p = tid >> 6, j = tid & 63; const float* w2 = pp->in[I_HW2] + (size_t)l * 64 * 64; float s = pp->in[I_HB2][l * 64 + j];
              for (int i = 0; i < 64; ++i) s += H1[p * 64 + i] * w2[i * 64 + j];
              H2[p * 64 + j] = sinf(pp->in[I_HFR2][l * 64 + j] * s); }
            __syncthreads();
            { const int j = tid; const float* w3 = pp->in[I_HW3] + (size_t)l * 64 * 512 + j; float acc[8];
#pragma unroll
              for (int p = 0; p < 8; ++p) acc[p] = 0.f;
              for (int i = 0; i < 64; ++i) { const float w = w3[(size_t)i * 512];
#pragma unroll
                  for (int p = 0; p < 8; ++p) acc[p] += H2[p * 64 + i] * w; }
              const float da = -3.0701134573253944f, db = -15.350567286626972f;
              const float delta = fabsf(da + (float)(j & 255) * ((db - da) / 255.0f));
              float* hr = (float*)(ws + WS_HRAW) + (which ? (size_t)2 * 512 * SL : (size_t)l * 512 * SL) + (size_t)j * T + t0;
#pragma unroll
              for (int p = 0; p < 8; ++p) hr[p] = acc[p] * expf(-Z[p * 36] * delta); }
            __syncthreads();
            continue;
        }
        r -= N_MLP;
        if (r < N_DFT) {
            if (r < 4096) { bf16_t* row = (bf16_t*)(ws + WS_ADFT) + (size_t)r * 4096; const bool isS = r > 2048; const int k = isS ? r - 2048 : r;
                for (int t = tid; t < 4096; t += 512) { const int idx = (k * t) & 4095; const float x = (float)idx * (1.0f / 2048.0f); const float v = (isS ? sinpif(x) : cospif(x)) * (1.0f / 512.0f); row[t] = (bf16_t)f2bf(v); } }
            else { const int rr = r - 4096; bf16_t* row = (bf16_t*)(ws + WS_ADFTC) + (size_t)rr * 256; const bool isS = rr > 128; const int k = isS ? rr - 128 : rr;
                if (tid < 256) { const int idx = (k * tid) & 255; const float x = (float)idx * (1.0f / 128.0f); const float v = (isS ? sinpif(x) : cospif(x)) * (1.0f / 128.0f); row[tid] = (bf16_t)f2bf(v); } }
            continue;
        }
        r -= N_DFT;
        if (r < N_T) {
            const int l = r >> 9, kk = r & 511; const bool isS = kk >= 256; const int gc = kk & 255, g = gc >> 6, c = gc & 63;
            if (tid < 256) { const float* wf = pp->in[I_WF] + (size_t)l * 256 * 256 + (size_t)(g * 64) * 256 + tid; float s = 0.f;
                for (int m = 0; m < 64; ++m) { const float x = (float)((m * c) & 63) * (1.0f / 32.0f); const float tr = isS ? -sinpif(x) : cospif(x); s += tr * wf[(size_t)m * 256]; }
                ((float*)(ws + WS_T))[((size_t)l * 512 + kk) * 256 + tid] = s; }
            continue;
        }
        { f32x2* tw = (f32x2*)(ws + WS_TW);
          for (int i = tid; i < 4096; i += 512) { const float x = (float)i * (1.0f / 4096.0f); tw[i] = (f32x2){cospif(x), -sinpif(x)}; }
          f32x2* tw2 = (f32x2*)(ws + WS_TW + 65536);
          if (tid < 256) { const float x = (float)tid * (1.0f / 256.0f); tw2[tid] = (f32x2){cospif(x), -sinpif(x)}; }
          float* rope = (float*)(ws + WS_TW + 131072);
          for (int i = tid; i < 1024; i += 512) { const int p = i >> 4, q = i & 15; const float inv = powf(10000.0f, -(float)q / 16.0f); const float a = (float)p * inv; rope[i] = cosf(a); rope[1024 + i] = sinf(a); } }
    }
}

__device__ __forceinline__ void setup1(KP pp, LAS unsigned char* lds, int tid) {
    unsigned char* ws = pp->ws;
    { const int gt = blockIdx.x * 512 + tid, NGT = gridDim.x * 512;
      for (int idx = gt; idx < 2 * 9 * 6144; idx += NGT) { const int l = idx / (9 * 6144), rj = idx % (9 * 6144), j = rj % 6144; float s = pp->in[I_BMOD][l * 6144 + j];
#pragma unroll
          for (int kc = 0; kc < 8; ++kc) s += ((const float*)(ws + WS_MODP))[((size_t)(l * 8 + kc) * 9) * 6144 + rj];
          ((float*)(ws + WS_MOD))[idx] = s; } }
    constexpr int N_KF = 768, N_W2 = 2048;
    LAS float* fl = (LAS float*)lds;
    for (int it = blockIdx.x; it < N_KF + N_W2; it += gridDim.x) {
        if (it < N_KF) {
            if (it < 512) { const int l = it >> 8, ch = it & 255;
                kf_job<13>(lds, (const float*)(ws + WS_HRAW) + (size_t)l * 512 * SL, (const f32x2*)(ws + WS_TW), (f32x2*)(ws + WS_KF) + (size_t)l * 256 * 8192, ch, tid); }
            else { const int ch = it - 512;
                kf_job<9>(lds, (const float*)(ws + WS_HRAW) + (size_t)2 * 512 * SL, (const f32x2*)(ws + WS_TW + 65536), (f32x2*)(ws + WS_KFC), ch, tid); }
            continue;
        }
        const int r = it - N_KF; const int l = r >> 10, kk = (r >> 1) & 511, nh = r & 1;
        if (tid < 256) fl[tid] = ((const float*)(ws + WS_T))[((size_t)l * 512 + kk) * 256 + tid];
        __syncthreads();
        { const int n = nh * 512 + tid; const float* wo = pp->in[I_WOUT] + (size_t)l * DM * DM + (size_t)512 * DM + n; float s = 0.f;
          for (int j = 0; j < 256; ++j) s += fl[j] * wo[(size_t)j * DM];
          wlayer(ws, l, OFF_WOUT)[(size_t)n * MIXK + 512 + kk] = (bf16_t)f2bf(s); }
        __syncthreads();
    }
}

__global__ void __launch_bounds__(512, 2) mega_fwd(Params P) {
    extern __shared__ __attribute__((aligned(16))) unsigned char lds_raw[];
    LAS unsigned char* lds = (LAS unsigned char*)lds_raw;
    { volatile LAS unsigned* m0 = (volatile LAS unsigned*)(lds + MISC_OFF); if (threadIdx.x < 32) m0[threadIdx.x] = 0u; }
    __syncthreads();
    XcdBarrier xbar;
    { KP pb = kp_get(); xbar = xcd_barrier_post((unsigned*)(pb->ws + WS_CTL) + 4096, (volatile LAS unsigned*)(lds + MISC_OFF) + 8);
      if (pb->ph_lo < 0) cg::this_grid().sync(); }
    int ph = 0;
#define PH_BEGIN { KP pp = kp_get(); const int lo = pp->ph_lo, hi = pp->ph_hi; if (ph >= lo && ph < hi) { unsigned char* ws = pp->ws; const int tid = mk_tid(), lane = tid & 63, wave = __builtin_amdgcn_readfirstlane(tid >> 6); const int G = gridDim.x, gw = blockIdx.x * 8 + wave, NGW = G * 8; (void)lane; (void)gw; (void)NGW; PTRS
#define PH_END   if (ph + 1 < hi) xcd_barrier(xbar); } } ++ph;
#define PTRS \
    bf16_t* XN = (bf16_t*)(ws + WS_XN); bf16_t* Qb = (bf16_t*)(ws + WS_Q); bf16_t* Kb = (bf16_t*)(ws + WS_K); bf16_t* Vb = (bf16_t*)(ws + WS_V); \
    bf16_t* fT = (bf16_t*)(ws + WS_FT); bf16_t* fTc = (bf16_t*)(ws + WS_FTC); bf16_t* PT = (bf16_t*)(ws + WS_PT); bf16_t* PTc = (bf16_t*)(ws + WS_PTC); \
    bf16_t* MIXb = (bf16_t*)(ws + WS_MIX); bf16_t* Ub = (bf16_t*)(ws + WS_U); bf16_t* Gb = (bf16_t*)(ws + WS_G); \
    float* CX = (float*)(ws + WS_CX); const float* MOD = (const float*)(ws + WS_MOD); \
    const float* rope = (const float*)(ws + WS_TW + 131072); \
    volatile LAS int* misc = (volatile LAS int*)(lds + MISC_OFF); \
    (void)XN; (void)Qb; (void)Kb; (void)Vb; (void)fT; (void)fTc; (void)PT; (void)PTc; (void)MIXb; (void)Ub; (void)Gb; (void)CX; (void)MOD; (void)rope; (void)misc;

    REP(6) { PH_BEGIN EN(0) setup0(pp, lds, tid, lane, wave); PH_END --ph; } ++ph;
    REP(6) { PH_BEGIN EN(1) setup1(pp, lds, tid); PH_END --ph; } ++ph;
    PH_BEGIN EN(2) norm_rows(gw, NGW, lane, MT, pp->in[I_X], pp->in[I_CTX], nullptr, nullptr, nullptr, nullptr, nullptr, 0, XN, pp->in[I_GPREMIX], MOD, 1024, 0); PH_END

    for (int l = 0; l < 2; ++l) {
        const bool last = (l == 1);
        const int MR = last ? ML : MT;
        PH_BEGIN {
            pg8::Gemm g{XN, wlayer(ws, l, OFF_WIN), MT, INW, DM}; pg8::StaticOrder S; S.init(MT, INW, G, (int)blockIdx.x);
            EpiInProj E{Qb, Kb, Vb, fT, fTc, PT, PTc, pp->in[I_GQ] + l * 64, pp->in[I_GK] + l * 64, rope, (LAS float*)(lds + XCH_OFF)};
            REP(0) EN(3) pg8::gemm_phase<EpiInProj, pg8::StaticOrder, true, true>(lds, g, S, E);
        } PH_END
        PH_BEGIN {
            const int nF = last ? 128 : 136, nA = last ? 1024 : 1088, nH1 = last ? 1024 : 2048, nH = nH1 * (1 + ((MK_REP >> 7) & 1));
            for (;;) {
                KP pq = kp_get(); unsigned char* wq = pq->ws; const int tq = mk_tid();
                if (tq == 0) misc[0] = (int)atomicAdd((unsigned*)(wq + WS_CTL) + 64 * (1 + l), 1u);
                __syncthreads();
                int it = misc[0];
                __syncthreads();
                if (it >= nF + nA + nH) break;
                bf16_t* MIXq = (bf16_t*)(wq + WS_MIX);
                if (it < nF) {
                    if (it < 128) { pg8::Gemm g{(const bf16_t*)(wq + WS_ADFT), (const bf16_t*)(wq + WS_FT), 4096, 2048, 4096}; OneUnit S{it >> 3, it & 7}; EpiFourier E{MIXq, 2048, 0, SL};
                        REP(3) EN(4) pg8::gemm_phase<EpiFourier, OneUnit, false, true>(lds, g, S, E); }
                    else { pg8::Gemm g{(const bf16_t*)(wq + WS_ADFTC), (const bf16_t*)(wq + WS_FTC), 256, 2048, 256}; OneUnit S{0, it - 128}; EpiFourier E{MIXq, 128, ML, CL};
                        REP(3) EN(4) pg8::gemm_phase<EpiFourier, OneUnit, false, true>(lds, g, S, E); }
                    continue;
                }
                it -= nF;
                if (it < nA) {
                    const bf16_t* Qq = (const bf16_t*)(wq + WS_Q); const bf16_t* Kq = (const bf16_t*)(wq + WS_K); const bf16_t* Vq = (const bf16_t*)(wq + WS_V);
                    int b, h, NT; size_t qrow;
                    if (it < 1024) { b = it >> 7; h = (it >> 4) & 7; qrow = (size_t)b * SL + (it & 15) * 256; NT = KVB / 64; }
                    else { const int r = it - 1024; b = r >> 3; h = r & 7; qrow = (size_t)ML + b * CL; NT = CL / 64; }
                    const size_t kv0 = (size_t)b * KVB;
                    REP(1) EN(5) attn_unit(Qq + qrow * QP + h * 64, Kq + kv0 * KVP + (h >> 2) * 64, Vq + kv0 * KVP + (h >> 2) * 64, MIXq + qrow * MIXK + h * 64, NT, (char*)lds_raw);
                    continue;
                }
                it -= nA; if (it >= nH1) it -= nH1;
                const float* wc = pq->in[I_WHC] + (size_t)l * 3 * 768; const float* bc = pq->in[I_BHC] + (size_t)l * 768; const float* hb = pq->in[I_HBIAS] + (size_t)l * 256;
                REP(2) EN(6) { if (it < 1024) hyena_job<13>(lds, (const bf16_t*)(wq + WS_PT), (const f32x2*)(wq + WS_TW), (const f32x2*)(wq + WS_KF) + (size_t)l * 256 * 8192, wc, bc, hb, MIXq, 0, it >> 8, it & 255, tq);
                else { const int r = it - 1024; hyena_job<9>(lds, (const bf16_t*)(wq + WS_PTC), (const f32x2*)(wq + WS_TW + 65536), (const f32x2*)(wq + WS_KFC), wc, bc, hb, MIXq, ML, r >> 8, r & 255, tq); } }
            }
        } PH_END
        PH_BEGIN {
            pg8::Gemm g{MIXb, wlayer(ws, l, OFF_WOUT), MR, DM, MIXK}; pg8::StaticOrder S; S.init(MR, DM, G, (int)blockIdx.x);
            EpiPlain E{XN, DM};
            REP(5) EN(7) pg8::gemm_phase<EpiPlain, pg8::StaticOrder, true, true>(lds, g, S, E);
        } PH_END
        PH_BEGIN EN(2) norm_rows(gw, NGW, lane, MR, l == 0 ? pp->in[I_X] : pp->out, l == 0 ? pp->in[I_CTX] : CX, pp->out, CX, XN, pp->in[I_GPOSTMIX] + l * DM, (MOD + (size_t)l * 9 * 6144), 2048,
                           XN, pp->in[I_GPREFFN] + l * DM, (MOD + (size_t)l * 9 * 6144), 4096, 3072); PH_END
        for (int hf = 0; hf < 2; ++hf) {
            const int r0 = hf ? HALF_A : 0, nr = hf ? (MR - HALF_A) : HALF_A;
            PH_BEGIN {
                pg8::Gemm g{XN + (size_t)r0 * DM, wlayer(ws, l, OFF_WUP), nr, UPW, DM}; pg8::StaticOrder S; S.init(nr, UPW, G, (int)blockIdx.x);
                EpiPlain E{Ub, UPW};
                REP(4) EN(8) pg8::gemm_phase<EpiPlain, pg8::StaticOrder, true, true>(lds, g, S, E);
            } PH_END
            PH_BEGIN REP(4) EN(9) glu_pass((int)blockIdx.x, G, tid, r0, nr, Ub, Gb, pp->in[I_WFC] + (size_t)l * 3 * UPW, pp->in[I_BFC] + (size_t)l * UPW); PH_END
            PH_BEGIN {
                pg8::Gemm g{Gb, wlayer(ws, l, OFF_WDOWN), nr, DM, DFF}; pg8::StaticOrder S; S.init(nr, DM, G, (int)blockIdx.x);
                EpiPlain E{XN + (size_t)r0 * DM, DM};
                REP(4) EN(10) pg8::gemm_phase<EpiPlain, pg8::StaticOrder, true, true>(lds, g, S, E);
            } PH_END
        }
        PH_BEGIN EN(2) norm_rows(gw, NGW, lane, MR, pp->out, CX, pp->out, CX, XN, pp->in[I_GPOSTFFN] + l * DM, (MOD + (size_t)l * 9 * 6144), 5120,
                           last ? nullptr : XN, pp->in[I_GPREMIX] + (last ? 0 : (l + 1) * DM), MOD + (size_t)(last ? 0 : (l + 1)) * 9 * 6144, 1024, 0); PH_END
    }
}

constexpr int N_PHASES = 3 + 2 * 11;
#ifndef MK_MULTI
#define MK_MULTI 0
#endif
extern "C" void kernel_launch(void* const* d_in, const int* in_sizes, int n_in, void* d_out, int out_size, void* d_ws, size_t ws_size, hipStream_t stream) {
    static int grid = 0;
    if (grid == 0) {
        if (n_in != 29 || ws_size < WS_END) { fprintf(stderr, "kernel_launch: bad args n_in %d ws %zu (need %zu)\n", n_in, ws_size, (size_t)WS_END); grid = -1; return; }
        int dev = 0, cus = 0, per_cu = 0;
        hipGetDevice(&dev); hipDeviceGetAttribute(&cus, hipDeviceAttributeMultiprocessorCount, dev);
        if (hipFuncSetAttribute((const void*)mega_fwd, hipFuncAttributeMaxDynamicSharedMemorySize, LDS_BYTES) != hipSuccess) { fprintf(stderr, "hipFuncSetAttribute failed\n"); grid = -1; return; }
        if (hipOccupancyMaxActiveBlocksPerMultiprocessor(&per_cu, (const void*)mega_fwd, 512, LDS_BYTES) != hipSuccess || per_cu < 1) { fprintf(stderr, "occupancy query: %d\n", per_cu); per_cu = 1; }
        (void)hipGetLastError();
        grid = cus * 1;
    }
    if (grid < 0) return;
    hipMemsetAsync((char*)d_ws + WS_CTL, 0, 1 * MiB, stream);
    Params p{};
    for (int i = 0; i < 29; ++i) p.in[i] = (const float*)d_in[i];
    p.out = (float*)d_out; p.ws = (unsigned char*)d_ws;
#if MK_MULTI
    for (int k = 0; k < N_PHASES; ++k) { p.ph_lo = k; p.ph_hi = k + 1; hipLaunchKernelGGL(mega_fwd, dim3(grid), dim3(512), LDS_BYTES, stream, p); }
#else
    p.ph_lo = 0; p.ph_hi = N_PHASES;
    void* args[] = {&p};
    hipError_t e = hipLaunchCooperativeKernel((const void*)mega_fwd, dim3(grid), dim3(512), args, LDS_BYTES, stream);
    if (e != hipSuccess) fprintf(stderr, "cooperative launch failed: %s (grid %d)\n", hipGetErrorString(e), grid);
#endif
}
```

```cpp
#define MK_REP 0
#include <hip/hip_runtime.h>
#include <hip/hip_cooperative_groups.h>
#include <hip/hip_bf16.h>
#include <cstdio>
#include <cstdint>
#include <cmath>
namespace cg = cooperative_groups;
__device__ __forceinline__ int mk_tid() { int t = threadIdx.x; asm volatile("" : "+v"(t)); return t; }
namespace pg8 {
#define PG8_LAS __attribute__((address_space(3)))
typedef unsigned short bf16_t;
typedef short bf16x8 __attribute__((ext_vector_type(8)));
typedef float f32x4 __attribute__((ext_vector_type(4)));
typedef unsigned u32x4 __attribute__((ext_vector_type(4)));
constexpr int BM = 256, BK = 64, HALF = 128, HTB = HALF * BK * 2  , STAGE_BYTES = 8 * HTB, NXCD = 8, WGM = 8;

__host__ __device__ __forceinline__ int lds_byte(int r, int c) { const int st = (r >> 4) * 2 + (c >> 5), rr = r & 15, cc = c & 31, ob = rr * 64 + cc * 2; return st * 1024 + (ob ^ (((ob >> 9) & 1) << 5)); }
__host__ __device__ __forceinline__ void stage_rc(int b, int& R, int& C) { const int st = b / 1024, sb = b % 1024, swz = sb ^ (((sb >> 9) & 1) << 5); R = (st >> 1) * 16 + swz / 64; C = (st & 1) * 32 + (swz % 64) / 2; }
__host__ __device__ __forceinline__ int perm32(int rho) { const int n = rho >> 4, i = rho & 15; return 8 * (i >> 2) + 4 * n + (i & 3); }

struct Unit { int pm, pn; };
struct Gemm { const bf16_t* A; const bf16_t* Bt; int M, N, K; };

struct StaticOrder {
    int nM, nN, nwg, G, c;
    __host__ __device__ void init(int M, int N, int G_, int c_) { nM = M / BM; nN = N / BM; nwg = nM * nN; G = G_; c = c_; }
    __host__ __device__ bool next(int i, Unit& u) const {
        const long L = (long)i * G + c; if (L >= nwg) return false;
        int wgid = (int)L; { const int q = nwg / NXCD, r = nwg % NXCD, xcd = wgid % NXCD, off = wgid / NXCD; wgid = (xcd < r ? xcd * (q + 1) : r * (q + 1) + (xcd - r) * q) + off; }
        const int nig = WGM * nN, gid = wgid / nig, fm = gid * WGM, gsz = (nM - fm) < WGM ? (nM - fm) : WGM;
        u.pm = fm + ((wgid % nig) % gsz); u.pn = (wgid % nig) / gsz; return true;
    }
    __device__ __forceinline__ void a_ready(const Unit&) const {}
    __device__ __forceinline__ void done(const Unit&) const {}
};
__device__ __forceinline__ unsigned cvt_pk_bf16(float lo, float hi) { unsigned r; asm volatile("v_cvt_pk_bf16_f32 %0, %1, %2" : "=v"(r) : "v"(lo), "v"(hi)); return r; }
typedef float f32x2 __attribute__((ext_vector_type(2)));
template <class Epi, class Sched, bool ALIGN_EPI = false, bool SP2 = false>
__device__ __forceinline__ void gemm_phase(PG8_LAS unsigned char* lds, const Gemm g, const Sched& S, const Epi& E) {
    const int tid = mk_tid(), wid = __builtin_amdgcn_readfirstlane(tid >> 6), lane = tid & 63, wr = wid >> 2, wc = wid & 3, fr = lane & 15, fq = lane >> 4;
    const int K = g.K, nt = K / BK;
    unsigned voffA[2], voffB[2];
#pragma unroll
    for (int i = 0; i < 2; ++i) { int R, C; stage_rc(tid * 16 + i * 8192, R, C); const int Rb = Epi::PERM ? ((R & ~31) + perm32(R & 31)) : R;
        voffA[i] = (unsigned)(R * K + C) * 2u; voffB[i] = (unsigned)(Rb * K + C) * 2u; }
    const size_t kstep = (size_t)(BK * 2);
    const size_t hstep = (size_t)HALF * K * 2;
    const size_t tstep = 2 * hstep;
    const unsigned ldsw = (unsigned)wid * 1024u;
    const int aoff = lds_byte(wr * 64 + fr, fq * 8), boff = lds_byte(wc * 32 + fr, fq * 8);
#define PG8_SA(b, h) (((b) * 2 + (h)) * HTB)
#define PG8_SB(b, h) ((4 + (b) * 2 + (h)) * HTB)
#define PG8_STAGE(bufoff, gbase, voff) do { _Pragma("unroll") for (int _i = 0; _i < 2; ++_i) \
        __builtin_amdgcn_global_load_lds((const unsigned*)((const char*)(gbase) + (voff)[_i]), (PG8_LAS unsigned*)(lds + (bufoff) + ldsw + _i * 8192), 16, 0, 0); } while (0)
#define PG8_LDA(dst, b, h) do { _Pragma("unroll") for (int m = 0; m < 4; ++m) _Pragma("unroll") for (int k = 0; k < 2; ++k) dst[m][k] = *(const PG8_LAS bf16x8*)(lds + PG8_SA(b, h) + aoff + m * 2048 + k * 1024); } while (0)
#define PG8_LDB(dst, b, h) do { _Pragma("unroll") for (int n = 0; n < 2; ++n) _Pragma("unroll") for (int k = 0; k < 2; ++k) dst[n][k] = *(const PG8_LAS bf16x8*)(lds + PG8_SB(b, h) + boff + n * 2048 + k * 1024); } while (0)
#define PG8_MMA(ai, bj, At, Bt) do { __builtin_amdgcn_s_setprio(1); _Pragma("unroll") for (int m = 0; m < 4; ++m) _Pragma("unroll") for (int n = 0; n < 2; ++n) _Pragma("unroll") for (int k = 0; k < 2; ++k) \
        acc[ai][bj][m][n] = __builtin_amdgcn_mfma_f32_16x16x32_bf16(Bt[n][k], At[m][k], acc[ai][bj][m][n], 0, 0, 0); __builtin_amdgcn_s_setprio(0); } while (0)
#define PG8_WAIT_V(n) asm volatile("s_waitcnt vmcnt(" #n ")" ::: "memory")
#define PG8_WAIT_L(n) asm volatile("s_waitcnt lgkmcnt(" #n ")" ::: "memory")
#define PG8_BAR __builtin_amdgcn_s_barrier()
#define PG8_SCHED __builtin_amdgcn_sched_barrier(0)
    Unit cur, nxt; int ui = 0;
    if (!S.next(0, cur)) return;
    f32x4 acc[2][2][4][2];
#pragma unroll
    for (int a = 0; a < 2; ++a)
#pragma unroll
        for (int b = 0; b < 2; ++b)
#pragma unroll
            for (int m = 0; m < 4; ++m)
#pragma unroll
                for (int n = 0; n < 2; ++n) acc[a][b][m][n] = (f32x4){0.f, 0.f, 0.f, 0.f};
    bf16x8 At[4][2], B0[2][2], B1[2][2];
    const char* cA = (const char*)g.A + (size_t)cur.pm * tstep; const char* cB = (const char*)g.Bt + (size_t)cur.pn * tstep;
    S.a_ready(cur);
    if constexpr (SP2) {
        PG8_STAGE(PG8_SB(0, 0), cB, voffB); PG8_STAGE(PG8_SB(0, 1), cB + hstep, voffB); PG8_STAGE(PG8_SA(0, 0), cA, voffA); PG8_STAGE(PG8_SA(0, 1), cA + hstep, voffA);
        if (wr == 1) PG8_BAR;
        PG8_WAIT_V(2); PG8_BAR;
        PG8_STAGE(PG8_SB(1, 0), cB + kstep, voffB); PG8_STAGE(PG8_SA(1, 0), cA + kstep, voffA); PG8_STAGE(PG8_SB(1, 1), cB + hstep + kstep, voffB);
        PG8_WAIT_V(6); PG8_BAR;
    } else {
        PG8_STAGE(PG8_SB(0, 0), cB, voffB); PG8_STAGE(PG8_SA(0, 0), cA, voffA); PG8_STAGE(PG8_SB(0, 1), cB + hstep, voffB); PG8_STAGE(PG8_SA(0, 1), cA + hstep, voffA);
        if (wr == 1) PG8_BAR;
        PG8_WAIT_V(4); PG8_BAR;
        PG8_STAGE(PG8_SB(1, 0), cB + kstep, voffB); PG8_STAGE(PG8_SA(1, 0), cA + kstep, voffA); PG8_STAGE(PG8_SB(1, 1), cB + hstep + kstep, voffB);
        PG8_WAIT_V(6); PG8_BAR;
    }
    for (;;) {
        const bool has_next = S.next(ui + 1, nxt);
        const char* nA = has_next ? (const char*)g.A + (size_t)nxt.pm * tstep : cA; const char* nB = has_next ? (const char*)g.Bt + (size_t)nxt.pn * tstep : cB;
        for (int t = 0; t < nt; t += 2) {
            const bool last = (t == nt - 2);
            const char* a1 = cA + (size_t)(t + 1) * kstep;
            const char* a2 = last ? nA : cA + (size_t)(t + 2) * kstep; const char* b2 = last ? nB : cB + (size_t)(t + 2) * kstep;
            const char* a3 = a2 + kstep; const char* b3 = b2 + kstep;
            if (last && has_next) S.a_ready(nxt);
            if constexpr (SP2) {
            PG8_LDB(B0, 0, 0); PG8_LDB(B1, 0, 1); PG8_SCHED; PG8_LDA(At, 0, 0); PG8_STAGE(PG8_SA(1, 1), a1 + hstep, voffA);
            PG8_WAIT_V(8); PG8_WAIT_L(0); PG8_BAR; PG8_MMA(0, 0, At, B0); PG8_MMA(0, 1, At, B1); PG8_BAR; PG8_SCHED;
            PG8_LDA(At, 0, 1); PG8_STAGE(PG8_SB(0, 0), b2, voffB); PG8_STAGE(PG8_SB(0, 1), b2 + hstep, voffB); PG8_STAGE(PG8_SA(0, 0), a2, voffA);
            PG8_WAIT_V(8); PG8_WAIT_L(0); PG8_BAR; PG8_MMA(1, 0, At, B0); PG8_MMA(1, 1, At, B1); PG8_BAR; PG8_SCHED;
            PG8_LDB(B0, 1, 0); PG8_LDB(B1, 1, 1); PG8_SCHED; PG8_LDA(At, 1, 0); PG8_STAGE(PG8_SA(0, 1), a2 + hstep, voffA);
            PG8_WAIT_V(8); PG8_WAIT_L(0); PG8_BAR; PG8_MMA(0, 0, At, B0); PG8_MMA(0, 1, At, B1); PG8_BAR; PG8_SCHED;
            PG8_LDA(At, 1, 1); PG8_STAGE(PG8_SB(1, 0), b3, voffB); PG8_STAGE(PG8_SB(1, 1), b3 + hstep, voffB); PG8_STAGE(PG8_SA(1, 0), a3, voffA);
            PG8_WAIT_V(8); PG8_WAIT_L(0); PG8_BAR; PG8_MMA(1, 0, At, B0); PG8_MMA(1, 1, At, B1); PG8_BAR; PG8_SCHED;
            } else {
            PG8_LDB(B0, 0, 0); PG8_SCHED; PG8_LDA(At, 0, 0); PG8_STAGE(PG8_SA(1, 1), a1 + hstep, voffA);
            PG8_WAIT_L(8); PG8_BAR; PG8_WAIT_L(0); PG8_MMA(0, 0, At, B0); PG8_BAR; PG8_SCHED;
            PG8_LDB(B1, 0, 1); PG8_STAGE(PG8_SB(0, 0), b2, voffB);
            PG8_BAR; PG8_WAIT_L(0); PG8_MMA(0, 1, At, B1); PG8_BAR;
            PG8_LDA(At, 0, 1); PG8_STAGE(PG8_SA(0, 0), a2, voffA);
            PG8_BAR; PG8_WAIT_L(0); PG8_MMA(1, 0, At, B0); PG8_BAR; PG8_SCHED;
            PG8_STAGE(PG8_SB(0, 1), b2 + hstep, voffB);
            PG8_WAIT_V(6); PG8_BAR; PG8_MMA(1, 1, At, B1); PG8_BAR;
            PG8_LDB(B0, 1, 0); PG8_SCHED; PG8_LDA(At, 1, 0); PG8_STAGE(PG8_SA(0, 1), a2 + hstep, voffA);
            PG8_WAIT_L(8); PG8_BAR; PG8_WAIT_L(0); PG8_MMA(0, 0, At, B0); PG8_BAR; PG8_SCHED;
            PG8_LDB(B1, 1, 1); PG8_STAGE(PG8_SB(1, 0), b3, voffB);
            PG8_BAR; PG8_WAIT_L(0); PG8_MMA(0, 1, At, B1); PG8_BAR;
            PG8_LDA(At, 1, 1); PG8_STAGE(PG8_SA(1, 0), a3, voffA);
            PG8_BAR; PG8_WAIT_L(0); PG8_MMA(1, 0, At, B0); PG8_BAR; PG8_SCHED;
            PG8_STAGE(PG8_SB(1, 1), b3 + hstep, voffB);
            PG8_WAIT_V(6); PG8_BAR; PG8_MMA(1, 1, At, B1); PG8_BAR;
            }
        }
        if constexpr (ALIGN_EPI) { if (wr == 0) PG8_BAR; }
        if constexpr (!Epi::AFTER_DRAIN) { E(acc, cur, wr, wc, fr, fq); S.done(cur); }
        if (!has_next) break;
#pragma unroll
        for (int a = 0; a < 2; ++a)
#pragma unroll
            for (int b = 0; b < 2; ++b)
#pragma unroll
                for (int m = 0; m < 4; ++m)
#pragma unroll
                    for (int n = 0; n < 2; ++n) acc[a][b][m][n] = (f32x4){0.f, 0.f, 0.f, 0.f};
        cur = nxt; cA = nA; cB = nB; ++ui;
        if constexpr (ALIGN_EPI) { if (wr == 1) PG8_BAR; }
    }
    PG8_WAIT_V(0);
    if constexpr (!ALIGN_EPI) { if (wr == 0) PG8_BAR; }
    PG8_BAR;
    if constexpr (Epi::AFTER_DRAIN) { E.fused(acc, cur, wr, wc, fr, fq, lds, wid, lane); S.done(cur); }
#undef PG8_SA
#undef PG8_SB
#undef PG8_STAGE
#undef PG8_LDA
#undef PG8_LDB
#undef PG8_MMA
#undef PG8_WAIT_V
#undef PG8_WAIT_L
#undef PG8_BAR
#undef PG8_SCHED
}
}
namespace attn_body {
using bf16=__hip_bfloat16;
using bf16x8=__attribute__((ext_vector_type(8)))short;
using s16x4=__attribute__((ext_vector_type(4)))short;
using f32x16=__attribute__((ext_vector_type(16)))float;
using u32x4=__attribute__((ext_vector_type(4)))unsigned;
__device__ __forceinline__ int crow(int r,int hi){return (r&3)+8*(r>>2)+4*hi;}
#define SBAR() __builtin_amdgcn_sched_barrier(0)
__device__ __forceinline__ void glds16(const void*gsrc,unsigned lds_dst){unsigned keep;
  asm volatile("s_mov_b32 %0, m0\n\ts_mov_b32 m0, %2\n\ts_nop 0\n\tglobal_load_lds_dwordx4 %1, off\n\ts_mov_b32 m0, %0":"=&s"(keep):"v"(gsrc),"s"(lds_dst):"memory");}
typedef float f32x2_t __attribute__((ext_vector_type(2))); typedef __bf16 bf16x2_t __attribute__((ext_vector_type(2)));
__device__ __forceinline__ unsigned cvtpk_s(float lo,float hi){f32x2_t v={lo,hi};bf16x2_t b=__builtin_convertvector(v,bf16x2_t);return __builtin_bit_cast(unsigned,b);}
#define WAIT_BAR(N) asm volatile("s_waitcnt vmcnt(" #N ") lgkmcnt(0)\n\ts_barrier":::"memory")
__device__ __forceinline__ void qkt(f32x16&p0,f32x16&p1,const char*Kslot,const bf16x8*qr,const f32x16&negm,int r32,int hi){
  const char*kb=Kslot+hi*1024+r32*16;
  #pragma unroll
  for(int d0=0;d0<4;++d0){
    const bf16x8 b0=*reinterpret_cast<const bf16x8*>(kb+d0*2048);
    const bf16x8 b1=*reinterpret_cast<const bf16x8*>(kb+d0*2048+512);
    if(d0==0){p0=__builtin_amdgcn_mfma_f32_32x32x16_bf16(b0,qr[0],negm,0,0,0);p1=__builtin_amdgcn_mfma_f32_32x32x16_bf16(b1,qr[0],negm,0,0,0);}
    else{p0=__builtin_amdgcn_mfma_f32_32x32x16_bf16(b0,qr[d0],p0,0,0,0);p1=__builtin_amdgcn_mfma_f32_32x32x16_bf16(b1,qr[d0],p1,0,0,0);}}
}
__device__ __forceinline__ void pv(f32x16*o,int vb,bf16x8 pa0,bf16x8 pa1,bf16x8 pa2,bf16x8 pa3){
  #pragma unroll
  for(int d0=0;d0<2;++d0){s16x4 lo[4],hi[4];
    #pragma unroll
    for(int ks=0;ks<4;++ks){
      asm volatile("ds_read_b64_tr_b16 %0,%1 offset:%c2":"=&v"(lo[ks]):"v"(vb),"i"(d0*4096+ks*1024):"memory");
      asm volatile("ds_read_b64_tr_b16 %0,%1 offset:%c2":"=&v"(hi[ks]):"v"(vb),"i"(d0*4096+ks*1024+512):"memory");}
    asm volatile("s_waitcnt lgkmcnt(0)":::"memory");SBAR();
    #define PK(k) (bf16x8){lo[k][0],lo[k][1],lo[k][2],lo[k][3],hi[k][0],hi[k][1],hi[k][2],hi[k][3]}
    o[d0]=__builtin_amdgcn_mfma_f32_32x32x16_bf16(pa0,PK(0),o[d0],0,0,0);
    o[d0]=__builtin_amdgcn_mfma_f32_32x32x16_bf16(pa1,PK(1),o[d0],0,0,0);
    o[d0]=__builtin_amdgcn_mfma_f32_32x32x16_bf16(pa2,PK(2),o[d0],0,0,0);
    o[d0]=__builtin_amdgcn_mfma_f32_32x32x16_bf16(pa3,PK(3),o[d0],0,0,0);
    #undef PK
  }
}
constexpr int QBLK=32,KVBLK=64,NW=8;
constexpr int NSLOT=3, SLOTB=8192;
constexpr int LDS_K=0, LDS_V=NSLOT*SLOTB, LDS_WS=2*NSLOT*SLOTB, LDS_OST=LDS_WS+NW*64*4, LDS_BYTES=LDS_OST+NW*4096;
__device__ __forceinline__ float max3f(float a,float b,float c){float r;asm("v_max3_f32 %0, %1, %2, %3":"=v"(r):"v"(a),"v"(b),"v"(c));return r;}
__device__ __forceinline__ float max2f(float a,float b){float r;asm("v_max_f32_e32 %0, %1, %2":"=v"(r):"v"(a),"v"(b));return r;}
__device__ __forceinline__ float fadd_s(float a,float b){float r;asm("v_add_f32_e32 %0, %1, %2":"=v"(r):"v"(a),"v"(b));return r;}
__device__ __forceinline__ float fsub_s(float a,float b){float r;asm("v_sub_f32_e32 %0, %1, %2":"=v"(r):"v"(a),"v"(b));return r;}
typedef __attribute__((address_space(3))) const char* lds_cptr;
typedef short v4i16_t __attribute__((ext_vector_type(4)));
__device__ __forceinline__ void kload8(bf16x8*kf,lds_cptr kp){
  kf[0]=*(const __attribute__((address_space(3))) bf16x8*)(kp);      kf[1]=*(const __attribute__((address_space(3))) bf16x8*)(kp+512);
  kf[2]=*(const __attribute__((address_space(3))) bf16x8*)(kp+2048); kf[3]=*(const __attribute__((address_space(3))) bf16x8*)(kp+2560);
  kf[4]=*(const __attribute__((address_space(3))) bf16x8*)(kp+4096); kf[5]=*(const __attribute__((address_space(3))) bf16x8*)(kp+4608);
  kf[6]=*(const __attribute__((address_space(3))) bf16x8*)(kp+6144); kf[7]=*(const __attribute__((address_space(3))) bf16x8*)(kp+6656);
}
__device__ __forceinline__ void kload2(bf16x8*kf,lds_cptr kp,int j){ kf[2*j]=*(const __attribute__((address_space(3))) bf16x8*)(kp+j*2048); kf[2*j+1]=*(const __attribute__((address_space(3))) bf16x8*)(kp+j*2048+512); }
__device__ __forceinline__ s16x4 vtr(lds_cptr p){ return __builtin_bit_cast(s16x4,__builtin_amdgcn_ds_read_tr16_b64_v4i16((__attribute__((address_space(3))) v4i16_t*)p)); }
__device__ __forceinline__ float rowmax(const f32x16&p0,const f32x16&p1){
  float a=max3f(p0[0],p0[1],p1[0]),b=max3f(p0[2],p0[3],p1[1]);a=max3f(a,p1[2],p1[3]);
  #pragma unroll
  for(int r=4;r<16;r+=4){a=max3f(a,p0[r],p0[r+1]);b=max3f(b,p0[r+2],p0[r+3]);a=max3f(a,p1[r],p1[r+1]);b=max3f(b,p1[r+2],p1[r+3]);}
  const float m=max2f(a,b);
  auto rr=__builtin_amdgcn_permlane32_swap(__float_as_uint(m),__float_as_uint(m),false,false);
  return max2f(__uint_as_float(rr[0]),__uint_as_float(rr[1]));
}
template<int THRL> __device__ __forceinline__ void attn_unit2(const bf16*Qu,const bf16*__restrict__ Kh,const bf16*__restrict__ Vh,bf16*Ou,const int NT,char*shm){
  constexpr int QPITCH=512,KVPITCH=128,OPITCH=1280;
  const int tid=mk_tid(),lane=tid&63,r32=lane&31,hi=lane>>5; const int wid=__builtin_amdgcn_readfirstlane(tid>>6);
  const bf16*Qw=Qu+(long)(wid*QBLK)*QPITCH;
  const unsigned lds0=(unsigned)(uintptr_t)shm;
  float*wsf=(float*)(shm+LDS_WS)+wid*64;
  const bf16*ksrc=Kh+(long)lane*KVPITCH+wid*8;
  const bf16*vsrc=Vh+(long)(16*(wid&3)+(lane>>2))*KVPITCH+(wid>>2)*32+(lane&3)*8;
  const unsigned kdst=lds0+LDS_K+wid*1024, vdst=lds0+LDS_V+wid*1024;
  #define DMA_K(t,slot) glds16(ksrc+(long)(t)*KVBLK*KVPITCH,(unsigned)__builtin_amdgcn_readfirstlane(kdst+(slot)))
  #define DMA_V(t,slot) glds16(vsrc+(long)(t)*KVBLK*KVPITCH,(unsigned)__builtin_amdgcn_readfirstlane(vdst+(slot)))
  const int vb0=(int)(lds0+LDS_V)+((lane>>4)&1)*32+(lane&3)*8+(4*hi+((lane&15)>>2))*64;
  const char*Kbase=shm+LDS_K; bf16x8 kf[8];
  const lds_cptr shm3=(lds_cptr)shm; const lds_cptr kp0=shm3+LDS_K+hi*1024+r32*16; const lds_cptr vp0=shm3+LDS_V+((lane>>4)&1)*32+(lane&3)*8+(4*hi+((lane&15)>>2))*64;
  DMA_K(0,0);DMA_V(0,0);DMA_K(1,SLOTB);
  bf16x8 qr[4];
  #pragma unroll
  for(int d0=0;d0<4;++d0)qr[d0]=*reinterpret_cast<const bf16x8*>(&Qw[(long)r32*QPITCH+d0*16+hi*8]);
  float mhat=0.f,l_reg=0.f;f32x16 o[2];o[0]=f32x16{};o[1]=f32x16{};f32x16 negm=f32x16{};asm volatile("":"+v"(negm));
  #define CMASK(P0,P1,t) do{}while(0)
  bool resc=false;
  #define START(P0,P1) do{ const float rm=rowmax(P0,P1); resc=false; \
    { const float dl=rm; mhat=fadd_s(mhat,dl); \
      _Pragma("unroll") for(int r=0;r<16;++r){P0[r]=fsub_s(P0[r],dl);P1[r]=fsub_s(P1[r],dl);} \
      _Pragma("unroll") for(int r=0;r<16;++r)negm[r]=-mhat; asm volatile("":"+v"(negm)); } \
    _Pragma("unroll") for(int r=0;r<16;++r)P0[r]=__builtin_amdgcn_exp2f(P0[r]); }while(0)
  #define RESC() do{ if(resc){ asm volatile("s_waitcnt lgkmcnt(0)":::"memory"); \
      _Pragma("unroll") for(int d_=0;d_<2;++d_) _Pragma("unroll") for(int r=0;r<16;++r)o[d_][r]*=wsf[crow(r,hi)]; } }while(0)
  f32x16 pA0,pA1,pB0,pB1;
  int sl_prev=0,sl_cur=0,sl_next=SLOTB;
  #define ROT() do{sl_prev=sl_cur;sl_cur=sl_next;sl_next=(sl_next==(NSLOT-1)*SLOTB)?0:sl_next+SLOTB;}while(0)
  DMA_K(2,2*SLOTB);
  WAIT_BAR(3);
  qkt(pA0,pA1,Kbase,qr,negm,r32,hi);asm volatile("s_nop 15\n\ts_nop 7":"+v"(pA0),"+v"(pA1));CMASK(pA0,pA1,0);
  START(pA0,pA1);
  _Pragma("unroll") for(int r=0;r<16;++r)pA1[r]=__builtin_amdgcn_exp2f(pA1[r]);
  WAIT_BAR(0);
  DMA_K(3,0);DMA_V(1,SLOTB);
  ROT();
  kload8(kf,kp0+sl_cur);
  WAIT_BAR(2);
  s16x4 vlo[8],vhi[8]; u32x4 pw0,pw1,pw2,pw3;
  #define PKW(P,B) cvtpk_s(P[B],P[B+1])
  #define PAF(k) __builtin_bit_cast(bf16x8,pw##k)
  #define VFR(i) (bf16x8){vlo[i][0],vlo[i][1],vlo[i][2],vlo[i][3],vhi[i][0],vhi[i][1],vhi[i][2],vhi[i][3]}
  #define PIN(x) asm volatile("":"+v"(x))
  #define MX3(a,b,c) __builtin_fmaxf(__builtin_fmaxf((a),(b)),(c))
  #define GAPA(MF,A0,A1,A2,A3,W0,W1,PW) do{ MF; sacc+=A0; sacc+=A1; sacc+=A2; sacc+=A3; PIN(sacc); W0; W1; PIN(PW); SBAR(); }while(0)
  #define EX(v) __builtin_amdgcn_exp2f(v)
  #define GAPB(MF,X,B) do{ MF; X[B]=EX(X[B]); X[B+1]=EX(X[B+1]); X[B+2]=EX(X[B+2]); X[B+3]=EX(X[B+3]); PIN(X); SBAR(); }while(0)
  #define VRD(i) do{ vlo[i]=vtr(vp_+(((i)>>2)*4096+((i)&3)*1024)); vhi[i]=vtr(vp_+(((i)>>2)*4096+((i)&3)*1024+512)); }while(0)
  #define KRD(G,j) do{ if(G){ kload2(kf,kp0+sl_next,j); SBAR(); } }while(0)
  #define STEP(C0,C1,P0,P1,t,GK,GV,GL) do{ SBAR(); \
    const lds_cptr vp_=vp0+sl_prev; \
    VRD(0); SBAR(); float sacc=(P0[0]+P0[1]); \
    GAPA(C0=__builtin_amdgcn_mfma_f32_32x32x16_bf16(kf[0],qr[0],negm,0,0,0), P0[2],P0[3],P0[4],P0[5],     pw0[0]=PKW(P0,0), pw0[1]=PKW(P0,2), pw0); \
    VRD(4); SBAR(); GAPA(C1=__builtin_amdgcn_mfma_f32_32x32x16_bf16(kf[1],qr[0],negm,0,0,0), P0[6],P0[7],P0[8],P0[9],     pw0[2]=PKW(P0,4), pw0[3]=PKW(P0,6), pw0); \
    VRD(1); SBAR(); GAPA(C0=__builtin_amdgcn_mfma_f32_32x32x16_bf16(kf[2],qr[1],C0,0,0,0),   P0[10],P0[11],P0[12],P0[13], pw1[0]=PKW(P0,8), pw1[1]=PKW(P0,10), pw1); \
    VRD(5); SBAR(); GAPA(C1=__builtin_amdgcn_mfma_f32_32x32x16_bf16(kf[3],qr[1],C1,0,0,0),   P0[14],P0[15],P1[0],P1[1],   pw1[2]=PKW(P0,12),pw1[3]=PKW(P0,14), pw1); \
    VRD(2); SBAR(); GAPA(C0=__builtin_amdgcn_mfma_f32_32x32x16_bf16(kf[4],qr[2],C0,0,0,0),   P1[2],P1[3],P1[4],P1[5],     pw2[0]=PKW(P1,0), pw2[1]=PKW(P1,2), pw2); \
    VRD(6); SBAR(); GAPA(C1=__builtin_amdgcn_mfma_f32_32x32x16_bf16(kf[5],qr[2],C1,0,0,0),   P1[6],P1[7],P1[8],P1[9],     pw2[2]=PKW(P1,4), pw2[3]=PKW(P1,6), pw2); \
    VRD(3); SBAR(); GAPA(C0=__builtin_amdgcn_mfma_f32_32x32x16_bf16(kf[6],qr[3],C0,0,0,0),   P1[10],P1[11],P1[12],P1[13], pw3[0]=PKW(P1,8), pw3[1]=PKW(P1,10), pw3); \
    VRD(7); SBAR(); GAPA(C1=__builtin_amdgcn_mfma_f32_32x32x16_bf16(kf[7],qr[3],C1,0,0,0),   P1[14],P1[15],0.f,0.f,       pw3[2]=PKW(P1,12),pw3[3]=PKW(P1,14), pw3); \
    l_reg+=sacc; \
    if(GK){DMA_K((t)+3,sl_cur);} if(GV){DMA_V((t)+1,sl_next);} \
    CMASK(C0,C1,t); \
    { float a=MX3(C0[0],C0[1],C1[0]),b=MX3(C0[2],C0[3],C1[1]); a=MX3(a,C1[2],C1[3]); \
      _Pragma("unroll") for(int r=4;r<16;r+=4){a=MX3(a,C0[r],C0[r+1]);b=MX3(b,C0[r+2],C0[r+3]);a=MX3(a,C1[r],C1[r+1]);b=MX3(b,C1[r+2],C1[r+3]);} \
      float rm=__builtin_fmaxf(a,b); { auto rr=__builtin_amdgcn_permlane32_swap(__float_as_uint(rm),__float_as_uint(rm),false,false); rm=__builtin_fmaxf(__uint_as_float(rr[0]),__uint_as_float(rr[1])); } \
      resc=false; \
      if(__builtin_expect(__any(rm>(float)THRL),0)){ const float dl=__builtin_fmaxf(rm,0.f); mhat+=dl; \
        _Pragma("unroll") for(int r=0;r<16;++r){C0[r]-=dl;C1[r]-=dl;} \
        _Pragma("unroll") for(int r=0;r<16;++r)negm[r]=-mhat; asm volatile("":"+v"(negm)); \
        const float f=__builtin_amdgcn_exp2f(-dl); l_reg*=f; if(hi==0)wsf[r32]=f; resc=true; } } \
    SBAR(); \
    GAPB(o[0]=__builtin_amdgcn_mfma_f32_32x32x16_bf16(PAF(0),VFR(0),o[0],0,0,0), C0,0); \
    GAPB(o[1]=__builtin_amdgcn_mfma_f32_32x32x16_bf16(PAF(0),VFR(4),o[1],0,0,0), C0,4); \
    KRD(GL,0); GAPB(o[0]=__builtin_amdgcn_mfma_f32_32x32x16_bf16(PAF(1),VFR(1),o[0],0,0,0), C0,8); \
    KRD(GL,1); GAPB(o[1]=__builtin_amdgcn_mfma_f32_32x32x16_bf16(PAF(1),VFR(5),o[1],0,0,0), C0,12); \
    KRD(GL,2); GAPB(o[0]=__builtin_amdgcn_mfma_f32_32x32x16_bf16(PAF(2),VFR(2),o[0],0,0,0), C1,0); \
    KRD(GL,3); GAPB(o[1]=__builtin_amdgcn_mfma_f32_32x32x16_bf16(PAF(2),VFR(6),o[1],0,0,0), C1,4); \
    GAPB(o[0]=__builtin_amdgcn_mfma_f32_32x32x16_bf16(PAF(3),VFR(3),o[0],0,0,0), C1,8); \
    GAPB(o[1]=__builtin_amdgcn_mfma_f32_32x32x16_bf16(PAF(3),VFR(7),o[1],0,0,0), C1,12); \
    }while(0)
  int t=1;
  #undef CMASK
  #define CMASK(P0,P1,t) do{}while(0)
  for(;t+5<NT;t+=2){
    STEP(pB0,pB1,pA0,pA1,t,true,true,true);     WAIT_BAR(2); RESC(); ROT();
    STEP(pA0,pA1,pB0,pB1,t+1,true,true,true);   WAIT_BAR(2); RESC(); ROT();
  }
  #undef CMASK
  #define CMASK(P0,P1,t) do{}while(0)
  #define ENDW(tt) do{ if((tt)+3<NT){WAIT_BAR(2);} else if((tt)+2<NT){WAIT_BAR(1);} else {WAIT_BAR(0);} }while(0)
  for(;t+1<NT;t+=2){
    STEP(pB0,pB1,pA0,pA1,t,(t+3<NT),(t+1<NT),(t+1<NT));       ENDW(t);   RESC(); ROT();
    STEP(pA0,pA1,pB0,pB1,t+1,(t+4<NT),(t+2<NT),(t+2<NT));     ENDW(t+1); RESC(); ROT();
  }
  STEP(pB0,pB1,pA0,pA1,NT-1,false,false,false); RESC();
  { float sacc=pB0[0]+pB0[1]; _Pragma("unroll") for(int r=2;r<16;++r)sacc+=pB0[r]; _Pragma("unroll") for(int r=0;r<16;++r)sacc+=pB1[r]; l_reg+=sacc;
    pw0=(u32x4){PKW(pB0,0),PKW(pB0,2),PKW(pB0,4),PKW(pB0,6)};pw1=(u32x4){PKW(pB0,8),PKW(pB0,10),PKW(pB0,12),PKW(pB0,14)};pw2=(u32x4){PKW(pB1,0),PKW(pB1,2),PKW(pB1,4),PKW(pB1,6)};pw3=(u32x4){PKW(pB1,8),PKW(pB1,10),PKW(pB1,12),PKW(pB1,14)};
    SBAR(); pv(o,vb0+sl_cur,PAF(0),PAF(1),PAF(2),PAF(3)); }
  #undef PKW
  #undef PAF
  #undef VFR
  #undef PIN
  #undef MX3
  #undef GAPA
  #undef GAPB
  #undef EX
  #undef VRD
  #undef KRD
  #undef STEP
  #undef ENDW
  {auto rr=__builtin_amdgcn_permlane32_swap(__float_as_uint(l_reg),__float_as_uint(l_reg),false,false);l_reg=__uint_as_float(rr[0])+__uint_as_float(rr[1]);}
  if(hi==0)wsf[32+r32]=l_reg;asm volatile("s_waitcnt lgkmcnt(0)":::"memory");
  float rli[16];
  #pragma unroll
  for(int r=0;r<16;++r)rli[r]=__builtin_amdgcn_rcpf(wsf[32+crow(r,hi)]);
  bf16*Ow=Ou+(long)(wid*QBLK)*OPITCH;
  { bf16*stg=(bf16*)(shm+LDS_OST)+wid*2048;
    #pragma unroll
    for(int r=0;r<16;++r){const int orow=crow(r,hi);
      #pragma unroll
      for(int d0=0;d0<2;++d0)stg[orow*64+d0*32+r32]=__float2bfloat16(o[d0][r]*rli[r]);}
    asm volatile("s_waitcnt lgkmcnt(0)":::"memory");
    #pragma unroll
    for(int i=0;i<4;++i){const int row=i*8+(lane>>3),ch=lane&7; const u32x4 v=*(const u32x4*)(stg+row*64+ch*8); *(u32x4*)(Ow+(long)row*OPITCH+ch*8)=v;} }
  asm volatile("s_waitcnt lgkmcnt(0)\n\ts_barrier":::"memory");
  #undef DMA_K
  #undef DMA_V
  #undef CMASK
  #undef START
  #undef RESC
  #undef ROT
}
#undef SBAR
#undef WAIT_BAR
}

namespace mk {
using pg8::bf16_t; using pg8::f32x4; using pg8::Unit; using pg8::cvt_pk_bf16;
#define LAS __attribute__((address_space(3)))
typedef unsigned u32x2 __attribute__((ext_vector_type(2)));
typedef unsigned u32x4 __attribute__((ext_vector_type(4)));
typedef float f32x2 __attribute__((ext_vector_type(2)));
typedef short bf16x8 __attribute__((ext_vector_type(8)));
typedef float f32x16 __attribute__((ext_vector_type(16)));

constexpr int DM = 1024, NB = 8, SL = 4096, CL = 256, ML = NB * SL, MC = NB * CL, MT = ML + MC;
constexpr int INW = 1792, DFF = 2816, UPW = 5632, MIXK = 1280, KVP = 128, QP = 512, KVB = SL + CL;
constexpr int HALF_A = 16384;
constexpr float EPS = 1e-6f;
constexpr float QSCALE = 0.125f * 1.4426950408889634f;

constexpr size_t MiB = 1u << 20;
constexpr size_t WS_CTL = 0;
constexpr size_t WS_MODP = 1 * MiB;
constexpr size_t WS_MOD = 5 * MiB;
constexpr size_t WS_T = 6 * MiB;
constexpr size_t WS_TW = 7 * MiB;
constexpr size_t WS_W = 8 * MiB;
constexpr size_t W_LAYER = 24 * MiB;
constexpr size_t WS_ADFT = 56 * MiB;
constexpr size_t WS_ADFTC = 88 * MiB;
constexpr size_t WS_KF = 89 * MiB;
constexpr size_t WS_KFC = 121 * MiB;
constexpr size_t WS_CX = 122 * MiB;
constexpr size_t WS_XN = 130 * MiB;
constexpr size_t WS_TMP = 198 * MiB;
constexpr size_t WS_Q = WS_TMP;
constexpr size_t WS_K = WS_TMP + 34 * MiB;
constexpr size_t WS_V = WS_TMP + 43 * MiB;
constexpr size_t WS_FT = WS_TMP + 52 * MiB;
constexpr size_t WS_FTC = WS_TMP + 68 * MiB;
constexpr size_t WS_PT = WS_TMP + 69 * MiB;
constexpr size_t WS_PTC = WS_TMP + 117 * MiB;
constexpr size_t WS_MIX = WS_TMP + 120 * MiB;
constexpr size_t WS_HRAW = WS_TMP + 206 * MiB;
constexpr size_t WS_U = WS_TMP;
constexpr size_t WS_G = WS_TMP + 198 * MiB;
constexpr size_t WS_END = WS_TMP + 297 * MiB;

struct Params { const float* in[29]; float* out; unsigned char* ws; int ph_lo, ph_hi; };
enum { I_X = 0, I_C, I_CTX, I_CCTX, I_WMOD, I_BMOD, I_GPREMIX, I_GPOSTMIX, I_GPREFFN, I_GPOSTFFN, I_WIN, I_GQ, I_GK, I_WF, I_WHC, I_BHC,
       I_HW1, I_HB1, I_HFR1, I_HW2, I_HB2, I_HFR2, I_HW3, I_HBIAS, I_WOUT, I_WUP, I_WFC, I_BFC, I_WDOWN };

__device__ __forceinline__ unsigned f2bf(float f) { unsigned u = __builtin_bit_cast(unsigned, f); return (u + 0x7fffu + ((u >> 16) & 1u)) >> 16; }
__device__ __forceinline__ unsigned pk2(float lo, float hi) { return f2bf(lo) | (f2bf(hi) << 16); }
__device__ __forceinline__ float bflo(unsigned w) { return __uint_as_float(w << 16); }
__device__ __forceinline__ float bfhi(unsigned w) { return __uint_as_float(w & 0xffff0000u); }
__device__ __forceinline__ float bf2f(bf16_t h) { return __uint_as_float((unsigned)h << 16); }
__device__ __forceinline__ float wave_sum(float v) {
#pragma unroll
    for (int o = 1; o < 64; o <<= 1) v += __shfl_xor(v, o);
    return v;
}

struct EpiPlain {
    static constexpr bool PERM = true, AFTER_DRAIN = false;
    bf16_t* O; int ldc;
    __device__ __forceinline__ void operator()(const f32x4 (&acc)[2][2][4][2], const Unit& u, int wr, int wc, int fr, int fq) const {
        const int row0 = u.pm * 256 + wr * 64 + fr; const int col0 = u.pn * 256 + wc * 32 + 8 * fq;
#pragma unroll
        for (int ai = 0; ai < 2; ++ai)
#pragma unroll
            for (int m = 0; m < 4; ++m) { bf16_t* rowp = O + (size_t)(row0 + ai * 128 + m * 16) * ldc + col0;
#pragma unroll
                for (int bj = 0; bj < 2; ++bj) { const f32x4 v0 = acc[ai][bj][m][0], v1 = acc[ai][bj][m][1];
                    u32x4 w; w.x = cvt_pk_bf16(v0[0], v0[1]); w.y = cvt_pk_bf16(v0[2], v0[3]); w.z = cvt_pk_bf16(v1[0], v1[1]); w.w = cvt_pk_bf16(v1[2], v1[3]);
                    *(u32x4*)(rowp + bj * 128) = w; } }
    }
};

struct EpiFourier {
    static constexpr bool PERM = true, AFTER_DRAIN = false;
    bf16_t* MIXp; int Lh; int rowbase0; int rowstride;
    __device__ __forceinline__ void operator()(const f32x4 (&acc)[2][2][4][2], const Unit& u, int wr, int wc, int fr, int fq) const {
        asm volatile("" : "+v"(fr), "+v"(fq), "+s"(wr), "+s"(wc));
        const int b = u.pn; const int len = 2 * Lh; const int rb = rowbase0 + b * rowstride;
#pragma unroll
        for (int ai = 0; ai < 2; ++ai)
#pragma unroll
            for (int m = 0; m < 4; ++m) {
                const int r = u.pm * 256 + ai * 128 + wr * 64 + m * 16 + fr;
                const bool isS = r > Lh; const int k = isS ? r - Lh : r;
                const bool edge = (k == 0) || (k == Lh);
#pragma unroll
                for (int bj = 0; bj < 2; ++bj) { const f32x4 v0 = acc[ai][bj][m][0], v1 = acc[ai][bj][m][1];
                    const int ch = bj * 128 + wc * 32 + 8 * fq;
                    u32x4 w; w.x = cvt_pk_bf16(v0[0], v0[1]); w.y = cvt_pk_bf16(v0[2], v0[3]); w.z = cvt_pk_bf16(v1[0], v1[1]); w.w = cvt_pk_bf16(v1[2], v1[3]);
                    const int col = 512 + (isS ? 256 : 0) + ch;
                    *(u32x4*)(MIXp + (size_t)(rb + k) * MIXK + col) = w;
                    if (!edge) { u32x4 wm = w; if (isS) { wm.x ^= 0x80008000u; wm.y ^= 0x80008000u; wm.z ^= 0x80008000u; wm.w ^= 0x80008000u; }
                        *(u32x4*)(MIXp + (size_t)(rb + len - k) * MIXK + col) = wm; }
                    else if (!isS) { *(u32x4*)(MIXp + (size_t)(rb + k) * MIXK + col + 256) = (u32x4){0u, 0u, 0u, 0u}; }
                }
            }
    }
};

struct EpiInProj {
    static constexpr bool PERM = false, AFTER_DRAIN = false;
    bf16_t *Q, *K, *V, *fT, *fTc, *PT, *PTc; const float *gq, *gk, *rope; LAS float* xch;
    __device__ __forceinline__ void operator()(const f32x4 (&acc)[2][2][4][2], const Unit& u, int wr, int wc, int fr, int fq) const {
        asm volatile("" : "+v"(fr), "+v"(fq), "+s"(wr), "+s"(wc));
        const int pn = u.pn, pm = u.pm; const bool isctx = pm >= 128;
        const int b = isctx ? pm - 128 : pm >> 4;
        const int tbase = isctx ? 0 : (pm & 15) * 256;
#ifdef T_NOQK
        if (false) {
#else
        if (pn <= 2) {
#endif
#pragma unroll
            for (int ai = 0; ai < 2; ++ai)
#pragma unroll
                for (int m = 0; m < 4; ++m)
#pragma unroll
                    for (int bj = 0; bj < 2; ++bj) {
                        float s = 0.f;
#pragma unroll
                        for (int n = 0; n < 2; ++n) { const f32x4 x = acc[ai][bj][m][n]; s += (x[0] * x[0] + x[1] * x[1]) + (x[2] * x[2] + x[3] * x[3]); }
                        s += __shfl_xor(s, 16); s += __shfl_xor(s, 32);
                        if (fq == 0) xch[((ai * 128 + wr * 64 + m * 16 + fr) * 2 + bj) * 4 + wc] = s;
                    }
            asm volatile("s_waitcnt lgkmcnt(0)\n\ts_barrier" ::: "memory");
            const float* gg = (pn == 2) ? gk : gq;
            const int dbase = (wc & 1) * 32 + 4 * fq;
            const f32x4 g1 = *(const f32x4*)(gg + dbase), g2 = *(const f32x4*)(gg + dbase + 16);
            const float osc = (pn == 2) ? 1.0f : QSCALE;
#pragma unroll
            for (int ai = 0; ai < 2; ++ai)
#pragma unroll
                for (int m = 0; m < 4; ++m) {
                    const int rl = ai * 128 + wr * 64 + m * 16 + fr; const int t = tbase + rl;
                    const int p = (wc & 1) ? (t & 63) : (t >> 6);
                    f32x4 cs = (f32x4){1.f, 1.f, 1.f, 1.f}, sn = (f32x4){0.f, 0.f, 0.f, 0.f};
                    if (!isctx) { cs = *(const f32x4*)(rope + p * 16 + 4 * fq); sn = *(const f32x4*)(rope + 1024 + p * 16 + 4 * fq); }
                    const size_t qrow = (size_t)pm * 256 + rl;
                    const size_t kvrow = isctx ? (size_t)b * KVB + rl : (size_t)b * KVB + CL + t;
#pragma unroll
                    for (int bj = 0; bj < 2; ++bj) {
                        if (pn == 2 && bj == 1) {
#pragma unroll
                            for (int n = 0; n < 2; ++n) { const f32x4 x = acc[ai][bj][m][n]; u32x2 w; w.x = cvt_pk_bf16(x[0], x[1]); w.y = cvt_pk_bf16(x[2], x[3]);
                                *(u32x2*)(V + kvrow * KVP + wc * 32 + 16 * n + 4 * fq) = w; }
                        } else {
                            const float ssq = xch[(rl * 2 + bj) * 4 + wc] + xch[(rl * 2 + bj) * 4 + (wc ^ 1)];
                            const float rstd = rsqrtf(ssq * (1.0f / 64.0f) + EPS) * osc;
                            const f32x4 y1 = acc[ai][bj][m][0] * rstd * g1, y2 = acc[ai][bj][m][1] * rstd * g2;
                            const f32x4 o1 = y1 * cs - y2 * sn, o2 = y2 * cs + y1 * sn;
                            u32x2 w1, w2; w1.x = cvt_pk_bf16(o1[0], o1[1]); w1.y = cvt_pk_bf16(o1[2], o1[3]); w2.x = cvt_pk_bf16(o2[0], o2[1]); w2.y = cvt_pk_bf16(o2[2], o2[3]);
                            bf16_t* dst = (pn == 2) ? (K + kvrow * KVP + wc * 32 + 4 * fq) : (Q + qrow * QP + pn * 256 + bj * 128 + wc * 32 + 4 * fq);
                            *(u32x2*)dst = w1; *(u32x2*)(dst + 16) = w2;
                        }
                    }
                    asm volatile("" ::: "memory"); __builtin_amdgcn_sched_barrier(0);
                }
        }
#ifndef T_NOTR
        else {
            const int NC = (pn == 3) ? 256 : 768; const int cb = (pn == 3) ? 0 : (pn - 4) * 256;
            bf16_t* base; int tl;
            if (isctx) { base = ((pn == 3) ? fTc : PTc) + (size_t)b * NC * CL; tl = CL; }
            else { base = ((pn == 3) ? fT : PT) + (size_t)b * NC * SL + tbase; tl = SL; }
            const int lane = fq * 16 + fr;
            LAS bf16_t* stg = (LAS bf16_t*)((LAS unsigned char*)xch + 8192) + (wr * 4 + wc) * 1152;
#pragma unroll
            for (int ai = 0; ai < 2; ++ai)
#pragma unroll
                for (int bj = 0; bj < 2; ++bj)
#pragma unroll
                    for (int n = 0; n < 2; ++n) {
#pragma unroll
                        for (int m = 0; m < 4; ++m) { const f32x4 x = acc[ai][bj][m][n];
#pragma unroll
                            for (int j = 0; j < 4; ++j) stg[(4 * fq + j) * 72 + m * 16 + fr] = (bf16_t)f2bf(x[j]); }
                        asm volatile("s_waitcnt lgkmcnt(0)" ::: "memory");
                        bf16_t* dst = base + (size_t)(cb + bj * 128 + wc * 32 + 16 * n) * tl + ai * 128 + wr * 64;
#pragma unroll
                        for (int i = 0; i < 2; ++i) { const int v = lane + 64 * i, col = v >> 3, k = v & 7;
                            const u32x4 w = *(const LAS u32x4*)(stg + col * 72 + k * 8);
                            *(u32x4*)(dst + (size_t)col * tl + 8 * k) = w; }
                        asm volatile("s_waitcnt lgkmcnt(0)" ::: "memory");
                    }
        }
#endif
    }
};

struct OneUnit { int pm, pn;
    __device__ __forceinline__ bool next(int i, Unit& u) const { if (i > 0) return false; u.pm = pm; u.pn = pn; return true; }
    __device__ __forceinline__ void a_ready(const Unit&) const {}
    __device__ __forceinline__ void done(const Unit&) const {}
};

constexpr int AT_K = 0, AT_V = 16384, AT_WS = 32768, AT_OST = 32768 + 2048;
__device__ __forceinline__ void attn_unit(const bf16_t* Qu, const bf16_t* Kh, const bf16_t* Vh, bf16_t* Ou, int NT, char* shm) {
    using namespace attn_body;
    const int tid = mk_tid(), lane = tid & 63, r32 = lane & 31, hi = lane >> 5; const int wid = __builtin_amdgcn_readfirstlane(tid >> 6);
    const unsigned lds0 = (unsigned)(uintptr_t)shm;
    float* wsf = (float*)(shm + AT_WS) + wid * 64;
    const bf16_t* ksrc = Kh + (size_t)lane * KVP + wid * 8;
    const bf16_t* vsrc = Vh + (size_t)(16 * (wid & 3) + (lane >> 2)) * KVP + (wid >> 2) * 32 + (lane & 3) * 8;
    const unsigned kdst = lds0 + AT_K + wid * 1024, vdst = lds0 + AT_V + wid * 1024;
#define DMA_K(t, slot) glds16(ksrc + (size_t)(t) * 64 * KVP, (unsigned)__builtin_amdgcn_readfirstlane(kdst + (slot)))
#define DMA_V(t, slot) glds16(vsrc + (size_t)(t) * 64 * KVP, (unsigned)__builtin_amdgcn_readfirstlane(vdst + (slot)))
    const int vb0 = (int)(lds0 + AT_V) + ((lane >> 4) & 1) * 32 + (lane & 3) * 8 + (4 * hi + ((lane & 15) >> 2)) * 64;
    DMA_K(0, 0); DMA_V(0, 0);
    const bf16_t* Qw = Qu + (size_t)(wid * 32) * QP;
    bf16x8 qr[4];
#pragma unroll
    for (int d0 = 0; d0 < 4; ++d0) qr[d0] = *reinterpret_cast<const bf16x8*>(&Qw[(size_t)r32 * QP + d0 * 16 + hi * 8]);
    float mrun = -INFINITY, l_reg = 0.f; f32x16 o[2]; o[0] = f32x16{}; o[1] = f32x16{};
    f32x16 zero16 = f32x16{};
    for (int t = 0; t < NT; ++t) {
        const int buf = (t & 1) * 8192;
        if (t + 1 < NT) { DMA_K(t + 1, buf ^ 8192); DMA_V(t + 1, buf ^ 8192); asm volatile("s_waitcnt vmcnt(2)\n\ts_barrier" ::: "memory"); }
        else { asm volatile("s_waitcnt vmcnt(0)\n\ts_barrier" ::: "memory"); }
        f32x16 p0, p1;
        qkt(p0, p1, shm + AT_K + buf, qr, zero16, r32, hi);
        float rm = p0[0];
#pragma unroll
        for (int r = 1; r < 16; ++r) rm = fmaxf(rm, p0[r]);
#pragma unroll
        for (int r = 0; r < 16; ++r) rm = fmaxf(rm, p1[r]);
        rm = fmaxf(rm, __shfl_xor(rm, 32));
        const float mnew = fmaxf(mrun, rm);
        const float f = __builtin_amdgcn_exp2f(mrun - mnew);
        mrun = mnew;
        float sacc = 0.f;
#pragma unroll
        for (int r = 0; r < 16; ++r) { p0[r] = __builtin_amdgcn_exp2f(p0[r] - mnew); p1[r] = __builtin_amdgcn_exp2f(p1[r] - mnew); sacc += p0[r] + p1[r]; }
        l_reg = l_reg * f + sacc;
        if (hi == 0) wsf[r32] = f;
        asm volatile("s_waitcnt lgkmcnt(0)" ::: "memory");
#pragma unroll
        for (int r = 0; r < 16; ++r) { const float fr_ = wsf[crow(r, hi)]; o[0][r] *= fr_; o[1][r] *= fr_; }
        u32x4 pw0, pw1, pw2, pw3;
        pw0 = (u32x4){cvtpk_s(p0[0], p0[1]), cvtpk_s(p0[2], p0[3]), cvtpk_s(p0[4], p0[5]), cvtpk_s(p0[6], p0[7])};
        pw1 = (u32x4){cvtpk_s(p0[8], p0[9]), cvtpk_s(p0[10], p0[11]), cvtpk_s(p0[12], p0[13]), cvtpk_s(p0[14], p0[15])};
        pw2 = (u32x4){cvtpk_s(p1[0], p1[1]), cvtpk_s(p1[2], p1[3]), cvtpk_s(p1[4], p1[5]), cvtpk_s(p1[6], p1[7])};
        pw3 = (u32x4){cvtpk_s(p1[8], p1[9]), cvtpk_s(p1[10], p1[11]), cvtpk_s(p1[12], p1[13]), cvtpk_s(p1[14], p1[15])};
        pv(o, vb0 + buf, __builtin_bit_cast(bf16x8, pw0), __builtin_bit_cast(bf16x8, pw1), __builtin_bit_cast(bf16x8, pw2), __builtin_bit_cast(bf16x8, pw3));
        asm volatile("s_waitcnt lgkmcnt(0)\n\ts_barrier" ::: "memory");
    }
    l_reg += __shfl_xor(l_reg, 32);
    if (hi == 0) wsf[32 + r32] = l_reg;
    asm volatile("s_waitcnt lgkmcnt(0)" ::: "memory");
    float rli[16];
#pragma unroll
    for (int r = 0; r < 16; ++r) rli[r] = 1.0f / wsf[32 + crow(r, hi)];
    bf16_t* Ow = Ou + (size_t)(wid * 32) * MIXK;
    { bf16_t* stg = (bf16_t*)(shm + AT_OST) + wid * 2048;
#pragma unroll
      for (int r = 0; r < 16; ++r) { const int orow = crow(r, hi);
#pragma unroll
        for (int d0 = 0; d0 < 2; ++d0) stg[orow * 64 + d0 * 32 + r32] = (bf16_t)f2bf(o[d0][r] * rli[r]); }
      asm volatile("s_waitcnt lgkmcnt(0)" ::: "memory");
#pragma unroll
      for (int i = 0; i < 4; ++i) { const int row = i * 8 + (lane >> 3), ch = lane & 7; const u32x4 v = *(const u32x4*)(stg + row * 64 + ch * 8); *(u32x4*)(Ow + (size_t)row * MIXK + ch * 8) = v; } }
    asm volatile("s_waitcnt vmcnt(0) lgkmcnt(0)\n\ts_barrier" ::: "memory");
#undef DMA_K
#undef DMA_V
}

__device__ __forceinline__ int PADI(int i) { return i + (i >> 5); }
constexpr int FFT_TW_OFF = 69632, FFT_RED_OFF = 69632 + 32768;
template <int LOGN, int R, bool INV>
__device__ __forceinline__ void fft_pass(LAS f32x2* d, const LAS f32x2* tw, int s, int tid) {
    constexpr int N = 1 << LOGN, RR = 1 << R;
    const int lgs = LOGN - s - R; const int stride = 1 << lgs;
    constexpr float C16[8] = {1.0f, 0.9238795325112867f, 0.7071067811865476f, 0.3826834323650898f, 0.0f, -0.3826834323650898f, -0.7071067811865476f, -0.9238795325112867f};
    constexpr float S16[8] = {0.0f, 0.3826834323650898f, 0.7071067811865476f, 0.9238795325112867f, 1.0f, 0.9238795325112867f, 0.7071067811865476f, 0.3826834323650898f};
    for (int g = tid; g < (N >> R); g += 512) {
        const int lo = g & (stride - 1), hi = g >> lgs; const int base = (hi << (lgs + R)) + lo;
        f32x2 v[RR];
#pragma unroll
        for (int e = 0; e < RR; ++e) v[e] = d[PADI(base + e * stride)];
        if constexpr (R == 1) { const f32x2 a = v[0], b = v[1]; v[0] = a + b; v[1] = a - b; }
        else {
            static_assert(R == 4 || R == 1, "radix");
            f32x2 Wb[4];
            Wb[0] = tw[lo << s];
#pragma unroll
            for (int j = 1; j < 4; ++j) Wb[j] = (f32x2){Wb[j - 1].x * Wb[j - 1].x - Wb[j - 1].y * Wb[j - 1].y, 2.0f * Wb[j - 1].x * Wb[j - 1].y};
#pragma unroll
            for (int jj = 0; jj < 4; ++jj) {
                const int j = INV ? (3 - jj) : jj;
                const int he = 8 >> j;
#pragma unroll
                for (int q = 0; q < 8; ++q) if (q < he) {
                    const int k = q << j;
                    const f32x2 w = (f32x2){Wb[j].x * C16[k] + Wb[j].y * S16[k], Wb[j].y * C16[k] - Wb[j].x * S16[k]};
#pragma unroll
                    for (int e = 0; e < 16; ++e) if ((e & he) == 0 && (e & (he - 1)) == q) {
                        const f32x2 a = v[e], b = v[e + he];
                        if (!INV) { const f32x2 dl = a - b; v[e] = a + b; v[e + he] = (f32x2){dl.x * w.x - dl.y * w.y, dl.x * w.y + dl.y * w.x}; }
                        else { const f32x2 bw = (f32x2){b.x * w.x + b.y * w.y, b.y * w.x - b.x * w.y}; v[e] = a + bw; v[e + he] = a - bw; }
                    }
                }
            }
        }
#pragma unroll
        for (int e = 0; e < RR; ++e) d[PADI(base + e * stride)] = v[e];
    }
    __syncthreads();
}
template <int LOGN> __device__ __forceinline__ void fft_fwd(LAS f32x2* d, const LAS f32x2* tw, int tid) {
    if constexpr (LOGN == 13) { fft_pass<13, 4, false>(d, tw, 0, tid); fft_pass<13, 4, false>(d, tw, 4, tid); fft_pass<13, 4, false>(d, tw, 8, tid); fft_pass<13, 1, false>(d, tw, 12, tid); }
    else { fft_pass<9, 4, false>(d, tw, 0, tid); fft_pass<9, 4, false>(d, tw, 4, tid); fft_pass<9, 1, false>(d, tw, 8, tid); }
}
template <int LOGN> __device__ __forceinline__ void fft_inv(LAS f32x2* d, const LAS f32x2* tw, int tid) {
    if constexpr (LOGN == 13) { fft_pass<13, 1, true>(d, tw, 12, tid); fft_pass<13, 4, true>(d, tw, 8, tid); fft_pass<13, 4, true>(d, tw, 4, tid); fft_pass<13, 4, true>(d, tw, 0, tid); }
    else { fft_pass<9, 1, true>(d, tw, 8, tid); fft_pass<9, 4, true>(d, tw, 4, tid); fft_pass<9, 4, true>(d, tw, 0, tid); }
}
template <int LOGN> __device__ __forceinline__ void load_tw(LAS f32x2* tw, const f32x2* g, int tid) {
    for (int i = tid; i < (1 << (LOGN - 1)); i += 512) tw[i] = g[i];
}

template <int LOGN> __device__ __forceinline__ void kf_job(LAS unsigned char* lds, const float* hrawT, const f32x2* twg, f32x2* kf, int ch, int tid) {
    constexpr int N = 1 << LOGN, T = N / 2;
    LAS f32x2* d = (LAS f32x2*)lds; LAS f32x2* tw = (LAS f32x2*)(lds + FFT_TW_OFF); LAS float* red = (LAS float*)(lds + FFT_RED_OFF);
    load_tw<LOGN>(tw, twg, tid);
    float s = 0.f;
    for (int n = tid; n < N; n += 512) {
        float v;
        if (n < T) v = hrawT[(size_t)ch * T + n]; else if (n == T) v = 0.f; else v = hrawT[(size_t)(256 + ch) * T + (N - n)];
        d[PADI(n)] = (f32x2){v, 0.f}; s += fabsf(v);
    }
    s = wave_sum(s);
    if ((tid & 63) == 0) red[tid >> 6] = s;
    __syncthreads();
    float tot = 0.f;
#pragma unroll
    for (int i = 0; i < 8; ++i) tot += red[i];
    const float inv = 1.0f / tot;
    for (int n = tid; n < N; n += 512) { f32x2 v = d[PADI(n)]; v.x *= inv; d[PADI(n)] = v; }
    __syncthreads();
    fft_fwd<LOGN>(d, tw, tid);
    for (int n = tid; n < N; n += 512) kf[(size_t)ch * N + n] = d[PADI(n)];
    __syncthreads();
}

template <int LOGN> __device__ __forceinline__ void hyena_job(LAS unsigned char* lds, const bf16_t* PTall, const f32x2* twg, const f32x2* kf, const float* wc, const float* bc, const float* hbias,
                                                            bf16_t* MIXp, int rowbase, int bp, int ch, int tid) {
    constexpr int N = 1 << LOGN, T = N / 2, PER = (T + 511) / 512;
    LAS f32x2* d = (LAS f32x2*)lds; LAS f32x2* tw = (LAS f32x2*)(lds + FFT_TW_OFF);
    load_tw<LOGN>(tw, twg, tid);
    const float w10 = wc[256 + ch], w11 = wc[768 + 256 + ch], w12 = wc[1536 + 256 + ch], b1 = bc[256 + ch];
    const float w20 = wc[512 + ch], w21 = wc[768 + 512 + ch], w22 = wc[1536 + 512 + ch], b2 = bc[512 + ch];
    const float w00 = wc[ch], w01 = wc[768 + ch], w02 = wc[1536 + ch], b0 = bc[ch];
    const float hb = hbias[ch];
    f32x2 ukeep[PER];
#pragma unroll
    for (int i = 0; i < PER; ++i) {
        const int t = tid + 512 * i;
        f32x2 u = (f32x2){0.f, 0.f};
        if (t < T) {
#pragma unroll
            for (int bb = 0; bb < 2; ++bb) {
                const bf16_t* p1 = PTall + ((size_t)(2 * bp + bb) * 768 + 256 + ch) * T; const bf16_t* p2 = PTall + ((size_t)(2 * bp + bb) * 768 + 512 + ch) * T;
                const float a_m = t > 0 ? bf2f(p1[t - 1]) : 0.f, a_0 = bf2f(p1[t]), a_p = t < T - 1 ? bf2f(p1[t + 1]) : 0.f;
                const float c_m = t > 0 ? bf2f(p2[t - 1]) : 0.f, c_0 = bf2f(p2[t]), c_p = t < T - 1 ? bf2f(p2[t + 1]) : 0.f;
                const float x1 = a_m * w10 + a_0 * w11 + a_p * w12 + b1, vv = c_m * w20 + c_0 * w21 + c_p * w22 + b2;
                if (bb == 0) u.x = x1 * vv; else u.y = x1 * vv;
            }
            d[PADI(t)] = u; d[PADI(t + T)] = (f32x2){0.f, 0.f};
        }
        ukeep[i] = u;
    }
    __syncthreads();
    fft_fwd<LOGN>(d, tw, tid);
    for (int n = tid; n < N; n += 512) { const f32x2 a = d[PADI(n)], k = kf[(size_t)ch * N + n]; d[PADI(n)] = (f32x2){a.x * k.x - a.y * k.y, a.x * k.y + a.y * k.x}; }
    __syncthreads();
    fft_inv<LOGN>(d, tw, tid);
    const float sc = 1.0f / (float)N;
#pragma unroll
    for (int i = 0; i < PER; ++i) {
        const int t = tid + 512 * i;
        if (t < T) {
            const f32x2 y = d[PADI(t)] * sc; const f32x2 u = ukeep[i];
#pragma unroll
            for (int bb = 0; bb < 2; ++bb) {
                const bf16_t* p0 = PTall + ((size_t)(2 * bp + bb) * 768 + ch) * T;
                const float a_m = t > 0 ? bf2f(p0[t - 1]) : 0.f, a_0 = bf2f(p0[t]), a_p = t < T - 1 ? bf2f(p0[t + 1]) : 0.f;
                const float x0 = a_m * w00 + a_0 * w01 + a_p * w02 + b0;
                const float yy = bb == 0 ? y.x : y.y, uu = bb == 0 ? u.x : u.y;
                MIXp[(size_t)(rowbase + (2 * bp + bb) * T + t) * MIXK + 1024 + ch] = (bf16_t)f2bf(x0 * (yy + uu * hb));
            }
        }
    }
    __syncthreads();
}

__device__ __forceinline__ void norm_rows(int gw, int NGW, int lane, int nrows, const float* xl_in, const float* xc_in, float* xl_out, float* xc_out,
                                          const bf16_t* Y, const float* gpost, const float* modA, int ga_off,
                                          bf16_t* XN, const float* gpre, const float* modB, int sc_off, int sh_off) {
    for (int row = gw; row < nrows; row += NGW) {
        const bool isctx = row >= ML; const int mb = isctx ? 8 : (row >> 12);
        const float* xin = isctx ? xc_in + (size_t)(row - ML) * DM : xl_in + (size_t)row * DM;
        f32x4 v[4];
#pragma unroll
        for (int j = 0; j < 4; ++j) v[j] = *(const f32x4*)(xin + 4 * lane + 256 * j);
        if (Y) {
            f32x4 y[4]; float s = 0.f;
#pragma unroll
            for (int j = 0; j < 4; ++j) { const u32x2 w = *(const u32x2*)(Y + (size_t)row * DM + 4 * lane + 256 * j); y[j] = (f32x4){bflo(w.x), bfhi(w.x), bflo(w.y), bfhi(w.y)};
                s += (y[j].x * y[j].x + y[j].y * y[j].y) + (y[j].z * y[j].z + y[j].w * y[j].w); }
            const float rstd = rsqrtf(wave_sum(s) * (1.0f / DM) + EPS);
            float* xo = isctx ? xc_out + (size_t)(row - ML) * DM : xl_out + (size_t)row * DM;
#pragma unroll
            for (int j = 0; j < 4; ++j) { const f32x4 g = *(const f32x4*)(gpost + 4 * lane + 256 * j); const f32x4 ga = *(const f32x4*)(modA + (size_t)mb * 6144 + ga_off + 4 * lane + 256 * j);
                v[j] = v[j] + ga * (y[j] * rstd * g); *(f32x4*)(xo + 4 * lane + 256 * j) = v[j]; }
        }
        if (XN) {
            float s = 0.f;
#pragma unroll
            for (int j = 0; j < 4; ++j) s += (v[j].x * v[j].x + v[j].y * v[j].y) + (v[j].z * v[j].z + v[j].w * v[j].w);
            const float rstd = rsqrtf(wave_sum(s) * (1.0f / DM) + EPS);
#pragma unroll
            for (int j = 0; j < 4; ++j) { const f32x4 g = *(const f32x4*)(gpre + 4 * lane + 256 * j); const f32x4 sc = *(const f32x4*)(modB + (size_t)mb * 6144 + sc_off + 4 * lane + 256 * j);
                const f32x4 sh = *(const f32x4*)(modB + (size_t)mb * 6144 + sh_off + 4 * lane + 256 * j);
                const f32x4 o = (v[j] * rstd * g) * (1.0f + sc) + sh; u32x2 w; w.x = pk2(o.x, o.y); w.y = pk2(o.z, o.w);
                *(u32x2*)(XN + (size_t)row * DM + 4 * lane + 256 * j) = w; }
        }
    }
}

__device__ __forceinline__ void glu_pass(int blk, int nblk, int tid, int r0, int nrows, const bf16_t* U, bf16_t* G, const float* wc, const float* bc) {
    const int nitems = nrows / 8;
    for (int it = blk; it < nitems; it += nblk) {
        for (int p = tid; p < 8 * 352; p += 512) {
            const int rl = it * 8 + p / 352, vc = p % 352, j0 = vc * 8; const int r = r0 + rl;
            int t, len; if (r >= ML) { t = (r - ML) & (CL - 1); len = CL; } else { t = r & (SL - 1); len = SL; }
            const bool hm = t > 0, hp = t < len - 1;
            const bf16_t* ur = U + (size_t)rl * UPW + j0;
            const u32x4 z4 = (u32x4){0u, 0u, 0u, 0u};
            const u32x4 g0 = *(const u32x4*)ur, gm = hm ? *(const u32x4*)(ur - UPW) : z4, gp = hp ? *(const u32x4*)(ur + UPW) : z4;
            const u32x4 v0 = *(const u32x4*)(ur + DFF), vm = hm ? *(const u32x4*)(ur + DFF - UPW) : z4, vp = hp ? *(const u32x4*)(ur + DFF + UPW) : z4;
            unsigned outw[4];
#pragma unroll
            for (int q = 0; q < 4; ++q) {
                float res[2];
#pragma unroll
                for (int h = 0; h < 2; ++h) {
                    const int j = j0 + 2 * q + h;
                    const float a_m = h ? bfhi(gm[q]) : bflo(gm[q]), a_0 = h ? bfhi(g0[q]) : bflo(g0[q]), a_p = h ? bfhi(gp[q]) : bflo(gp[q]);
                    const float c_m = h ? bfhi(vm[q]) : bflo(vm[q]), c_0 = h ? bfhi(v0[q]) : bflo(v0[q]), c_p = h ? bfhi(vp[q]) : bflo(vp[q]);
                    const float cg = a_m * wc[j] + a_0 * wc[UPW + j] + a_p * wc[2 * UPW + j] + bc[j];
                    const float cv = c_m * wc[DFF + j] + c_0 * wc[UPW + DFF + j] + c_p * wc[2 * UPW + DFF + j] + bc[DFF + j];
                    const float sg = cg / (1.0f + __expf(-cg));
                    res[h] = sg * cv;
                }
                outw[q] = pk2(res[0], res[1]);
            }
            *(u32x4*)(G + (size_t)rl * DFF + j0) = (u32x4){outw[0], outw[1], outw[2], outw[3]};
        }
    }
}

__device__ __forceinline__ void transpose_item(const float* W, int ldw, bf16_t* WT, int ldt, int nblk, int item, LAS float* scr, int lane) {
    const int kb = item / nblk, nb = item % nblk, k0 = 64 * kb, n0 = 32 * nb;
#pragma unroll 8
    for (int i = 0; i < 32; ++i) { const int kk = 2 * i + (lane >> 5); scr[kk * 33 + (lane & 31)] = W[(size_t)(k0 + kk) * ldw + n0 + (lane & 31)]; }
    asm volatile("s_waitcnt lgkmcnt(0)" ::: "memory");
    const int c = lane & 7;
#pragma unroll
    for (int j = 0; j < 4; ++j) { const int n = (lane >> 3) + 8 * j; const LAS float* s = scr + (8 * c) * 33 + n;
        u32x4 o; o.x = pk2(s[0 * 33], s[1 * 33]); o.y = pk2(s[2 * 33], s[3 * 33]); o.z = pk2(s[4 * 33], s[5 * 33]); o.w = pk2(s[6 * 33], s[7 * 33]);
        *(u32x4*)(WT + (size_t)(n0 + n) * ldt + k0 + 8 * c) = o; }
    asm volatile("s_waitcnt lgkmcnt(0)" ::: "memory");
}
}

using namespace mk;
typedef const __attribute__((address_space(4))) Params* KP;
__device__ __forceinline__ KP kp_get() { KP p = (KP)__builtin_amdgcn_kernarg_segment_ptr(); asm volatile("" : "+s"(p)); return p; }
#ifndef MK_REP
#define MK_REP 0
#endif
#define REP(k) for (int rep_ = 0; rep_ < 1 + ((MK_REP >> (k)) & 1); ++rep_)
#ifndef MK_EN
#define MK_EN 0xffff
#endif
#define EN(k) if constexpr ((MK_EN >> (k)) & 1)
constexpr int LDS_BYTES = 159744;
constexpr int XCH_OFF = 131072;
constexpr int MISC_OFF = 131072 + 8192 + 18432;

#define RLX_AGENT __ATOMIC_RELAXED, __HIP_MEMORY_SCOPE_AGENT
#define XB_TMO      128
#define XB_XCNT(j)  (256  + 64 * (j))
#define XB_XSUB(j)  (1280 + 64 * (j))
#define XB_XGEN(j)  (2304 + 64 * (j))
#define XB_TOP      3328
#define XB_TOPGEN   3392
#define XCD_BAR_WORDS 3456
#define XB_SPIN_CAP (1u << 18)

__device__ __forceinline__ unsigned xb_ld(unsigned* p)              { return __hip_atomic_load(p, __ATOMIC_RELAXED, __HIP_MEMORY_SCOPE_AGENT); }
__device__ __forceinline__ unsigned xb_add(unsigned* p, unsigned v) { return __hip_atomic_fetch_add(p, v, __ATOMIC_RELAXED, __HIP_MEMORY_SCOPE_AGENT); }
__device__ __forceinline__ unsigned xb_xcc_id() { return (unsigned)__builtin_amdgcn_s_getreg((3 << 11) | 20) & 0xFu; }
#define XB_SPIN(cond, bar) do { unsigned _sp = 0; while (cond) { __builtin_amdgcn_s_sleep(1); \
    if ((++_sp & 255u) == 0u) { if (xb_ld(&(bar)[XB_TMO])) break; if (_sp > XB_SPIN_CAP) { atomicAdd(&(bar)[XB_TMO], 1u); break; } } } } while (0)

struct XcdBarrier {
    unsigned* bar; unsigned x;
    volatile LAS unsigned* st;
};

__device__ __forceinline__ XcdBarrier xcd_barrier_post(unsigned* bar, volatile LAS unsigned* st) {
    XcdBarrier b; b.bar = bar; b.x = xb_xcc_id(); b.st = st;
    if (threadIdx.x == 0) (void)xb_add(&bar[XB_XCNT(b.x)], 1u);
    return b;
}
__device__ __forceinline__ void xcd_barrier_complete(unsigned* bar, unsigned x, unsigned& nloc, unsigned& nx) {
    const unsigned G = gridDim.x * gridDim.y * gridDim.z;
    unsigned sum, cnt, mine, sp = 0u;
    for (;;) {
        sum = 0u; cnt = 0u; mine = 0u;
#pragma unroll
        for (unsigned j = 0; j < 16; ++j) { const unsigned c = xb_ld(&bar[XB_XCNT(j)]); sum += c; cnt += (c > 0u) ? 1u : 0u; mine = (j == x) ? c : mine; }
        if (sum == G) break;
        __builtin_amdgcn_s_sleep(1);
        if ((++sp & 255u) == 0u) { if (xb_ld(&bar[XB_TMO])) break; if (sp > XB_SPIN_CAP) { atomicAdd(&bar[XB_TMO], 1u); break; } }
    }
    nloc = mine > 0u ? mine : 1u; nx = cnt > 0u ? cnt : 1u;
}

__device__ __forceinline__ void xcd_barrier(const XcdBarrier& b) {
    asm volatile("s_waitcnt vmcnt(0)" ::: "memory");
    __syncthreads();
    if (threadIdx.x == 0) {
        unsigned* bar = b.bar;
        __builtin_amdgcn_s_waitcnt(0);
        unsigned nloc = b.st[0], nx = b.st[1];
        if (nloc == 0u) { xcd_barrier_complete(bar, b.x, nloc, nx); b.st[0] = nloc; b.st[1] = nx; }
        const unsigned old = xb_add(&bar[XB_XSUB(b.x)], 1u);
        const unsigned gen = old / nloc;
        if (old + 1u == (gen + 1u) * nloc) {
            __builtin_amdgcn_fence(__ATOMIC_RELEASE, "agent");
            asm volatile("s_waitcnt vmcnt(0)" ::: "memory");
            const unsigned og = xb_add(&bar[XB_TOP], 1u);
            const unsigned tg = og / nx;
            if (og + 1u == (tg + 1u) * nx) xb_add(&bar[XB_TOPGEN], 1u);
            else XB_SPIN(xb_ld(&bar[XB_TOPGEN]) == tg, bar);
            __builtin_amdgcn_fence(__ATOMIC_ACQUIRE, "agent");
            xb_add(&bar[XB_XGEN(b.x)], 1u);
            asm volatile("s_waitcnt vmcnt(0)" ::: "memory");
        } else {
            XB_SPIN(xb_ld(&bar[XB_XGEN(b.x)]) == gen, bar);
            __builtin_amdgcn_fence(__ATOMIC_ACQUIRE, "agent");
            asm volatile("s_waitcnt vmcnt(0)" ::: "memory");
        }
    }
    __syncthreads();
}

__device__ __forceinline__ bf16_t* wlayer(unsigned char* ws, int l, size_t off) { return (bf16_t*)(ws + WS_W + (size_t)l * W_LAYER + off); }
constexpr size_t OFF_WIN = 0, OFF_WOUT = 4 * MiB, OFF_WUP = 7 * MiB, OFF_WDOWN = 18 * MiB;

__device__ __forceinline__ void setup0(KP pp, LAS unsigned char* lds, int tid, int lane, int wave) {
    unsigned char* ws = pp->ws;
    {
        LAS float* scr = (LAS float*)(lds + wave * 16384);
        const int gw = blockIdx.x * 8 + wave, NGW = gridDim.x * 8;
        constexpr int I_IN = 16 * 56, I_UP = 16 * 176, I_DN = 44 * 32, I_OA = 8 * 32, I_OH = 4 * 32, I_L = I_IN + I_UP + I_DN + I_OA + I_OH;
        for (int it = gw; it < 2 * I_L; it += NGW) {
            const int l = it / I_L; int r = it % I_L;
            if (r < I_IN) { transpose_item(pp->in[I_WIN] + (size_t)l * DM * INW, INW, wlayer(ws, l, OFF_WIN), DM, 56, r, scr, lane); continue; } r -= I_IN;
            if (r < I_UP) { transpose_item(pp->in[I_WUP] + (size_t)l * DM * UPW, UPW, wlayer(ws, l, OFF_WUP), DM, 176, r, scr, lane); continue; } r -= I_UP;
            if (r < I_DN) { transpose_item(pp->in[I_WDOWN] + (size_t)l * DFF * DM, DM, wlayer(ws, l, OFF_WDOWN), DFF, 32, r, scr, lane); continue; } r -= I_DN;
            if (r < I_OA) { transpose_item(pp->in[I_WOUT] + (size_t)l * DM * DM, DM, wlayer(ws, l, OFF_WOUT), MIXK, 32, r, scr, lane); continue; } r -= I_OA;
            transpose_item(pp->in[I_WOUT] + (size_t)l * DM * DM + (size_t)768 * DM, DM, wlayer(ws, l, OFF_WOUT) + 1024, MIXK, 32, r, scr, lane);
        }
    }
    __syncthreads();
    constexpr int N_MOD = 192, N_MLP = 512 + 32 + 512, N_DFT = 4096 + 256, N_T = 1024, N_TAB = 1;
    constexpr int NIT = N_MOD + N_MLP + N_DFT + N_T + N_TAB;
    LAS float* fl = (LAS float*)lds;
    for (int it = blockIdx.x; it < NIT; it += gridDim.x) {
        int r = it;
        if (r < N_MOD) {
            const int l = r / 96, cb = (r % 96) / 8, kc = r % 8;
            for (int idx = tid; idx < 9 * 128; idx += 512) { const int rr = idx / 128, k = idx % 128; const float cv = rr < 8 ? pp->in[I_C][rr * DM + kc * 128 + k] : pp->in[I_CCTX][kc * 128 + k];
                fl[idx] = cv / (1.0f + __expf(-cv)); }
            __syncthreads();
            const int j = cb * 512 + tid; float acc[9];
#pragma unroll
            for (int rr = 0; rr < 9; ++rr) acc[rr] = 0.f;
            const float* wm = pp->in[I_WMOD] + (size_t)l * DM * 6144 + (size_t)(kc * 128) * 6144 + j;
            for (int k = 0; k < 128; ++k) { const float w = wm[(size_t)k * 6144];
#pragma unroll
                for (int rr = 0; rr < 9; ++rr) acc[rr] += fl[rr * 128 + k] * w; }
            float* mp = (float*)(ws + WS_MODP) + ((size_t)(l * 8 + kc) * 9) * 6144 + j;
#pragma unroll
            for (int rr = 0; rr < 9; ++rr) mp[(size_t)rr * 6144] = acc[rr];
            __syncthreads();
            continue;
        }
        r -= N_MOD;
        if (r < N_MLP) {
            int l, which, t0;
            if (r < 512) { l = 0; which = 0; t0 = r * 8; } else if (r < 544) { l = 0; which = 1; t0 = (r - 512) * 8; } else { l = 1; which = 0; t0 = (r - 544) * 8; }
            const int T = which ? CL : SL;
            LAS float* Z = fl; LAS float* H1 = fl + 8 * 36; LAS float* H2 = H1 + 512;
            if (tid < 128) { const int p = tid >> 4, i = tid & 15; const int t = t0 + p; const float band = 1e-4f + (float)i * ((15.0f - 1e-4f) / 15.0f);
                const float ang = ((6.2831855f * (float)t) / (float)T) * band; Z[p * 36 + 1 + i] = cosf(ang); Z[p * 36 + 17 + i] = -sinf(ang);
                if (i == 0) Z[p * 36] = (float)t / (float)(T - 1); }
            __syncthreads();
            { const int p = tid >> 6, j = tid & 63; const float* w1 = pp->in[I_HW1] + (size_t)l * 33 * 64; float s = pp->in[I_HB1][l * 64 + j];
              for (int i = 0; i < 33; ++i) s += Z[p * 36 + i] * w1[i * 64 + j];
              H1[p * 64 + j] = sinf(pp->in[I_HFR1][l * 64 + j] * s); }
            __syncthreads();
            { const int p = tid >> 6, j = tid & 63; const float* w2 = pp->in[I_HW2] + (size_t)l * 64 * 64; float s = pp->in[I_HB2][l * 64 + j];
              for (int i = 0; i < 64; ++i) s += H1[p * 64 + i] * w2[i * 64 + j];
              H2[p * 64 + j] = sinf(pp->in[I_HFR2][l * 64 + j] * s); }
            __syncthreads();
            { const int j = tid; const float* w3 = pp->in[I_HW3] + (size_t)l * 64 * 512 + j; float acc[8];
#pragma unroll
              for (int p = 0; p < 8; ++p) acc[p] = 0.f;
              for (int i = 0; i < 64; ++i) { const float w = w3[(size_t)i * 512];
#pragma unroll
                  for (int p = 0; p < 8; ++p) acc[p] += H2[p * 64 + i] * w; }
              const float da = -3.0701134573253944f, db = -15.350567286626972f;
              const float delta = fabsf(da + (float)(j & 255) * ((db - da) / 255.0f));
              float* hr = (float*)(ws + WS_HRAW) + (which ? (size_t)2 * 512 * SL : (size_t)l * 512 * SL) + (size_t)j * T + t0;
#pragma unroll
              for (int p = 0; p < 8; ++p) hr[p] = acc[p] * expf(-Z[p * 36] * delta); }
            __syncthreads();
            continue;
        }
        r -= N_MLP;
        if (r < N_DFT) {
            if (r < 4096) { bf16_t* row = (bf16_t*)(ws + WS_ADFT) + (size_t)r * 4096; const bool isS = r > 2048; const int k = isS ? r - 2048 : r;
                for (int t = tid; t < 4096; t += 512) { const int idx = (k * t) & 4095; const float x = (float)idx * (1.0f / 2048.0f); const float v = (isS ? sinpif(x) : cospif(x)) * (1.0f / 512.0f); row[t] = (bf16_t)f2bf(v); } }
            else { const int rr = r - 4096; bf16_t* row = (bf16_t*)(ws + WS_ADFTC) + (size_t)rr * 256; const bool isS = rr > 128; const int k = isS ? rr - 128 : rr;
                if (tid < 256) { const int idx = (k * tid) & 255; const float x = (float)idx * (1.0f / 128.0f); const float v = (isS ? sinpif(x) : cospif(x)) * (1.0f / 128.0f); row[tid] = (bf16_t)f2bf(v); } }
            continue;
        }
        r -= N_DFT;
        if (r < N_T) {
            const int l = r >> 9, kk = r & 511; const bool isS = kk >= 256; const int gc = kk & 255, g = gc >> 6, c = gc & 63;
            if (tid < 256) { const float* wf = pp->in[I_WF] + (size_t)l * 256 * 256 + (size_t)(g * 64) * 256 + tid; float s = 0.f;
                for (int m = 0; m < 64; ++m) { const float x = (float)((m * c) & 63) * (1.0f / 32.0f); const float tr = isS ? -sinpif(x) : cospif(x); s += tr * wf[(size_t)m * 256]; }
                ((float*)(ws + WS_T))[((size_t)l * 512 + kk) * 256 + tid] = s; }
            continue;
        }
        { f32x2* tw = (f32x2*)(ws + WS_TW);
          for (int i = tid; i < 4096; i += 512) { const float x = (float)i * (1.0f / 4096.0f); tw[i] = (f32x2){cospif(x), -sinpif(x)}; }
          f32x2* tw2 = (f32x2*)(ws + WS_TW + 65536);
          if (tid < 256) { const float x = (float)tid * (1.0f / 256.0f); tw2[tid] = (f32x2){cospif(x), -sinpif(x)}; }
          float* rope = (float*)(ws + WS_TW + 131072);
          for (int i = tid; i < 1024; i += 512) { const int p = i >> 4, q = i & 15; const float inv = powf(10000.0f, -(float)q / 16.0f); const float a = (float)p * inv; rope[i] = cosf(a); rope[1024 + i] = sinf(a); } }
    }
}

__device__ __forceinline__ void setup1(KP pp, LAS unsigned char* lds, int tid) {
    unsigned char* ws = pp->ws;
    { const int gt = blockIdx.x * 512 + tid, NGT = gridDim.x * 512;
      for (int idx = gt; idx < 2 * 9 * 6144; idx += NGT) { const int l = idx / (9 * 6144), rj = idx % (9 * 6144), j = rj % 6144; float s = pp->in[I_BMOD][l * 6144 + j];
#pragma unroll
          for (int kc = 0; kc < 8; ++kc) s += ((const float*)(ws + WS_MODP))[((size_t)(l * 8 + kc) * 9) * 6144 + rj];
          ((float*)(ws + WS_MOD))[idx] = s; } }
    constexpr int N_KF = 768, N_W2 = 2048;
    LAS float* fl = (LAS float*)lds;
    for (int it = blockIdx.x; it < N_KF + N_W2; it += gridDim.x) {
        if (it < N_KF) {
            if (it < 512) { const int l = it >> 8, ch = it & 255;
                kf_job<13>(lds, (const float*)(ws + WS_HRAW) + (size_t)l * 512 * SL, (const f32x2*)(ws + WS_TW), (f32x2*)(ws + WS_KF) + (size_t)l * 256 * 8192, ch, tid); }
            else { const int ch = it - 512;
                kf_job<9>(lds, (const float*)(ws + WS_HRAW) + (size_t)2 * 512 * SL, (const f32x2*)(ws + WS_TW + 65536), (f32x2*)(ws + WS_KFC), ch, tid); }
            continue;
        }
        const int r = it - N_KF; const int l = r >> 10, kk = (r >> 1) & 511, nh = r & 1;
        if (tid < 256) fl[tid] = ((const float*)(ws + WS_T))[((size_t)l * 512 + kk) * 256 + tid];
        __syncthreads();
        { const int n = nh * 512 + tid; const float* wo = pp->in[I_WOUT] + (size_t)l * DM * DM + (size_t)512 * DM + n; float s = 0.f;
          for (int j = 0; j < 256; ++j) s += fl[j] * wo[(size_t)j * DM];
          wlayer(ws, l, OFF_WOUT)[(size_t)n * MIXK + 512 + kk] = (bf16_t)f2bf(s); }
        __syncthreads();
    }
}

__global__ void __launch_bounds__(512, 2) mega_fwd(Params P) {
    extern __shared__ __attribute__((aligned(16))) unsigned char lds_raw[];
    LAS unsigned char* lds = (LAS unsigned char*)lds_raw;
    { volatile LAS unsigned* m0 = (volatile LAS unsigned*)(lds + MISC_OFF); if (threadIdx.x < 32) m0[threadIdx.x] = 0u; }
    __syncthreads();
    XcdBarrier xbar;
    { KP pb = kp_get(); xbar = xcd_barrier_post((unsigned*)(pb->ws + WS_CTL) + 4096, (volatile LAS unsigned*)(lds + MISC_OFF) + 8);
      if (pb->ph_lo < 0) cg::this_grid().sync(); }
    int ph = 0;
#define PH_BEGIN { KP pp = kp_get(); const int lo = pp->ph_lo, hi = pp->ph_hi; if (ph >= lo && ph < hi) { unsigned char* ws = pp->ws; const int tid = mk_tid(), lane = tid & 63, wave = __builtin_amdgcn_readfirstlane(tid >> 6); const int G = gridDim.x, gw = blockIdx.x * 8 + wave, NGW = G * 8; (void)lane; (void)gw; (void)NGW; PTRS
#define PH_END   if (ph + 1 < hi) xcd_barrier(xbar); } } ++ph;
#define PTRS \
    bf16_t* XN = (bf16_t*)(ws + WS_XN); bf16_t* Qb = (bf16_t*)(ws + WS_Q); bf16_t* Kb = (bf16_t*)(ws + WS_K); bf16_t* Vb = (bf16_t*)(ws + WS_V); \
    bf16_t* fT = (bf16_t*)(ws + WS_FT); bf16_t* fTc = (bf16_t*)(ws + WS_FTC); bf16_t* PT = (bf16_t*)(ws + WS_PT); bf16_t* PTc = (bf16_t*)(ws + WS_PTC); \
    bf16_t* MIXb = (bf16_t*)(ws + WS_MIX); bf16_t* Ub = (bf16_t*)(ws + WS_U); bf16_t* Gb = (bf16_t*)(ws + WS_G); \
    float* CX = (float*)(ws + WS_CX); const float* MOD = (const float*)(ws + WS_MOD); \
    const float* rope = (const float*)(ws + WS_TW + 131072); \
    volatile LAS int* misc = (volatile LAS int*)(lds + MISC_OFF); \
    (void)XN; (void)Qb; (void)Kb; (void)Vb; (void)fT; (void)fTc; (void)PT; (void)PTc; (void)MIXb; (void)Ub; (void)Gb; (void)CX; (void)MOD; (void)rope; (void)misc;

    REP(6) { PH_BEGIN EN(0) setup0(pp, lds, tid, lane, wave); PH_END --ph; } ++ph;
    REP(6) { PH_BEGIN EN(1) setup1(pp, lds, tid); PH_END --ph; } ++ph;
    PH_BEGIN EN(2) norm_rows(gw, NGW, lane, MT, pp->in[I_X], pp->in[I_CTX], nullptr, nullptr, nullptr, nullptr, nullptr, 0, XN, pp->in[I_GPREMIX], MOD, 1024, 0); PH_END

    for (int l = 0; l < 2; ++l) {
        const bool last = (l == 1);
        const int MR = last ? ML : MT;
        PH_BEGIN {
            pg8::Gemm g{XN, wlayer(ws, l, OFF_WIN), MT, INW, DM}; pg8::StaticOrder S; S.init(MT, INW, G, (int)blockIdx.x);
            EpiInProj E{Qb, Kb, Vb, fT, fTc, PT, PTc, pp->in[I_GQ] + l * 64, pp->in[I_GK] + l * 64, rope, (LAS float*)(lds + XCH_OFF)};
            REP(0) EN(3) pg8::gemm_phase<EpiInProj, pg8::StaticOrder, true, true>(lds, g, S, E);
        } PH_END
        PH_BEGIN {
            const int nF = last ? 128 : 136, nA = last ? 1024 : 1088, nH1 = last ? 1024 : 2048, nH = nH1 * (1 + ((MK_REP >> 7) & 1));
            for (;;) {
                KP pq = kp_get(); unsigned char* wq = pq->ws; const int tq = mk_tid();
                if (tq == 0) misc[0] = (int)atomicAdd((unsigned*)(wq + WS_CTL) + 64 * (1 + l), 1u);
                __syncthreads();
                int it = misc[0];
                __syncthreads();
                if (it >= nF + nA + nH) break;
                bf16_t* MIXq = (bf16_t*)(wq + WS_MIX);
                if (it < nF) {
                    if (it < 128) { pg8::Gemm g{(const bf16_t*)(wq + WS_ADFT), (const bf16_t*)(wq + WS_FT), 4096, 2048, 4096}; OneUnit S{it >> 3, it & 7}; EpiFourier E{MIXq, 2048, 0, SL};
                        REP(3) EN(4) pg8::gemm_phase<EpiFourier, OneUnit, false, true>(lds, g, S, E); }
                    else { pg8::Gemm g{(const bf16_t*)(wq + WS_ADFTC), (const bf16_t*)(wq + WS_FTC), 256, 2048, 256}; OneUnit S{0, it - 128}; EpiFourier E{MIXq, 128, ML, CL};
                        REP(3) EN(4) pg8::gemm_phase<EpiFourier, OneUnit, false, true>(lds, g, S, E); }
                    continue;
                }
                it -= nF;
                if (it < nA) {
                    const bf16_t* Qq = (const bf16_t*)(wq + WS_Q); const bf16_t* Kq = (const bf16_t*)(wq + WS_K); const bf16_t* Vq = (const bf16_t*)(wq + WS_V);
                    int b, h, NT; size_t qrow;
                    if (it < 1024) { b = it >> 7; h = (it >> 4) & 7; qrow = (size_t)b * SL + (it & 15) * 256; NT = KVB / 64; }
                    else { const int r = it - 1024; b = r >> 3; h = r & 7; qrow = (size_t)ML + b * CL; NT = CL / 64; }
                    const size_t kv0 = (size_t)b * KVB;
                    REP(1) EN(5) attn_body::attn_unit2<8>((const attn_body::bf16*)(Qq + qrow * QP + h * 64), (const attn_body::bf16*)(Kq + kv0 * KVP + (h >> 2) * 64), (const attn_body::bf16*)(Vq + kv0 * KVP + (h >> 2) * 64), (attn_body::bf16*)(MIXq + qrow * MIXK + h * 64), NT, (char*)lds_raw);
                    continue;
                }
                it -= nA; if (it >= nH1) it -= nH1;
                const float* wc = pq->in[I_WHC] + (size_t)l * 3 * 768; const float* bc = pq->in[I_BHC] + (size_t)l * 768; const float* hb = pq->in[I_HBIAS] + (size_t)l * 256;
                REP(2) EN(6) { if (it < 1024) hyena_job<13>(lds, (const bf16_t*)(wq + WS_PT), (const f32x2*)(wq + WS_TW), (const f32x2*)(wq + WS_KF) + (size_t)l * 256 * 8192, wc, bc, hb, MIXq, 0, it >> 8, it & 255, tq);
                else { const int r = it - 1024; hyena_job<9>(lds, (const bf16_t*)(wq + WS_PTC), (const f32x2*)(wq + WS_TW + 65536), (const f32x2*)(wq + WS_KFC), wc, bc, hb, MIXq, ML, r >> 8, r & 255, tq); } }
            }
        } PH_END
        PH_BEGIN {
            pg8::Gemm g{MIXb, wlayer(ws, l, OFF_WOUT), MR, DM, MIXK}; pg8::StaticOrder S; S.init(MR, DM, G, (int)blockIdx.x);
            EpiPlain E{XN, DM};
            REP(5) EN(7) pg8::gemm_phase<EpiPlain, pg8::StaticOrder, true, true>(lds, g, S, E);
        } PH_END
        PH_BEGIN EN(2) norm_rows(gw, NGW, lane, MR, l == 0 ? pp->in[I_X] : pp->out, l == 0 ? pp->in[I_CTX] : CX, pp->out, CX, XN, pp->in[I_GPOSTMIX] + l * DM, (MOD + (size_t)l * 9 * 6144), 2048,
                           XN, pp->in[I_GPREFFN] + l * DM, (MOD + (size_t)l * 9 * 6144), 4096, 3072); PH_END
        for (int hf = 0; hf < 2; ++hf) {
            const int r0 = hf ? HALF_A : 0, nr = hf ? (MR - HALF_A) : HALF_A;
            PH_BEGIN {
                pg8::Gemm g{XN + (size_t)r0 * DM, wlayer(ws, l, OFF_WUP), nr, UPW, DM}; pg8::StaticOrder S; S.init(nr, UPW, G, (int)blockIdx.x);
                EpiPlain E{Ub, UPW};
                REP(4) EN(8) pg8::gemm_phase<EpiPlain, pg8::StaticOrder, true, true>(lds, g, S, E);
            } PH_END
            PH_BEGIN REP(4) EN(9) glu_pass((int)blockIdx.x, G, tid, r0, nr, Ub, Gb, pp->in[I_WFC] + (size_t)l * 3 * UPW, pp->in[I_BFC] + (size_t)l * UPW); PH_END
            PH_BEGIN {
                pg8::Gemm g{Gb, wlayer(ws, l, OFF_WDOWN), nr, DM, DFF}; pg8::StaticOrder S; S.init(nr, DM, G, (int)blockIdx.x);
                EpiPlain E{XN + (size_t)r0 * DM, DM};
                REP(4) EN(10) pg8::gemm_phase<EpiPlain, pg8::StaticOrder, true, true>(lds, g, S, E);
            } PH_END
        }
        PH_BEGIN EN(2) norm_rows(gw, NGW, lane, MR, pp->out, CX, pp->out, CX, XN, pp->in[I_GPOSTFFN] + l * DM, (MOD + (size_t)l * 9 * 6144), 5120,
                           last ? nullptr : XN, pp->in[I_GPREMIX] + (last ? 0 : (l + 1) * DM), MOD + (size_t)(last ? 0 : (l + 1)) * 9 * 6144, 1024, 0); PH_END
    }
}

constexpr int N_PHASES = 3 + 2 * 11;
#ifndef MK_MULTI
#define MK_MULTI 0
#endif
extern "C" void kernel_launch(void* const* d_in, const int* in_sizes, int n_in, void* d_out, int out_size, void* d_ws, size_t ws_size, hipStream_t stream) {
    static int grid = 0;
    if (grid == 0) {
        if (n_in != 29 || ws_size < WS_END) { fprintf(stderr, "kernel_launch: bad args n_in %d ws %zu (need %zu)\n", n_in, ws_size, (size_t)WS_END); grid = -1; return; }
        int dev = 0, cus = 0, per_cu = 0;
        hipGetDevice(&dev); hipDeviceGetAttribute(&cus, hipDeviceAttributeMultiprocessorCount, dev);
        if (hipFuncSetAttribute((const void*)mega_fwd, hipFuncAttributeMaxDynamicSharedMemorySize, LDS_BYTES) != hipSuccess) { fprintf(stderr, "hipFuncSetAttribute failed\n"); grid = -1; return; }
        if (hipOccupancyMaxActiveBlocksPerMultiprocessor(&per_cu, (const void*)mega_fwd, 512, LDS_BYTES) != hipSuccess || per_cu < 1) { fprintf(stderr, "occupancy query: %d\n", per_cu); per_cu = 1; }
        (void)hipGetLastError();
        grid = cus * 1;
    }
    if (grid < 0) return;
    hipMemsetAsync((char*)d_ws + WS_CTL, 0, 1 * MiB, stream);
    Params p{};
    for (int i = 0; i < 29; ++i) p.in[i] = (const float*)d_in[i];
    p.out = (float*)d_out; p.ws = (unsigned char*)d_ws;
#if MK_MULTI
    for (int k = 0; k < N_PHASES; ++k) { p.ph_lo = k; p.ph_hi = k + 1; hipLaunchKernelGGL(mega_fwd, dim3(grid), dim3(512), LDS_BYTES, stream, p); }
#else
    p.ph_lo = 0; p.ph_hi = N_PHASES;
    void* args[] = {&p};
    hipError_t e = hipLaunchCooperativeKernel((const void*)mega_fwd, dim3(grid), dim3(512), args, LDS_BYTES, stream);
    if (e != hipSuccess) fprintf(stderr, "cooperative launch failed: %s (grid %d)\n", hipGetErrorString(e), grid);
#endif
}
```

```cpp
#define MK_REP 0
#include <hip/hip_runtime.h>
#include <hip/hip_cooperative_groups.h>
#include <hip/hip_bf16.h>
#include <cstdio>
#include <cstdint>
#include <cmath>
namespace cg = cooperative_groups;
__device__ __forceinline__ int mk_tid() { int t = threadIdx.x; asm volatile("" : "+v"(t)); return t; }
namespace pg8 {
#define PG8_LAS __attribute__((address_space(3)))
typedef unsigned short bf16_t;
typedef short bf16x8 __attribute__((ext_vector_type(8)));
typedef float f32x4 __attribute__((ext_vector_type(4)));
typedef unsigned u32x4 __attribute__((ext_vector_type(4)));
constexpr int BM = 256, BK = 64, HALF = 128, HTB = HALF * BK * 2  , STAGE_BYTES = 8 * HTB, NXCD = 8, WGM = 8;

__host__ __device__ __forceinline__ int lds_byte(int r, int c) { const int st = (r >> 4) * 2 + (c >> 5), rr = r & 15, cc = c & 31, ob = rr * 64 + cc * 2; return st * 1024 + (ob ^ (((ob >> 9) & 1) << 5)); }
__host__ __device__ __forceinline__ void stage_rc(int b, int& R, int& C) { const int st = b / 1024, sb = b % 1024, swz = sb ^ (((sb >> 9) & 1) << 5); R = (st >> 1) * 16 + swz / 64; C = (st & 1) * 32 + (swz % 64) / 2; }
__host__ __device__ __forceinline__ int perm32(int rho) { const int n = rho >> 4, i = rho & 15; return 8 * (i >> 2) + 4 * n + (i & 3); }

struct Unit { int pm, pn; };
struct Gemm { const bf16_t* A; const bf16_t* Bt; int M, N, K; };

struct StaticOrder {
    int nM, nN, nwg, G, c;
    __host__ __device__ void init(int M, int N, int G_, int c_) { nM = M / BM; nN = N / BM; nwg = nM * nN; G = G_; c = c_; }
    __host__ __device__ bool next(int i, Unit& u) const {
        const long L = (long)i * G + c; if (L >= nwg) return false;
        int wgid = (int)L; { const int q = nwg / NXCD, r = nwg % NXCD, xcd = wgid % NXCD, off = wgid / NXCD; wgid = (xcd < r ? xcd * (q + 1) : r * (q + 1) + (xcd - r) * q) + off; }
        const int nig = WGM * nN, gid = wgid / nig, fm = gid * WGM, gsz = (nM - fm) < WGM ? (nM - fm) : WGM;
        u.pm = fm + ((wgid % nig) % gsz); u.pn = (wgid % nig) / gsz; return true;
    }
    __device__ __forceinline__ void a_ready(const Unit&) const {}
    __device__ __forceinline__ void done(const Unit&) const {}
};
__device__ __forceinline__ unsigned cvt_pk_bf16(float lo, float hi) { unsigned r; asm volatile("v_cvt_pk_bf16_f32 %0, %1, %2" : "=v"(r) : "v"(lo), "v"(hi)); return r; }
typedef float f32x2 __attribute__((ext_vector_type(2)));
template <class Epi, class Sched, bool ALIGN_EPI = false, bool SP2 = false>
__device__ __forceinline__ void gemm_phase(PG8_LAS unsigned char* lds, const Gemm g, const Sched& S, const Epi& E) {
    const int tid = mk_tid(), wid = __builtin_amdgcn_readfirstlane(tid >> 6), lane = tid & 63, wr = wid >> 2, wc = wid & 3, fr = lane & 15, fq = lane >> 4;
    const int K = g.K, nt = K / BK;
    unsigned voffA[2], voffB[2];
#pragma unroll
    for (int i = 0; i < 2; ++i) { int R, C; stage_rc(tid * 16 + i * 8192, R, C); const int Rb = Epi::PERM ? ((R & ~31) + perm32(R & 31)) : R;
        voffA[i] = (unsigned)(R * K + C) * 2u; voffB[i] = (unsigned)(Rb * K + C) * 2u; }
    const size_t kstep = (size_t)(BK * 2);
    const size_t hstep = (size_t)HALF * K * 2;
    const size_t tstep = 2 * hstep;
    const unsigned ldsw = (unsigned)wid * 1024u;
    const int aoff = lds_byte(wr * 64 + fr, fq * 8), boff = lds_byte(wc * 32 + fr, fq * 8);
#define PG8_SA(b, h) (((b) * 2 + (h)) * HTB)
#define PG8_SB(b, h) ((4 + (b) * 2 + (h)) * HTB)
#define PG8_STAGE(bufoff, gbase, voff) do { _Pragma("unroll") for (int _i = 0; _i < 2; ++_i) \
        __builtin_amdgcn_global_load_lds((const unsigned*)((const char*)(gbase) + (voff)[_i]), (PG8_LAS unsigned*)(lds + (bufoff) + ldsw + _i * 8192), 16, 0, 0); } while (0)
#define PG8_LDA(dst, b, h) do { _Pragma("unroll") for (int m = 0; m < 4; ++m) _Pragma("unroll") for (int k = 0; k < 2; ++k) dst[m][k] = *(const PG8_LAS bf16x8*)(lds + PG8_SA(b, h) + aoff + m * 2048 + k * 1024); } while (0)
#define PG8_LDB(dst, b, h) do { _Pragma("unroll") for (int n = 0; n < 2; ++n) _Pragma("unroll") for (int k = 0; k < 2; ++k) dst[n][k] = *(const PG8_LAS bf16x8*)(lds + PG8_SB(b, h) + boff + n * 2048 + k * 1024); } while (0)
#define PG8_MMA(ai, bj, At, Bt) do { __builtin_amdgcn_s_setprio(1); _Pragma("unroll") for (int m = 0; m < 4; ++m) _Pragma("unroll") for (int n = 0; n < 2; ++n) _Pragma("unroll") for (int k = 0; k < 2; ++k) \
        acc[ai][bj][m][n] = __builtin_amdgcn_mfma_f32_16x16x32_bf16(Bt[n][k], At[m][k], acc[ai][bj][m][n], 0, 0, 0); __builtin_amdgcn_s_setprio(0); } while (0)
#define PG8_WAIT_V(n) asm volatile("s_waitcnt vmcnt(" #n ")" ::: "memory")
#define PG8_WAIT_L(n) asm volatile("s_waitcnt lgkmcnt(" #n ")" ::: "memory")
#define PG8_BAR __builtin_amdgcn_s_barrier()
#define PG8_SCHED __builtin_amdgcn_sched_barrier(0)
    Unit cur, nxt; int ui = 0;
    if (!S.next(0, cur)) return;
    f32x4 acc[2][2][4][2];
#pragma unroll
    for (int a = 0; a < 2; ++a)
#pragma unroll
        for (int b = 0; b < 2; ++b)
#pragma unroll
            for (int m = 0; m < 4; ++m)
#pragma unroll
                for (int n = 0; n < 2; ++n) acc[a][b][m][n] = (f32x4){0.f, 0.f, 0.f, 0.f};
    bf16x8 At[4][2], B0[2][2], B1[2][2];
    const char* cA = (const char*)g.A + (size_t)cur.pm * tstep; const char* cB = (const char*)g.Bt + (size_t)cur.pn * tstep;
    S.a_ready(cur);
    if constexpr (SP2) {
        PG8_STAGE(PG8_SB(0, 0), cB, voffB); PG8_STAGE(PG8_SB(0, 1), cB + hstep, voffB); PG8_STAGE(PG8_SA(0, 0), cA, voffA); PG8_STAGE(PG8_SA(0, 1), cA + hstep, voffA);
        if (wr == 1) PG8_BAR;
        PG8_WAIT_V(2); PG8_BAR;
        PG8_STAGE(PG8_SB(1, 0), cB + kstep, voffB); PG8_STAGE(PG8_SA(1, 0), cA + kstep, voffA); PG8_STAGE(PG8_SB(1, 1), cB + hstep + kstep, voffB);
        PG8_WAIT_V(6); PG8_BAR;
    } else {
        PG8_STAGE(PG8_SB(0, 0), cB, voffB); PG8_STAGE(PG8_SA(0, 0), cA, voffA); PG8_STAGE(PG8_SB(0, 1), cB + hstep, voffB); PG8_STAGE(PG8_SA(0, 1), cA + hstep, voffA);
        if (wr == 1) PG8_BAR;
        PG8_WAIT_V(4); PG8_BAR;
        PG8_STAGE(PG8_SB(1, 0), cB + kstep, voffB); PG8_STAGE(PG8_SA(1, 0), cA + kstep, voffA); PG8_STAGE(PG8_SB(1, 1), cB + hstep + kstep, voffB);
        PG8_WAIT_V(6); PG8_BAR;
    }
    for (;;) {
        const bool has_next = S.next(ui + 1, nxt);
        const char* nA = has_next ? (const char*)g.A + (size_t)nxt.pm * tstep : cA; const char* nB = has_next ? (const char*)g.Bt + (size_t)nxt.pn * tstep : cB;
        for (int t = 0; t < nt; t += 2) {
            const bool last = (t == nt - 2);
            const char* a1 = cA + (size_t)(t + 1) * kstep;
            const char* a2 = last ? nA : cA + (size_t)(t + 2) * kstep; const char* b2 = last ? nB : cB + (size_t)(t + 2) * kstep;
            const char* a3 = a2 + kstep; const char* b3 = b2 + kstep;
            if (last && has_next) S.a_ready(nxt);
            if constexpr (SP2) {
            PG8_LDB(B0, 0, 0); PG8_LDB(B1, 0, 1); PG8_SCHED; PG8_LDA(At, 0, 0); PG8_STAGE(PG8_SA(1, 1), a1 + hstep, voffA);
            PG8_WAIT_V(8); PG8_WAIT_L(0); PG8_BAR; PG8_MMA(0, 0, At, B0); PG8_MMA(0, 1, At, B1); PG8_BAR; PG8_SCHED;
            PG8_LDA(At, 0, 1); PG8_STAGE(PG8_SB(0, 0), b2, voffB); PG8_STAGE(PG8_SB(0, 1), b2 + hstep, voffB); PG8_STAGE(PG8_SA(0, 0), a2, voffA);
            PG8_WAIT_V(8); PG8_WAIT_L(0); PG8_BAR; PG8_MMA(1, 0, At, B0); PG8_MMA(1, 1, At, B1); PG8_BAR; PG8_SCHED;
            PG8_LDB(B0, 1, 0); PG8_LDB(B1, 1, 1); PG8_SCHED; PG8_LDA(At, 1, 0); PG8_STAGE(PG8_SA(0, 1), a2 + hstep, voffA);
            PG8_WAIT_V(8); PG8_WAIT_L(0); PG8_BAR; PG8_MMA(0, 0, At, B0); PG8_MMA(0, 1, At, B1); PG8_BAR; PG8_SCHED;
            PG8_LDA(At, 1, 1); PG8_STAGE(PG8_SB(1, 0), b3, voffB); PG8_STAGE(PG8_SB(1, 1), b3 + hstep, voffB); PG8_STAGE(PG8_SA(1, 0), a3, voffA);
            PG8_WAIT_V(8); PG8_WAIT_L(0); PG8_BAR; PG8_MMA(1, 0, At, B0); PG8_MMA(1, 1, At, B1); PG8_BAR; PG8_SCHED;
            } else {
            PG8_LDB(B0, 0, 0); PG8_SCHED; PG8_LDA(At, 0, 0); PG8_STAGE(PG8_SA(1, 1), a1 + hstep, voffA);
            PG8_WAIT_L(8); PG8_BAR; PG8_WAIT_L(0); PG8_MMA(0, 0, At, B0); PG8_BAR; PG8_SCHED;
            PG8_LDB(B1, 0, 1); PG8_STAGE(PG8_SB(0, 0), b2, voffB);
            PG8_BAR; PG8_WAIT_L(0); PG8_MMA(0, 1, At, B1); PG8_BAR;
            PG8_LDA(At, 0, 1); PG8_STAGE(PG8_SA(0, 0), a2, voffA);
            PG8_BAR; PG8_WAIT_L(0); PG8_MMA(1, 0, At, B0); PG8_BAR; PG8_SCHED;
            PG8_STAGE(PG8_SB(0, 1), b2 + hstep, voffB);
            PG8_WAIT_V(6); PG8_BAR; PG8_MMA(1, 1, At, B1); PG8_BAR;
            PG8_LDB(B0, 1, 0); PG8_SCHED; PG8_LDA(At, 1, 0); PG8_STAGE(PG8_SA(0, 1), a2 + hstep, voffA);
            PG8_WAIT_L(8); PG8_BAR; PG8_WAIT_L(0); PG8_MMA(0, 0, At, B0); PG8_BAR; PG8_SCHED;
            PG8_LDB(B1, 1, 1); PG8_STAGE(PG8_SB(1, 0), b3, voffB);
            PG8_BAR; PG8_WAIT_L(0); PG8_MMA(0, 1, At, B1); PG8_BAR;
            PG8_LDA(At, 1, 1); PG8_STAGE(PG8_SA(1, 0), a3, voffA);
            PG8_BAR; PG8_WAIT_L(0); PG8_MMA(1, 0, At, B0); PG8_BAR; PG8_SCHED;
            PG8_STAGE(PG8_SB(1, 1), b3 + hstep, voffB);
            PG8_WAIT_V(6); PG8_BAR; PG8_MMA(1, 1, At, B1); PG8_BAR;
            }
        }
        if constexpr (ALIGN_EPI) { if (wr == 0) PG8_BAR; }
        if constexpr (!Epi::AFTER_DRAIN) { E(acc, cur, wr, wc, fr, fq); S.done(cur); }
        if (!has_next) break;
#pragma unroll
        for (int a = 0; a < 2; ++a)
#pragma unroll
            for (int b = 0; b < 2; ++b)
#pragma unroll
                for (int m = 0; m < 4; ++m)
#pragma unroll
                    for (int n = 0; n < 2; ++n) acc[a][b][m][n] = (f32x4){0.f, 0.f, 0.f, 0.f};
        cur = nxt; cA = nA; cB = nB; ++ui;
        if constexpr (ALIGN_EPI) { if (wr == 1) PG8_BAR; }
    }
    PG8_WAIT_V(0);
    if constexpr (!ALIGN_EPI) { if (wr == 0) PG8_BAR; }
    PG8_BAR;
    if constexpr (Epi::AFTER_DRAIN) { E.fused(acc, cur, wr, wc, fr, fq, lds, wid, lane); S.done(cur); }
#undef PG8_SA
#undef PG8_SB
#undef PG8_STAGE
#undef PG8_LDA
#undef PG8_LDB
#undef PG8_MMA
#undef PG8_WAIT_V
#undef PG8_WAIT_L
#undef PG8_BAR
#undef PG8_SCHED
}
}
namespace attn_body {
using bf16=__hip_bfloat16;
using bf16x8=__attribute__((ext_vector_type(8)))short;
using s16x4=__attribute__((ext_vector_type(4)))short;
using f32x16=__attribute__((ext_vector_type(16)))float;
using u32x4=__attribute__((ext_vector_type(4)))unsigned;
__device__ __forceinline__ int crow(int r,int hi){return (r&3)+8*(r>>2)+4*hi;}
#define SBAR() __builtin_amdgcn_sched_barrier(0)
__device__ __forceinline__ void glds16(const void*gsrc,unsigned lds_dst){unsigned keep;
  asm volatile("s_mov_b32 %0, m0\n\ts_mov_b32 m0, %2\n\ts_nop 0\n\tglobal_load_lds_dwordx4 %1, off\n\ts_mov_b32 m0, %0":"=&s"(keep):"v"(gsrc),"s"(lds_dst):"memory");}
typedef float f32x2_t __attribute__((ext_vector_type(2))); typedef __bf16 bf16x2_t __attribute__((ext_vector_type(2)));
__device__ __forceinline__ unsigned cvtpk_s(float lo,float hi){f32x2_t v={lo,hi};bf16x2_t b=__builtin_convertvector(v,bf16x2_t);return __builtin_bit_cast(unsigned,b);}
#define WAIT_BAR(N) asm volatile("s_waitcnt vmcnt(" #N ") lgkmcnt(0)\n\ts_barrier":::"memory")
__device__ __forceinline__ void qkt(f32x16&p0,f32x16&p1,const char*Kslot,const bf16x8*qr,const f32x16&negm,int r32,int hi){
  const char*kb=Kslot+hi*1024+r32*16;
  #pragma unroll
  for(int d0=0;d0<4;++d0){
    const bf16x8 b0=*reinterpret_cast<const bf16x8*>(kb+d0*2048);
    const bf16x8 b1=*reinterpret_cast<const bf16x8*>(kb+d0*2048+512);
    if(d0==0){p0=__builtin_amdgcn_mfma_f32_32x32x16_bf16(b0,qr[0],negm,0,0,0);p1=__builtin_amdgcn_mfma_f32_32x32x16_bf16(b1,qr[0],negm,0,0,0);}
    else{p0=__builtin_amdgcn_mfma_f32_32x32x16_bf16(b0,qr[d0],p0,0,0,0);p1=__builtin_amdgcn_mfma_f32_32x32x16_bf16(b1,qr[d0],p1,0,0,0);}}
}
__device__ __forceinline__ void pv(f32x16*o,int vb,bf16x8 pa0,bf16x8 pa1,bf16x8 pa2,bf16x8 pa3){
  #pragma unroll
  for(int d0=0;d0<2;++d0){s16x4 lo[4],hi[4];
    #pragma unroll
    for(int ks=0;ks<4;++ks){
      asm volatile("ds_read_b64_tr_b16 %0,%1 offset:%c2":"=&v"(lo[ks]):"v"(vb),"i"(d0*4096+ks*1024):"memory");
      asm volatile("ds_read_b64_tr_b16 %0,%1 offset:%c2":"=&v"(hi[ks]):"v"(vb),"i"(d0*4096+ks*1024+512):"memory");}
    asm volatile("s_waitcnt lgkmcnt(0)":::"memory");SBAR();
    #define PK(k) (bf16x8){lo[k][0],lo[k][1],lo[k][2],lo[k][3],hi[k][0],hi[k][1],hi[k][2],hi[k][3]}
    o[d0]=__builtin_amdgcn_mfma_f32_32x32x16_bf16(pa0,PK(0),o[d0],0,0,0);
    o[d0]=__builtin_amdgcn_mfma_f32_32x32x16_bf16(pa1,PK(1),o[d0],0,0,0);
    o[d0]=__builtin_amdgcn_mfma_f32_32x32x16_bf16(pa2,PK(2),o[d0],0,0,0);
    o[d0]=__builtin_amdgcn_mfma_f32_32x32x16_bf16(pa3,PK(3),o[d0],0,0,0);
    #undef PK
  }
}
constexpr int QBLK=32,KVBLK=64,NW=8;
constexpr int NSLOT=3, SLOTB=8192;
constexpr int LDS_K=0, LDS_V=NSLOT*SLOTB, LDS_WS=2*NSLOT*SLOTB, LDS_OST=LDS_WS+NW*64*4, LDS_BYTES=LDS_OST+NW*4096;
__device__ __forceinline__ float max3f(float a,float b,float c){float r;asm("v_max3_f32 %0, %1, %2, %3":"=v"(r):"v"(a),"v"(b),"v"(c));return r;}
__device__ __forceinline__ float max2f(float a,float b){float r;asm("v_max_f32_e32 %0, %1, %2":"=v"(r):"v"(a),"v"(b));return r;}
__device__ __forceinline__ float fadd_s(float a,float b){float r;asm("v_add_f32_e32 %0, %1, %2":"=v"(r):"v"(a),"v"(b));return r;}
__device__ __forceinline__ float fsub_s(float a,float b){float r;asm("v_sub_f32_e32 %0, %1, %2":"=v"(r):"v"(a),"v"(b));return r;}
typedef __attribute__((address_space(3))) const char* lds_cptr;
typedef short v4i16_t __attribute__((ext_vector_type(4)));
__device__ __forceinline__ void kload8(bf16x8*kf,lds_cptr kp){
  kf[0]=*(const __attribute__((address_space(3))) bf16x8*)(kp);      kf[1]=*(const __attribute__((address_space(3))) bf16x8*)(kp+512);
  kf[2]=*(const __attribute__((address_space(3))) bf16x8*)(kp+2048); kf[3]=*(const __attribute__((address_space(3))) bf16x8*)(kp+2560);
  kf[4]=*(const __attribute__((address_space(3))) bf16x8*)(kp+4096); kf[5]=*(const __attribute__((address_space(3))) bf16x8*)(kp+4608);
  kf[6]=*(const __attribute__((address_space(3))) bf16x8*)(kp+6144); kf[7]=*(const __attribute__((address_space(3))) bf16x8*)(kp+6656);
}
__device__ __forceinline__ void kload2(bf16x8*kf,lds_cptr kp,int j){ kf[2*j]=*(const __attribute__((address_space(3))) bf16x8*)(kp+j*2048); kf[2*j+1]=*(const __attribute__((address_space(3))) bf16x8*)(kp+j*2048+512); }
__device__ __forceinline__ s16x4 vtr(lds_cptr p){ return __builtin_bit_cast(s16x4,__builtin_amdgcn_ds_read_tr16_b64_v4i16((__attribute__((address_space(3))) v4i16_t*)p)); }
__device__ __forceinline__ float rowmax(const f32x16&p0,const f32x16&p1){
  float a=max3f(p0[0],p0[1],p1[0]),b=max3f(p0[2],p0[3],p1[1]);a=max3f(a,p1[2],p1[3]);
  #pragma unroll
  for(int r=4;r<16;r+=4){a=max3f(a,p0[r],p0[r+1]);b=max3f(b,p0[r+2],p0[r+3]);a=max3f(a,p1[r],p1[r+1]);b=max3f(b,p1[r+2],p1[r+3]);}
  const float m=max2f(a,b);
  auto rr=__builtin_amdgcn_permlane32_swap(__float_as_uint(m),__float_as_uint(m),false,false);
  return max2f(__uint_as_float(rr[0]),__uint_as_float(rr[1]));
}
template<int THRL> __device__ __forceinline__ void attn_unit2(const bf16*Qu,const bf16*__restrict__ Kh,const bf16*__restrict__ Vh,bf16*Ou,const int NT,char*shm){
  constexpr int QPITCH=512,KVPITCH=128,OPITCH=1280;
  const int tid=mk_tid(),lane=tid&63,r32=lane&31,hi=lane>>5; const int wid=__builtin_amdgcn_readfirstlane(tid>>6);
  const bf16*Qw=Qu+(long)(wid*QBLK)*QPITCH;
  const unsigned lds0=(unsigned)(uintptr_t)shm;
  float*wsf=(float*)(shm+LDS_WS)+wid*64;
  const bf16*ksrc=Kh+(long)lane*KVPITCH+wid*8;
  const bf16*vsrc=Vh+(long)(16*(wid&3)+(lane>>2))*KVPITCH+(wid>>2)*32+(lane&3)*8;
  const unsigned kdst=lds0+LDS_K+wid*1024, vdst=lds0+LDS_V+wid*1024;
  #define DMA_K(t,slot) glds16(ksrc+(long)(t)*KVBLK*KVPITCH,(unsigned)__builtin_amdgcn_readfirstlane(kdst+(slot)))
  #define DMA_V(t,slot) glds16(vsrc+(long)(t)*KVBLK*KVPITCH,(unsigned)__builtin_amdgcn_readfirstlane(vdst+(slot)))
  const int vb0=(int)(lds0+LDS_V)+((lane>>4)&1)*32+(lane&3)*8+(4*hi+((lane&15)>>2))*64;
  const char*Kbase=shm+LDS_K; bf16x8 kf[8];
  const lds_cptr shm3=(lds_cptr)shm; const lds_cptr kp0=shm3+LDS_K+hi*1024+r32*16; const lds_cptr vp0=shm3+LDS_V+((lane>>4)&1)*32+(lane&3)*8+(4*hi+((lane&15)>>2))*64;
  DMA_K(0,0);DMA_V(0,0);DMA_K(1,SLOTB);
  bf16x8 qr[4];
  #pragma unroll
  for(int d0=0;d0<4;++d0)qr[d0]=*reinterpret_cast<const bf16x8*>(&Qw[(long)r32*QPITCH+d0*16+hi*8]);
  float mhat=0.f,l_reg=0.f;f32x16 o[2];o[0]=f32x16{};o[1]=f32x16{};f32x16 negm=f32x16{};asm volatile("":"+v"(negm));
  #define CMASK(P0,P1,t) do{}while(0)
  bool resc=false;
  #define START(P0,P1) do{ const float rm=rowmax(P0,P1); resc=false; \
    { const float dl=rm; mhat=fadd_s(mhat,dl); \
      _Pragma("unroll") for(int r=0;r<16;++r){P0[r]=fsub_s(P0[r],dl);P1[r]=fsub_s(P1[r],dl);} \
      _Pragma("unroll") for(int r=0;r<16;++r)negm[r]=-mhat; asm volatile("":"+v"(negm)); } \
    _Pragma("unroll") for(int r=0;r<16;++r)P0[r]=__builtin_amdgcn_exp2f(P0[r]); }while(0)
  #define RESC() do{ if(resc){ asm volatile("s_waitcnt lgkmcnt(0)":::"memory"); \
      _Pragma("unroll") for(int d_=0;d_<2;++d_) _Pragma("unroll") for(int r=0;r<16;++r)o[d_][r]*=wsf[crow(r,hi)]; } }while(0)
  f32x16 pA0,pA1,pB0,pB1;
  int sl_prev=0,sl_cur=0,sl_next=SLOTB;
  #define ROT() do{sl_prev=sl_cur;sl_cur=sl_next;sl_next=(sl_next==(NSLOT-1)*SLOTB)?0:sl_next+SLOTB;}while(0)
  DMA_K(2,2*SLOTB);
  WAIT_BAR(3);
  qkt(pA0,pA1,Kbase,qr,negm,r32,hi);asm volatile("s_nop 15\n\ts_nop 7":"+v"(pA0),"+v"(pA1));CMASK(pA0,pA1,0);
  START(pA0,pA1);
  _Pragma("unroll") for(int r=0;r<16;++r)pA1[r]=__builtin_amdgcn_exp2f(pA1[r]);
  WAIT_BAR(0);
  DMA_K(3,0);DMA_V(1,SLOTB);
  ROT();
  kload8(kf,kp0+sl_cur);
  WAIT_BAR(2);
  s16x4 vlo[8],vhi[8]; u32x4 pw0,pw1,pw2,pw3;
  #define PKW(P,B) cvtpk_s(P[B],P[B+1])
  #define PAF(k) __builtin_bit_cast(bf16x8,pw##k)
  #define VFR(i) (bf16x8){vlo[i][0],vlo[i][1],vlo[i][2],vlo[i][3],vhi[i][0],vhi[i][1],vhi[i][2],vhi[i][3]}
  #define PIN(x) asm volatile("":"+v"(x))
  #define MX3(a,b,c) __builtin_fmaxf(__builtin_fmaxf((a),(b)),(c))
  #define GAPA(MF,A0,A1,A2,A3,W0,W1,PW) do{ MF; sacc+=A0; sacc+=A1; sacc+=A2; sacc+=A3; PIN(sacc); W0; W1; PIN(PW); SBAR(); }while(0)
  #define EX(v) __builtin_amdgcn_exp2f(v)
  #define GAPB(MF,X,B) do{ MF; X[B]=EX(X[B]); X[B+1]=EX(X[B+1]); X[B+2]=EX(X[B+2]); X[B+3]=EX(X[B+3]); PIN(X); SBAR(); }while(0)
  #define VRD(i) do{ vlo[i]=vtr(vp_+(((i)>>2)*4096+((i)&3)*1024)); vhi[i]=vtr(vp_+(((i)>>2)*4096+((i)&3)*1024+512)); }while(0)
  #define KRD(G,j) do{ if(G){ kload2(kf,kp0+sl_next,j); SBAR(); } }while(0)
  #define STEP(C0,C1,P0,P1,t,GK,GV,GL) do{ SBAR(); \
    const lds_cptr vp_=vp0+sl_prev; \
    VRD(0); SBAR(); float sacc=(P0[0]+P0[1]); \
    GAPA(C0=__builtin_amdgcn_mfma_f32_32x32x16_bf16(kf[0],qr[0],negm,0,0,0), P0[2],P0[3],P0[4],P0[5],     pw0[0]=PKW(P0,0), pw0[1]=PKW(P0,2), pw0); \
    VRD(4); SBAR(); GAPA(C1=__builtin_amdgcn_mfma_f32_32x32x16_bf16(kf[1],qr[0],negm,0,0,0), P0[6],P0[7],P0[8],P0[9],     pw0[2]=PKW(P0,4), pw0[3]=PKW(P0,6), pw0); \
    VRD(1); SBAR(); GAPA(C0=__builtin_amdgcn_mfma_f32_32x32x16_bf16(kf[2],qr[1],C0,0,0,0),   P0[10],P0[11],P0[12],P0[13], pw1[0]=PKW(P0,8), pw1[1]=PKW(P0,10), pw1); \
    VRD(5); SBAR(); GAPA(C1=__builtin_amdgcn_mfma_f32_32x32x16_bf16(kf[3],qr[1],C1,0,0,0),   P0[14],P0[15],P1[0],P1[1],   pw1[2]=PKW(P0,12),pw1[3]=PKW(P0,14), pw1); \
    VRD(2); SBAR(); GAPA(C0=__builtin_amdgcn_mfma_f32_32x32x16_bf16(kf[4],qr[2],C0,0,0,0),   P1[2],P1[3],P1[4],P1[5],     pw2[0]=PKW(P1,0), pw2[1]=PKW(P1,2), pw2); \
    VRD(6); SBAR(); GAPA(C1=__builtin_amdgcn_mfma_f32_32x32x16_bf16(kf[5],qr[2],C1,0,0,0),   P1[6],P1[7],P1[8],P1[9],     pw2[2]=PKW(P1,4), pw2[3]=PKW(P1,6), pw2); \
    VRD(3); SBAR(); GAPA(C0=__builtin_amdgcn_mfma_f32_32x32x16_bf16(kf[6],qr[3],C0,0,0,0),   P1[10],P1[11],P1[12],P1[13], pw3[0]=PKW(P1,8), pw3[1]=PKW(P1,10), pw3); \
    VRD(7); SBAR(); GAPA(C1=__builtin_amdgcn_mfma_f32_32x32x16_bf16(kf[7],qr[3],C1,0,0,0),   P1[14],P1[15],0.f,0.f,       pw3[2]=PKW(P1,12),pw3[3]=PKW(P1,14), pw3); \
    l_reg+=sacc; \
    if(GK){DMA_K((t)+3,sl_cur);} if(GV){DMA_V((t)+1,sl_next);} \
    CMASK(C0,C1,t); \
    { float a=MX3(C0[0],C0[1],C1[0]),b=MX3(C0[2],C0[3],C1[1]); a=MX3(a,C1[2],C1[3]); \
      _Pragma("unroll") for(int r=4;r<16;r+=4){a=MX3(a,C0[r],C0[r+1]);b=MX3(b,C0[r+2],C0[r+3]);a=MX3(a,C1[r],C1[r+1]);b=MX3(b,C1[r+2],C1[r+3]);} \
      float rm=__builtin_fmaxf(a,b); { auto rr=__builtin_amdgcn_permlane32_swap(__float_as_uint(rm),__float_as_uint(rm),false,false); rm=__builtin_fmaxf(__uint_as_float(rr[0]),__uint_as_float(rr[1])); } \
      resc=false; \
      if(__builtin_expect(__any(rm>(float)THRL),0)){ const float dl=__builtin_fmaxf(rm,0.f); mhat+=dl; \
        _Pragma("unroll") for(int r=0;r<16;++r){C0[r]-=dl;C1[r]-=dl;} \
        _Pragma("unroll") for(int r=0;r<16;++r)negm[r]=-mhat; asm volatile("":"+v"(negm)); \
        const float f=__builtin_amdgcn_exp2f(-dl); l_reg*=f; if(hi==0)wsf[r32]=f; resc=true; } } \
    SBAR(); \
    GAPB(o[0]=__builtin_amdgcn_mfma_f32_32x32x16_bf16(PAF(0),VFR(0),o[0],0,0,0), C0,0); \
    GAPB(o[1]=__builtin_amdgcn_mfma_f32_32x32x16_bf16(PAF(0),VFR(4),o[1],0,0,0), C0,4); \
    KRD(GL,0); GAPB(o[0]=__builtin_amdgcn_mfma_f32_32x32x16_bf16(PAF(1),VFR(1),o[0],0,0,0), C0,8); \
    KRD(GL,1); GAPB(o[1]=__builtin_amdgcn_mfma_f32_32x32x16_bf16(PAF(1),VFR(5),o[1],0,0,0), C0,12); \
    KRD(GL,2); GAPB(o[0]=__builtin_amdgcn_mfma_f32_32x32x16_bf16(PAF(2),VFR(2),o[0],0,0,0), C1,0); \
    KRD(GL,3); GAPB(o[1]=__builtin_amdgcn_mfma_f32_32x32x16_bf16(PAF(2),VFR(6),o[1],0,0,0), C1,4); \
    GAPB(o[0]=__builtin_amdgcn_mfma_f32_32x32x16_bf16(PAF(3),VFR(3),o[0],0,0,0), C1,8); \
    GAPB(o[1]=__builtin_amdgcn_mfma_f32_32x32x16_bf16(PAF(3),VFR(7),o[1],0,0,0), C1,12); \
    }while(0)
  int t=1;
  #undef CMASK
  #define CMASK(P0,P1,t) do{}while(0)
  for(;t+5<NT;t+=2){
    STEP(pB0,pB1,pA0,pA1,t,true,true,true);     WAIT_BAR(2); RESC(); ROT();
    STEP(pA0,pA1,pB0,pB1,t+1,true,true,true);   WAIT_BAR(2); RESC(); ROT();
  }
  #undef CMASK
  #define CMASK(P0,P1,t) do{}while(0)
  #define ENDW(tt) do{ if((tt)+3<NT){WAIT_BAR(2);} else if((tt)+2<NT){WAIT_BAR(1);} else {WAIT_BAR(0);} }while(0)
  for(;t+1<NT;t+=2){
    STEP(pB0,pB1,pA0,pA1,t,(t+3<NT),(t+1<NT),(t+1<NT));       ENDW(t);   RESC(); ROT();
    STEP(pA0,pA1,pB0,pB1,t+1,(t+4<NT),(t+2<NT),(t+2<NT));     ENDW(t+1); RESC(); ROT();
  }
  STEP(pB0,pB1,pA0,pA1,NT-1,false,false,false); RESC();
  { float sacc=pB0[0]+pB0[1]; _Pragma("unroll") for(int r=2;r<16;++r)sacc+=pB0[r]; _Pragma("unroll") for(int r=0;r<16;++r)sacc+=pB1[r]; l_reg+=sacc;
    pw0=(u32x4){PKW(pB0,0),PKW(pB0,2),PKW(pB0,4),PKW(pB0,6)};pw1=(u32x4){PKW(pB0,8),PKW(pB0,10),PKW(pB0,12),PKW(pB0,14)};pw2=(u32x4){PKW(pB1,0),PKW(pB1,2),PKW(pB1,4),PKW(pB1,6)};pw3=(u32x4){PKW(pB1,8),PKW(pB1,10),PKW(pB1,12),PKW(pB1,14)};
    SBAR(); pv(o,vb0+sl_cur,PAF(0),PAF(1),PAF(2),PAF(3)); }
  #undef PKW
  #undef PAF
  #undef VFR
  #undef PIN
  #undef MX3
  #undef GAPA
  #undef GAPB
  #undef EX
  #undef VRD
  #undef KRD
  #undef STEP
  #undef ENDW
  {auto rr=__builtin_amdgcn_permlane32_swap(__float_as_uint(l_reg),__float_as_uint(l_reg),false,false);l_reg=__uint_as_float(rr[0])+__uint_as_float(rr[1]);}
  if(hi==0)wsf[32+r32]=l_reg;asm volatile("s_waitcnt lgkmcnt(0)":::"memory");
  float rli[16];
  #pragma unroll
  for(int r=0;r<16;++r)rli[r]=__builtin_amdgcn_rcpf(wsf[32+crow(r,hi)]);
  bf16*Ow=Ou+(long)(wid*QBLK)*OPITCH;
  { bf16*stg=(bf16*)(shm+LDS_OST)+wid*2048;
    #pragma unroll
    for(int r=0;r<16;++r){const int orow=crow(r,hi);
      #pragma unroll
      for(int d0=0;d0<2;++d0)stg[orow*64+d0*32+r32]=__float2bfloat16(o[d0][r]*rli[r]);}
    asm volatile("s_waitcnt lgkmcnt(0)":::"memory");
    #pragma unroll
    for(int i=0;i<4;++i){const int row=i*8+(lane>>3),ch=lane&7; const u32x4 v=*(const u32x4*)(stg+row*64+ch*8); *(u32x4*)(Ow+(long)row*OPITCH+ch*8)=v;} }
  asm volatile("s_waitcnt lgkmcnt(0)\n\ts_barrier":::"memory");
  #undef DMA_K
  #undef DMA_V
  #undef CMASK
  #undef START
  #undef RESC
  #undef ROT
}
#undef SBAR
#undef WAIT_BAR
}

namespace mk {
using pg8::bf16_t; using pg8::f32x4; using pg8::Unit; using pg8::cvt_pk_bf16;
#define LAS __attribute__((address_space(3)))
typedef unsigned u32x2 __attribute__((ext_vector_type(2)));
typedef unsigned u32x4 __attribute__((ext_vector_type(4)));
typedef float f32x2 __attribute__((ext_vector_type(2)));
typedef short bf16x8 __attribute__((ext_vector_type(8)));
typedef float f32x16 __attribute__((ext_vector_type(16)));

constexpr int DM = 1024, NB = 8, SL = 4096, CL = 256, ML = NB * SL, MC = NB * CL, MT = ML + MC;
constexpr int INW = 1792, DFF = 2816, UPW = 5632, MIXK = 1280, KVP = 128, QP = 512, KVB = SL + CL;
constexpr int HALF_A = 16384;
constexpr float EPS = 1e-6f;
constexpr float QSCALE = 0.125f * 1.4426950408889634f;

constexpr size_t MiB = 1u << 20;
constexpr size_t WS_CTL = 0;
constexpr size_t WS_MODP = 1 * MiB;
constexpr size_t WS_MOD = 5 * MiB;
constexpr size_t WS_T = 6 * MiB;
constexpr size_t WS_TW = 7 * MiB;
constexpr size_t WS_W = 8 * MiB;
constexpr size_t W_LAYER = 24 * MiB;
constexpr size_t WS_ADFT = 56 * MiB;
constexpr size_t WS_ADFTC = 88 * MiB;
constexpr size_t WS_KF = 89 * MiB;
constexpr size_t WS_KFC = 121 * MiB;
constexpr size_t WS_CX = 122 * MiB;
constexpr size_t WS_XN = 130 * MiB;
constexpr size_t WS_TMP = 198 * MiB;
constexpr size_t WS_Q = WS_TMP;
constexpr size_t WS_K = WS_TMP + 34 * MiB;
constexpr size_t WS_V = WS_TMP + 43 * MiB;
constexpr size_t WS_FT = WS_TMP + 52 * MiB;
constexpr size_t WS_FTC = WS_TMP + 68 * MiB;
constexpr size_t WS_PT = WS_TMP + 69 * MiB;
constexpr size_t WS_PTC = WS_TMP + 117 * MiB;
constexpr size_t WS_MIX = WS_TMP + 120 * MiB;
constexpr size_t WS_HRAW = WS_TMP + 206 * MiB;
constexpr size_t WS_U = WS_TMP;
constexpr size_t WS_G = WS_TMP;
constexpr size_t WS_SB = WS_TMP + 190 * MiB;
constexpr size_t WS_END = WS_TMP + 297 * MiB;

struct Params { const float* in[29]; float* out; unsigned char* ws; int ph_lo, ph_hi; };
enum { I_X = 0, I_C, I_CTX, I_CCTX, I_WMOD, I_BMOD, I_GPREMIX, I_GPOSTMIX, I_GPREFFN, I_GPOSTFFN, I_WIN, I_GQ, I_GK, I_WF, I_WHC, I_BHC,
       I_HW1, I_HB1, I_HFR1, I_HW2, I_HB2, I_HFR2, I_HW3, I_HBIAS, I_WOUT, I_WUP, I_WFC, I_BFC, I_WDOWN };

__device__ __forceinline__ unsigned f2bf(float f) { unsigned u = __builtin_bit_cast(unsigned, f); return (u + 0x7fffu + ((u >> 16) & 1u)) >> 16; }
__device__ __forceinline__ unsigned pk2(float lo, float hi) { return f2bf(lo) | (f2bf(hi) << 16); }
__device__ __forceinline__ float bflo(unsigned w) { return __uint_as_float(w << 16); }
__device__ __forceinline__ float bfhi(unsigned w) { return __uint_as_float(w & 0xffff0000u); }
__device__ __forceinline__ float bf2f(bf16_t h) { return __uint_as_float((unsigned)h << 16); }
__device__ __forceinline__ float wave_sum(float v) {
#pragma unroll
    for (int o = 1; o < 64; o <<= 1) v += __shfl_xor(v, o);
    return v;
}

struct EpiPlain {
    static constexpr bool PERM = true, AFTER_DRAIN = false;
    bf16_t* O; int ldc;
    __device__ __forceinline__ void operator()(const f32x4 (&acc)[2][2][4][2], const Unit& u, int wr, int wc, int fr, int fq) const {
        const int row0 = u.pm * 256 + wr * 64 + fr; const int col0 = u.pn * 256 + wc * 32 + 8 * fq;
#pragma unroll
        for (int ai = 0; ai < 2; ++ai)
#pragma unroll
            for (int m = 0; m < 4; ++m) { bf16_t* rowp = O + (size_t)(row0 + ai * 128 + m * 16) * ldc + col0;
#pragma unroll
                for (int bj = 0; bj < 2; ++bj) { const f32x4 v0 = acc[ai][bj][m][0], v1 = acc[ai][bj][m][1];
                    u32x4 w; w.x = cvt_pk_bf16(v0[0], v0[1]); w.y = cvt_pk_bf16(v0[2], v0[3]); w.z = cvt_pk_bf16(v1[0], v1[1]); w.w = cvt_pk_bf16(v1[2], v1[3]);
                    *(u32x4*)(rowp + bj * 128) = w; } }
    }
};

struct EpiFourier {
    static constexpr bool PERM = true, AFTER_DRAIN = false;
    bf16_t* MIXp; int Lh; int rowbase0; int rowstride;
    __device__ __forceinline__ void operator()(const f32x4 (&acc)[2][2][4][2], const Unit& u, int wr, int wc, int fr, int fq) const {
        asm volatile("" : "+v"(fr), "+v"(fq), "+s"(wr), "+s"(wc));
        const int b = u.pn; const int len = 2 * Lh; const int rb = rowbase0 + b * rowstride;
#pragma unroll
        for (int ai = 0; ai < 2; ++ai)
#pragma unroll
            for (int m = 0; m < 4; ++m) {
                const int r = u.pm * 256 + ai * 128 + wr * 64 + m * 16 + fr;
                const bool isS = r > Lh; const int k = isS ? r - Lh : r;
                const bool edge = (k == 0) || (k == Lh);
#pragma unroll
                for (int bj = 0; bj < 2; ++bj) { const f32x4 v0 = acc[ai][bj][m][0], v1 = acc[ai][bj][m][1];
                    const int ch = bj * 128 + wc * 32 + 8 * fq;
                    u32x4 w; w.x = cvt_pk_bf16(v0[0], v0[1]); w.y = cvt_pk_bf16(v0[2], v0[3]); w.z = cvt_pk_bf16(v1[0], v1[1]); w.w = cvt_pk_bf16(v1[2], v1[3]);
                    const int col = 512 + (isS ? 256 : 0) + ch;
                    *(u32x4*)(MIXp + (size_t)(rb + k) * MIXK + col) = w;
                    if (!edge) { u32x4 wm = w; if (isS) { wm.x ^= 0x80008000u; wm.y ^= 0x80008000u; wm.z ^= 0x80008000u; wm.w ^= 0x80008000u; }
                        *(u32x4*)(MIXp + (size_t)(rb + len - k) * MIXK + col) = wm; }
                    else if (!isS) { *(u32x4*)(MIXp + (size_t)(rb + k) * MIXK + col + 256) = (u32x4){0u, 0u, 0u, 0u}; }
                }
            }
    }
};

struct EpiInProj {
    static constexpr bool PERM = false, AFTER_DRAIN = false;
    bf16_t *Q, *K, *V, *fT, *fTc, *PT, *PTc; const float *gq, *gk, *rope; LAS float* xch;
    __device__ __forceinline__ void operator()(const f32x4 (&acc)[2][2][4][2], const Unit& u, int wr, int wc, int fr, int fq) const {
        asm volatile("" : "+v"(fr), "+v"(fq), "+s"(wr), "+s"(wc));
        const int pn = u.pn, pm = u.pm; const bool isctx = pm >= 128;
        const int b = isctx ? pm - 128 : pm >> 4;
        const int tbase = isctx ? 0 : (pm & 15) * 256;
#ifdef T_NOQK
        if (false) {
#else
        if (pn <= 2) {
#endif
#pragma unroll
            for (int ai = 0; ai < 2; ++ai)
#pragma unroll
                for (int m = 0; m < 4; ++m)
#pragma unroll
                    for (int bj = 0; bj < 2; ++bj) {
                        float s = 0.f;
#pragma unroll
                        for (int n = 0; n < 2; ++n) { const f32x4 x = acc[ai][bj][m][n]; s += (x[0] * x[0] + x[1] * x[1]) + (x[2] * x[2] + x[3] * x[3]); }
                        s += __shfl_xor(s, 16); s += __shfl_xor(s, 32);
                        if (fq == 0) xch[((ai * 128 + wr * 64 + m * 16 + fr) * 2 + bj) * 4 + wc] = s;
                    }
            asm volatile("s_waitcnt lgkmcnt(0)\n\ts_barrier" ::: "memory");
            const float* gg = (pn == 2) ? gk : gq;
            const int dbase = (wc & 1) * 32 + 4 * fq;
            const f32x4 g1 = *(const f32x4*)(gg + dbase), g2 = *(const f32x4*)(gg + dbase + 16);
            const float osc = (pn == 2) ? 1.0f : QSCALE;
#pragma unroll
            for (int ai = 0; ai < 2; ++ai)
#pragma unroll
                for (int m = 0; m < 4; ++m) {
                    const int rl = ai * 128 + wr * 64 + m * 16 + fr; const int t = tbase + rl;
                    const int p = (wc & 1) ? (t & 63) : (t >> 6);
                    f32x4 cs = (f32x4){1.f, 1.f, 1.f, 1.f}, sn = (f32x4){0.f, 0.f, 0.f, 0.f};
                    if (!isctx) { cs = *(const f32x4*)(rope + p * 16 + 4 * fq); sn = *(const f32x4*)(rope + 1024 + p * 16 + 4 * fq); }
                    const size_t qrow = (size_t)pm * 256 + rl;
                    const size_t kvrow = isctx ? (size_t)b * KVB + rl : (size_t)b * KVB + CL + t;
#pragma unroll
                    for (int bj = 0; bj < 2; ++bj) {
                        if (pn == 2 && bj == 1) {
#pragma unroll
                            for (int n = 0; n < 2; ++n) { const f32x4 x = acc[ai][bj][m][n]; u32x2 w; w.x = cvt_pk_bf16(x[0], x[1]); w.y = cvt_pk_bf16(x[2], x[3]);
                                *(u32x2*)(V + kvrow * KVP + wc * 32 + 16 * n + 4 * fq) = w; }
                        } else {
                            const float ssq = xch[(rl * 2 + bj) * 4 + wc] + xch[(rl * 2 + bj) * 4 + (wc ^ 1)];
                            const float rstd = rsqrtf(ssq * (1.0f / 64.0f) + EPS) * osc;
                            const f32x4 y1 = acc[ai][bj][m][0] * rstd * g1, y2 = acc[ai][bj][m][1] * rstd * g2;
                            const f32x4 o1 = y1 * cs - y2 * sn, o2 = y2 * cs + y1 * sn;
                            u32x2 w1, w2; w1.x = cvt_pk_bf16(o1[0], o1[1]); w1.y = cvt_pk_bf16(o1[2], o1[3]); w2.x = cvt_pk_bf16(o2[0], o2[1]); w2.y = cvt_pk_bf16(o2[2], o2[3]);
                            bf16_t* dst = (pn == 2) ? (K + kvrow * KVP + wc * 32 + 4 * fq) : (Q + qrow * QP + pn * 256 + bj * 128 + wc * 32 + 4 * fq);
                            *(u32x2*)dst = w1; *(u32x2*)(dst + 16) = w2;
                        }
                    }
                    asm volatile("" ::: "memory"); __builtin_amdgcn_sched_barrier(0);
                }
        }
#ifndef T_NOTR
        else {
            const int NC = (pn == 3) ? 256 : 768; const int cb = (pn == 3) ? 0 : (pn - 4) * 256;
            bf16_t* base; int tl;
            if (isctx) { base = ((pn == 3) ? fTc : PTc) + (size_t)b * NC * CL; tl = CL; }
            else { base = ((pn == 3) ? fT : PT) + (size_t)b * NC * SL + tbase; tl = SL; }
            const int lane = fq * 16 + fr;
            LAS bf16_t* stg = (LAS bf16_t*)((LAS unsigned char*)xch + 8192) + (wr * 4 + wc) * 1152;
#pragma unroll
            for (int ai = 0; ai < 2; ++ai)
#pragma unroll
                for (int bj = 0; bj < 2; ++bj)
#pragma unroll
                    for (int n = 0; n < 2; ++n) {
#pragma unroll
                        for (int m = 0; m < 4; ++m) { const f32x4 x = acc[ai][bj][m][n];
#pragma unroll
                            for (int j = 0; j < 4; ++j) stg[(4 * fq + j) * 72 + m * 16 + fr] = (bf16_t)f2bf(x[j]); }
                        asm volatile("s_waitcnt lgkmcnt(0)" ::: "memory");
                        bf16_t* dst = base + (size_t)(cb + bj * 128 + wc * 32 + 16 * n) * tl + ai * 128 + wr * 64;
#pragma unroll
                        for (int i = 0; i < 2; ++i) { const int v = lane + 64 * i, col = v >> 3, k = v & 7;
                            const u32x4 w = *(const LAS u32x4*)(stg + col * 72 + k * 8);
                            *(u32x4*)(dst + (size_t)col * tl + 8 * k) = w; }
                        asm volatile("s_waitcnt lgkmcnt(0)" ::: "memory");
                    }
        }
#endif
    }
};


__device__ __forceinline__ float dppf(float old, float src, int ctrl_sel) {
    const int o = __builtin_bit_cast(int, old), s = __builtin_bit_cast(int, src); int r;
    if (ctrl_sel == 0) r = __builtin_amdgcn_update_dpp(o, s, 0x111, 0xf, 0xf, false);
    else if (ctrl_sel == 1) r = __builtin_amdgcn_update_dpp(o, s, 0x101, 0xf, 0xf, false);
    else if (ctrl_sel == 2) r = __builtin_amdgcn_update_dpp(o, s, 0x121, 0xf, 0xf, false);
    else r = __builtin_amdgcn_update_dpp(o, s, 0x12F, 0xf, 0xf, false);
    return __builtin_bit_cast(float, r);
}
__device__ __forceinline__ float silu_mul(float cg, float cv) { return cg * cv * __builtin_amdgcn_rcpf(1.0f + __builtin_amdgcn_exp2f(-1.4426950408889634f * cg)); }

struct EpiGlu {
    static constexpr bool PERM = true, AFTER_DRAIN = false;
    bf16_t* G; bf16_t* SB; const float* wcv; const float* bcv; LAS float* xb;
    __device__ __forceinline__ void operator()(const f32x4 (&acc)[2][2][4][2], const Unit& u, int wr, int wc, int fr, int fq) const {
        asm volatile("" : "+v"(fr), "+v"(fq), "+s"(wr), "+s"(wc));
        const int c0 = 128 * u.pn + 32 * wc + 8 * fq;
#pragma unroll
        for (int ai = 0; ai < 2; ++ai) {
            if (fr == 0 || fr == 15) {
                const int which = fr == 0 ? 0 : 1; LAS float* dst = xb + ((((ai * 2 + wr) * 2 + which) * 4 + wc) * 4 + fq) * 16;
#pragma unroll
                for (int bj = 0; bj < 2; ++bj)
#pragma unroll
                    for (int n = 0; n < 2; ++n) { const f32x4 x = fr == 0 ? acc[ai][bj][0][n] : acc[ai][bj][3][n]; *(LAS f32x4*)(dst + bj * 8 + n * 4) = x; }
            }
        }
        asm volatile("s_waitcnt lgkmcnt(0)\n\ts_barrier" ::: "memory");
#pragma unroll
        for (int n = 0; n < 2; ++n) {
            f32x4 wg[3], wv[3], bg, bv;
#pragma unroll
            for (int d = 0; d < 3; ++d) { wg[d] = *(const f32x4*)(wcv + d * UPW + c0 + 4 * n); wv[d] = *(const f32x4*)(wcv + d * UPW + DFF + c0 + 4 * n); }
            bg = *(const f32x4*)(bcv + c0 + 4 * n); bv = *(const f32x4*)(bcv + DFF + c0 + 4 * n);
#pragma unroll
            for (int ai = 0; ai < 2; ++ai) {
                int pblk = -1, nblk = -1;
                if (wr == 1) pblk = ai * 2 + 0; else if (ai == 1) pblk = 0 * 2 + 1;
                if (wr == 0) nblk = ai * 2 + 1; else if (ai == 0) nblk = 1 * 2 + 0;
#pragma unroll
                for (int m = 0; m < 4; ++m) {
                    f32x4 pg = (f32x4){0.f, 0.f, 0.f, 0.f}, pv = pg, ng = pg, nv = pg;
                    if (m == 0 && pblk >= 0) { const LAS float* s = xb + (((pblk * 2 + 1) * 4 + wc) * 4 + fq) * 16; pg = *(const LAS f32x4*)(s + n * 4); pv = *(const LAS f32x4*)(s + 8 + n * 4); }
                    if (m == 3 && nblk >= 0) { const LAS float* s = xb + (((nblk * 2 + 0) * 4 + wc) * 4 + fq) * 16; ng = *(const LAS f32x4*)(s + n * 4); nv = *(const LAS f32x4*)(s + 8 + n * 4); }
                    float res[4];
#pragma unroll
                    for (int j = 0; j < 4; ++j) {
                        const float cg = acc[ai][0][m][n][j], cv = acc[ai][1][m][n][j];
                        const float og = m > 0 ? dppf(0.f, acc[ai][0][m - 1][n][j], 2) : pg[j], ov = m > 0 ? dppf(0.f, acc[ai][1][m - 1][n][j], 2) : pv[j];
                        const float qg = m < 3 ? dppf(0.f, acc[ai][0][m + 1][n][j], 3) : ng[j], qv = m < 3 ? dppf(0.f, acc[ai][1][m + 1][n][j], 3) : nv[j];
                        const float prg = dppf(og, cg, 0), prv = dppf(ov, cv, 0), nxg = dppf(qg, cg, 1), nxv = dppf(qv, cv, 1);
                        const float sg = prg * wg[0][j] + cg * wg[1][j] + nxg * wg[2][j] + bg[j];
                        const float sv = prv * wv[0][j] + cv * wv[1][j] + nxv * wv[2][j] + bv[j];
                        res[j] = silu_mul(sg, sv);
                    }
                    const int rl = ai * 128 + wr * 64 + m * 16 + fr;
                    u32x2 w; w.x = cvt_pk_bf16(res[0], res[1]); w.y = cvt_pk_bf16(res[2], res[3]);
                    *(u32x2*)(G + (size_t)(u.pm * 256 + rl) * DFF + c0 + 4 * n) = w;
                    if (rl < 2 || rl >= 254) {
                        const int which = rl < 2 ? rl : rl - 252; bf16_t* sb = SB + ((size_t)u.pm * 4 + which) * UPW + c0 + 4 * n;
                        const f32x4 g0 = acc[ai][0][m][n], v0 = acc[ai][1][m][n];
                        u32x2 a; a.x = cvt_pk_bf16(g0[0], g0[1]); a.y = cvt_pk_bf16(g0[2], g0[3]);
                        u32x2 b; b.x = cvt_pk_bf16(v0[0], v0[1]); b.y = cvt_pk_bf16(v0[2], v0[3]);
                        *(u32x2*)sb = a; *(u32x2*)(sb + DFF) = b;
                    }
                }
            }
            asm volatile("" ::: "memory");
        }
    }
};

__device__ __forceinline__ void glu_fixup(int blk, int nblk, int tid, int ntiles, const bf16_t* SB, bf16_t* G, const float* wc, const float* bc) {
    for (int it = blk; it < 2 * ntiles; it += nblk) {
        const int pm = it >> 1, b = it & 1;
        const bool isctx = pm >= 128; const bool has_prev = !isctx && (pm & 15) != 0, has_next = !isctx && (pm & 15) != 15;
        const bf16_t* rp; const bf16_t* rc; const bf16_t* rn; bool hp, hn;
        if (b == 0) { rp = SB + ((size_t)(pm - 1) * 4 + 3) * UPW; rc = SB + ((size_t)pm * 4 + 0) * UPW; rn = SB + ((size_t)pm * 4 + 1) * UPW; hp = has_prev; hn = true; }
        else { rp = SB + ((size_t)pm * 4 + 2) * UPW; rc = SB + ((size_t)pm * 4 + 3) * UPW; rn = SB + ((size_t)(pm + 1) * 4 + 0) * UPW; hp = true; hn = has_next; }
        bf16_t* grow = G + (size_t)(pm * 256 + (b ? 255 : 0)) * DFF;
        for (int c = tid; c < DFF; c += 512) {
            const float gp = hp ? bf2f(rp[c]) : 0.f, gc = bf2f(rc[c]), gn = hn ? bf2f(rn[c]) : 0.f;
            const float vp = hp ? bf2f(rp[DFF + c]) : 0.f, vc = bf2f(rc[DFF + c]), vn = hn ? bf2f(rn[DFF + c]) : 0.f;
            const float sg = gp * wc[c] + gc * wc[UPW + c] + gn * wc[2 * UPW + c] + bc[c];
            const float sv = vp * wc[DFF + c] + vc * wc[UPW + DFF + c] + vn * wc[2 * UPW + DFF + c] + bc[DFF + c];
            grow[c] = (bf16_t)f2bf(silu_mul(sg, sv));
        }
    }
}

struct OneUnit { int pm, pn;
    __device__ __forceinline__ bool next(int i, Unit& u) const { if (i > 0) return false; u.pm = pm; u.pn = pn; return true; }
    __device__ __forceinline__ void a_ready(const Unit&) const {}
    __device__ __forceinline__ void done(const Unit&) const {}
};

constexpr int AT_K = 0, AT_V = 16384, AT_WS = 32768, AT_OST = 32768 + 2048;
__device__ __forceinline__ void attn_unit(const bf16_t* Qu, const bf16_t* Kh, const bf16_t* Vh, bf16_t* Ou, int NT, char* shm) {
    using namespace attn_body;
    const int tid = mk_tid(), lane = tid & 63, r32 = lane & 31, hi = lane >> 5; const int wid = __builtin_amdgcn_readfirstlane(tid >> 6);
    const unsigned lds0 = (unsigned)(uintptr_t)shm;
    float* wsf = (float*)(shm + AT_WS) + wid * 64;
    const bf16_t* ksrc = Kh + (size_t)lane * KVP + wid * 8;
    const bf16_t* vsrc = Vh + (size_t)(16 * (wid & 3) + (lane >> 2)) * KVP + (wid >> 2) * 32 + (lane & 3) * 8;
    const unsigned kdst = lds0 + AT_K + wid * 1024, vdst = lds0 + AT_V + wid * 1024;
#define DMA_K(t, slot) glds16(ksrc + (size_t)(t) * 64 * KVP, (unsigned)__builtin_amdgcn_readfirstlane(kdst + (slot)))
#define DMA_V(t, slot) glds16(vsrc + (size_t)(t) * 64 * KVP, (unsigned)__builtin_amdgcn_readfirstlane(vdst + (slot)))
    const int vb0 = (int)(lds0 + AT_V) + ((lane >> 4) & 1) * 32 + (lane & 3) * 8 + (4 * hi + ((lane & 15) >> 2)) * 64;
    DMA_K(0, 0); DMA_V(0, 0);
    const bf16_t* Qw = Qu + (size_t)(wid * 32) * QP;
    bf16x8 qr[4];
#pragma unroll
    for (int d0 = 0; d0 < 4; ++d0) qr[d0] = *reinterpret_cast<const bf16x8*>(&Qw[(size_t)r32 * QP + d0 * 16 + hi * 8]);
    float mrun = -INFINITY, l_reg = 0.f; f32x16 o[2]; o[0] = f32x16{}; o[1] = f32x16{};
    f32x16 zero16 = f32x16{};
    for (int t = 0; t < NT; ++t) {
        const int buf = (t & 1) * 8192;
        if (t + 1 < NT) { DMA_K(t + 1, buf ^ 8192); DMA_V(t + 1, buf ^ 8192); asm volatile("s_waitcnt vmcnt(2)\n\ts_barrier" ::: "memory"); }
        else { asm volatile("s_waitcnt vmcnt(0)\n\ts_barrier" ::: "memory"); }
        f32x16 p0, p1;
        qkt(p0, p1, shm + AT_K + buf, qr, zero16, r32, hi);
        float rm = p0[0];
#pragma unroll
        for (int r = 1; r < 16; ++r) rm = fmaxf(rm, p0[r]);
#pragma unroll
        for (int r = 0; r < 16; ++r) rm = fmaxf(rm, p1[r]);
        rm = fmaxf(rm, __shfl_xor(rm, 32));
        const float mnew = fmaxf(mrun, rm);
        const float f = __builtin_amdgcn_exp2f(mrun - mnew);
        mrun = mnew;
        float sacc = 0.f;
#pragma unroll
        for (int r = 0; r < 16; ++r) { p0[r] = __builtin_amdgcn_exp2f(p0[r] - mnew); p1[r] = __builtin_amdgcn_exp2f(p1[r] - mnew); sacc += p0[r] + p1[r]; }
        l_reg = l_reg * f + sacc;
        if (hi == 0) wsf[r32] = f;
        asm volatile("s_waitcnt lgkmcnt(0)" ::: "memory");
#pragma unroll
        for (int r = 0; r < 16; ++r) { const float fr_ = wsf[crow(r, hi)]; o[0][r] *= fr_; o[1][r] *= fr_; }
        u32x4 pw0, pw1, pw2, pw3;
        pw0 = (u32x4){cvtpk_s(p0[0], p0[1]), cvtpk_s(p0[2], p0[3]), cvtpk_s(p0[4], p0[5]), cvtpk_s(p0[6], p0[7])};
        pw1 = (u32x4){cvtpk_s(p0[8], p0[9]), cvtpk_s(p0[10], p0[11]), cvtpk_s(p0[12], p0[13]), cvtpk_s(p0[14], p0[15])};
        pw2 = (u32x4){cvtpk_s(p1[0], p1[1]), cvtpk_s(p1[2], p1[3]), cvtpk_s(p1[4], p1[5]), cvtpk_s(p1[6], p1[7])};
        pw3 = (u32x4){cvtpk_s(p1[8], p1[9]), cvtpk_s(p1[10], p1[11]), cvtpk_s(p1[12], p1[13]), cvtpk_s(p1[14], p1[15])};
        pv(o, vb0 + buf, __builtin_bit_cast(bf16x8, pw0), __builtin_bit_cast(bf16x8, pw1), __builtin_bit_cast(bf16x8, pw2), __builtin_bit_cast(bf16x8, pw3));
        asm volatile("s_waitcnt lgkmcnt(0)\n\ts_barrier" ::: "memory");
    }
    l_reg += __shfl_xor(l_reg, 32);
    if (hi == 0) wsf[32 + r32] = l_reg;
    asm volatile("s_waitcnt lgkmcnt(0)" ::: "memory");
    float rli[16];
#pragma unroll
    for (int r = 0; r < 16; ++r) rli[r] = 1.0f / wsf[32 + crow(r, hi)];
    bf16_t* Ow = Ou + (size_t)(wid * 32) * MIXK;
    { bf16_t* stg = (bf16_t*)(shm + AT_OST) + wid * 2048;
#pragma unroll
      for (int r = 0; r < 16; ++r) { const int orow = crow(r, hi);
#pragma unroll
        for (int d0 = 0; d0 < 2; ++d0) stg[orow * 64 + d0 * 32 + r32] = (bf16_t)f2bf(o[d0][r] * rli[r]); }
      asm volatile("s_waitcnt lgkmcnt(0)" ::: "memory");
#pragma unroll
      for (int i = 0; i < 4; ++i) { const int row = i * 8 + (lane >> 3), ch = lane & 7; const u32x4 v = *(const u32x4*)(stg + row * 64 + ch * 8); *(u32x4*)(Ow + (size_t)row * MIXK + ch * 8) = v; } }
    asm volatile("s_waitcnt vmcnt(0) lgkmcnt(0)\n\ts_barrier" ::: "memory");
#undef DMA_K
#undef DMA_V
}

__device__ __forceinline__ int PADI(int i) { return i + (i >> 5); }
constexpr int FFT_TW_OFF = 69632, FFT_RED_OFF = 69632 + 32768;
template <int LOGN, int R, bool INV>
__device__ __forceinline__ void fft_pass(LAS f32x2* d, const LAS f32x2* tw, int s, int tid) {
    constexpr int N = 1 << LOGN, RR = 1 << R;
    const int lgs = LOGN - s - R; const int stride = 1 << lgs;
    constexpr float C16[8] = {1.0f, 0.9238795325112867f, 0.7071067811865476f, 0.3826834323650898f, 0.0f, -0.3826834323650898f, -0.7071067811865476f, -0.9238795325112867f};
    constexpr float S16[8] = {0.0f, 0.3826834323650898f, 0.7071067811865476f, 0.9238795325112867f, 1.0f, 0.9238795325112867f, 0.7071067811865476f, 0.3826834323650898f};
    for (int g = tid; g < (N >> R); g += 512) {
        const int lo = g & (stride - 1), hi = g >> lgs; const int base = (hi << (lgs + R)) + lo;
        f32x2 v[RR];
#pragma unroll
        for (int e = 0; e < RR; ++e) v[e] = d[PADI(base + e * stride)];
        if constexpr (R == 1) { const f32x2 a = v[0], b = v[1]; v[0] = a + b; v[1] = a - b; }
        else {
            static_assert(R == 4 || R == 1, "radix");
            f32x2 Wb[4];
            Wb[0] = tw[lo << s];
#pragma unroll
            for (int j = 1; j < 4; ++j) Wb[j] = (f32x2){Wb[j - 1].x * Wb[j - 1].x - Wb[j - 1].y * Wb[j - 1].y, 2.0f * Wb[j - 1].x * Wb[j - 1].y};
#pragma unroll
            for (int jj = 0; jj < 4; ++jj) {
                const int j = INV ? (3 - jj) : jj;
                const int he = 8 >> j;
#pragma unroll
                for (int q = 0; q < 8; ++q) if (q < he) {
                    const int k = q << j;
                    const f32x2 w = (f32x2){Wb[j].x * C16[k] + Wb[j].y * S16[k], Wb[j].y * C16[k] - Wb[j].x * S16[k]};
#pragma unroll
                    for (int e = 0; e < 16; ++e) if ((e & he) == 0 && (e & (he - 1)) == q) {
                        const f32x2 a = v[e], b = v[e + he];
                        if (!INV) { const f32x2 dl = a - b; v[e] = a + b; v[e + he] = (f32x2){dl.x * w.x - dl.y * w.y, dl.x * w.y + dl.y * w.x}; }
                        else { const f32x2 bw = (f32x2){b.x * w.x + b.y * w.y, b.y * w.x - b.x * w.y}; v[e] = a + bw; v[e + he] = a - bw; }
                    }
                }
            }
        }
#pragma unroll
        for (int e = 0; e < RR; ++e) d[PADI(base + e * stride)] = v[e];
    }
    __syncthreads();
}
template <int LOGN> __device__ __forceinline__ void fft_fwd(LAS f32x2* d, const LAS f32x2* tw, int tid) {
    if constexpr (LOGN == 13) { fft_pass<13, 4, false>(d, tw, 0, tid); fft_pass<13, 4, false>(d, tw, 4, tid); fft_pass<13, 4, false>(d, tw, 8, tid); fft_pass<13, 1, false>(d, tw, 12, tid); }
    else { fft_pass<9, 4, false>(d, tw, 0, tid); fft_pass<9, 4, false>(d, tw, 4, tid); fft_pass<9, 1, false>(d, tw, 8, tid); }
}
template <int LOGN> __device__ __forceinline__ void fft_inv(LAS f32x2* d, const LAS f32x2* tw, int tid) {
    if constexpr (LOGN == 13) { fft_pass<13, 1, true>(d, tw, 12, tid); fft_pass<13, 4, true>(d, tw, 8, tid); fft_pass<13, 4, true>(d, tw, 4, tid); fft_pass<13, 4, true>(d, tw, 0, tid); }
    else { fft_pass<9, 1, true>(d, tw, 8, tid); fft_pass<9, 4, true>(d, tw, 4, tid); fft_pass<9, 4, true>(d, tw, 0, tid); }
}
template <int LOGN> __device__ __forceinline__ void load_tw(LAS f32x2* tw, const f32x2* g, int tid) {
    for (int i = tid; i < (1 << (LOGN - 1)); i += 512) tw[i] = g[i];
}

template <int LOGN> __device__ __forceinline__ void kf_job(LAS unsigned char* lds, const float* hrawT, const f32x2* twg, f32x2* kf, int ch, int tid) {
    constexpr int N = 1 << LOGN, T = N / 2;
    LAS f32x2* d = (LAS f32x2*)lds; LAS f32x2* tw = (LAS f32x2*)(lds + FFT_TW_OFF); LAS float* red = (LAS float*)(lds + FFT_RED_OFF);
    load_tw<LOGN>(tw, twg, tid);
    float s = 0.f;
    for (int n = tid; n < N; n += 512) {
        float v;
        if (n < T) v = hrawT[(size_t)ch * T + n]; else if (n == T) v = 0.f; else v = hrawT[(size_t)(256 + ch) * T + (N - n)];
        d[PADI(n)] = (f32x2){v, 0.f}; s += fabsf(v);
    }
    s = wave_sum(s);
    if ((tid & 63) == 0) red[tid >> 6] = s;
    __syncthreads();
    float tot = 0.f;
#pragma unroll
    for (int i = 0; i < 8; ++i) tot += red[i];
    const float inv = 1.0f / tot;
    for (int n = tid; n < N; n += 512) { f32x2 v = d[PADI(n)]; v.x *= inv; d[PADI(n)] = v; }
    __syncthreads();
    fft_fwd<LOGN>(d, tw, tid);
    for (int n = tid; n < N; n += 512) kf[(size_t)ch * N + n] = d[PADI(n)];
    __syncthreads();
}

template <int LOGN> __device__ __forceinline__ void hyena_job(LAS unsigned char* lds, const bf16_t* PTall, const f32x2* twg, const f32x2* kf, const float* wc, const float* bc, const float* hbias,
                                                            bf16_t* MIXp, int rowbase, int bp, int ch, int tid) {
    constexpr int N = 1 << LOGN, T = N / 2, PER = (T + 511) / 512;
    LAS f32x2* d = (LAS f32x2*)lds; LAS f32x2* tw = (LAS f32x2*)(lds + FFT_TW_OFF);
    load_tw<LOGN>(tw, twg, tid);
    const float w10 = wc[256 + ch], w11 = wc[768 + 256 + ch], w12 = wc[1536 + 256 + ch], b1 = bc[256 + ch];
    const float w20 = wc[512 + ch], w21 = wc[768 + 512 + ch], w22 = wc[1536 + 512 + ch], b2 = bc[512 + ch];
    const float w00 = wc[ch], w01 = wc[768 + ch], w02 = wc[1536 + ch], b0 = bc[ch];
    const float hb = hbias[ch];
    f32x2 ukeep[PER];
#pragma unroll
    for (int i = 0; i < PER; ++i) {
        const int t = tid + 512 * i;
        f32x2 u = (f32x2){0.f, 0.f};
        if (t < T) {
#pragma unroll
            for (int bb = 0; bb < 2; ++bb) {
                const bf16_t* p1 = PTall + ((size_t)(2 * bp + bb) * 768 + 256 + ch) * T; const bf16_t* p2 = PTall + ((size_t)(2 * bp + bb) * 768 + 512 + ch) * T;
                const float a_m = t > 0 ? bf2f(p1[t - 1]) : 0.f, a_0 = bf2f(p1[t]), a_p = t < T - 1 ? bf2f(p1[t + 1]) : 0.f;
                const float c_m = t > 0 ? bf2f(p2[t - 1]) : 0.f, c_0 = bf2f(p2[t]), c_p = t < T - 1 ? bf2f(p2[t + 1]) : 0.f;
                const float x1 = a_m * w10 + a_0 * w11 + a_p * w12 + b1, vv = c_m * w20 + c_0 * w21 + c_p * w22 + b2;
                if (bb == 0) u.x = x1 * vv; else u.y = x1 * vv;
            }
            d[PADI(t)] = u; d[PADI(t + T)] = (f32x2){0.f, 0.f};
        }
        ukeep[i] = u;
    }
    __syncthreads();
    fft_fwd<LOGN>(d, tw, tid);
    for (int n = tid; n < N; n += 512) { const f32x2 a = d[PADI(n)], k = kf[(size_t)ch * N + n]; d[PADI(n)] = (f32x2){a.x * k.x - a.y * k.y, a.x * k.y + a.y * k.x}; }
    __syncthreads();
    fft_inv<LOGN>(d, tw, tid);
    const float sc = 1.0f / (float)N;
#pragma unroll
    for (int i = 0; i < PER; ++i) {
        const int t = tid + 512 * i;
        if (t < T) {
            const f32x2 y = d[PADI(t)] * sc; const f32x2 u = ukeep[i];
#pragma unroll
            for (int bb = 0; bb < 2; ++bb) {
                const bf16_t* p0 = PTall + ((size_t)(2 * bp + bb) * 768 + ch) * T;
                const float a_m = t > 0 ? bf2f(p0[t - 1]) : 0.f, a_0 = bf2f(p0[t]), a_p = t < T - 1 ? bf2f(p0[t + 1]) : 0.f;
                const float x0 = a_m * w00 + a_0 * w01 + a_p * w02 + b0;
                const float yy = bb == 0 ? y.x : y.y, uu = bb == 0 ? u.x : u.y;
                MIXp[(size_t)(rowbase + (2 * bp + bb) * T + t) * MIXK + 1024 + ch] = (bf16_t)f2bf(x0 * (yy + uu * hb));
            }
        }
    }
    __syncthreads();
}

__device__ __forceinline__ void norm_rows(int gw, int NGW, int lane, int nrows, const float* xl_in, const float* xc_in, float* xl_out, float* xc_out,
                                          const bf16_t* Y, const float* gpost, const float* modA, int ga_off,
                                          bf16_t* XN, const float* gpre, const float* modB, int sc_off, int sh_off) {
    for (int row = gw; row < nrows; row += NGW) {
        const bool isctx = row >= ML; const int mb = isctx ? 8 : (row >> 12);
        const float* xin = isctx ? xc_in + (size_t)(row - ML) * DM : xl_in + (size_t)row * DM;
        f32x4 v[4];
#pragma unroll
        for (int j = 0; j < 4; ++j) v[j] = *(const f32x4*)(xin + 4 * lane + 256 * j);
        if (Y) {
            f32x4 y[4]; float s = 0.f;
#pragma unroll
            for (int j = 0; j < 4; ++j) { const u32x2 w = *(const u32x2*)(Y + (size_t)row * DM + 4 * lane + 256 * j); y[j] = (f32x4){bflo(w.x), bfhi(w.x), bflo(w.y), bfhi(w.y)};
                s += (y[j].x * y[j].x + y[j].y * y[j].y) + (y[j].z * y[j].z + y[j].w * y[j].w); }
            const float rstd = rsqrtf(wave_sum(s) * (1.0f / DM) + EPS);
            float* xo = isctx ? xc_out + (size_t)(row - ML) * DM : xl_out + (size_t)row * DM;
#pragma unroll
            for (int j = 0; j < 4; ++j) { const f32x4 g = *(const f32x4*)(gpost + 4 * lane + 256 * j); const f32x4 ga = *(const f32x4*)(modA + (size_t)mb * 6144 + ga_off + 4 * lane + 256 * j);
                v[j] = v[j] + ga * (y[j] * rstd * g); *(f32x4*)(xo + 4 * lane + 256 * j) = v[j]; }
        }
        if (XN) {
            float s = 0.f;
#pragma unroll
            for (int j = 0; j < 4; ++j) s += (v[j].x * v[j].x + v[j].y * v[j].y) + (v[j].z * v[j].z + v[j].w * v[j].w);
            const float rstd = rsqrtf(wave_sum(s) * (1.0f / DM) + EPS);
#pragma unroll
            for (int j = 0; j < 4; ++j) { const f32x4 g = *(const f32x4*)(gpre + 4 * lane + 256 * j); const f32x4 sc = *(const f32x4*)(modB + (size_t)mb * 6144 + sc_off + 4 * lane + 256 * j);
                const f32x4 sh = *(const f32x4*)(modB + (size_t)mb * 6144 + sh_off + 4 * lane + 256 * j);
                const f32x4 o = (v[j] * rstd * g) * (1.0f + sc) + sh; u32x2 w; w.x = pk2(o.x, o.y); w.y = pk2(o.z, o.w);
                *(u32x2*)(XN + (size_t)row * DM + 4 * lane + 256 * j) = w; }
        }
    }
}

__device__ __forceinline__ void glu_pass(int blk, int nblk, int tid, int r0, int nrows, const bf16_t* U, bf16_t* G, const float* wc, const float* bc) {
    const int nitems = nrows / 8;
    for (int it = blk; it < nitems; it += nblk) {
        for (int p = tid; p < 8 * 352; p += 512) {
            const int rl = it * 8 + p / 352, vc = p % 352, j0 = vc * 8; const int r = r0 + rl;
            int t, len; if (r >= ML) { t = (r - ML) & (CL - 1); len = CL; } else { t = r & (SL - 1); len = SL; }
            const bool hm = t > 0, hp = t < len - 1;
            const bf16_t* ur = U + (size_t)rl * UPW + j0;
            const u32x4 z4 = (u32x4){0u, 0u, 0u, 0u};
            const u32x4 g0 = *(const u32x4*)ur, gm = hm ? *(const u32x4*)(ur - UPW) : z4, gp = hp ? *(const u32x4*)(ur + UPW) : z4;
            const u32x4 v0 = *(const u32x4*)(ur + DFF), vm = hm ? *(const u32x4*)(ur + DFF - UPW) : z4, vp = hp ? *(const u32x4*)(ur + DFF + UPW) : z4;
            unsigned outw[4];
#pragma unroll
            for (int q = 0; q < 4; ++q) {
                float res[2];
#pragma unroll
                for (int h = 0; h < 2; ++h) {
                    const int j = j0 + 2 * q + h;
                    const float a_m = h ? bfhi(gm[q]) : bflo(gm[q]), a_0 = h ? bfhi(g0[q]) : bflo(g0[q]), a_p = h ? bfhi(gp[q]) : bflo(gp[q]);
                    const float c_m = h ? bfhi(vm[q]) : bflo(vm[q]), c_0 = h ? bfhi(v0[q]) : bflo(v0[q]), c_p = h ? bfhi(vp[q]) : bflo(vp[q]);
                    const float cg = a_m * wc[j] + a_0 * wc[UPW + j] + a_p * wc[2 * UPW + j] + bc[j];
                    const float cv = c_m * wc[DFF + j] + c_0 * wc[UPW + DFF + j] + c_p * wc[2 * UPW + DFF + j] + bc[DFF + j];
                    const float sg = cg / (1.0f + __expf(-cg));
                    res[h] = sg * cv;
                }
                outw[q] = pk2(res[0], res[1]);
            }
            *(u32x4*)(G + (size_t)rl * DFF + j0) = (u32x4){outw[0], outw[1], outw[2], outw[3]};
        }
    }
}

__device__ __forceinline__ void transpose_item(const float* W, int ldw, bf16_t* WT, int ldt, int nblk, int item, LAS float* scr, int lane, bool remap = false) {
    const int kb = item / nblk, nb = item % nblk, k0 = 64 * kb, n0 = 32 * nb;
    int n0d = n0;
    if (remap) { if (n0 < DFF) n0d = 256 * (n0 >> 7) + (n0 & 127); else { const int c = n0 - DFF; n0d = 256 * (c >> 7) + 128 + (c & 127); } }
#pragma unroll 8
    for (int i = 0; i < 32; ++i) { const int kk = 2 * i + (lane >> 5); scr[kk * 33 + (lane & 31)] = W[(size_t)(k0 + kk) * ldw + n0 + (lane & 31)]; }
    asm volatile("s_waitcnt lgkmcnt(0)" ::: "memory");
    const int c = lane & 7;
#pragma unroll
    for (int j = 0; j < 4; ++j) { const int n = (lane >> 3) + 8 * j; const LAS float* s = scr + (8 * c) * 33 + n;
        u32x4 o; o.x = pk2(s[0 * 33], s[1 * 33]); o.y = pk2(s[2 * 33], s[3 * 33]); o.z = pk2(s[4 * 33], s[5 * 33]); o.w = pk2(s[6 * 33], s[7 * 33]);
        *(u32x4*)(WT + (size_t)(n0d + n) * ldt + k0 + 8 * c) = o; }
    asm volatile("s_waitcnt lgkmcnt(0)" ::: "memory");
}
}

using namespace mk;
typedef const __attribute__((address_space(4))) Params* KP;
__device__ __forceinline__ KP kp_get() { KP p = (KP)__builtin_amdgcn_kernarg_segment_ptr(); asm volatile("" : "+s"(p)); return p; }
#ifndef MK_REP
#define MK_REP 0
#endif
#define REP(k) for (int rep_ = 0; rep_ < 1 + ((MK_REP >> (k)) & 1); ++rep_)
#ifndef MK_EN
#define MK_EN 0xffff
#endif
#define EN(k) if constexpr ((MK_EN >> (k)) & 1)
constexpr int LDS_BYTES = 159744;
constexpr int XCH_OFF = 131072;
constexpr int MISC_OFF = 131072 + 8192 + 18432;

#define RLX_AGENT __ATOMIC_RELAXED, __HIP_MEMORY_SCOPE_AGENT
#define XB_TMO      128
#define XB_XCNT(j)  (256  + 64 * (j))
#define XB_XSUB(j)  (1280 + 64 * (j))
#define XB_XGEN(j)  (2304 + 64 * (j))
#define XB_TOP      3328
#define XB_TOPGEN   3392
#define XCD_BAR_WORDS 3456
#define XB_SPIN_CAP (1u << 18)

__device__ __forceinline__ unsigned xb_ld(unsigned* p)              { return __hip_atomic_load(p, __ATOMIC_RELAXED, __HIP_MEMORY_SCOPE_AGENT); }
__device__ __forceinline__ unsigned xb_add(unsigned* p, unsigned v) { return __hip_atomic_fetch_add(p, v, __ATOMIC_RELAXED, __HIP_MEMORY_SCOPE_AGENT); }
__device__ __forceinline__ unsigned xb_xcc_id() { return (unsigned)__builtin_amdgcn_s_getreg((3 << 11) | 20) & 0xFu; }
#define XB_SPIN(cond, bar) do { unsigned _sp = 0; while (cond) { __builtin_amdgcn_s_sleep(1); \
    if ((++_sp & 255u) == 0u) { if (xb_ld(&(bar)[XB_TMO])) break; if (_sp > XB_SPIN_CAP) { atomicAdd(&(bar)[XB_TMO], 1u); break; } } } } while (0)

struct XcdBarrier {
    unsigned* bar; unsigned x;
    volatile LAS unsigned* st;
};

__device__ __forceinline__ XcdBarrier xcd_barrier_post(unsigned* bar, volatile LAS unsigned* st) {
    XcdBarrier b; b.bar = bar; b.x = xb_xcc_id(); b.st = st;
    if (threadIdx.x == 0) (void)xb_add(&bar[XB_XCNT(b.x)], 1u);
    return b;
}
__device__ __forceinline__ void xcd_barrier_complete(unsigned* bar, unsigned x, unsigned& nloc, unsigned& nx) {
    const unsigned G = gridDim.x * gridDim.y * gridDim.z;
    unsigned sum, cnt, mine, sp = 0u;
    for (;;) {
        sum = 0u; cnt = 0u; mine = 0u;
#pragma unroll
        for (unsigned j = 0; j < 16; ++j) { const unsigned c = xb_ld(&bar[XB_XCNT(j)]); sum += c; cnt += (c > 0u) ? 1u : 0u; mine = (j == x) ? c : mine; }
        if (sum == G) break;
        __builtin_amdgcn_s_sleep(1);
        if ((++sp & 255u) == 0u) { if (xb_ld(&bar[XB_TMO])) break; if (sp > XB_SPIN_CAP) { atomicAdd(&bar[XB_TMO], 1u); break; } }
    }
    nloc = mine > 0u ? mine : 1u; nx = cnt > 0u ? cnt : 1u;
}

__device__ __forceinline__ void xcd_barrier(const XcdBarrier& b) {
    asm volatile("s_waitcnt vmcnt(0)" ::: "memory");
    __syncthreads();
    if (threadIdx.x == 0) {
        unsigned* bar = b.bar;
        __builtin_amdgcn_s_waitcnt(0);
        unsigned nloc = b.st[0], nx = b.st[1];
        if (nloc == 0u) { xcd_barrier_complete(bar, b.x, nloc, nx); b.st[0] = nloc; b.st[1] = nx; }
        const unsigned old = xb_add(&bar[XB_XSUB(b.x)], 1u);
        const unsigned gen = old / nloc;
        if (old + 1u == (gen + 1u) * nloc) {
            __builtin_amdgcn_fence(__ATOMIC_RELEASE, "agent");
            asm volatile("s_waitcnt vmcnt(0)" ::: "memory");
            const unsigned og = xb_add(&bar[XB_TOP], 1u);
            const unsigned tg = og / nx;
            if (og + 1u == (tg + 1u) * nx) xb_add(&bar[XB_TOPGEN], 1u);
            else XB_SPIN(xb_ld(&bar[XB_TOPGEN]) == tg, bar);
            __builtin_amdgcn_fence(__ATOMIC_ACQUIRE, "agent");
            xb_add(&bar[XB_XGEN(b.x)], 1u);
            asm volatile("s_waitcnt vmcnt(0)" ::: "memory");
        } else {
            XB_SPIN(xb_ld(&bar[XB_XGEN(b.x)]) == gen, bar);
            __builtin_amdgcn_fence(__ATOMIC_ACQUIRE, "agent");
            asm volatile("s_waitcnt vmcnt(0)" ::: "memory");
        }
    }
    __syncthreads();
}

__device__ __forceinline__ bf16_t* wlayer(unsigned char* ws, int l, size_t off) { return (bf16_t*)(ws + WS_W + (size_t)l * W_LAYER + off); }
constexpr size_t OFF_WIN = 0, OFF_WOUT = 4 * MiB, OFF_WUP = 7 * MiB, OFF_WDOWN = 18 * MiB;

__device__ __forceinline__ void setup0(KP pp, LAS unsigned char* lds, int tid, int lane, int wave) {
    unsigned char* ws = pp->ws;
    {
        LAS float* scr = (LAS float*)(lds + wave * 16384);
        const int gw = blockIdx.x * 8 + wave, NGW = gridDim.x * 8;
        constexpr int I_IN = 16 * 56, I_UP = 16 * 176, I_DN = 44 * 32, I_OA = 8 * 32, I_OH = 4 * 32, I_L = I_IN + I_UP + I_DN + I_OA + I_OH;
        for (int it = gw; it < 2 * I_L; it += NGW) {
            const int l = it / I_L; int r = it % I_L;
            if (r < I_IN) { transpose_item(pp->in[I_WIN] + (size_t)l * DM * INW, INW, wlayer(ws, l, OFF_WIN), DM, 56, r, scr, lane); continue; } r -= I_IN;
            if (r < I_UP) { transpose_item(pp->in[I_WUP] + (size_t)l * DM * UPW, UPW, wlayer(ws, l, OFF_WUP), DM, 176, r, scr, lane, true); continue; } r -= I_UP;
            if (r < I_DN) { transpose_item(pp->in[I_WDOWN] + (size_t)l * DFF * DM, DM, wlayer(ws, l, OFF_WDOWN), DFF, 32, r, scr, lane); continue; } r -= I_DN;
            if (r < I_OA) { transpose_item(pp->in[I_WOUT] + (size_t)l * DM * DM, DM, wlayer(ws, l, OFF_WOUT), MIXK, 32, r, scr, lane); continue; } r -= I_OA;
            transpose_item(pp->in[I_WOUT] + (size_t)l * DM * DM + (size_t)768 * DM, DM, wlayer(ws, l, OFF_WOUT) + 1024, MIXK, 32, r, scr, lane);
        }
    }
    __syncthreads();
    constexpr int N_MOD = 192, N_MLP = 512 + 32 + 512, N_DFT = 4096 + 256, N_T = 1024, N_TAB = 1;
    constexpr int NIT = N_MOD + N_MLP + N_DFT + N_T + N_TAB;
    LAS float* fl = (LAS float*)lds;
    for (int it = blockIdx.x; it < NIT; it += gridDim.x) {
        int r = it;
        if (r < N_MOD) {
            const int l = r / 96, cb = (r % 96) / 8, kc = r % 8;
            for (int idx = tid; idx < 9 * 128; idx += 512) { const int rr = idx / 128, k = idx % 128; const float cv = rr < 8 ? pp->in[I_C][rr * DM + kc * 128 + k] : pp->in[I_CCTX][kc * 128 + k];
                fl[idx] = cv / (1.0f + __expf(-cv)); }
            __syncthreads();
            const int j = cb * 512 + tid; float acc[9];
#pragma unroll
            for (int rr = 0; rr < 9; ++rr) acc[rr] = 0.f;
            const float* wm = pp->in[I_WMOD] + (size_t)l * DM * 6144 + (size_t)(kc * 128) * 6144 + j;
            for (int k = 0; k < 128; ++k) { const float w = wm[(size_t)k * 6144];
#pragma unroll
                for (int rr = 0; rr < 9; ++rr) acc[rr] += fl[rr * 128 + k] * w; }
            float* mp = (float*)(ws + WS_MODP) + ((size_t)(l * 8 + kc) * 9) * 6144 + j;
#pragma unroll
            for (int rr = 0; rr < 9; ++rr) mp[(size_t)rr * 6144] = acc[rr];
            __syncthreads();
            continue;
        }
        r -= N_MOD;
        if (r < N_MLP) {
            int l, which, t0;
            if (r < 512) { l = 0; which = 0; t0 = r * 8; } else if (r < 544) { l = 0; which = 1; t0 = (r - 512) * 8; } else { l = 1; which = 0; t0 = (r - 544) * 8; }
            const int T = which ? CL : SL;
            LAS float* Z = fl; LAS float* H1 = fl + 8 * 36; LAS float* H2 = H1 + 512;
            if (tid < 128) { const int p = tid >> 4, i = tid & 15; const int t = t0 + p; const float band = 1e-4f + (float)i * ((15.0f - 1e-4f) / 15.0f);
                const float ang = ((6.2831855f * (float)t) / (float)T) * band; Z[p * 36 + 1 + i] = cosf(ang); Z[p * 36 + 17 + i] = -sinf(ang);
                if (i == 0) Z[p * 36] = (float)t / (float)(T - 1); }
            __syncthreads();
            { const int p = tid >> 6, j = tid & 63; const float* w1 = pp->in[I_HW1] + (size_t)l * 33 * 64; float s = pp->in[I_HB1][l * 64 + j];
              for (int i = 0; i < 33; ++i) s += Z[p * 36 + i] * w1[i * 64 + j];
              H1[p * 64 + j] = sinf(pp->in[I_HFR1][l * 64 + j] * s); }
            __syncthreads();
            { const int p = tid >> 6, j = tid & 63; const float* w2 = pp->in[I_HW2] + (size_t)l * 64 * 64; float s = pp->in[I_HB2][l * 64 + j];
              for (int i = 0; i < 64; ++i) s += H1[p * 64 + i] * w2[i * 64 + j];
              H2[p * 64 + j] = sinf(pp->in[I_HFR2][l * 64 + j] * s); }
            __syncthreads();
            { const int j = tid; const float* w3 = pp->in[I_HW3] + (size_t)l * 64 * 512 + j; float acc[8];
#pragma unroll
              for (int p = 0; p < 8; ++p) acc[p] = 0.f;
              for (int i = 0; i < 64; ++i) { const float w = w3[(size_t)i * 512];
#pragma unroll
                  for (int p = 0; p < 8; ++p) acc[p] += H2[p * 64 + i] * w; }
              const float da = -3.0701134573253944f, db = -15.350567286626972f;
              const float delta = fabsf(da + (float)(j & 255) * ((db - da) / 255.0f));
              float* hr = (float*)(ws + WS_HRAW) + (which ? (size_t)2 * 512 * SL : (size_t)l * 512 * SL) + (size_t)j * T + t0;
#pragma unroll
              for (int p = 0; p < 8; ++p) hr[p] = acc[p] * expf(-Z[p * 36] * delta); }
            __syncthreads();
            continue;
        }
        r -= N_MLP;
        if (r < N_DFT) {
            if (r < 4096) { bf16_t* row = (bf16_t*)(ws + WS_ADFT) + (size_t)r * 4096; const bool isS = r > 2048; const int k = isS ? r - 2048 : r;
                for (int t = tid; t < 4096; t += 512) { const int idx = (k * t) & 4095; const float x = (float)idx * (1.0f / 2048.0f); const float v = (isS ? sinpif(x) : cospif(x)) * (1.0f / 512.0f); row[t] = (bf16_t)f2bf(v); } }
            else { const int rr = r - 4096; bf16_t* row = (bf16_t*)(ws + WS_ADFTC) + (size_t)rr * 256; const bool isS = rr > 128; const int k = isS ? rr - 128 : rr;
                if (tid < 256) { const int idx = (k * tid) & 255; const float x = (float)idx * (1.0f / 128.0f); const float v = (isS ? sinpif(x) : cospif(x)) * (1.0f / 128.0f); row[tid] = (bf16_t)f2bf(v); } }
            continue;
        }
        r -= N_DFT;
        if (r < N_T) {
            const int l = r >> 9, kk = r & 511; const bool isS = kk >= 256; const int gc = kk & 255, g = gc >> 6, c = gc & 63;
            if (tid < 256) { const float* wf = pp->in[I_WF] + (size_t)l * 256 * 256 + (size_t)(g * 64) * 256 + tid; float s = 0.f;
                for (int m = 0; m < 64; ++m) { const float x = (float)((m * c) & 63) * (1.0f / 32.0f); const float tr = isS ? -sinpif(x) : cospif(x); s += tr * wf[(size_t)m * 256]; }
                ((float*)(ws + WS_T))[((size_t)l * 512 + kk) * 256 + tid] = s; }
            continue;
        }
        { f32x2* tw = (f32x2*)(ws + WS_TW);
          for (int i = tid; i < 4096; i += 512) { const float x = (float)i * (1.0f / 4096.0f); tw[i] = (f32x2){cospif(x), -sinpif(x)}; }
          f32x2* tw2 = (f32x2*)(ws + WS_TW + 65536);
          if (tid < 256) { const float x = (float)tid * (1.0f / 256.0f); tw2[tid] = (f32x2){cospif(x), -sinpif(x)}; }
          float* rope = (float*)(ws + WS_TW + 131072);
          for (int i = tid; i < 1024; i += 512) { const int p = i >> 4, q = i & 15; const float inv = powf(10000.0f, -(float)q / 16.0f); const float a = (float)p * inv; rope[i] = cosf(a); rope[1024 + i] = sinf(a); } }
    }
}

__device__ __forceinline__ void setup1(KP pp, LAS unsigned char* lds, int tid) {
    unsigned char* ws = pp->ws;
    { const int gt = blockIdx.x * 512 + tid, NGT = gridDim.x * 512;
      for (int idx = gt; idx < 2 * 9 * 6144; idx += NGT) { const int l = idx / (9 * 6144), rj = idx % (9 * 6144), j = rj % 6144; float s = pp->in[I_BMOD][l * 6144 + j];
#pragma unroll
          for (int kc = 0; kc < 8; ++kc) s += ((const float*)(ws + WS_MODP))[((size_t)(l * 8 + kc) * 9) * 6144 + rj];
          ((float*)(ws + WS_MOD))[idx] = s; } }
    constexpr int N_KF = 768, N_W2 = 2048;
    LAS float* fl = (LAS float*)lds;
    for (int it = blockIdx.x; it < N_KF + N_W2; it += gridDim.x) {
        if (it < N_KF) {
            if (it < 512) { const int l = it >> 8, ch = it & 255;
                kf_job<13>(lds, (const float*)(ws + WS_HRAW) + (size_t)l * 512 * SL, (const f32x2*)(ws + WS_TW), (f32x2*)(ws + WS_KF) + (size_t)l * 256 * 8192, ch, tid); }
            else { const int ch = it - 512;
                kf_job<9>(lds, (const float*)(ws + WS_HRAW) + (size_t)2 * 512 * SL, (const f32x2*)(ws + WS_TW + 65536), (f32x2*)(ws + WS_KFC), ch, tid); }
            continue;
        }
        const int r = it - N_KF; const int l = r >> 10, kk = (r >> 1) & 511, nh = r & 1;
        if (tid < 256) fl[tid] = ((const float*)(ws + WS_T))[((size_t)l * 512 + kk) * 256 + tid];
        __syncthreads();
        { const int n = nh * 512 + tid; const float* wo = pp->in[I_WOUT] + (size_t)l * DM * DM + (size_t)512 * DM + n; float s = 0.f;
          for (int j = 0; j < 256; ++j) s += fl[j] * wo[(size_t)j * DM];
          wlayer(ws, l, OFF_WOUT)[(size_t)n * MIXK + 512 + kk] = (bf16_t)f2bf(s); }
        __syncthreads();
    }
}

__global__ void __launch_bounds__(512, 2) mega_fwd(Params P) {
    extern __shared__ __attribute__((aligned(16))) unsigned char lds_raw[];
    LAS unsigned char* lds = (LAS unsigned char*)lds_raw;
    { volatile LAS unsigned* m0 = (volatile LAS unsigned*)(lds + MISC_OFF); if (threadIdx.x < 32) m0[threadIdx.x] = 0u; }
    __syncthreads();
    XcdBarrier xbar;
    { KP pb = kp_get(); xbar = xcd_barrier_post((unsigned*)(pb->ws + WS_CTL) + 4096, (volatile LAS unsigned*)(lds + MISC_OFF) + 8);
      if (pb->ph_lo < 0) cg::this_grid().sync(); }
    int ph = 0;
#define PH_BEGIN { KP pp = kp_get(); const int lo = pp->ph_lo, hi = pp->ph_hi; if (ph >= lo && ph < hi) { unsigned char* ws = pp->ws; const int tid = mk_tid(), lane = tid & 63, wave = __builtin_amdgcn_readfirstlane(tid >> 6); const int G = gridDim.x, gw = blockIdx.x * 8 + wave, NGW = G * 8; (void)lane; (void)gw; (void)NGW; PTRS
#define PH_END   if (ph + 1 < hi) xcd_barrier(xbar); } } ++ph;
#define PTRS \
    bf16_t* XN = (bf16_t*)(ws + WS_XN); bf16_t* Qb = (bf16_t*)(ws + WS_Q); bf16_t* Kb = (bf16_t*)(ws + WS_K); bf16_t* Vb = (bf16_t*)(ws + WS_V); \
    bf16_t* fT = (bf16_t*)(ws + WS_FT); bf16_t* fTc = (bf16_t*)(ws + WS_FTC); bf16_t* PT = (bf16_t*)(ws + WS_PT); bf16_t* PTc = (bf16_t*)(ws + WS_PTC); \
    bf16_t* MIXb = (bf16_t*)(ws + WS_MIX); bf16_t* Ub = (bf16_t*)(ws + WS_U); bf16_t* Gb = (bf16_t*)(ws + WS_G); \
    float* CX = (float*)(ws + WS_CX); const float* MOD = (const float*)(ws + WS_MOD); \
    const float* rope = (const float*)(ws + WS_TW + 131072); \
    volatile LAS int* misc = (volatile LAS int*)(lds + MISC_OFF); \
    (void)XN; (void)Qb; (void)Kb; (void)Vb; (void)fT; (void)fTc; (void)PT; (void)PTc; (void)MIXb; (void)Ub; (void)Gb; (void)CX; (void)MOD; (void)rope; (void)misc;

    REP(6) { PH_BEGIN EN(0) setup0(pp, lds, tid, lane, wave); PH_END --ph; } ++ph;
    REP(6) { PH_BEGIN EN(1) setup1(pp, lds, tid); PH_END --ph; } ++ph;
    PH_BEGIN EN(2) norm_rows(gw, NGW, lane, MT, pp->in[I_X], pp->in[I_CTX], nullptr, nullptr, nullptr, nullptr, nullptr, 0, XN, pp->in[I_GPREMIX], MOD, 1024, 0); PH_END

    for (int l = 0; l < 2; ++l) {
        const bool last = (l == 1);
        const int MR = last ? ML : MT;
        PH_BEGIN {
            pg8::Gemm g{XN, wlayer(ws, l, OFF_WIN), MT, INW, DM}; pg8::StaticOrder S; S.init(MT, INW, G, (int)blockIdx.x);
            EpiInProj E{Qb, Kb, Vb, fT, fTc, PT, PTc, pp->in[I_GQ] + l * 64, pp->in[I_GK] + l * 64, rope, (LAS float*)(lds + XCH_OFF)};
            REP(0) EN(3) pg8::gemm_phase<EpiInProj, pg8::StaticOrder, true, true>(lds, g, S, E);
        } PH_END
        PH_BEGIN {
            const int nF = last ? 128 : 136, nA = last ? 1024 : 1088, nH1 = last ? 1024 : 2048, nH = nH1 * (1 + ((MK_REP >> 7) & 1));
            for (;;) {
                KP pq = kp_get(); unsigned char* wq = pq->ws; const int tq = mk_tid();
                if (tq == 0) misc[0] = (int)atomicAdd((unsigned*)(wq + WS_CTL) + 64 * (1 + l), 1u);
                __syncthreads();
                int it = misc[0];
                __syncthreads();
                if (it >= nF + nA + nH) break;
                bf16_t* MIXq = (bf16_t*)(wq + WS_MIX);
                if (it < nF) {
                    if (it < 128) { pg8::Gemm g{(const bf16_t*)(wq + WS_ADFT), (const bf16_t*)(wq + WS_FT), 4096, 2048, 4096}; OneUnit S{it >> 3, it & 7}; EpiFourier E{MIXq, 2048, 0, SL};
                        REP(3) EN(4) pg8::gemm_phase<EpiFourier, OneUnit, false, true>(lds, g, S, E); }
                    else { pg8::Gemm g{(const bf16_t*)(wq + WS_ADFTC), (const bf16_t*)(wq + WS_FTC), 256, 2048, 256}; OneUnit S{0, it - 128}; EpiFourier E{MIXq, 128, ML, CL};
                        REP(3) EN(4) pg8::gemm_phase<EpiFourier, OneUnit, false, true>(lds, g, S, E); }
                    continue;
                }
                it -= nF;
                if (it < nA) {
                    const bf16_t* Qq = (const bf16_t*)(wq + WS_Q); const bf16_t* Kq = (const bf16_t*)(wq + WS_K); const bf16_t* Vq = (const bf16_t*)(wq + WS_V);
                    int b, h, NT; size_t qrow;
                    if (it < 1024) { b = it >> 7; h = (it >> 4) & 7; qrow = (size_t)b * SL + (it & 15) * 256; NT = KVB / 64; }
                    else { const int r = it - 1024; b = r >> 3; h = r & 7; qrow = (size_t)ML + b * CL; NT = CL / 64; }
                    const size_t kv0 = (size_t)b * KVB;
                    REP(1) EN(5) attn_body::attn_unit2<8>((const attn_body::bf16*)(Qq + qrow * QP + h * 64), (const attn_body::bf16*)(Kq + kv0 * KVP + (h >> 2) * 64), (const attn_body::bf16*)(Vq + kv0 * KVP + (h >> 2) * 64), (attn_body::bf16*)(MIXq + qrow * MIXK + h * 64), NT, (char*)lds_raw);
                    continue;
                }
                it -= nA; if (it >= nH1) it -= nH1;
                const float* wc = pq->in[I_WHC] + (size_t)l * 3 * 768; const float* bc = pq->in[I_BHC] + (size_t)l * 768; const float* hb = pq->in[I_HBIAS] + (size_t)l * 256;
                REP(2) EN(6) { if (it < 1024) hyena_job<13>(lds, (const bf16_t*)(wq + WS_PT), (const f32x2*)(wq + WS_TW), (const f32x2*)(wq + WS_KF) + (size_t)l * 256 * 8192, wc, bc, hb, MIXq, 0, it >> 8, it & 255, tq);
                else { const int r = it - 1024; hyena_job<9>(lds, (const bf16_t*)(wq + WS_PTC), (const f32x2*)(wq + WS_TW + 65536), (const f32x2*)(wq + WS_KFC), wc, bc, hb, MIXq, ML, r >> 8, r & 255, tq); } }
            }
        } PH_END
        PH_BEGIN {
            pg8::Gemm g{MIXb, wlayer(ws, l, OFF_WOUT), MR, DM, MIXK}; pg8::StaticOrder S; S.init(MR, DM, G, (int)blockIdx.x);
            EpiPlain E{XN, DM};
            REP(5) EN(7) pg8::gemm_phase<EpiPlain, pg8::StaticOrder, true, true>(lds, g, S, E);
        } PH_END
        PH_BEGIN EN(2) norm_rows(gw, NGW, lane, MR, l == 0 ? pp->in[I_X] : pp->out, l == 0 ? pp->in[I_CTX] : CX, pp->out, CX, XN, pp->in[I_GPOSTMIX] + l * DM, (MOD + (size_t)l * 9 * 6144), 2048,
                           XN, pp->in[I_GPREFFN] + l * DM, (MOD + (size_t)l * 9 * 6144), 4096, 3072); PH_END
        PH_BEGIN {
            pg8::Gemm g{XN, wlayer(ws, l, OFF_WUP), MR, UPW, DM}; pg8::StaticOrder S; S.init(MR, UPW, G, (int)blockIdx.x);
            EpiGlu E{Gb, (bf16_t*)(ws + WS_SB), pp->in[I_WFC] + (size_t)l * 3 * UPW, pp->in[I_BFC] + (size_t)l * UPW, (LAS float*)(lds + XCH_OFF)};
            REP(4) EN(8) pg8::gemm_phase<EpiGlu, pg8::StaticOrder, true, true>(lds, g, S, E);
        } PH_END
        PH_BEGIN EN(9) glu_fixup((int)blockIdx.x, G, tid, MR / 256, (const bf16_t*)(ws + WS_SB), Gb, pp->in[I_WFC] + (size_t)l * 3 * UPW, pp->in[I_BFC] + (size_t)l * UPW); PH_END
        PH_BEGIN {
            pg8::Gemm g{Gb, wlayer(ws, l, OFF_WDOWN), MR, DM, DFF}; pg8::StaticOrder S; S.init(MR, DM, G, (int)blockIdx.x);
            EpiPlain E{XN, DM};
            REP(4) EN(10) pg8::gemm_phase<EpiPlain, pg8::StaticOrder, true, true>(lds, g, S, E);
        } PH_END
        PH_BEGIN EN(2) norm_rows(gw, NGW, lane, MR, pp->out, CX, pp->out, CX, XN, pp->in[I_GPOSTFFN] + l * DM, (MOD + (size_t)l * 9 * 6144), 5120,
                           last ? nullptr : XN, pp->in[I_GPREMIX] + (last ? 0 : (l + 1) * DM), MOD + (size_t)(last ? 0 : (l + 1)) * 9 * 6144, 1024, 0); PH_END
    }
}

constexpr int N_PHASES = 3 + 2 * 8;
#ifndef MK_MULTI
#define MK_MULTI 0
#endif
extern "C" void kernel_launch(void* const* d_in, const int* in_sizes, int n_in, void* d_out, int out_size, void* d_ws, size_t ws_size, hipStream_t stream) {
    static int grid = 0;
    if (grid == 0) {
        if (n_in != 29 || ws_size < WS_END) { fprintf(stderr, "kernel_launch: bad args n_in %d ws %zu (need %zu)\n", n_in, ws_size, (size_t)WS_END); grid = -1; return; }
        int dev = 0, cus = 0, per_cu = 0;
        hipGetDevice(&dev); hipDeviceGetAttribute(&cus, hipDeviceAttributeMultiprocessorCount, dev);
        if (hipFuncSetAttribute((const void*)mega_fwd, hipFuncAttributeMaxDynamicSharedMemorySize, LDS_BYTES) != hipSuccess) { fprintf(stderr, "hipFuncSetAttribute failed\n"); grid = -1; return; }
        if (hipOccupancyMaxActiveBlocksPerMultiprocessor(&per_cu, (const void*)mega_fwd, 512, LDS_BYTES) != hipSuccess || per_cu < 1) { fprintf(stderr, "occupancy query: %d\n", per_cu); per_cu = 1; }
        (void)hipGetLastError();
        grid = cus * 1;
    }
    if (grid < 0) return;
    hipMemsetAsync((char*)d_ws + WS_CTL, 0, 1 * MiB, stream);
    Params p{};
    for (int i = 0; i < 29; ++i) p.in[i] = (const float*)d_in[i];
    p.out = (float*)d_out; p.ws = (unsigned char*)d_ws;
#if MK_MULTI
    for (int k = 0; k < N_PHASES; ++k) { p.ph_lo = k; p.ph_hi = k + 1; hipLaunchKernelGGL(mega_fwd, dim3(grid), dim3(512), LDS_BYTES, stream, p); }
#else
    p.ph_lo = 0; p.ph_hi = N_PHASES;
    void* args[] = {&p};
    hipError_t e = hipLaunchCooperativeKernel((const void*)mega_fwd, dim3(grid), dim3(512), args, LDS_BYTES, stream);
    if (e != hipSuccess) fprintf(stderr, "cooperative launch failed: %s (grid %d)\n", hipGetErrorString(e), grid);
#endif
}
```

```cpp
#define MK_REP 0
#include <hip/hip_runtime.h>
#include <hip/hip_cooperative_groups.h>
#include <hip/hip_bf16.h>
#include <cstdio>
#include <cstdint>
#include <cmath>
namespace cg = cooperative_groups;
__device__ __forceinline__ int mk_tid() { int t = threadIdx.x; asm volatile("" : "+v"(t)); return t; }
namespace pg8 {
#define PG8_LAS __attribute__((address_space(3)))
typedef unsigned short bf16_t;
typedef short bf16x8 __attribute__((ext_vector_type(8)));
typedef float f32x4 __attribute__((ext_vector_type(4)));
typedef unsigned u32x4 __attribute__((ext_vector_type(4)));
constexpr int BM = 256, BK = 64, HALF = 128, HTB = HALF * BK * 2  , STAGE_BYTES = 8 * HTB, NXCD = 8, WGM = 8;

__host__ __device__ __forceinline__ int lds_byte(int r, int c) { const int st = (r >> 4) * 2 + (c >> 5), rr = r & 15, cc = c & 31, ob = rr * 64 + cc * 2; return st * 1024 + (ob ^ (((ob >> 9) & 1) << 5)); }
__host__ __device__ __forceinline__ void stage_rc(int b, int& R, int& C) { const int st = b / 1024, sb = b % 1024, swz = sb ^ (((sb >> 9) & 1) << 5); R = (st >> 1) * 16 + swz / 64; C = (st & 1) * 32 + (swz % 64) / 2; }
__host__ __device__ __forceinline__ int perm32(int rho) { const int n = rho >> 4, i = rho & 15; return 8 * (i >> 2) + 4 * n + (i & 3); }

struct Unit { int pm, pn; };
struct Gemm { const bf16_t* A; const bf16_t* Bt; int M, N, K; };

struct StaticOrder {
    int nM, nN, nwg, G, c;
    __host__ __device__ void init(int M, int N, int G_, int c_) { nM = M / BM; nN = N / BM; nwg = nM * nN; G = G_; c = c_; }
    __host__ __device__ bool next(int i, Unit& u) const {
        const long L = (long)i * G + c; if (L >= nwg) return false;
        int wgid = (int)L; { const int q = nwg / NXCD, r = nwg % NXCD, xcd = wgid % NXCD, off = wgid / NXCD; wgid = (xcd < r ? xcd * (q + 1) : r * (q + 1) + (xcd - r) * q) + off; }
        const int nig = WGM * nN, gid = wgid / nig, fm = gid * WGM, gsz = (nM - fm) < WGM ? (nM - fm) : WGM;
        u.pm = fm + ((wgid % nig) % gsz); u.pn = (wgid % nig) / gsz; return true;
    }
    __device__ __forceinline__ void a_ready(const Unit&) const {}
    __device__ __forceinline__ void done(const Unit&) const {}
};
__device__ __forceinline__ unsigned cvt_pk_bf16(float lo, float hi) { unsigned r; asm volatile("v_cvt_pk_bf16_f32 %0, %1, %2" : "=v"(r) : "v"(lo), "v"(hi)); return r; }
typedef float f32x2 __attribute__((ext_vector_type(2)));
template <class Epi, class Sched, bool ALIGN_EPI = false, bool SP2 = false>
__device__ __forceinline__ void gemm_phase(PG8_LAS unsigned char* lds, const Gemm g, const Sched& S, const Epi& E) {
    const int tid = mk_tid(), wid = __builtin_amdgcn_readfirstlane(tid >> 6), lane = tid & 63, wr = wid >> 2, wc = wid & 3, fr = lane & 15, fq = lane >> 4;
    const int K = g.K, nt = K / BK;
    unsigned voffA[2], voffB[2];
#pragma unroll
    for (int i = 0; i < 2; ++i) { int R, C; stage_rc(tid * 16 + i * 8192, R, C); const int Rb = Epi::PERM ? ((R & ~31) + perm32(R & 31)) : R;
        voffA[i] = (unsigned)(R * K + C) * 2u; voffB[i] = (unsigned)(Rb * K + C) * 2u; }
    const size_t kstep = (size_t)(BK * 2);
    const size_t hstep = (size_t)HALF * K * 2;
    const size_t tstep = 2 * hstep;
    const unsigned ldsw = (unsigned)wid * 1024u;
    const int aoff = lds_byte(wr * 64 + fr, fq * 8), boff = lds_byte(wc * 32 + fr, fq * 8);
#define PG8_SA(b, h) (((b) * 2 + (h)) * HTB)
#define PG8_SB(b, h) ((4 + (b) * 2 + (h)) * HTB)
#define PG8_STAGE(bufoff, gbase, voff) do { _Pragma("unroll") for (int _i = 0; _i < 2; ++_i) \
        __builtin_amdgcn_global_load_lds((const unsigned*)((const char*)(gbase) + (voff)[_i]), (PG8_LAS unsigned*)(lds + (bufoff) + ldsw + _i * 8192), 16, 0, 0); } while (0)
#define PG8_LDA(dst, b, h) do { _Pragma("unroll") for (int m = 0; m < 4; ++m) _Pragma("unroll") for (int k = 0; k < 2; ++k) dst[m][k] = *(const PG8_LAS bf16x8*)(lds + PG8_SA(b, h) + aoff + m * 2048 + k * 1024); } while (0)
#define PG8_LDB(dst, b, h) do { _Pragma("unroll") for (int n = 0; n < 2; ++n) _Pragma("unroll") for (int k = 0; k < 2; ++k) dst[n][k] = *(const PG8_LAS bf16x8*)(lds + PG8_SB(b, h) + boff + n * 2048 + k * 1024); } while (0)
#define PG8_MMA(ai, bj, At, Bt) do { __builtin_amdgcn_s_setprio(1); _Pragma("unroll") for (int m = 0; m < 4; ++m) _Pragma("unroll") for (int n = 0; n < 2; ++n) _Pragma("unroll") for (int k = 0; k < 2; ++k) \
        acc[ai][bj][m][n] = __builtin_amdgcn_mfma_f32_16x16x32_bf16(Bt[n][k], At[m][k], acc[ai][bj][m][n], 0, 0, 0); __builtin_amdgcn_s_setprio(0); } while (0)
#define PG8_WAIT_V(n) asm volatile("s_waitcnt vmcnt(" #n ")" ::: "memory")
#define PG8_WAIT_L(n) asm volatile("s_waitcnt lgkmcnt(" #n ")" ::: "memory")
#define PG8_BAR __builtin_amdgcn_s_barrier()
#define PG8_SCHED __builtin_amdgcn_sched_barrier(0)
    Unit cur, nxt; int ui = 0;
    if (!S.next(0, cur)) return;
    f32x4 acc[2][2][4][2];
#pragma unroll
    for (int a = 0; a < 2; ++a)
#pragma unroll
        for (int b = 0; b < 2; ++b)
#pragma unroll
            for (int m = 0; m < 4; ++m)
#pragma unroll
                for (int n = 0; n < 2; ++n) acc[a][b][m][n] = (f32x4){0.f, 0.f, 0.f, 0.f};
    bf16x8 At[4][2], B0[2][2], B1[2][2];
    const char* cA = (const char*)g.A + (size_t)cur.pm * tstep; const char* cB = (const char*)g.Bt + (size_t)cur.pn * tstep;
    S.a_ready(cur);
    if constexpr (SP2) {
        PG8_STAGE(PG8_SB(0, 0), cB, voffB); PG8_STAGE(PG8_SB(0, 1), cB + hstep, voffB); PG8_STAGE(PG8_SA(0, 0), cA, voffA); PG8_STAGE(PG8_SA(0, 1), cA + hstep, voffA);
        if (wr == 1) PG8_BAR;
        PG8_WAIT_V(2); PG8_BAR;
        PG8_STAGE(PG8_SB(1, 0), cB + kstep, voffB); PG8_STAGE(PG8_SA(1, 0), cA + kstep, voffA); PG8_STAGE(PG8_SB(1, 1), cB + hstep + kstep, voffB);
        PG8_WAIT_V(6); PG8_BAR;
    } else {
        PG8_STAGE(PG8_SB(0, 0), cB, voffB); PG8_STAGE(PG8_SA(0, 0), cA, voffA); PG8_STAGE(PG8_SB(0, 1), cB + hstep, voffB); PG8_STAGE(PG8_SA(0, 1), cA + hstep, voffA);
        if (wr == 1) PG8_BAR;
        PG8_WAIT_V(4); PG8_BAR;
        PG8_STAGE(PG8_SB(1, 0), cB + kstep, voffB); PG8_STAGE(PG8_SA(1, 0), cA + kstep, voffA); PG8_STAGE(PG8_SB(1, 1), cB + hstep + kstep, voffB);
        PG8_WAIT_V(6); PG8_BAR;
    }
    for (;;) {
        const bool has_next = S.next(ui + 1, nxt);
        const char* nA = has_next ? (const char*)g.A + (size_t)nxt.pm * tstep : cA; const char* nB = has_next ? (const char*)g.Bt + (size_t)nxt.pn * tstep : cB;
        for (int t = 0; t < nt; t += 2) {
            const bool last = (t == nt - 2);
            const char* a1 = cA + (size_t)(t + 1) * kstep;
            const char* a2 = last ? nA : cA + (size_t)(t + 2) * kstep; const char* b2 = last ? nB : cB + (size_t)(t + 2) * kstep;
            const char* a3 = a2 + kstep; const char* b3 = b2 + kstep;
            if (last && has_next) S.a_ready(nxt);
            if constexpr (SP2) {
            PG8_LDB(B0, 0, 0); PG8_LDB(B1, 0, 1); PG8_SCHED; PG8_LDA(At, 0, 0); PG8_STAGE(PG8_SA(1, 1), a1 + hstep, voffA);
            PG8_WAIT_V(8); PG8_WAIT_L(0); PG8_BAR; PG8_MMA(0, 0, At, B0); PG8_MMA(0, 1, At, B1); PG8_BAR; PG8_SCHED;
            PG8_LDA(At, 0, 1); PG8_STAGE(PG8_SB(0, 0), b2, voffB); PG8_STAGE(PG8_SB(0, 1), b2 + hstep, voffB); PG8_STAGE(PG8_SA(0, 0), a2, voffA);
            PG8_WAIT_V(8); PG8_WAIT_L(0); PG8_BAR; PG8_MMA(1, 0, At, B0); PG8_MMA(1, 1, At, B1); PG8_BAR; PG8_SCHED;
            PG8_LDB(B0, 1, 0); PG8_LDB(B1, 1, 1); PG8_SCHED; PG8_LDA(At, 1, 0); PG8_STAGE(PG8_SA(0, 1), a2 + hstep, voffA);
            PG8_WAIT_V(8); PG8_WAIT_L(0); PG8_BAR; PG8_MMA(0, 0, At, B0); PG8_MMA(0, 1, At, B1); PG8_BAR; PG8_SCHED;
            PG8_LDA(At, 1, 1); PG8_STAGE(PG8_SB(1, 0), b3, voffB); PG8_STAGE(PG8_SB(1, 1), b3 + hstep, voffB); PG8_STAGE(PG8_SA(1, 0), a3, voffA);
            PG8_WAIT_V(8); PG8_WAIT_L(0); PG8_BAR; PG8_MMA(1, 0, At, B0); PG8_MMA(1, 1, At, B1); PG8_BAR; PG8_SCHED;
            } else {
            PG8_LDB(B0, 0, 0); PG8_SCHED; PG8_LDA(At, 0, 0); PG8_STAGE(PG8_SA(1, 1), a1 + hstep, voffA);
            PG8_WAIT_L(8); PG8_BAR; PG8_WAIT_L(0); PG8_MMA(0, 0, At, B0); PG8_BAR; PG8_SCHED;
            PG8_LDB(B1, 0, 1); PG8_STAGE(PG8_SB(0, 0), b2, voffB);
            PG8_BAR; PG8_WAIT_L(0); PG8_MMA(0, 1, At, B1); PG8_BAR;
            PG8_LDA(At, 0, 1); PG8_STAGE(PG8_SA(0, 0), a2, voffA);
            PG8_BAR; PG8_WAIT_L(0); PG8_MMA(1, 0, At, B0); PG8_BAR; PG8_SCHED;
            PG8_STAGE(PG8_SB(0, 1), b2 + hstep, voffB);
            PG8_WAIT_V(6); PG8_BAR; PG8_MMA(1, 1, At, B1); PG8_BAR;
            PG8_LDB(B0, 1, 0); PG8_SCHED; PG8_LDA(At, 1, 0); PG8_STAGE(PG8_SA(0, 1), a2 + hstep, voffA);
            PG8_WAIT_L(8); PG8_BAR; PG8_WAIT_L(0); PG8_MMA(0, 0, At, B0); PG8_BAR; PG8_SCHED;
            PG8_LDB(B1, 1, 1); PG8_STAGE(PG8_SB(1, 0), b3, voffB);
            PG8_BAR; PG8_WAIT_L(0); PG8_MMA(0, 1, At, B1); PG8_BAR;
            PG8_LDA(At, 1, 1); PG8_STAGE(PG8_SA(1, 0), a3, voffA);
            PG8_BAR; PG8_WAIT_L(0); PG8_MMA(1, 0, At, B0); PG8_BAR; PG8_SCHED;
            PG8_STAGE(PG8_SB(1, 1), b3 + hstep, voffB);
            PG8_WAIT_V(6); PG8_BAR; PG8_MMA(1, 1, At, B1); PG8_BAR;
            }
        }
        if constexpr (ALIGN_EPI) { if (wr == 0) PG8_BAR; }
        if constexpr (!Epi::AFTER_DRAIN) { E(acc, cur, wr, wc, fr, fq); S.done(cur); }
        if (!has_next) break;
#pragma unroll
        for (int a = 0; a < 2; ++a)
#pragma unroll
            for (int b = 0; b < 2; ++b)
#pragma unroll
                for (int m = 0; m < 4; ++m)
#pragma unroll
                    for (int n = 0; n < 2; ++n) acc[a][b][m][n] = (f32x4){0.f, 0.f, 0.f, 0.f};
        cur = nxt; cA = nA; cB = nB; ++ui;
        if constexpr (ALIGN_EPI) { if (wr == 1) PG8_BAR; }
    }
    PG8_WAIT_V(0);
    if constexpr (!ALIGN_EPI) { if (wr == 0) PG8_BAR; }
    PG8_BAR;
    if constexpr (Epi::AFTER_DRAIN) { E.fused(acc, cur, wr, wc, fr, fq, lds, wid, lane); S.done(cur); }
#undef PG8_SA
#undef PG8_SB
#undef PG8_STAGE
#undef PG8_LDA
#undef PG8_LDB
#undef PG8_MMA
#undef PG8_WAIT_V
#undef PG8_WAIT_L
#undef PG8_BAR
#undef PG8_SCHED
}
}
namespace attn_body {
using bf16=__hip_bfloat16;
using bf16x8=__attribute__((ext_vector_type(8)))short;
using s16x4=__attribute__((ext_vector_type(4)))short;
using f32x16=__attribute__((ext_vector_type(16)))float;
using u32x4=__attribute__((ext_vector_type(4)))unsigned;
__device__ __forceinline__ int crow(int r,int hi){return (r&3)+8*(r>>2)+4*hi;}
#define SBAR() __builtin_amdgcn_sched_barrier(0)
__device__ __forceinline__ void glds16(const void*gsrc,unsigned lds_dst){unsigned keep;
  asm volatile("s_mov_b32 %0, m0\n\ts_mov_b32 m0, %2\n\ts_nop 0\n\tglobal_load_lds_dwordx4 %1, off\n\ts_mov_b32 m0, %0":"=&s"(keep):"v"(gsrc),"s"(lds_dst):"memory");}
typedef float f32x2_t __attribute__((ext_vector_type(2))); typedef __bf16 bf16x2_t __attribute__((ext_vector_type(2)));
__device__ __forceinline__ unsigned cvtpk_s(float lo,float hi){f32x2_t v={lo,hi};bf16x2_t b=__builtin_convertvector(v,bf16x2_t);return __builtin_bit_cast(unsigned,b);}
#define WAIT_BAR(N) asm volatile("s_waitcnt vmcnt(" #N ") lgkmcnt(0)\n\ts_barrier":::"memory")
__device__ __forceinline__ void qkt(f32x16&p0,f32x16&p1,const char*Kslot,const bf16x8*qr,const f32x16&negm,int r32,int hi){
  const char*kb=Kslot+hi*1024+r32*16;
  #pragma unroll
  for(int d0=0;d0<4;++d0){
    const bf16x8 b0=*reinterpret_cast<const bf16x8*>(kb+d0*2048);
    const bf16x8 b1=*reinterpret_cast<const bf16x8*>(kb+d0*2048+512);
    if(d0==0){p0=__builtin_amdgcn_mfma_f32_32x32x16_bf16(b0,qr[0],negm,0,0,0);p1=__builtin_amdgcn_mfma_f32_32x32x16_bf16(b1,qr[0],negm,0,0,0);}
    else{p0=__builtin_amdgcn_mfma_f32_32x32x16_bf16(b0,qr[d0],p0,0,0,0);p1=__builtin_amdgcn_mfma_f32_32x32x16_bf16(b1,qr[d0],p1,0,0,0);}}
}
__device__ __forceinline__ void pv(f32x16*o,int vb,bf16x8 pa0,bf16x8 pa1,bf16x8 pa2,bf16x8 pa3){
  #pragma unroll
  for(int d0=0;d0<2;++d0){s16x4 lo[4],hi[4];
    #pragma unroll
    for(int ks=0;ks<4;++ks){
      asm volatile("ds_read_b64_tr_b16 %0,%1 offset:%c2":"=&v"(lo[ks]):"v"(vb),"i"(d0*4096+ks*1024):"memory");
      asm volatile("ds_read_b64_tr_b16 %0,%1 offset:%c2":"=&v"(hi[ks]):"v"(vb),"i"(d0*4096+ks*1024+512):"memory");}
    asm volatile("s_waitcnt lgkmcnt(0)":::"memory");SBAR();
    #define PK(k) (bf16x8){lo[k][0],lo[k][1],lo[k][2],lo[k][3],hi[k][0],hi[k][1],hi[k][2],hi[k][3]}
    o[d0]=__builtin_amdgcn_mfma_f32_32x32x16_bf16(pa0,PK(0),o[d0],0,0,0);
    o[d0]=__builtin_amdgcn_mfma_f32_32x32x16_bf16(pa1,PK(1),o[d0],0,0,0);
    o[d0]=__builtin_amdgcn_mfma_f32_32x32x16_bf16(pa2,PK(2),o[d0],0,0,0);
    o[d0]=__builtin_amdgcn_mfma_f32_32x32x16_bf16(pa3,PK(3),o[d0],0,0,0);
    #undef PK
  }
}
constexpr int QBLK=32,KVBLK=64,NW=8;
constexpr int NSLOT=3, SLOTB=8192;
constexpr int LDS_K=0, LDS_V=NSLOT*SLOTB, LDS_WS=2*NSLOT*SLOTB, LDS_OST=LDS_WS+NW*64*4, LDS_BYTES=LDS_OST+NW*4096;
__device__ __forceinline__ float max3f(float a,float b,float c){float r;asm("v_max3_f32 %0, %1, %2, %3":"=v"(r):"v"(a),"v"(b),"v"(c));return r;}
__device__ __forceinline__ float max2f(float a,float b){float r;asm("v_max_f32_e32 %0, %1, %2":"=v"(r):"v"(a),"v"(b));return r;}
__device__ __forceinline__ float fadd_s(float a,float b){float r;asm("v_add_f32_e32 %0, %1, %2":"=v"(r):"v"(a),"v"(b));return r;}
__device__ __forceinline__ float fsub_s(float a,float b){float r;asm("v_sub_f32_e32 %0, %1, %2":"=v"(r):"v"(a),"v"(b));return r;}
typedef __attribute__((address_space(3))) const char* lds_cptr;
typedef short v4i16_t __attribute__((ext_vector_type(4)));
__device__ __forceinline__ void kload8(bf16x8*kf,lds_cptr kp){
  kf[0]=*(const __attribute__((address_space(3))) bf16x8*)(kp);      kf[1]=*(const __attribute__((address_space(3))) bf16x8*)(kp+512);
  kf[2]=*(const __attribute__((address_space(3))) bf16x8*)(kp+2048); kf[3]=*(const __attribute__((address_space(3))) bf16x8*)(kp+2560);
  kf[4]=*(const __attribute__((address_space(3))) bf16x8*)(kp+4096); kf[5]=*(const __attribute__((address_space(3))) bf16x8*)(kp+4608);
  kf[6]=*(const __attribute__((address_space(3))) bf16x8*)(kp+6144); kf[7]=*(const __attribute__((address_space(3))) bf16x8*)(kp+6656);
}
__device__ __forceinline__ void kload2(bf16x8*kf,lds_cptr kp,int j){ kf[2*j]=*(const __attribute__((address_space(3))) bf16x8*)(kp+j*2048); kf[2*j+1]=*(const __attribute__((address_space(3))) bf16x8*)(kp+j*2048+512); }
__device__ __forceinline__ s16x4 vtr(lds_cptr p){ return __builtin_bit_cast(s16x4,__builtin_amdgcn_ds_read_tr16_b64_v4i16((__attribute__((address_space(3))) v4i16_t*)p)); }
__device__ __forceinline__ float rowmax(const f32x16&p0,const f32x16&p1){
  float a=max3f(p0[0],p0[1],p1[0]),b=max3f(p0[2],p0[3],p1[1]);a=max3f(a,p1[2],p1[3]);
  #pragma unroll
  for(int r=4;r<16;r+=4){a=max3f(a,p0[r],p0[r+1]);b=max3f(b,p0[r+2],p0[r+3]);a=max3f(a,p1[r],p1[r+1]);b=max3f(b,p1[r+2],p1[r+3]);}
  const float m=max2f(a,b);
  auto rr=__builtin_amdgcn_permlane32_swap(__float_as_uint(m),__float_as_uint(m),false,false);
  return max2f(__uint_as_float(rr[0]),__uint_as_float(rr[1]));
}
template<int THRL> __device__ __forceinline__ void attn_unit2(const bf16*Qu,const bf16*__restrict__ Kh,const bf16*__restrict__ Vh,bf16*Ou,const int NT,char*shm){
  constexpr int QPITCH=512,KVPITCH=128,OPITCH=1280;
  const int tid=mk_tid(),lane=tid&63,r32=lane&31,hi=lane>>5; const int wid=__builtin_amdgcn_readfirstlane(tid>>6);
  const bf16*Qw=Qu+(long)(wid*QBLK)*QPITCH;
  const unsigned lds0=(unsigned)(uintptr_t)shm;
  float*wsf=(float*)(shm+LDS_WS)+wid*64;
  const bf16*ksrc=Kh+(long)lane*KVPITCH+wid*8;
  const bf16*vsrc=Vh+(long)(16*(wid&3)+(lane>>2))*KVPITCH+(wid>>2)*32+(lane&3)*8;
  const unsigned kdst=lds0+LDS_K+wid*1024, vdst=lds0+LDS_V+wid*1024;
  #define DMA_K(t,slot) glds16(ksrc+(long)(t)*KVBLK*KVPITCH,(unsigned)__builtin_amdgcn_readfirstlane(kdst+(slot)))
  #define DMA_V(t,slot) glds16(vsrc+(long)(t)*KVBLK*KVPITCH,(unsigned)__builtin_amdgcn_readfirstlane(vdst+(slot)))
  const int vb0=(int)(lds0+LDS_V)+((lane>>4)&1)*32+(lane&3)*8+(4*hi+((lane&15)>>2))*64;
  const char*Kbase=shm+LDS_K; bf16x8 kf[8];
  const lds_cptr shm3=(lds_cptr)shm; const lds_cptr kp0=shm3+LDS_K+hi*1024+r32*16; const lds_cptr vp0=shm3+LDS_V+((lane>>4)&1)*32+(lane&3)*8+(4*hi+((lane&15)>>2))*64;
  DMA_K(0,0);DMA_V(0,0);DMA_K(1,SLOTB);
  bf16x8 qr[4];
  #pragma unroll
  for(int d0=0;d0<4;++d0)qr[d0]=*reinterpret_cast<const bf16x8*>(&Qw[(long)r32*QPITCH+d0*16+hi*8]);
  float mhat=0.f,l_reg=0.f;f32x16 o[2];o[0]=f32x16{};o[1]=f32x16{};f32x16 negm=f32x16{};asm volatile("":"+v"(negm));
  #define CMASK(P0,P1,t) do{}while(0)
  bool resc=false;
  #define START(P0,P1) do{ const float rm=rowmax(P0,P1); resc=false; \
    { const float dl=rm; mhat=fadd_s(mhat,dl); \
      _Pragma("unroll") for(int r=0;r<16;++r){P0[r]=fsub_s(P0[r],dl);P1[r]=fsub_s(P1[r],dl);} \
      _Pragma("unroll") for(int r=0;r<16;++r)negm[r]=-mhat; asm volatile("":"+v"(negm)); } \
    _Pragma("unroll") for(int r=0;r<16;++r)P0[r]=__builtin_amdgcn_exp2f(P0[r]); }while(0)
  #define RESC() do{ if(resc){ asm volatile("s_waitcnt lgkmcnt(0)":::"memory"); \
      _Pragma("unroll") for(int d_=0;d_<2;++d_) _Pragma("unroll") for(int r=0;r<16;++r)o[d_][r]*=wsf[crow(r,hi)]; } }while(0)
  f32x16 pA0,pA1,pB0,pB1;
  int sl_prev=0,sl_cur=0,sl_next=SLOTB;
  #define ROT() do{sl_prev=sl_cur;sl_cur=sl_next;sl_next=(sl_next==(NSLOT-1)*SLOTB)?0:sl_next+SLOTB;}while(0)
  DMA_K(2,2*SLOTB);
  WAIT_BAR(3);
  qkt(pA0,pA1,Kbase,qr,negm,r32,hi);asm volatile("s_nop 15\n\ts_nop 7":"+v"(pA0),"+v"(pA1));CMASK(pA0,pA1,0);
  START(pA0,pA1);
  _Pragma("unroll") for(int r=0;r<16;++r)pA1[r]=__builtin_amdgcn_exp2f(pA1[r]);
  WAIT_BAR(0);
  DMA_K(3,0);DMA_V(1,SLOTB);
  ROT();
  kload8(kf,kp0+sl_cur);
  WAIT_BAR(2);
  s16x4 vlo[8],vhi[8]; u32x4 pw0,pw1,pw2,pw3;
  #define PKW(P,B) cvtpk_s(P[B],P[B+1])
  #define PAF(k) __builtin_bit_cast(bf16x8,pw##k)
  #define VFR(i) (bf16x8){vlo[i][0],vlo[i][1],vlo[i][2],vlo[i][3],vhi[i][0],vhi[i][1],vhi[i][2],vhi[i][3]}
  #define PIN(x) asm volatile("":"+v"(x))
  #define MX3(a,b,c) __builtin_fmaxf(__builtin_fmaxf((a),(b)),(c))
  #define GAPA(MF,A0,A1,A2,A3,W0,W1,PW) do{ MF; sacc+=A0; sacc+=A1; sacc+=A2; sacc+=A3; PIN(sacc); W0; W1; PIN(PW); SBAR(); }while(0)
  #define EX(v) __builtin_amdgcn_exp2f(v)
  #define GAPB(MF,X,B) do{ MF; X[B]=EX(X[B]); X[B+1]=EX(X[B+1]); X[B+2]=EX(X[B+2]); X[B+3]=EX(X[B+3]); PIN(X); SBAR(); }while(0)
  #define VRD(i) do{ vlo[i]=vtr(vp_+(((i)>>2)*4096+((i)&3)*1024)); vhi[i]=vtr(vp_+(((i)>>2)*4096+((i)&3)*1024+512)); }while(0)
  #define KRD(G,j) do{ if(G){ kload2(kf,kp0+sl_next,j); SBAR(); } }while(0)
  #define STEP(C0,C1,P0,P1,t,GK,GV,GL) do{ SBAR(); \
    const lds_cptr vp_=vp0+sl_prev; \
    VRD(0); SBAR(); float sacc=(P0[0]+P0[1]); \
    GAPA(C0=__builtin_amdgcn_mfma_f32_32x32x16_bf16(kf[0],qr[0],negm,0,0,0), P0[2],P0[3],P0[4],P0[5],     pw0[0]=PKW(P0,0), pw0[1]=PKW(P0,2), pw0); \
    VRD(4); SBAR(); GAPA(C1=__builtin_amdgcn_mfma_f32_32x32x16_bf16(kf[1],qr[0],negm,0,0,0), P0[6],P0[7],P0[8],P0[9],     pw0[2]=PKW(P0,4), pw0[3]=PKW(P0,6), pw0); \
    VRD(1); SBAR(); GAPA(C0=__builtin_amdgcn_mfma_f32_32x32x16_bf16(kf[2],qr[1],C0,0,0,0),   P0[10],P0[11],P0[12],P0[13], pw1[0]=PKW(P0,8), pw1[1]=PKW(P0,10), pw1); \
    VRD(5); SBAR(); GAPA(C1=__builtin_amdgcn_mfma_f32_32x32x16_bf16(kf[3],qr[1],C1,0,0,0),   P0[14],P0[15],P1[0],P1[1],   pw1[2]=PKW(P0,12),pw1[3]=PKW(P0,14), pw1); \
    VRD(2); SBAR(); GAPA(C0=__builtin_amdgcn_mfma_f32_32x32x16_bf16(kf[4],qr[2],C0,0,0,0),   P1[2],P1[3],P1[4],P1[5],     pw2[0]=PKW(P1,0), pw2[1]=PKW(P1,2), pw2); \
    VRD(6); SBAR(); GAPA(C1=__builtin_amdgcn_mfma_f32_32x32x16_bf16(kf[5],qr[2],C1,0,0,0),   P1[6],P1[7],P1[8],P1[9],     pw2[2]=PKW(P1,4), pw2[3]=PKW(P1,6), pw2); \
    VRD(3); SBAR(); GAPA(C0=__builtin_amdgcn_mfma_f32_32x32x16_bf16(kf[6],qr[3],C0,0,0,0),   P1[10],P1[11],P1[12],P1[13], pw3[0]=PKW(P1,8), pw3[1]=PKW(P1,10), pw3); \
    VRD(7); SBAR(); GAPA(C1=__builtin_amdgcn_mfma_f32_32x32x16_bf16(kf[7],qr[3],C1,0,0,0),   P1[14],P1[15],0.f,0.f,       pw3[2]=PKW(P1,12),pw3[3]=PKW(P1,14), pw3); \
    l_reg+=sacc; \
    if(GK){DMA_K((t)+3,sl_cur);} if(GV){DMA_V((t)+1,sl_next);} \
    CMASK(C0,C1,t); \
    { float a=MX3(C0[0],C0[1],C1[0]),b=MX3(C0[2],C0[3],C1[1]); a=MX3(a,C1[2],C1[3]); \
      _Pragma("unroll") for(int r=4;r<16;r+=4){a=MX3(a,C0[r],C0[r+1]);b=MX3(b,C0[r+2],C0[r+3]);a=MX3(a,C1[r],C1[r+1]);b=MX3(b,C1[r+2],C1[r+3]);} \
      float rm=__builtin_fmaxf(a,b); { auto rr=__builtin_amdgcn_permlane32_swap(__float_as_uint(rm),__float_as_uint(rm),false,false); rm=__builtin_fmaxf(__uint_as_float(rr[0]),__uint_as_float(rr[1])); } \
      resc=false; \
      if(__builtin_expect(__any(rm>(float)THRL),0)){ const float dl=__builtin_fmaxf(rm,0.f); mhat+=dl; \
        _Pragma("unroll") for(int r=0;r<16;++r){C0[r]-=dl;C1[r]-=dl;} \
        _Pragma("unroll") for(int r=0;r<16;++r)negm[r]=-mhat; asm volatile("":"+v"(negm)); \
        const float f=__builtin_amdgcn_exp2f(-dl); l_reg*=f; if(hi==0)wsf[r32]=f; resc=true; } } \
    SBAR(); \
    GAPB(o[0]=__builtin_amdgcn_mfma_f32_32x32x16_bf16(PAF(0),VFR(0),o[0],0,0,0), C0,0); \
    GAPB(o[1]=__builtin_amdgcn_mfma_f32_32x32x16_bf16(PAF(0),VFR(4),o[1],0,0,0), C0,4); \
    KRD(GL,0); GAPB(o[0]=__builtin_amdgcn_mfma_f32_32x32x16_bf16(PAF(1),VFR(1),o[0],0,0,0), C0,8); \
    KRD(GL,1); GAPB(o[1]=__builtin_amdgcn_mfma_f32_32x32x16_bf16(PAF(1),VFR(5),o[1],0,0,0), C0,12); \
    KRD(GL,2); GAPB(o[0]=__builtin_amdgcn_mfma_f32_32x32x16_bf16(PAF(2),VFR(2),o[0],0,0,0), C1,0); \
    KRD(GL,3); GAPB(o[1]=__builtin_amdgcn_mfma_f32_32x32x16_bf16(PAF(2),VFR(6),o[1],0,0,0), C1,4); \
    GAPB(o[0]=__builtin_amdgcn_mfma_f32_32x32x16_bf16(PAF(3),VFR(3),o[0],0,0,0), C1,8); \
    GAPB(o[1]=__builtin_amdgcn_mfma_f32_32x32x16_bf16(PAF(3),VFR(7),o[1],0,0,0), C1,12); \
    }while(0)
  int t=1;
  #undef CMASK
  #define CMASK(P0,P1,t) do{}while(0)
  for(;t+5<NT;t+=2){
    STEP(pB0,pB1,pA0,pA1,t,true,true,true);     WAIT_BAR(2); RESC(); ROT();
    STEP(pA0,pA1,pB0,pB1,t+1,true,true,true);   WAIT_BAR(2); RESC(); ROT();
  }
  #undef CMASK
  #define CMASK(P0,P1,t) do{}while(0)
  #define ENDW(tt) do{ if((tt)+3<NT){WAIT_BAR(2);} else if((tt)+2<NT){WAIT_BAR(1);} else {WAIT_BAR(0);} }while(0)
  for(;t+1<NT;t+=2){
    STEP(pB0,pB1,pA0,pA1,t,(t+3<NT),(t+1<NT),(t+1<NT));       ENDW(t);   RESC(); ROT();
    STEP(pA0,pA1,pB0,pB1,t+1,(t+4<NT),(t+2<NT),(t+2<NT));     ENDW(t+1); RESC(); ROT();
  }
  STEP(pB0,pB1,pA0,pA1,NT-1,false,false,false); RESC();
  { float sacc=pB0[0]+pB0[1]; _Pragma("unroll") for(int r=2;r<16;++r)sacc+=pB0[r]; _Pragma("unroll") for(int r=0;r<16;++r)sacc+=pB1[r]; l_reg+=sacc;
    pw0=(u32x4){PKW(pB0,0),PKW(pB0,2),PKW(pB0,4),PKW(pB0,6)};pw1=(u32x4){PKW(pB0,8),PKW(pB0,10),PKW(pB0,12),PKW(pB0,14)};pw2=(u32x4){PKW(pB1,0),PKW(pB1,2),PKW(pB1,4),PKW(pB1,6)};pw3=(u32x4){PKW(pB1,8),PKW(pB1,10),PKW(pB1,12),PKW(pB1,14)};
    SBAR(); pv(o,vb0+sl_cur,PAF(0),PAF(1),PAF(2),PAF(3)); }
  #undef PKW
  #undef PAF
  #undef VFR
  #undef PIN
  #undef MX3
  #undef GAPA
  #undef GAPB
  #undef EX
  #undef VRD
  #undef KRD
  #undef STEP
  #undef ENDW
  {auto rr=__builtin_amdgcn_permlane32_swap(__float_as_uint(l_reg),__float_as_uint(l_reg),false,false);l_reg=__uint_as_float(rr[0])+__uint_as_float(rr[1]);}
  if(hi==0)wsf[32+r32]=l_reg;asm volatile("s_waitcnt lgkmcnt(0)":::"memory");
  float rli[16];
  #pragma unroll
  for(int r=0;r<16;++r)rli[r]=__builtin_amdgcn_rcpf(wsf[32+crow(r,hi)]);
  bf16*Ow=Ou+(long)(wid*QBLK)*OPITCH;
  { bf16*stg=(bf16*)(shm+LDS_OST)+wid*2048;
    #pragma unroll
    for(int r=0;r<16;++r){const int orow=crow(r,hi);
      #pragma unroll
      for(int d0=0;d0<2;++d0)stg[orow*64+d0*32+r32]=__float2bfloat16(o[d0][r]*rli[r]);}
    asm volatile("s_waitcnt lgkmcnt(0)":::"memory");
    #pragma unroll
    for(int i=0;i<4;++i){const int row=i*8+(lane>>3),ch=lane&7; const u32x4 v=*(const u32x4*)(stg+row*64+ch*8); *(u32x4*)(Ow+(long)row*OPITCH+ch*8)=v;} }
  asm volatile("s_waitcnt lgkmcnt(0)\n\ts_barrier":::"memory");
  #undef DMA_K
  #undef DMA_V
  #undef CMASK
  #undef START
  #undef RESC
  #undef ROT
}
#undef SBAR
#undef WAIT_BAR
}

namespace mk {
using pg8::bf16_t; using pg8::f32x4; using pg8::Unit; using pg8::cvt_pk_bf16;
#define LAS __attribute__((address_space(3)))
typedef unsigned u32x2 __attribute__((ext_vector_type(2)));
typedef unsigned u32x4 __attribute__((ext_vector_type(4)));
typedef float f32x2 __attribute__((ext_vector_type(2)));
typedef short bf16x8 __attribute__((ext_vector_type(8)));
typedef float f32x16 __attribute__((ext_vector_type(16)));

constexpr int DM = 1024, NB = 8, SL = 4096, CL = 256, ML = NB * SL, MC = NB * CL, MT = ML + MC;
constexpr int INW = 1792, DFF = 2816, UPW = 5632, MIXK = 1280, KVP = 128, QP = 512, KVB = SL + CL;
constexpr int HALF_A = 16384;
constexpr float EPS = 1e-6f;
constexpr float QSCALE = 0.125f * 1.4426950408889634f;

constexpr size_t MiB = 1u << 20;
constexpr size_t WS_CTL = 0;
constexpr size_t WS_MODP = 1 * MiB;
constexpr size_t WS_MOD = 5 * MiB;
constexpr size_t WS_T = 6 * MiB;
constexpr size_t WS_TW = 7 * MiB;
constexpr size_t WS_W = 8 * MiB;
constexpr size_t W_LAYER = 24 * MiB;
constexpr size_t WS_ADFT = 56 * MiB;
constexpr size_t WS_ADFTC = 88 * MiB;
constexpr size_t WS_KF = 89 * MiB;
constexpr size_t WS_KFC = 121 * MiB;
constexpr size_t WS_CX = 122 * MiB;
constexpr size_t WS_XN = 130 * MiB;
constexpr size_t WS_TMP = 198 * MiB;
constexpr size_t WS_Q = WS_TMP;
constexpr size_t WS_K = WS_TMP + 34 * MiB;
constexpr size_t WS_V = WS_TMP + 43 * MiB;
constexpr size_t WS_FT = WS_TMP + 52 * MiB;
constexpr size_t WS_FTC = WS_TMP + 68 * MiB;
constexpr size_t WS_PT = WS_TMP + 69 * MiB;
constexpr size_t WS_PTC = WS_TMP + 117 * MiB;
constexpr size_t WS_MIX = WS_TMP + 120 * MiB;
constexpr size_t WS_HRAW = WS_TMP + 206 * MiB;
constexpr size_t WS_U = WS_TMP;
constexpr size_t WS_G = WS_TMP;
constexpr size_t WS_SB = WS_TMP + 190 * MiB;
constexpr size_t WS_END = WS_TMP + 297 * MiB;

struct Params { const float* in[29]; float* out; unsigned char* ws; int ph_lo, ph_hi; };
enum { I_X = 0, I_C, I_CTX, I_CCTX, I_WMOD, I_BMOD, I_GPREMIX, I_GPOSTMIX, I_GPREFFN, I_GPOSTFFN, I_WIN, I_GQ, I_GK, I_WF, I_WHC, I_BHC,
       I_HW1, I_HB1, I_HFR1, I_HW2, I_HB2, I_HFR2, I_HW3, I_HBIAS, I_WOUT, I_WUP, I_WFC, I_BFC, I_WDOWN };

__device__ __forceinline__ unsigned f2bf(float f) { unsigned u = __builtin_bit_cast(unsigned, f); return (u + 0x7fffu + ((u >> 16) & 1u)) >> 16; }
__device__ __forceinline__ unsigned pk2(float lo, float hi) { return f2bf(lo) | (f2bf(hi) << 16); }
__device__ __forceinline__ float bflo(unsigned w) { return __uint_as_float(w << 16); }
__device__ __forceinline__ float bfhi(unsigned w) { return __uint_as_float(w & 0xffff0000u); }
__device__ __forceinline__ float bf2f(bf16_t h) { return __uint_as_float((unsigned)h << 16); }
__device__ __forceinline__ float wave_sum(float v) {
#pragma unroll
    for (int o = 1; o < 64; o <<= 1) v += __shfl_xor(v, o);
    return v;
}

struct EpiPlain {
    static constexpr bool PERM = true, AFTER_DRAIN = false;
    bf16_t* O; int ldc;
    __device__ __forceinline__ void operator()(const f32x4 (&acc)[2][2][4][2], const Unit& u, int wr, int wc, int fr, int fq) const {
        const int row0 = u.pm * 256 + wr * 64 + fr; const int col0 = u.pn * 256 + wc * 32 + 8 * fq;
#pragma unroll
        for (int ai = 0; ai < 2; ++ai)
#pragma unroll
            for (int m = 0; m < 4; ++m) { bf16_t* rowp = O + (size_t)(row0 + ai * 128 + m * 16) * ldc + col0;
#pragma unroll
                for (int bj = 0; bj < 2; ++bj) { const f32x4 v0 = acc[ai][bj][m][0], v1 = acc[ai][bj][m][1];
                    u32x4 w; w.x = cvt_pk_bf16(v0[0], v0[1]); w.y = cvt_pk_bf16(v0[2], v0[3]); w.z = cvt_pk_bf16(v1[0], v1[1]); w.w = cvt_pk_bf16(v1[2], v1[3]);
                    *(u32x4*)(rowp + bj * 128) = w; } }
    }
};

struct EpiFourier {
    static constexpr bool PERM = true, AFTER_DRAIN = false;
    bf16_t* MIXp; int Lh; int rowbase0; int rowstride;
    __device__ __forceinline__ void operator()(const f32x4 (&acc)[2][2][4][2], const Unit& u, int wr, int wc, int fr, int fq) const {
        asm volatile("" : "+v"(fr), "+v"(fq), "+s"(wr), "+s"(wc));
        const int b = u.pn; const int len = 2 * Lh; const int rb = rowbase0 + b * rowstride;
#pragma unroll
        for (int ai = 0; ai < 2; ++ai)
#pragma unroll
            for (int m = 0; m < 4; ++m) {
                const int r = u.pm * 256 + ai * 128 + wr * 64 + m * 16 + fr;
                const bool isS = r > Lh; const int k = isS ? r - Lh : r;
                const bool edge = (k == 0) || (k == Lh);
#pragma unroll
                for (int bj = 0; bj < 2; ++bj) { const f32x4 v0 = acc[ai][bj][m][0], v1 = acc[ai][bj][m][1];
                    const int ch = bj * 128 + wc * 32 + 8 * fq;
                    u32x4 w; w.x = cvt_pk_bf16(v0[0], v0[1]); w.y = cvt_pk_bf16(v0[2], v0[3]); w.z = cvt_pk_bf16(v1[0], v1[1]); w.w = cvt_pk_bf16(v1[2], v1[3]);
                    const int col = 512 + (isS ? 256 : 0) + ch;
                    *(u32x4*)(MIXp + (size_t)(rb + k) * MIXK + col) = w;
                    if (!edge) { u32x4 wm = w; if (isS) { wm.x ^= 0x80008000u; wm.y ^= 0x80008000u; wm.z ^= 0x80008000u; wm.w ^= 0x80008000u; }
                        *(u32x4*)(MIXp + (size_t)(rb + len - k) * MIXK + col) = wm; }
                    else if (!isS) { *(u32x4*)(MIXp + (size_t)(rb + k) * MIXK + col + 256) = (u32x4){0u, 0u, 0u, 0u}; }
                }
            }
    }
};

struct EpiInProj {
    static constexpr bool PERM = false, AFTER_DRAIN = false;
    bf16_t *Q, *K, *V, *fT, *fTc, *PT, *PTc; const float *gq, *gk, *rope; LAS float* xch;
    __device__ __forceinline__ void operator()(const f32x4 (&acc)[2][2][4][2], const Unit& u, int wr, int wc, int fr, int fq) const {
        asm volatile("" : "+v"(fr), "+v"(fq), "+s"(wr), "+s"(wc));
        const int pn = u.pn, pm = u.pm; const bool isctx = pm >= 128;
        const int b = isctx ? pm - 128 : pm >> 4;
        const int tbase = isctx ? 0 : (pm & 15) * 256;
#ifdef T_NOQK
        if (false) {
#else
        if (pn <= 2) {
#endif
#pragma unroll
            for (int ai = 0; ai < 2; ++ai)
#pragma unroll
                for (int m = 0; m < 4; ++m)
#pragma unroll
                    for (int bj = 0; bj < 2; ++bj) {
                        float s = 0.f;
#pragma unroll
                        for (int n = 0; n < 2; ++n) { const f32x4 x = acc[ai][bj][m][n]; s += (x[0] * x[0] + x[1] * x[1]) + (x[2] * x[2] + x[3] * x[3]); }
                        s += __shfl_xor(s, 16); s += __shfl_xor(s, 32);
                        if (fq == 0) xch[((ai * 128 + wr * 64 + m * 16 + fr) * 2 + bj) * 4 + wc] = s;
                    }
            asm volatile("s_waitcnt lgkmcnt(0)\n\ts_barrier" ::: "memory");
            const float* gg = (pn == 2) ? gk : gq;
            const int dbase = (wc & 1) * 32 + 4 * fq;
            const f32x4 g1 = *(const f32x4*)(gg + dbase), g2 = *(const f32x4*)(gg + dbase + 16);
            const float osc = (pn == 2) ? 1.0f : QSCALE;
#pragma unroll
            for (int ai = 0; ai < 2; ++ai)
#pragma unroll
                for (int m = 0; m < 4; ++m) {
                    const int rl = ai * 128 + wr * 64 + m * 16 + fr; const int t = tbase + rl;
                    const int p = (wc & 1) ? (t & 63) : (t >> 6);
                    f32x4 cs = (f32x4){1.f, 1.f, 1.f, 1.f}, sn = (f32x4){0.f, 0.f, 0.f, 0.f};
                    if (!isctx) { cs = *(const f32x4*)(rope + p * 16 + 4 * fq); sn = *(const f32x4*)(rope + 1024 + p * 16 + 4 * fq); }
                    const size_t qrow = (size_t)pm * 256 + rl;
                    const size_t kvrow = isctx ? (size_t)b * KVB + rl : (size_t)b * KVB + CL + t;
#pragma unroll
                    for (int bj = 0; bj < 2; ++bj) {
                        if (pn == 2 && bj == 1) {
#pragma unroll
                            for (int n = 0; n < 2; ++n) { const f32x4 x = acc[ai][bj][m][n]; u32x2 w; w.x = cvt_pk_bf16(x[0], x[1]); w.y = cvt_pk_bf16(x[2], x[3]);
                                *(u32x2*)(V + kvrow * KVP + wc * 32 + 16 * n + 4 * fq) = w; }
                        } else {
                            const float ssq = xch[(rl * 2 + bj) * 4 + wc] + xch[(rl * 2 + bj) * 4 + (wc ^ 1)];
                            const float rstd = rsqrtf(ssq * (1.0f / 64.0f) + EPS) * osc;
                            const f32x4 y1 = acc[ai][bj][m][0] * rstd * g1, y2 = acc[ai][bj][m][1] * rstd * g2;
                            const f32x4 o1 = y1 * cs - y2 * sn, o2 = y2 * cs + y1 * sn;
                            u32x2 w1, w2; w1.x = cvt_pk_bf16(o1[0], o1[1]); w1.y = cvt_pk_bf16(o1[2], o1[3]); w2.x = cvt_pk_bf16(o2[0], o2[1]); w2.y = cvt_pk_bf16(o2[2], o2[3]);
                            bf16_t* dst = (pn == 2) ? (K + kvrow * KVP + wc * 32 + 4 * fq) : (Q + qrow * QP + pn * 256 + bj * 128 + wc * 32 + 4 * fq);
                            *(u32x2*)dst = w1; *(u32x2*)(dst + 16) = w2;
                        }
                    }
                    asm volatile("" ::: "memory"); __builtin_amdgcn_sched_barrier(0);
                }
        }
#ifndef T_NOTR
        else {
            const int NC = (pn == 3) ? 256 : 768; const int cb = (pn == 3) ? 0 : (pn - 4) * 256;
            bf16_t* base; int tl;
            if (isctx) { base = ((pn == 3) ? fTc : PTc) + (size_t)b * NC * CL; tl = CL; }
            else { base = ((pn == 3) ? fT : PT) + (size_t)b * NC * SL + tbase; tl = SL; }
            const int lane = fq * 16 + fr;
            LAS bf16_t* stg = (LAS bf16_t*)((LAS unsigned char*)xch + 8192) + (wr * 4 + wc) * 1152;
#pragma unroll
            for (int ai = 0; ai < 2; ++ai)
#pragma unroll
                for (int bj = 0; bj < 2; ++bj)
#pragma unroll
                    for (int n = 0; n < 2; ++n) {
#pragma unroll
                        for (int m = 0; m < 4; ++m) { const f32x4 x = acc[ai][bj][m][n];
#pragma unroll
                            for (int j = 0; j < 4; ++j) stg[(4 * fq + j) * 72 + m * 16 + fr] = (bf16_t)f2bf(x[j]); }
                        asm volatile("s_waitcnt lgkmcnt(0)" ::: "memory");
                        bf16_t* dst = base + (size_t)(cb + bj * 128 + wc * 32 + 16 * n) * tl + ai * 128 + wr * 64;
#pragma unroll
                        for (int i = 0; i < 2; ++i) { const int v = lane + 64 * i, col = v >> 3, k = v & 7;
                            const u32x4 w = *(const LAS u32x4*)(stg + col * 72 + k * 8);
                            *(u32x4*)(dst + (size_t)col * tl + 8 * k) = w; }
                        asm volatile("s_waitcnt lgkmcnt(0)" ::: "memory");
                    }
        }
#endif
    }
};


__device__ __forceinline__ float dppf(float old, float src, int ctrl_sel) {
    const int o = __builtin_bit_cast(int, old), s = __builtin_bit_cast(int, src); int r;
    if (ctrl_sel == 0) r = __builtin_amdgcn_update_dpp(o, s, 0x111, 0xf, 0xf, false);
    else if (ctrl_sel == 1) r = __builtin_amdgcn_update_dpp(o, s, 0x101, 0xf, 0xf, false);
    else if (ctrl_sel == 2) r = __builtin_amdgcn_update_dpp(o, s, 0x121, 0xf, 0xf, false);
    else r = __builtin_amdgcn_update_dpp(o, s, 0x12F, 0xf, 0xf, false);
    return __builtin_bit_cast(float, r);
}
__device__ __forceinline__ float silu_mul(float cg, float cv) { return cg * cv * __builtin_amdgcn_rcpf(1.0f + __builtin_amdgcn_exp2f(-1.4426950408889634f * cg)); }

struct EpiGlu {
    static constexpr bool PERM = true, AFTER_DRAIN = false;
    bf16_t* G; bf16_t* SB; const float* wcv; const float* bcv; LAS float* xb;
    __device__ __forceinline__ void operator()(const f32x4 (&acc)[2][2][4][2], const Unit& u, int wr, int wc, int fr, int fq) const {
        asm volatile("" : "+v"(fr), "+v"(fq), "+s"(wr), "+s"(wc));
        const int c0 = 128 * u.pn + 32 * wc + 8 * fq;
#pragma unroll
        for (int ai = 0; ai < 2; ++ai) {
            if (fr == 0 || fr == 15) {
                const int which = fr == 0 ? 0 : 1; LAS float* dst = xb + ((((ai * 2 + wr) * 2 + which) * 4 + wc) * 4 + fq) * 16;
#pragma unroll
                for (int bj = 0; bj < 2; ++bj)
#pragma unroll
                    for (int n = 0; n < 2; ++n) { const f32x4 x = fr == 0 ? acc[ai][bj][0][n] : acc[ai][bj][3][n]; *(LAS f32x4*)(dst + bj * 8 + n * 4) = x; }
            }
        }
        asm volatile("s_waitcnt lgkmcnt(0)\n\ts_barrier" ::: "memory");
#pragma unroll
        for (int n = 0; n < 2; ++n) {
            f32x4 wg[3], wv[3], bg, bv;
#pragma unroll
            for (int d = 0; d < 3; ++d) { wg[d] = *(const f32x4*)(wcv + d * UPW + c0 + 4 * n); wv[d] = *(const f32x4*)(wcv + d * UPW + DFF + c0 + 4 * n); }
            bg = *(const f32x4*)(bcv + c0 + 4 * n); bv = *(const f32x4*)(bcv + DFF + c0 + 4 * n);
#pragma unroll
            for (int ai = 0; ai < 2; ++ai) {
                int pblk = -1, nblk = -1;
                if (wr == 1) pblk = ai * 2 + 0; else if (ai == 1) pblk = 0 * 2 + 1;
                if (wr == 0) nblk = ai * 2 + 1; else if (ai == 0) nblk = 1 * 2 + 0;
#pragma unroll
                for (int m = 0; m < 4; ++m) {
                    f32x4 pg = (f32x4){0.f, 0.f, 0.f, 0.f}, pv = pg, ng = pg, nv = pg;
                    if (m == 0 && pblk >= 0) { const LAS float* s = xb + (((pblk * 2 + 1) * 4 + wc) * 4 + fq) * 16; pg = *(const LAS f32x4*)(s + n * 4); pv = *(const LAS f32x4*)(s + 8 + n * 4); }
                    if (m == 3 && nblk >= 0) { const LAS float* s = xb + (((nblk * 2 + 0) * 4 + wc) * 4 + fq) * 16; ng = *(const LAS f32x4*)(s + n * 4); nv = *(const LAS f32x4*)(s + 8 + n * 4); }
                    float res[4];
#pragma unroll
                    for (int j = 0; j < 4; ++j) {
                        const float cg = acc[ai][0][m][n][j], cv = acc[ai][1][m][n][j];
                        const float og = m > 0 ? dppf(0.f, acc[ai][0][m - 1][n][j], 2) : pg[j], ov = m > 0 ? dppf(0.f, acc[ai][1][m - 1][n][j], 2) : pv[j];
                        const float qg = m < 3 ? dppf(0.f, acc[ai][0][m + 1][n][j], 3) : ng[j], qv = m < 3 ? dppf(0.f, acc[ai][1][m + 1][n][j], 3) : nv[j];
                        const float prg = dppf(og, cg, 0), prv = dppf(ov, cv, 0), nxg = dppf(qg, cg, 1), nxv = dppf(qv, cv, 1);
                        const float sg = prg * wg[0][j] + cg * wg[1][j] + nxg * wg[2][j] + bg[j];
                        const float sv = prv * wv[0][j] + cv * wv[1][j] + nxv * wv[2][j] + bv[j];
                        res[j] = silu_mul(sg, sv);
                    }
                    const int rl = ai * 128 + wr * 64 + m * 16 + fr;
                    u32x2 w; w.x = cvt_pk_bf16(res[0], res[1]); w.y = cvt_pk_bf16(res[2], res[3]);
                    *(u32x2*)(G + (size_t)(u.pm * 256 + rl) * DFF + c0 + 4 * n) = w;
                    if (rl < 2 || rl >= 254) {
                        const int which = rl < 2 ? rl : rl - 252; bf16_t* sb = SB + ((size_t)u.pm * 4 + which) * UPW + c0 + 4 * n;
                        const f32x4 g0 = acc[ai][0][m][n], v0 = acc[ai][1][m][n];
                        u32x2 a; a.x = cvt_pk_bf16(g0[0], g0[1]); a.y = cvt_pk_bf16(g0[2], g0[3]);
                        u32x2 b; b.x = cvt_pk_bf16(v0[0], v0[1]); b.y = cvt_pk_bf16(v0[2], v0[3]);
                        *(u32x2*)sb = a; *(u32x2*)(sb + DFF) = b;
                    }
                }
            }
            asm volatile("" ::: "memory");
        }
    }
};

__device__ __forceinline__ void glu_fixup(int blk, int nblk, int tid, int ntiles, const bf16_t* SB, bf16_t* G, const float* wc, const float* bc) {
    for (int it = blk; it < 2 * ntiles; it += nblk) {
        const int pm = it >> 1, b = it & 1;
        const bool isctx = pm >= 128; const bool has_prev = !isctx && (pm & 15) != 0, has_next = !isctx && (pm & 15) != 15;
        const bf16_t* rp; const bf16_t* rc; const bf16_t* rn; bool hp, hn;
        if (b == 0) { rp = SB + ((size_t)(pm - 1) * 4 + 3) * UPW; rc = SB + ((size_t)pm * 4 + 0) * UPW; rn = SB + ((size_t)pm * 4 + 1) * UPW; hp = has_prev; hn = true; }
        else { rp = SB + ((size_t)pm * 4 + 2) * UPW; rc = SB + ((size_t)pm * 4 + 3) * UPW; rn = SB + ((size_t)(pm + 1) * 4 + 0) * UPW; hp = true; hn = has_next; }
        bf16_t* grow = G + (size_t)(pm * 256 + (b ? 255 : 0)) * DFF;
        for (int c = tid; c < DFF; c += 512) {
            const float gp = hp ? bf2f(rp[c]) : 0.f, gc = bf2f(rc[c]), gn = hn ? bf2f(rn[c]) : 0.f;
            const float vp = hp ? bf2f(rp[DFF + c]) : 0.f, vc = bf2f(rc[DFF + c]), vn = hn ? bf2f(rn[DFF + c]) : 0.f;
            const float sg = gp * wc[c] + gc * wc[UPW + c] + gn * wc[2 * UPW + c] + bc[c];
            const float sv = vp * wc[DFF + c] + vc * wc[UPW + DFF + c] + vn * wc[2 * UPW + DFF + c] + bc[DFF + c];
            grow[c] = (bf16_t)f2bf(silu_mul(sg, sv));
        }
    }
}

struct OneUnit { int pm, pn;
    __device__ __forceinline__ bool next(int i, Unit& u) const { if (i > 0) return false; u.pm = pm; u.pn = pn; return true; }
    __device__ __forceinline__ void a_ready(const Unit&) const {}
    __device__ __forceinline__ void done(const Unit&) const {}
};

constexpr int AT_K = 0, AT_V = 16384, AT_WS = 32768, AT_OST = 32768 + 2048;
__device__ __forceinline__ void attn_unit(const bf16_t* Qu, const bf16_t* Kh, const bf16_t* Vh, bf16_t* Ou, int NT, char* shm) {
    using namespace attn_body;
    const int tid = mk_tid(), lane = tid & 63, r32 = lane & 31, hi = lane >> 5; const int wid = __builtin_amdgcn_readfirstlane(tid >> 6);
    const unsigned lds0 = (unsigned)(uintptr_t)shm;
    float* wsf = (float*)(shm + AT_WS) + wid * 64;
    const bf16_t* ksrc = Kh + (size_t)lane * KVP + wid * 8;
    const bf16_t* vsrc = Vh + (size_t)(16 * (wid & 3) + (lane >> 2)) * KVP + (wid >> 2) * 32 + (lane & 3) * 8;
    const unsigned kdst = lds0 + AT_K + wid * 1024, vdst = lds0 + AT_V + wid * 1024;
#define DMA_K(t, slot) glds16(ksrc + (size_t)(t) * 64 * KVP, (unsigned)__builtin_amdgcn_readfirstlane(kdst + (slot)))
#define DMA_V(t, slot) glds16(vsrc + (size_t)(t) * 64 * KVP, (unsigned)__builtin_amdgcn_readfirstlane(vdst + (slot)))
    const int vb0 = (int)(lds0 + AT_V) + ((lane >> 4) & 1) * 32 + (lane & 3) * 8 + (4 * hi + ((lane & 15) >> 2)) * 64;
    DMA_K(0, 0); DMA_V(0, 0);
    const bf16_t* Qw = Qu + (size_t)(wid * 32) * QP;
    bf16x8 qr[4];
#pragma unroll
    for (int d0 = 0; d0 < 4; ++d0) qr[d0] = *reinterpret_cast<const bf16x8*>(&Qw[(size_t)r32 * QP + d0 * 16 + hi * 8]);
    float mrun = -INFINITY, l_reg = 0.f; f32x16 o[2]; o[0] = f32x16{}; o[1] = f32x16{};
    f32x16 zero16 = f32x16{};
    for (int t = 0; t < NT; ++t) {
        const int buf = (t & 1) * 8192;
        if (t + 1 < NT) { DMA_K(t + 1, buf ^ 8192); DMA_V(t + 1, buf ^ 8192); asm volatile("s_waitcnt vmcnt(2)\n\ts_barrier" ::: "memory"); }
        else { asm volatile("s_waitcnt vmcnt(0)\n\ts_barrier" ::: "memory"); }
        f32x16 p0, p1;
        qkt(p0, p1, shm + AT_K + buf, qr, zero16, r32, hi);
        float rm = p0[0];
#pragma unroll
        for (int r = 1; r < 16; ++r) rm = fmaxf(rm, p0[r]);
#pragma unroll
        for (int r = 0; r < 16; ++r) rm = fmaxf(rm, p1[r]);
        rm = fmaxf(rm, __shfl_xor(rm, 32));
        const float mnew = fmaxf(mrun, rm);
        const float f = __builtin_amdgcn_exp2f(mrun - mnew);
        mrun = mnew;
        float sacc = 0.f;
#pragma unroll
        for (int r = 0; r < 16; ++r) { p0[r] = __builtin_amdgcn_exp2f(p0[r] - mnew); p1[r] = __builtin_amdgcn_exp2f(p1[r] - mnew); sacc += p0[r] + p1[r]; }
        l_reg = l_reg * f + sacc;
        if (hi == 0) wsf[r32] = f;
        asm volatile("s_waitcnt lgkmcnt(0)" ::: "memory");
#pragma unroll
        for (int r = 0; r < 16; ++r) { const float fr_ = wsf[crow(r, hi)]; o[0][r] *= fr_; o[1][r] *= fr_; }
        u32x4 pw0, pw1, pw2, pw3;
        pw0 = (u32x4){cvtpk_s(p0[0], p0[1]), cvtpk_s(p0[2], p0[3]), cvtpk_s(p0[4], p0[5]), cvtpk_s(p0[6], p0[7])};
        pw1 = (u32x4){cvtpk_s(p0[8], p0[9]), cvtpk_s(p0[10], p0[11]), cvtpk_s(p0[12], p0[13]), cvtpk_s(p0[14], p0[15])};
        pw2 = (u32x4){cvtpk_s(p1[0], p1[1]), cvtpk_s(p1[2], p1[3]), cvtpk_s(p1[4], p1[5]), cvtpk_s(p1[6], p1[7])};
        pw3 = (u32x4){cvtpk_s(p1[8], p1[9]), cvtpk_s(p1[10], p1[11]), cvtpk_s(p1[12], p1[13]), cvtpk_s(p1[14], p1[15])};
        pv(o, vb0 + buf, __builtin_bit_cast(bf16x8, pw0), __builtin_bit_cast(bf16x8, pw1), __builtin_bit_cast(bf16x8, pw2), __builtin_bit_cast(bf16x8, pw3));
        asm volatile("s_waitcnt lgkmcnt(0)\n\ts_barrier" ::: "memory");
    }
    l_reg += __shfl_xor(l_reg, 32);
    if (hi == 0) wsf[32 + r32] = l_reg;
    asm volatile("s_waitcnt lgkmcnt(0)" ::: "memory");
    float rli[16];
#pragma unroll
    for (int r = 0; r < 16; ++r) rli[r] = 1.0f / wsf[32 + crow(r, hi)];
    bf16_t* Ow = Ou + (size_t)(wid * 32) * MIXK;
    { bf16_t* stg = (bf16_t*)(shm + AT_OST) + wid * 2048;
#pragma unroll
      for (int r = 0; r < 16; ++r) { const int orow = crow(r, hi);
#pragma unroll
        for (int d0 = 0; d0 < 2; ++d0) stg[orow * 64 + d0 * 32 + r32] = (bf16_t)f2bf(o[d0][r] * rli[r]); }
      asm volatile("s_waitcnt lgkmcnt(0)" ::: "memory");
#pragma unroll
      for (int i = 0; i < 4; ++i) { const int row = i * 8 + (lane >> 3), ch = lane & 7; const u32x4 v = *(const u32x4*)(stg + row * 64 + ch * 8); *(u32x4*)(Ow + (size_t)row * MIXK + ch * 8) = v; } }
    asm volatile("s_waitcnt vmcnt(0) lgkmcnt(0)\n\ts_barrier" ::: "memory");
#undef DMA_K
#undef DMA_V
}

__device__ __forceinline__ int PADI(int i) { return i + (i >> 5); }
constexpr int FFT_TW_OFF = 69632, FFT_RED_OFF = 69632 + 32768;
template <int LOGN, int R, bool INV>
__device__ __forceinline__ void fft_pass(LAS f32x2* d, const LAS f32x2* tw, int s, int tid) {
    constexpr int N = 1 << LOGN, RR = 1 << R;
    const int lgs = LOGN - s - R; const int stride = 1 << lgs;
    constexpr float C16[8] = {1.0f, 0.9238795325112867f, 0.7071067811865476f, 0.3826834323650898f, 0.0f, -0.3826834323650898f, -0.7071067811865476f, -0.9238795325112867f};
    constexpr float S16[8] = {0.0f, 0.3826834323650898f, 0.7071067811865476f, 0.9238795325112867f, 1.0f, 0.9238795325112867f, 0.7071067811865476f, 0.3826834323650898f};
    for (int g = tid; g < (N >> R); g += 512) {
        const int lo = g & (stride - 1), hi = g >> lgs; const int base = (hi << (lgs + R)) + lo;
        f32x2 v[RR];
#pragma unroll
        for (int e = 0; e < RR; ++e) v[e] = d[PADI(base + e * stride)];
        if constexpr (R == 1) { const f32x2 a = v[0], b = v[1]; v[0] = a + b; v[1] = a - b; }
        else {
            static_assert(R == 4 || R == 1, "radix");
            f32x2 Wb[4];
            Wb[0] = tw[lo << s];
#pragma unroll
            for (int j = 1; j < 4; ++j) Wb[j] = (f32x2){Wb[j - 1].x * Wb[j - 1].x - Wb[j - 1].y * Wb[j - 1].y, 2.0f * Wb[j - 1].x * Wb[j - 1].y};
#pragma unroll
            for (int jj = 0; jj < 4; ++jj) {
                const int j = INV ? (3 - jj) : jj;
                const int he = 8 >> j;
#pragma unroll
                for (int q = 0; q < 8; ++q) if (q < he) {
                    const int k = q << j;
                    const f32x2 w = (f32x2){Wb[j].x * C16[k] + Wb[j].y * S16[k], Wb[j].y * C16[k] - Wb[j].x * S16[k]};
#pragma unroll
                    for (int e = 0; e < 16; ++e) if ((e & he) == 0 && (e & (he - 1)) == q) {
                        const f32x2 a = v[e], b = v[e + he];
                        if (!INV) { const f32x2 dl = a - b; v[e] = a + b; v[e + he] = (f32x2){dl.x * w.x - dl.y * w.y, dl.x * w.y + dl.y * w.x}; }
                        else { const f32x2 bw = (f32x2){b.x * w.x + b.y * w.y, b.y * w.x - b.x * w.y}; v[e] = a + bw; v[e + he] = a - bw; }
                    }
                }
            }
        }
#pragma unroll
        for (int e = 0; e < RR; ++e) d[PADI(base + e * stride)] = v[e];
    }
    __syncthreads();
}
template <int LOGN> __device__ __forceinline__ void fft_fwd(LAS f32x2* d, const LAS f32x2* tw, int tid) {
    if constexpr (LOGN == 13) { fft_pass<13, 4, false>(d, tw, 0, tid); fft_pass<13, 4, false>(d, tw, 4, tid); fft_pass<13, 4, false>(d, tw, 8, tid); fft_pass<13, 1, false>(d, tw, 12, tid); }
    else { fft_pass<9, 4, false>(d, tw, 0, tid); fft_pass<9, 4, false>(d, tw, 4, tid); fft_pass<9, 1, false>(d, tw, 8, tid); }
}
template <int LOGN> __device__ __forceinline__ void fft_inv(LAS f32x2* d, const LAS f32x2* tw, int tid) {
    if constexpr (LOGN == 13) { fft_pass<13, 1, true>(d, tw, 12, tid); fft_pass<13, 4, true>(d, tw, 8, tid); fft_pass<13, 4, true>(d, tw, 4, tid); fft_pass<13, 4, true>(d, tw, 0, tid); }
    else { fft_pass<9, 1, true>(d, tw, 8, tid); fft_pass<9, 4, true>(d, tw, 4, tid); fft_pass<9, 4, true>(d, tw, 0, tid); }
}
template <int LOGN> __device__ __forceinline__ void load_tw(LAS f32x2* tw, const f32x2* g, int tid) {
    for (int i = tid; i < (1 << (LOGN - 1)); i += 512) tw[i] = g[i];
}

template <int LOGN> __device__ __forceinline__ void kf_job(LAS unsigned char* lds, const float* hrawT, const f32x2* twg, f32x2* kf, int ch, int tid) {
    constexpr int N = 1 << LOGN, T = N / 2;
    LAS f32x2* d = (LAS f32x2*)lds; LAS f32x2* tw = (LAS f32x2*)(lds + FFT_TW_OFF); LAS float* red = (LAS float*)(lds + FFT_RED_OFF);
    load_tw<LOGN>(tw, twg, tid);
    float s = 0.f;
    { constexpr int NI = (N + 511) / 512; float hv[NI];
#pragma unroll
      for (int i = 0; i < NI; ++i) { const int n = tid + 512 * i; float v = 0.f;
          if (n < N) { if (n < T) v = hrawT[(size_t)ch * T + n]; else if (n > T) v = hrawT[(size_t)(256 + ch) * T + (N - n)]; }
          hv[i] = v; }
#pragma unroll
      for (int i = 0; i < NI; ++i) { const int n = tid + 512 * i; if (n < N) { d[PADI(n)] = (f32x2){hv[i], 0.f}; s += fabsf(hv[i]); } } }
    s = wave_sum(s);
    if ((tid & 63) == 0) red[tid >> 6] = s;
    __syncthreads();
    float tot = 0.f;
#pragma unroll
    for (int i = 0; i < 8; ++i) tot += red[i];
    const float inv = 1.0f / tot;
    for (int n = tid; n < N; n += 512) { f32x2 v = d[PADI(n)]; v.x *= inv; d[PADI(n)] = v; }
    __syncthreads();
    fft_fwd<LOGN>(d, tw, tid);
    for (int n = tid; n < N; n += 512) kf[(size_t)ch * N + n] = d[PADI(n)];
    __syncthreads();
}

template <int LOGN> __device__ __forceinline__ void hyena_job(LAS unsigned char* lds, const bf16_t* PTall, const f32x2* twg, const f32x2* kf, const float* wc, const float* bc, const float* hbias,
                                                            bf16_t* MIXp, int rowbase, int bp, int ch, int tid) {
    constexpr int N = 1 << LOGN, T = N / 2;
    constexpr int VEC = (T >= 4096) ? 8 : 1;
    constexpr int NKF = (N + 511) / 512;
    LAS f32x2* d = (LAS f32x2*)lds; LAS f32x2* tw = (LAS f32x2*)(lds + FFT_TW_OFF);
    load_tw<LOGN>(tw, twg, tid);
    f32x2 kfr[NKF];
#pragma unroll
    for (int i = 0; i < NKF; ++i) { const int n = tid + 512 * i; kfr[i] = (n < N) ? kf[(size_t)ch * N + n] : (f32x2){0.f, 0.f}; }
    const float w10 = wc[256 + ch], w11 = wc[768 + 256 + ch], w12 = wc[1536 + 256 + ch], b1 = bc[256 + ch];
    const float w20 = wc[512 + ch], w21 = wc[768 + 512 + ch], w22 = wc[1536 + 512 + ch], b2 = bc[512 + ch];
    const float w00 = wc[ch], w01 = wc[768 + ch], w02 = wc[1536 + ch], b0 = bc[ch];
    const float hb = hbias[ch];
    const int t0 = tid * VEC; const bool act = t0 < T;
    float raw[2][3][VEC + 2];
#pragma unroll
    for (int bb = 0; bb < 2; ++bb)
#pragma unroll
        for (int st = 0; st < 3; ++st) {
            const bf16_t* p = PTall + ((size_t)(2 * bp + bb) * 768 + st * 256 + ch) * T;
            if (act) {
                if constexpr (VEC == 8) { const u32x4 w = *(const u32x4*)(p + t0);
                    raw[bb][st][1] = bflo(w.x); raw[bb][st][2] = bfhi(w.x); raw[bb][st][3] = bflo(w.y); raw[bb][st][4] = bfhi(w.y);
                    raw[bb][st][5] = bflo(w.z); raw[bb][st][6] = bfhi(w.z); raw[bb][st][7] = bflo(w.w); raw[bb][st][8] = bfhi(w.w); }
                else raw[bb][st][1] = bf2f(p[t0]);
                raw[bb][st][0] = t0 > 0 ? bf2f(p[t0 - 1]) : 0.f;
                raw[bb][st][VEC + 1] = (t0 + VEC < T) ? bf2f(p[t0 + VEC]) : 0.f;
            } else {
#pragma unroll
                for (int i = 0; i < VEC + 2; ++i) raw[bb][st][i] = 0.f;
            }
        }
    f32x2 ukeep[VEC]; float x0k[2][VEC];
#pragma unroll
    for (int i = 0; i < VEC; ++i) {
        f32x2 u;
#pragma unroll
        for (int bb = 0; bb < 2; ++bb) {
            const float x1 = raw[bb][1][i] * w10 + raw[bb][1][i + 1] * w11 + raw[bb][1][i + 2] * w12 + b1;
            const float vv = raw[bb][2][i] * w20 + raw[bb][2][i + 1] * w21 + raw[bb][2][i + 2] * w22 + b2;
            x0k[bb][i] = raw[bb][0][i] * w00 + raw[bb][0][i + 1] * w01 + raw[bb][0][i + 2] * w02 + b0;
            if (bb == 0) u.x = x1 * vv; else u.y = x1 * vv;
        }
        ukeep[i] = u;
        if (act) { d[PADI(t0 + i)] = u; d[PADI(t0 + i + T)] = (f32x2){0.f, 0.f}; }
    }
    __syncthreads();
    fft_fwd<LOGN>(d, tw, tid);
#pragma unroll
    for (int i = 0; i < NKF; ++i) { const int n = tid + 512 * i; if (n < N) { const f32x2 a = d[PADI(n)], k = kfr[i]; d[PADI(n)] = (f32x2){a.x * k.x - a.y * k.y, a.x * k.y + a.y * k.x}; } }
    __syncthreads();
    fft_inv<LOGN>(d, tw, tid);
    const float sc = 1.0f / (float)N;
    if (act) {
#pragma unroll
        for (int i = 0; i < VEC; ++i) {
            const f32x2 y = d[PADI(t0 + i)] * sc; const f32x2 u = ukeep[i];
#pragma unroll
            for (int bb = 0; bb < 2; ++bb) {
                const float yy = bb == 0 ? y.x : y.y, uu = bb == 0 ? u.x : u.y;
                MIXp[(size_t)(rowbase + (2 * bp + bb) * T + t0 + i) * MIXK + 1024 + ch] = (bf16_t)f2bf(x0k[bb][i] * (yy + uu * hb));
            }
        }
    }
    __syncthreads();
}

__device__ __forceinline__ void norm_rows(int gw, int NGW, int lane, int nrows, const float* xl_in, const float* xc_in, float* xl_out, float* xc_out,
                                          const bf16_t* Y, const float* gpost, const float* modA, int ga_off,
                                          bf16_t* XN, const float* gpre, const float* modB, int sc_off, int sh_off) {
    constexpr int NR = 1;
    for (int row0 = gw; row0 < nrows; row0 += NR * NGW) {
        f32x4 v[NR][4]; u32x2 yw[NR][4]; bool ok[NR]; int mb[NR]; bool isc[NR]; int rowi[NR];
#pragma unroll
        for (int q = 0; q < NR; ++q) {
            const int row = row0 + q * NGW; ok[q] = row < nrows; rowi[q] = ok[q] ? row : row0;
            isc[q] = rowi[q] >= ML; mb[q] = isc[q] ? 8 : (rowi[q] >> 12);
            const float* xin = isc[q] ? xc_in + (size_t)(rowi[q] - ML) * DM : xl_in + (size_t)rowi[q] * DM;
#pragma unroll
            for (int j = 0; j < 4; ++j) v[q][j] = *(const f32x4*)(xin + 4 * lane + 256 * j);
            if (Y) {
#pragma unroll
                for (int j = 0; j < 4; ++j) yw[q][j] = *(const u32x2*)(Y + (size_t)rowi[q] * DM + 4 * lane + 256 * j);
            }
        }
        if (Y) {
            float s[NR];
#pragma unroll
            for (int q = 0; q < NR; ++q) { s[q] = 0.f;
#pragma unroll
                for (int j = 0; j < 4; ++j) { const float a = bflo(yw[q][j].x), b = bfhi(yw[q][j].x), c = bflo(yw[q][j].y), d = bfhi(yw[q][j].y); s[q] += (a * a + b * b) + (c * c + d * d); } }
#pragma unroll
            for (int o = 1; o < 64; o <<= 1) {
#pragma unroll
                for (int q = 0; q < NR; ++q) s[q] += __shfl_xor(s[q], o); }
#pragma unroll
            for (int q = 0; q < NR; ++q) {
                const float rstd = rsqrtf(s[q] * (1.0f / DM) + EPS);
                float* xo = isc[q] ? xc_out + (size_t)(rowi[q] - ML) * DM : xl_out + (size_t)rowi[q] * DM;
#pragma unroll
                for (int j = 0; j < 4; ++j) { const f32x4 g = *(const f32x4*)(gpost + 4 * lane + 256 * j); const f32x4 ga = *(const f32x4*)(modA + (size_t)mb[q] * 6144 + ga_off + 4 * lane + 256 * j);
                    const f32x4 y = (f32x4){bflo(yw[q][j].x), bfhi(yw[q][j].x), bflo(yw[q][j].y), bfhi(yw[q][j].y)};
                    v[q][j] = v[q][j] + ga * (y * rstd * g); if (ok[q]) *(f32x4*)(xo + 4 * lane + 256 * j) = v[q][j]; }
            }
        }
        if (XN) {
            float s[NR];
#pragma unroll
            for (int q = 0; q < NR; ++q) { s[q] = 0.f;
#pragma unroll
                for (int j = 0; j < 4; ++j) s[q] += (v[q][j].x * v[q][j].x + v[q][j].y * v[q][j].y) + (v[q][j].z * v[q][j].z + v[q][j].w * v[q][j].w); }
#pragma unroll
            for (int o = 1; o < 64; o <<= 1) {
#pragma unroll
                for (int q = 0; q < NR; ++q) s[q] += __shfl_xor(s[q], o); }
#pragma unroll
            for (int q = 0; q < NR; ++q) {
                const float rstd = rsqrtf(s[q] * (1.0f / DM) + EPS);
#pragma unroll
                for (int j = 0; j < 4; ++j) { const f32x4 g = *(const f32x4*)(gpre + 4 * lane + 256 * j); const f32x4 sc = *(const f32x4*)(modB + (size_t)mb[q] * 6144 + sc_off + 4 * lane + 256 * j);
                    const f32x4 sh = *(const f32x4*)(modB + (size_t)mb[q] * 6144 + sh_off + 4 * lane + 256 * j);
                    const f32x4 o = (v[q][j] * rstd * g) * (1.0f + sc) + sh; u32x2 w; w.x = pk2(o.x, o.y); w.y = pk2(o.z, o.w);
                    if (ok[q]) *(u32x2*)(XN + (size_t)rowi[q] * DM + 4 * lane + 256 * j) = w; }
            }
        }
    }
}

__device__ __forceinline__ void glu_pass(int blk, int nblk, int tid, int r0, int nrows, const bf16_t* U, bf16_t* G, const float* wc, const float* bc) {
    const int nitems = nrows / 8;
    for (int it = blk; it < nitems; it += nblk) {
        for (int p = tid; p < 8 * 352; p += 512) {
            const int rl = it * 8 + p / 352, vc = p % 352, j0 = vc * 8; const int r = r0 + rl;
            int t, len; if (r >= ML) { t = (r - ML) & (CL - 1); len = CL; } else { t = r & (SL - 1); len = SL; }
            const bool hm = t > 0, hp = t < len - 1;
            const bf16_t* ur = U + (size_t)rl * UPW + j0;
            const u32x4 z4 = (u32x4){0u, 0u, 0u, 0u};
            const u32x4 g0 = *(const u32x4*)ur, gm = hm ? *(const u32x4*)(ur - UPW) : z4, gp = hp ? *(const u32x4*)(ur + UPW) : z4;
            const u32x4 v0 = *(const u32x4*)(ur + DFF), vm = hm ? *(const u32x4*)(ur + DFF - UPW) : z4, vp = hp ? *(const u32x4*)(ur + DFF + UPW) : z4;
            unsigned outw[4];
#pragma unroll
            for (int q = 0; q < 4; ++q) {
                float res[2];
#pragma unroll
                for (int h = 0; h < 2; ++h) {
                    const int j = j0 + 2 * q + h;
                    const float a_m = h ? bfhi(gm[q]) : bflo(gm[q]), a_0 = h ? bfhi(g0[q]) : bflo(g0[q]), a_p = h ? bfhi(gp[q]) : bflo(gp[q]);
                    const float c_m = h ? bfhi(vm[q]) : bflo(vm[q]), c_0 = h ? bfhi(v0[q]) : bflo(v0[q]), c_p = h ? bfhi(vp[q]) : bflo(vp[q]);
                    const float cg = a_m * wc[j] + a_0 * wc[UPW + j] + a_p * wc[2 * UPW + j] + bc[j];
                    const float cv = c_m * wc[DFF + j] + c_0 * wc[UPW + DFF + j] + c_p * wc[2 * UPW + DFF + j] + bc[DFF + j];
                    const float sg = cg / (1.0f + __expf(-cg));
                    res[h] = sg * cv;
                }
                outw[q] = pk2(res[0], res[1]);
            }
            *(u32x4*)(G + (size_t)rl * DFF + j0) = (u32x4){outw[0], outw[1], outw[2], outw[3]};
        }
    }
}

__device__ __forceinline__ void transpose_item(const float* W, int ldw, bf16_t* WT, int ldt, int nblk, int item, LAS float* scr, int lane, bool remap = false) {
    const int kb = item / nblk, nb = item % nblk, k0 = 64 * kb, n0 = 32 * nb;
    int n0d = n0;
    if (remap) { if (n0 < DFF) n0d = 256 * (n0 >> 7) + (n0 & 127); else { const int c = n0 - DFF; n0d = 256 * (c >> 7) + 128 + (c & 127); } }
    float tv[32];
#pragma unroll
    for (int i = 0; i < 32; ++i) tv[i] = W[(size_t)(k0 + 2 * i + (lane >> 5)) * ldw + n0 + (lane & 31)];
#pragma unroll
    for (int i = 0; i < 32; ++i) scr[(2 * i + (lane >> 5)) * 33 + (lane & 31)] = tv[i];
    asm volatile("s_waitcnt lgkmcnt(0)" ::: "memory");
    const int c = lane & 7;
#pragma unroll
    for (int j = 0; j < 4; ++j) { const int n = (lane >> 3) + 8 * j; const LAS float* s = scr + (8 * c) * 33 + n;
        u32x4 o; o.x = pk2(s[0 * 33], s[1 * 33]); o.y = pk2(s[2 * 33], s[3 * 33]); o.z = pk2(s[4 * 33], s[5 * 33]); o.w = pk2(s[6 * 33], s[7 * 33]);
        *(u32x4*)(WT + (size_t)(n0d + n) * ldt + k0 + 8 * c) = o; }
    asm volatile("s_waitcnt lgkmcnt(0)" ::: "memory");
}
}

using namespace mk;
typedef const __attribute__((address_space(4))) Params* KP;
__device__ __forceinline__ KP kp_get() { KP p = (KP)__builtin_amdgcn_kernarg_segment_ptr(); asm volatile("" : "+s"(p)); return p; }
#ifndef MK_REP
#define MK_REP 0
#endif
#define REP(k) for (int rep_ = 0; rep_ < 1 + ((MK_REP >> (k)) & 1); ++rep_)
#ifndef MK_EN
#define MK_EN 0xffff
#endif
#define EN(k) if constexpr ((MK_EN >> (k)) & 1)
constexpr int LDS_BYTES = 159744;
constexpr int XCH_OFF = 131072;
constexpr int MISC_OFF = 131072 + 8192 + 18432;

#define RLX_AGENT __ATOMIC_RELAXED, __HIP_MEMORY_SCOPE_AGENT
#define XB_TMO      128
#define XB_XCNT(j)  (256  + 64 * (j))
#define XB_XSUB(j)  (1280 + 64 * (j))
#define XB_XGEN(j)  (2304 + 64 * (j))
#define XB_TOP      3328
#define XB_TOPGEN   3392
#define XCD_BAR_WORDS 3456
#define XB_SPIN_CAP (1u << 18)

__device__ __forceinline__ unsigned xb_ld(unsigned* p)              { return __hip_atomic_load(p, __ATOMIC_RELAXED, __HIP_MEMORY_SCOPE_AGENT); }
__device__ __forceinline__ unsigned xb_add(unsigned* p, unsigned v) { return __hip_atomic_fetch_add(p, v, __ATOMIC_RELAXED, __HIP_MEMORY_SCOPE_AGENT); }
__device__ __forceinline__ unsigned xb_xcc_id() { return (unsigned)__builtin_amdgcn_s_getreg((3 << 11) | 20) & 0xFu; }
#define XB_SPIN(cond, bar) do { unsigned _sp = 0; while (cond) { __builtin_amdgcn_s_sleep(1); \
    if ((++_sp & 255u) == 0u) { if (xb_ld(&(bar)[XB_TMO])) break; if (_sp > XB_SPIN_CAP) { atomicAdd(&(bar)[XB_TMO], 1u); break; } } } } while (0)

struct XcdBarrier {
    unsigned* bar; unsigned x;
    volatile LAS unsigned* st;
};

__device__ __forceinline__ XcdBarrier xcd_barrier_post(unsigned* bar, volatile LAS unsigned* st) {
    XcdBarrier b; b.bar = bar; b.x = xb_xcc_id(); b.st = st;
    if (threadIdx.x == 0) (void)xb_add(&bar[XB_XCNT(b.x)], 1u);
    return b;
}
__device__ __forceinline__ void xcd_barrier_complete(unsigned* bar, unsigned x, unsigned& nloc, unsigned& nx) {
    const unsigned G = gridDim.x * gridDim.y * gridDim.z;
    unsigned sum, cnt, mine, sp = 0u;
    for (;;) {
        sum = 0u; cnt = 0u; mine = 0u;
#pragma unroll
        for (unsigned j = 0; j < 16; ++j) { const unsigned c = xb_ld(&bar[XB_XCNT(j)]); sum += c; cnt += (c > 0u) ? 1u : 0u; mine = (j == x) ? c : mine; }
        if (sum == G) break;
        __builtin_amdgcn_s_sleep(1);
        if ((++sp & 255u) == 0u) { if (xb_ld(&bar[XB_TMO])) break; if (sp > XB_SPIN_CAP) { atomicAdd(&bar[XB_TMO], 1u); break; } }
    }
    nloc = mine > 0u ? mine : 1u; nx = cnt > 0u ? cnt : 1u;
}

__device__ __forceinline__ void xcd_barrier(const XcdBarrier& b) {
    asm volatile("s_waitcnt vmcnt(0)" ::: "memory");
    __syncthreads();
    if (threadIdx.x == 0) {
        unsigned* bar = b.bar;
        __builtin_amdgcn_s_waitcnt(0);
        unsigned nloc = b.st[0], nx = b.st[1];
        if (nloc == 0u) { xcd_barrier_complete(bar, b.x, nloc, nx); b.st[0] = nloc; b.st[1] = nx; }
        const unsigned old = xb_add(&bar[XB_XSUB(b.x)], 1u);
        const unsigned gen = old / nloc;
        if (old + 1u == (gen + 1u) * nloc) {
            __builtin_amdgcn_fence(__ATOMIC_RELEASE, "agent");
            asm volatile("s_waitcnt vmcnt(0)" ::: "memory");
            const unsigned og = xb_add(&bar[XB_TOP], 1u);
            const unsigned tg = og / nx;
            if (og + 1u == (tg + 1u) * nx) xb_add(&bar[XB_TOPGEN], 1u);
            else XB_SPIN(xb_ld(&bar[XB_TOPGEN]) == tg, bar);
            __builtin_amdgcn_fence(__ATOMIC_ACQUIRE, "agent");
            xb_add(&bar[XB_XGEN(b.x)], 1u);
            asm volatile("s_waitcnt vmcnt(0)" ::: "memory");
        } else {
            XB_SPIN(xb_ld(&bar[XB_XGEN(b.x)]) == gen, bar);
            __builtin_amdgcn_fence(__ATOMIC_ACQUIRE, "agent");
            asm volatile("s_waitcnt vmcnt(0)" ::: "memory");
        }
    }
    __syncthreads();
}

__device__ __forceinline__ bf16_t* wlayer(unsigned char* ws, int l, size_t off) { return (bf16_t*)(ws + WS_W + (size_t)l * W_LAYER + off); }
constexpr size_t OFF_WIN = 0, OFF_WOUT = 4 * MiB, OFF_WUP = 7 * MiB, OFF_WDOWN = 18 * MiB;

__device__ __forceinline__ void setup0(KP pp, LAS unsigned char* lds, int tid, int lane, int wave) {
    unsigned char* ws = pp->ws;
    {
        LAS float* scr = (LAS float*)(lds + wave * 16384);
        const int gw = blockIdx.x * 8 + wave, NGW = gridDim.x * 8;
        constexpr int I_IN = 16 * 56, I_UP = 16 * 176, I_DN = 44 * 32, I_OA = 8 * 32, I_OH = 4 * 32, I_L = I_IN + I_UP + I_DN + I_OA + I_OH;
        for (int it = gw; it < 2 * I_L; it += NGW) {
            const int l = it / I_L; int r = it % I_L;
            if (r < I_IN) { transpose_item(pp->in[I_WIN] + (size_t)l * DM * INW, INW, wlayer(ws, l, OFF_WIN), DM, 56, r, scr, lane); continue; } r -= I_IN;
            if (r < I_UP) { transpose_item(pp->in[I_WUP] + (size_t)l * DM * UPW, UPW, wlayer(ws, l, OFF_WUP), DM, 176, r, scr, lane, true); continue; } r -= I_UP;
            if (r < I_DN) { transpose_item(pp->in[I_WDOWN] + (size_t)l * DFF * DM, DM, wlayer(ws, l, OFF_WDOWN), DFF, 32, r, scr, lane); continue; } r -= I_DN;
            if (r < I_OA) { transpose_item(pp->in[I_WOUT] + (size_t)l * DM * DM, DM, wlayer(ws, l, OFF_WOUT), MIXK, 32, r, scr, lane); continue; } r -= I_OA;
            transpose_item(pp->in[I_WOUT] + (size_t)l * DM * DM + (size_t)768 * DM, DM, wlayer(ws, l, OFF_WOUT) + 1024, MIXK, 32, r, scr, lane);
        }
    }
    __syncthreads();
    constexpr int N_MOD = 192, N_MLP = 512 + 32 + 512, N_DFT = 4096 + 256, N_T = 512, N_TAB = 1;
    constexpr int NIT = N_MOD + N_MLP + N_DFT + N_T + N_TAB;
    LAS float* fl = (LAS float*)lds; bool tab_ready = false;
    for (int it = blockIdx.x; it < NIT; it += gridDim.x) {
        int r = it;
        if (r < N_MOD) {
            const int l = r / 96, cb = (r % 96) / 8, kc = r % 8;
            for (int idx = tid; idx < 9 * 128; idx += 512) { const int rr = idx / 128, k = idx % 128; const float cv = rr < 8 ? pp->in[I_C][rr * DM + kc * 128 + k] : pp->in[I_CCTX][kc * 128 + k];
                fl[idx] = cv / (1.0f + __expf(-cv)); }
            __syncthreads();
            const int j = cb * 512 + tid; float acc[9];
#pragma unroll
            for (int rr = 0; rr < 9; ++rr) acc[rr] = 0.f;
            const float* wm = pp->in[I_WMOD] + (size_t)l * DM * 6144 + (size_t)(kc * 128) * 6144 + j;
#pragma unroll 16
            for (int k = 0; k < 128; ++k) { const float w = wm[(size_t)k * 6144];
#pragma unroll
                for (int rr = 0; rr < 9; ++rr) acc[rr] += fl[rr * 128 + k] * w; }
            float* mp = (float*)(ws + WS_MODP) + ((size_t)(l * 8 + kc) * 9) * 6144 + j;
#pragma unroll
            for (int rr = 0; rr < 9; ++rr) mp[(size_t)rr * 6144] = acc[rr];
            __syncthreads();
            continue;
        }
        r -= N_MOD;
        if (r < N_MLP) {
            int l, which, t0;
            if (r < 512) { l = 0; which = 0; t0 = r * 8; } else if (r < 544) { l = 0; which = 1; t0 = (r - 512) * 8; } else { l = 1; which = 0; t0 = (r - 544) * 8; }
            const int T = which ? CL : SL;
            LAS float* Z = fl; LAS float* H1 = fl + 8 * 36; LAS float* H2 = H1 + 512;
            if (tid < 128) { const int p = tid >> 4, i = tid & 15; const int t = t0 + p; const float band = 1e-4f + (float)i * ((15.0f - 1e-4f) / 15.0f);
                const float ang = ((6.2831855f * (float)t) / (float)T) * band; Z[p * 36 + 1 + i] = cosf(ang); Z[p * 36 + 17 + i] = -sinf(ang);
                if (i == 0) Z[p * 36] = (float)t / (float)(T - 1); }
            __syncthreads();
            { const int p = tid >> 6, j = tid & 63; const float* w1 = pp->in[I_HW1] + (size_t)l * 33 * 64; float s = pp->in[I_HB1][l * 64 + j];
              float wr_[33];
#pragma unroll
              for (int i = 0; i < 33; ++i) wr_[i] = w1[i * 64 + j];
#pragma unroll
              for (int i = 0; i < 33; ++i) s += Z[p * 36 + i] * wr_[i];
              H1[p * 64 + j] = sinf(pp->in[I_HFR1][l * 64 + j] * s); }
            __syncthreads();
            { const int p = tid >> 6, j = tid & 63; const float* w2 = pp->in[I_HW2] + (size_t)l * 64 * 64; float s = pp->in[I_HB2][l * 64 + j];
              float wr_[64];
#pragma unroll
              for (int i = 0; i < 64; ++i) wr_[i] = w2[i * 64 + j];
#pragma unroll
              for (int i = 0; i < 64; ++i) s += H1[p * 64 + i] * wr_[i];
              H2[p * 64 + j] = sinf(pp->in[I_HFR2][l * 64 + j] * s); }
            __syncthreads();
            { const int j = tid; const float* w3 = pp->in[I_HW3] + (size_t)l * 64 * 512 + j; float acc[8];
#pragma unroll
              for (int p = 0; p < 8; ++p) acc[p] = 0.f;
              float wr_[64];
#pragma unroll
              for (int i = 0; i < 64; ++i) wr_[i] = w3[(size_t)i * 512];
#pragma unroll
              for (int i = 0; i < 64; ++i) {
#pragma unroll
                  for (int p = 0; p < 8; ++p) acc[p] += H2[p * 64 + i] * wr_[i]; }
              const float da = -3.0701134573253944f, db = -15.350567286626972f;
              const float delta = fabsf(da + (float)(j & 255) * ((db - da) / 255.0f));
              float* hr = (float*)(ws + WS_HRAW) + (which ? (size_t)2 * 512 * SL : (size_t)l * 512 * SL) + (size_t)j * T + t0;
#pragma unroll
              for (int p = 0; p < 8; ++p) hr[p] = acc[p] * expf(-Z[p * 36] * delta); }
            __syncthreads();
            continue;
        }
        r -= N_MLP;
        if (r < N_DFT) {
            LAS float* ctab = (LAS float*)(lds + 65536);
            if (!tab_ready) { for (int q = tid; q < 4096; q += 512) ctab[q] = cospif((float)q * (1.0f / 2048.0f)) * (1.0f / 512.0f); tab_ready = true; __syncthreads(); }
            if (r < 4096) { bf16_t* row = (bf16_t*)(ws + WS_ADFT) + (size_t)r * 4096; const bool isS = r > 2048; const int k = isS ? r - 2048 : r; const int sh = isS ? 3072 : 0;
                for (int t = tid * 2; t < 4096; t += 1024) { const float v0 = ctab[((k * t) + sh) & 4095], v1 = ctab[((k * (t + 1)) + sh) & 4095]; *(unsigned*)(row + t) = pk2(v0, v1); } }
            else { const int rr = r - 4096; bf16_t* row = (bf16_t*)(ws + WS_ADFTC) + (size_t)rr * 256; const bool isS = rr > 128; const int k = isS ? rr - 128 : rr; const int sh = isS ? 3072 : 0;
                if (tid < 256) { const float v = ctab[(((k * tid) & 255) * 16 + sh) & 4095] * 4.0f; row[tid] = (bf16_t)f2bf(v); } }
            continue;
        }
        r -= N_DFT;
        if (r < N_T) {
            LAS float* ctab = (LAS float*)(lds + 65536);
            if (!tab_ready) { for (int q = tid; q < 4096; q += 512) ctab[q] = cospif((float)q * (1.0f / 2048.0f)) * (1.0f / 512.0f); tab_ready = true; __syncthreads(); }
            const int rr2 = 2 * r + (tid >> 8); const int l = rr2 >> 9, kk = rr2 & 511; const bool isS = kk >= 256; const int gc = kk & 255, g = gc >> 6, c = gc & 63; const int j = tid & 255;
            const float* wf = pp->in[I_WF] + (size_t)l * 256 * 256 + (size_t)(g * 64) * 256 + j; float s = 0.f;
#pragma unroll 16
            for (int m = 0; m < 64; ++m) { const int q = ((m * c) & 63) * 64; const float tr = isS ? -ctab[(q + 3072) & 4095] : ctab[q]; s += tr * wf[(size_t)m * 256]; }
            ((float*)(ws + WS_T))[((size_t)l * 512 + kk) * 256 + j] = s * 512.0f;
            continue;
        }
        { f32x2* tw = (f32x2*)(ws + WS_TW);
          for (int i = tid; i < 4096; i += 512) { const float x = (float)i * (1.0f / 4096.0f); tw[i] = (f32x2){cospif(x), -sinpif(x)}; }
          f32x2* tw2 = (f32x2*)(ws + WS_TW + 65536);
          if (tid < 256) { const float x = (float)tid * (1.0f / 256.0f); tw2[tid] = (f32x2){cospif(x), -sinpif(x)}; }
          float* rope = (float*)(ws + WS_TW + 131072);
          for (int i = tid; i < 1024; i += 512) { const int p = i >> 4, q = i & 15; const float inv = powf(10000.0f, -(float)q / 16.0f); const float a = (float)p * inv; rope[i] = cosf(a); rope[1024 + i] = sinf(a); } }
    }
}

__device__ __forceinline__ void setup1(KP pp, LAS unsigned char* lds, int tid) {
    unsigned char* ws = pp->ws;
    { const int gt = blockIdx.x * 512 + tid, NGT = gridDim.x * 512;
      for (int idx = gt; idx < 2 * 9 * 6144; idx += NGT) { const int l = idx / (9 * 6144), rj = idx % (9 * 6144), j = rj % 6144; float s = pp->in[I_BMOD][l * 6144 + j];
#pragma unroll
          for (int kc = 0; kc < 8; ++kc) s += ((const float*)(ws + WS_MODP))[((size_t)(l * 8 + kc) * 9) * 6144 + rj];
          ((float*)(ws + WS_MOD))[idx] = s; } }
    constexpr int N_KF = 768, N_W2 = 256;
    LAS float* fl = (LAS float*)lds;
    for (int it = blockIdx.x; it < N_KF + N_W2; it += gridDim.x) {
        if (it < N_KF) {
            if (it < 512) { const int l = it >> 8, ch = it & 255;
                kf_job<13>(lds, (const float*)(ws + WS_HRAW) + (size_t)l * 512 * SL, (const f32x2*)(ws + WS_TW), (f32x2*)(ws + WS_KF) + (size_t)l * 256 * 8192, ch, tid); }
            else { const int ch = it - 512;
                kf_job<9>(lds, (const float*)(ws + WS_HRAW) + (size_t)2 * 512 * SL, (const f32x2*)(ws + WS_TW + 65536), (f32x2*)(ws + WS_KFC), ch, tid); }
            continue;
        }
        const int r = it - N_KF; const int l = r >> 7, nh = (r >> 6) & 1, kb = r & 63;
        for (int idx = tid; idx < 8 * 256; idx += 512) fl[idx] = ((const float*)(ws + WS_T))[((size_t)l * 512 + 8 * kb) * 256 + idx];
        __syncthreads();
        { const int n = nh * 512 + tid; const float* wo = pp->in[I_WOUT] + (size_t)l * DM * DM + (size_t)512 * DM + n; float s[8];
#pragma unroll
          for (int q = 0; q < 8; ++q) s[q] = 0.f;
#pragma unroll 8
          for (int j = 0; j < 256; ++j) { const float w = wo[(size_t)j * DM];
#pragma unroll
              for (int q = 0; q < 8; ++q) s[q] += fl[q * 256 + j] * w; }
          bf16_t* dst = wlayer(ws, l, OFF_WOUT) + (size_t)n * MIXK + 512 + 8 * kb;
          u32x4 o; o.x = pk2(s[0], s[1]); o.y = pk2(s[2], s[3]); o.z = pk2(s[4], s[5]); o.w = pk2(s[6], s[7]);
          *(u32x4*)dst = o; }
        __syncthreads();
    }
}

__global__ void __launch_bounds__(512, 2) mega_fwd(Params P) {
    extern __shared__ __attribute__((aligned(16))) unsigned char lds_raw[];
    LAS unsigned char* lds = (LAS unsigned char*)lds_raw;
    { volatile LAS unsigned* m0 = (volatile LAS unsigned*)(lds + MISC_OFF); if (threadIdx.x < 32) m0[threadIdx.x] = 0u; }
    __syncthreads();
    XcdBarrier xbar;
    { KP pb = kp_get(); xbar = xcd_barrier_post((unsigned*)(pb->ws + WS_CTL) + 4096, (volatile LAS unsigned*)(lds + MISC_OFF) + 8);
      if (pb->ph_lo < 0) cg::this_grid().sync(); }
    int ph = 0;
#define PH_BEGIN { KP pp = kp_get(); const int lo = pp->ph_lo, hi = pp->ph_hi; if (ph >= lo && ph < hi) { unsigned char* ws = pp->ws; const int tid = mk_tid(), lane = tid & 63, wave = __builtin_amdgcn_readfirstlane(tid >> 6); const int G = gridDim.x, gw = blockIdx.x * 8 + wave, NGW = G * 8; (void)lane; (void)gw; (void)NGW; PTRS
#define PH_END   if (ph + 1 < hi) xcd_barrier(xbar); } } ++ph;
#define PTRS \
    bf16_t* XN = (bf16_t*)(ws + WS_XN); bf16_t* Qb = (bf16_t*)(ws + WS_Q); bf16_t* Kb = (bf16_t*)(ws + WS_K); bf16_t* Vb = (bf16_t*)(ws + WS_V); \
    bf16_t* fT = (bf16_t*)(ws + WS_FT); bf16_t* fTc = (bf16_t*)(ws + WS_FTC); bf16_t* PT = (bf16_t*)(ws + WS_PT); bf16_t* PTc = (bf16_t*)(ws + WS_PTC); \
    bf16_t* MIXb = (bf16_t*)(ws + WS_MIX); bf16_t* Ub = (bf16_t*)(ws + WS_U); bf16_t* Gb = (bf16_t*)(ws + WS_G); \
    float* CX = (float*)(ws + WS_CX); const float* MOD = (const float*)(ws + WS_MOD); \
    const float* rope = (const float*)(ws + WS_TW + 131072); \
    volatile LAS int* misc = (volatile LAS int*)(lds + MISC_OFF); \
    (void)XN; (void)Qb; (void)Kb; (void)Vb; (void)fT; (void)fTc; (void)PT; (void)PTc; (void)MIXb; (void)Ub; (void)Gb; (void)CX; (void)MOD; (void)rope; (void)misc;

    REP(6) { PH_BEGIN EN(0) setup0(pp, lds, tid, lane, wave); PH_END --ph; } ++ph;
    REP(8) { PH_BEGIN EN(1) setup1(pp, lds, tid); PH_END --ph; } ++ph;
    PH_BEGIN REP(9) EN(2) norm_rows(gw, NGW, lane, MT, pp->in[I_X], pp->in[I_CTX], nullptr, nullptr, nullptr, nullptr, nullptr, 0, XN, pp->in[I_GPREMIX], MOD, 1024, 0); PH_END

    for (int l = 0; l < 2; ++l) {
        const bool last = (l == 1);
        const int MR = last ? ML : MT;
        PH_BEGIN {
            pg8::Gemm g{XN, wlayer(ws, l, OFF_WIN), MT, INW, DM}; pg8::StaticOrder S; S.init(MT, INW, G, (int)blockIdx.x);
            EpiInProj E{Qb, Kb, Vb, fT, fTc, PT, PTc, pp->in[I_GQ] + l * 64, pp->in[I_GK] + l * 64, rope, (LAS float*)(lds + XCH_OFF)};
            REP(0) EN(3) pg8::gemm_phase<EpiInProj, pg8::StaticOrder, true, true>(lds, g, S, E);
        } PH_END
        PH_BEGIN {
            const int nF = last ? 128 : 136, nA = last ? 1024 : 1088, nH1 = last ? 1024 : 2048, nH = nH1 * (1 + ((MK_REP >> 7) & 1));
            for (;;) {
                KP pq = kp_get(); unsigned char* wq = pq->ws; const int tq = mk_tid();
                if (tq == 0) misc[0] = (int)atomicAdd((unsigned*)(wq + WS_CTL) + 64 * (1 + l), 1u);
                __syncthreads();
                int it = misc[0];
                __syncthreads();
                if (it >= nF + nA + nH) break;
                bf16_t* MIXq = (bf16_t*)(wq + WS_MIX);
                if (it < nF) {
                    if (it < 128) { pg8::Gemm g{(const bf16_t*)(wq + WS_ADFT), (const bf16_t*)(wq + WS_FT), 4096, 2048, 4096}; OneUnit S{it >> 3, it & 7}; EpiFourier E{MIXq, 2048, 0, SL};
                        REP(3) EN(4) pg8::gemm_phase<EpiFourier, OneUnit, false, true>(lds, g, S, E); }
                    else { pg8::Gemm g{(const bf16_t*)(wq + WS_ADFTC), (const bf16_t*)(wq + WS_FTC), 256, 2048, 256}; OneUnit S{0, it - 128}; EpiFourier E{MIXq, 128, ML, CL};
                        REP(3) EN(4) pg8::gemm_phase<EpiFourier, OneUnit, false, true>(lds, g, S, E); }
                    continue;
                }
                it -= nF;
                if (it < nA) {
                    const bf16_t* Qq = (const bf16_t*)(wq + WS_Q); const bf16_t* Kq = (const bf16_t*)(wq + WS_K); const bf16_t* Vq = (const bf16_t*)(wq + WS_V);
                    int b, h, NT; size_t qrow;
                    if (it < 1024) { b = it >> 7; h = (it >> 4) & 7; qrow = (size_t)b * SL + (it & 15) * 256; NT = KVB / 64; }
                    else { const int r = it - 1024; b = r >> 3; h = r & 7; qrow = (size_t)ML + b * CL; NT = CL / 64; }
                    const size_t kv0 = (size_t)b * KVB;
                    REP(1) EN(5) attn_body::attn_unit2<8>((const attn_body::bf16*)(Qq + qrow * QP + h * 64), (const attn_body::bf16*)(Kq + kv0 * KVP + (h >> 2) * 64), (const attn_body::bf16*)(Vq + kv0 * KVP + (h >> 2) * 64), (attn_body::bf16*)(MIXq + qrow * MIXK + h * 64), NT, (char*)lds_raw);
                    continue;
                }
                it -= nA; if (it >= nH1) it -= nH1;
                const float* wc = pq->in[I_WHC] + (size_t)l * 3 * 768; const float* bc = pq->in[I_BHC] + (size_t)l * 768; const float* hb = pq->in[I_HBIAS] + (size_t)l * 256;
                REP(2) EN(6) { if (it < 1024) hyena_job<13>(lds, (const bf16_t*)(wq + WS_PT), (const f32x2*)(wq + WS_TW), (const f32x2*)(wq + WS_KF) + (size_t)l * 256 * 8192, wc, bc, hb, MIXq, 0, it >> 8, it & 255, tq);
                else { const int r = it - 1024; hyena_job<9>(lds, (const bf16_t*)(wq + WS_PTC), (const f32x2*)(wq + WS_TW + 65536), (const f32x2*)(wq + WS_KFC), wc, bc, hb, MIXq, ML, r >> 8, r & 255, tq); } }
            }
        } PH_END
        PH_BEGIN {
            pg8::Gemm g{MIXb, wlayer(ws, l, OFF_WOUT), MR, DM, MIXK}; pg8::StaticOrder S; S.init(MR, DM, G, (int)blockIdx.x);
            EpiPlain E{XN, DM};
            REP(5) EN(7) pg8::gemm_phase<EpiPlain, pg8::StaticOrder, true, true>(lds, g, S, E);
        } PH_END
        PH_BEGIN EN(2) norm_rows(gw, NGW, lane, MR, l == 0 ? pp->in[I_X] : pp->out, l == 0 ? pp->in[I_CTX] : CX, pp->out, CX, XN, pp->in[I_GPOSTMIX] + l * DM, (MOD + (size_t)l * 9 * 6144), 2048,
                           XN, pp->in[I_GPREFFN] + l * DM, (MOD + (size_t)l * 9 * 6144), 4096, 3072); PH_END
        PH_BEGIN {
            pg8::Gemm g{XN, wlayer(ws, l, OFF_WUP), MR, UPW, DM}; pg8::StaticOrder S; S.init(MR, UPW, G, (int)blockIdx.x);
            EpiGlu E{Gb, (bf16_t*)(ws + WS_SB), pp->in[I_WFC] + (size_t)l * 3 * UPW, pp->in[I_BFC] + (size_t)l * UPW, (LAS float*)(lds + XCH_OFF)};
            REP(4) EN(8) pg8::gemm_phase<EpiGlu, pg8::StaticOrder, true, true>(lds, g, S, E);
        } PH_END
        PH_BEGIN EN(9) glu_fixup((int)blockIdx.x, G, tid, MR / 256, (const bf16_t*)(ws + WS_SB), Gb, pp->in[I_WFC] + (size_t)l * 3 * UPW, pp->in[I_BFC] + (size_t)l * UPW); PH_END
        PH_BEGIN {
            pg8::Gemm g{Gb, wlayer(ws, l, OFF_WDOWN), MR, DM, DFF}; pg8::StaticOrder S; S.init(MR, DM, G, (int)blockIdx.x);
            EpiPlain E{XN, DM};
            REP(4) EN(10) pg8::gemm_phase<EpiPlain, pg8::StaticOrder, true, true>(lds, g, S, E);
        } PH_END
        PH_BEGIN EN(2) norm_rows(gw, NGW, lane, MR, pp->out, CX, pp->out, CX, XN, pp->in[I_GPOSTFFN] + l * DM, (MOD + (size_t)l * 9 * 6144), 5120,
                           last ? nullptr : XN, pp->in[I_GPREMIX] + (last ? 0 : (l + 1) * DM), MOD + (size_t)(last ? 0 : (l + 1)) * 9 * 6144, 1024, 0); PH_END
    }
}

constexpr int N_PHASES = 3 + 2 * 8;
#ifndef MK_MULTI
#define MK_MULTI 0
#endif
extern "C" void kernel_launch(void* const* d_in, const int* in_sizes, int n_in, void* d_out, int out_size, void* d_ws, size_t ws_size, hipStream_t stream) {
    static int grid = 0;
    if (grid == 0) {
        if (n_in != 29 || ws_size < WS_END) { fprintf(stderr, "kernel_launch: bad args n_in %d ws %zu (need %zu)\n", n_in, ws_size, (size_t)WS_END); grid = -1; return; }
        int dev = 0, cus = 0, per_cu = 0;
        hipGetDevice(&dev); hipDeviceGetAttribute(&cus, hipDeviceAttributeMultiprocessorCount, dev);
        if (hipFuncSetAttribute((const void*)mega_fwd, hipFuncAttributeMaxDynamicSharedMemorySize, LDS_BYTES) != hipSuccess) { fprintf(stderr, "hipFuncSetAttribute failed\n"); grid = -1; return; }
        if (hipOccupancyMaxActiveBlocksPerMultiprocessor(&per_cu, (const void*)mega_fwd, 512, LDS_BYTES) != hipSuccess || per_cu < 1) { fprintf(stderr, "occupancy query: %d\n", per_cu); per_cu = 1; }
        (void)hipGetLastError();
        grid = cus * 1;
    }
    if (grid < 0) return;
    hipMemsetAsync((char*)d_ws + WS_CTL, 0, 1 * MiB, stream);
    Params p{};
    for (int i = 0; i < 29; ++i) p.in[i] = (const float*)d_in[i];
    p.out = (float*)d_out; p.ws = (unsigned char*)d_ws;
#if MK_MULTI
    for (int k = 0; k < N_PHASES; ++k) { p.ph_lo = k; p.ph_hi = k + 1; hipLaunchKernelGGL(mega_fwd, dim3(grid), dim3(512), LDS_BYTES, stream, p); }
#else
    p.ph_lo = 0; p.ph_hi = N_PHASES;
    void* args[] = {&p};
    hipError_t e = hipLaunchCooperativeKernel((const void*)mega_fwd, dim3(grid), dim3(512), args, LDS_BYTES, stream);
    if (e != hipSuccess) fprintf(stderr, "cooperative launch failed: %s (grid %d)\n", hipGetErrorString(e), grid);
#endif
}
```

```cpp
#define MK_REP 0
#define MK_TMASK 0
#include <hip/hip_runtime.h>
#include <hip/hip_cooperative_groups.h>
#include <hip/hip_bf16.h>
#include <cstdio>
#include <cstdint>
#include <cmath>
namespace cg = cooperative_groups;
__device__ __forceinline__ int mk_tid() { int t = threadIdx.x; asm volatile("" : "+v"(t)); return t; }
namespace pg8 {
#define PG8_LAS __attribute__((address_space(3)))
typedef unsigned short bf16_t;
typedef short bf16x8 __attribute__((ext_vector_type(8)));
typedef float f32x4 __attribute__((ext_vector_type(4)));
typedef unsigned u32x4 __attribute__((ext_vector_type(4)));
constexpr int BM = 256, BK = 64, HALF = 128, HTB = HALF * BK * 2  , STAGE_BYTES = 8 * HTB, NXCD = 8, WGM = 8;

__host__ __device__ __forceinline__ int lds_byte(int r, int c) { const int st = (r >> 4) * 2 + (c >> 5), rr = r & 15, cc = c & 31, ob = rr * 64 + cc * 2; return st * 1024 + (ob ^ (((ob >> 9) & 1) << 5)); }
__host__ __device__ __forceinline__ void stage_rc(int b, int& R, int& C) { const int st = b / 1024, sb = b % 1024, swz = sb ^ (((sb >> 9) & 1) << 5); R = (st >> 1) * 16 + swz / 64; C = (st & 1) * 32 + (swz % 64) / 2; }
__host__ __device__ __forceinline__ int perm32(int rho) { const int n = rho >> 4, i = rho & 15; return 8 * (i >> 2) + 4 * n + (i & 3); }

struct Unit { int pm, pn; };
struct Gemm { const bf16_t* A; const bf16_t* Bt; int M, N, K; };

struct StaticOrder {
    int nM, nN, nwg, G, c;
    __host__ __device__ void init(int M, int N, int G_, int c_) { nM = M / BM; nN = N / BM; nwg = nM * nN; G = G_; c = c_; }
    __host__ __device__ bool next(int i, Unit& u) const {
        const long L = (long)i * G + c; if (L >= nwg) return false;
        int wgid = (int)L; { const int q = nwg / NXCD, r = nwg % NXCD, xcd = wgid % NXCD, off = wgid / NXCD; wgid = (xcd < r ? xcd * (q + 1) : r * (q + 1) + (xcd - r) * q) + off; }
        const int nig = WGM * nN, gid = wgid / nig, fm = gid * WGM, gsz = (nM - fm) < WGM ? (nM - fm) : WGM;
        u.pm = fm + ((wgid % nig) % gsz); u.pn = (wgid % nig) / gsz; return true;
    }
    __device__ __forceinline__ void a_ready(const Unit&) const {}
    __device__ __forceinline__ void done(const Unit&) const {}
};
__device__ __forceinline__ unsigned cvt_pk_bf16(float lo, float hi) { unsigned r; asm volatile("v_cvt_pk_bf16_f32 %0, %1, %2" : "=v"(r) : "v"(lo), "v"(hi)); return r; }
typedef float f32x2 __attribute__((ext_vector_type(2)));
template <class Epi, class Sched, bool ALIGN_EPI = false, bool SP2 = false>
__device__ __forceinline__ void gemm_phase(PG8_LAS unsigned char* lds, const Gemm g, const Sched& S, const Epi& E) {
    const int tid = mk_tid(), wid = __builtin_amdgcn_readfirstlane(tid >> 6), lane = tid & 63, wr = wid >> 2, wc = wid & 3, fr = lane & 15, fq = lane >> 4;
    const int K = g.K, nt = K / BK;
    unsigned voffA[2], voffB[2];
#pragma unroll
    for (int i = 0; i < 2; ++i) { int R, C; stage_rc(tid * 16 + i * 8192, R, C); const int Rb = Epi::PERM ? ((R & ~31) + perm32(R & 31)) : R;
        const int Ra = Epi::APERM ? ((R & ~63) + 4 * (R & 15) + ((R >> 4) & 3)) : R;
        voffA[i] = (unsigned)(Ra * K + C) * 2u; voffB[i] = (unsigned)(Rb * K + C) * 2u; }
    const size_t kstep = (size_t)(BK * 2);
    const size_t hstep = (size_t)HALF * K * 2;
    const size_t tstep = 2 * hstep;
    const unsigned ldsw = (unsigned)wid * 1024u;
    const int aoff = lds_byte(wr * 64 + fr, fq * 8), boff = lds_byte(wc * 32 + fr, fq * 8);
#define PG8_SA(b, h) (((b) * 2 + (h)) * HTB)
#define PG8_SB(b, h) ((4 + (b) * 2 + (h)) * HTB)
#define PG8_STAGE(bufoff, gbase, voff) do { _Pragma("unroll") for (int _i = 0; _i < 2; ++_i) \
        __builtin_amdgcn_global_load_lds((const unsigned*)((const char*)(gbase) + (voff)[_i]), (PG8_LAS unsigned*)(lds + (bufoff) + ldsw + _i * 8192), 16, 0, 0); } while (0)
#define PG8_LDA(dst, b, h) do { _Pragma("unroll") for (int m = 0; m < 4; ++m) _Pragma("unroll") for (int k = 0; k < 2; ++k) dst[m][k] = *(const PG8_LAS bf16x8*)(lds + PG8_SA(b, h) + aoff + m * 2048 + k * 1024); } while (0)
#define PG8_LDB(dst, b, h) do { _Pragma("unroll") for (int n = 0; n < 2; ++n) _Pragma("unroll") for (int k = 0; k < 2; ++k) dst[n][k] = *(const PG8_LAS bf16x8*)(lds + PG8_SB(b, h) + boff + n * 2048 + k * 1024); } while (0)
#define PG8_MMA(ai, bj, At, Bt) do { __builtin_amdgcn_s_setprio(1); _Pragma("unroll") for (int m = 0; m < 4; ++m) _Pragma("unroll") for (int n = 0; n < 2; ++n) _Pragma("unroll") for (int k = 0; k < 2; ++k) \
        acc[ai][bj][m][n] = __builtin_amdgcn_mfma_f32_16x16x32_bf16(Bt[n][k], At[m][k], acc[ai][bj][m][n], 0, 0, 0); __builtin_amdgcn_s_setprio(0); } while (0)
#define PG8_WAIT_V(n) asm volatile("s_waitcnt vmcnt(" #n ")" ::: "memory")
#define PG8_WAIT_L(n) asm volatile("s_waitcnt lgkmcnt(" #n ")" ::: "memory")
#define PG8_BAR __builtin_amdgcn_s_barrier()
#define PG8_SCHED __builtin_amdgcn_sched_barrier(0)
    Unit cur, nxt; int ui = 0;
    if (!S.next(0, cur)) return;
    f32x4 acc[2][2][4][2];
#pragma unroll
    for (int a = 0; a < 2; ++a)
#pragma unroll
        for (int b = 0; b < 2; ++b)
#pragma unroll
            for (int m = 0; m < 4; ++m)
#pragma unroll
                for (int n = 0; n < 2; ++n) acc[a][b][m][n] = (f32x4){0.f, 0.f, 0.f, 0.f};
    bf16x8 At[4][2], B0[2][2], B1[2][2];
    const char* cA = (const char*)g.A + (size_t)cur.pm * tstep; const char* cB = (const char*)g.Bt + (size_t)cur.pn * tstep;
    S.a_ready(cur);
    if constexpr (SP2) {
        PG8_STAGE(PG8_SB(0, 0), cB, voffB); PG8_STAGE(PG8_SB(0, 1), cB + hstep, voffB); PG8_STAGE(PG8_SA(0, 0), cA, voffA); PG8_STAGE(PG8_SA(0, 1), cA + hstep, voffA);
        if (wr == 1) PG8_BAR;
        PG8_WAIT_V(2); PG8_BAR;
        PG8_STAGE(PG8_SB(1, 0), cB + kstep, voffB); PG8_STAGE(PG8_SA(1, 0), cA + kstep, voffA); PG8_STAGE(PG8_SB(1, 1), cB + hstep + kstep, voffB);
        PG8_WAIT_V(6); PG8_BAR;
    } else {
        PG8_STAGE(PG8_SB(0, 0), cB, voffB); PG8_STAGE(PG8_SA(0, 0), cA, voffA); PG8_STAGE(PG8_SB(0, 1), cB + hstep, voffB); PG8_STAGE(PG8_SA(0, 1), cA + hstep, voffA);
        if (wr == 1) PG8_BAR;
        PG8_WAIT_V(4); PG8_BAR;
        PG8_STAGE(PG8_SB(1, 0), cB + kstep, voffB); PG8_STAGE(PG8_SA(1, 0), cA + kstep, voffA); PG8_STAGE(PG8_SB(1, 1), cB + hstep + kstep, voffB);
        PG8_WAIT_V(6); PG8_BAR;
    }
    for (;;) {
        const bool has_next = S.next(ui + 1, nxt);
        const char* nA = has_next ? (const char*)g.A + (size_t)nxt.pm * tstep : cA; const char* nB = has_next ? (const char*)g.Bt + (size_t)nxt.pn * tstep : cB;
        for (int t = 0; t < nt; t += 2) {
            const bool last = (t == nt - 2);
            const char* a1 = cA + (size_t)(t + 1) * kstep;
            const char* a2 = last ? nA : cA + (size_t)(t + 2) * kstep; const char* b2 = last ? nB : cB + (size_t)(t + 2) * kstep;
            const char* a3 = a2 + kstep; const char* b3 = b2 + kstep;
            if (last && has_next) S.a_ready(nxt);
            if constexpr (SP2) {
            PG8_LDB(B0, 0, 0); PG8_LDB(B1, 0, 1); PG8_SCHED; PG8_LDA(At, 0, 0); PG8_STAGE(PG8_SA(1, 1), a1 + hstep, voffA);
            PG8_WAIT_V(8); PG8_WAIT_L(0); PG8_BAR; PG8_MMA(0, 0, At, B0); PG8_MMA(0, 1, At, B1); PG8_BAR; PG8_SCHED;
            PG8_LDA(At, 0, 1); PG8_STAGE(PG8_SB(0, 0), b2, voffB); PG8_STAGE(PG8_SB(0, 1), b2 + hstep, voffB); PG8_STAGE(PG8_SA(0, 0), a2, voffA);
            PG8_WAIT_V(8); PG8_WAIT_L(0); PG8_BAR; PG8_MMA(1, 0, At, B0); PG8_MMA(1, 1, At, B1); PG8_BAR; PG8_SCHED;
            PG8_LDB(B0, 1, 0); PG8_LDB(B1, 1, 1); PG8_SCHED; PG8_LDA(At, 1, 0); PG8_STAGE(PG8_SA(0, 1), a2 + hstep, voffA);
            PG8_WAIT_V(8); PG8_WAIT_L(0); PG8_BAR; PG8_MMA(0, 0, At, B0); PG8_MMA(0, 1, At, B1); PG8_BAR; PG8_SCHED;
            PG8_LDA(At, 1, 1); PG8_STAGE(PG8_SB(1, 0), b3, voffB); PG8_STAGE(PG8_SB(1, 1), b3 + hstep, voffB); PG8_STAGE(PG8_SA(1, 0), a3, voffA);
            PG8_WAIT_V(8); PG8_WAIT_L(0); PG8_BAR; PG8_MMA(1, 0, At, B0); PG8_MMA(1, 1, At, B1); PG8_BAR; PG8_SCHED;
            } else {
            PG8_LDB(B0, 0, 0); PG8_SCHED; PG8_LDA(At, 0, 0); PG8_STAGE(PG8_SA(1, 1), a1 + hstep, voffA);
            PG8_WAIT_L(8); PG8_BAR; PG8_WAIT_L(0); PG8_MMA(0, 0, At, B0); PG8_BAR; PG8_SCHED;
            PG8_LDB(B1, 0, 1); PG8_STAGE(PG8_SB(0, 0), b2, voffB);
            PG8_BAR; PG8_WAIT_L(0); PG8_MMA(0, 1, At, B1); PG8_BAR;
            PG8_LDA(At, 0, 1); PG8_STAGE(PG8_SA(0, 0), a2, voffA);
            PG8_BAR; PG8_WAIT_L(0); PG8_MMA(1, 0, At, B0); PG8_BAR; PG8_SCHED;
            PG8_STAGE(PG8_SB(0, 1), b2 + hstep, voffB);
            PG8_WAIT_V(6); PG8_BAR; PG8_MMA(1, 1, At, B1); PG8_BAR;
            PG8_LDB(B0, 1, 0); PG8_SCHED; PG8_LDA(At, 1, 0); PG8_STAGE(PG8_SA(0, 1), a2 + hstep, voffA);
            PG8_WAIT_L(8); PG8_BAR; PG8_WAIT_L(0); PG8_MMA(0, 0, At, B0); PG8_BAR; PG8_SCHED;
            PG8_LDB(B1, 1, 1); PG8_STAGE(PG8_SB(1, 0), b3, voffB);
            PG8_BAR; PG8_WAIT_L(0); PG8_MMA(0, 1, At, B1); PG8_BAR;
            PG8_LDA(At, 1, 1); PG8_STAGE(PG8_SA(1, 0), a3, voffA);
            PG8_BAR; PG8_WAIT_L(0); PG8_MMA(1, 0, At, B0); PG8_BAR; PG8_SCHED;
            PG8_STAGE(PG8_SB(1, 1), b3 + hstep, voffB);
            PG8_WAIT_V(6); PG8_BAR; PG8_MMA(1, 1, At, B1); PG8_BAR;
            }
        }
        if constexpr (ALIGN_EPI) { if (wr == 0) PG8_BAR; }
        if constexpr (!Epi::AFTER_DRAIN) { E(acc, cur, wr, wc, fr, fq); S.done(cur); }
        if (!has_next) break;
#pragma unroll
        for (int a = 0; a < 2; ++a)
#pragma unroll
            for (int b = 0; b < 2; ++b)
#pragma unroll
                for (int m = 0; m < 4; ++m)
#pragma unroll
                    for (int n = 0; n < 2; ++n) acc[a][b][m][n] = (f32x4){0.f, 0.f, 0.f, 0.f};
        cur = nxt; cA = nA; cB = nB; ++ui;
        if constexpr (ALIGN_EPI) { if (wr == 1) PG8_BAR; }
    }
    PG8_WAIT_V(0);
    if constexpr (!ALIGN_EPI) { if (wr == 0) PG8_BAR; }
    PG8_BAR;
    if constexpr (Epi::AFTER_DRAIN) { E.fused(acc, cur, wr, wc, fr, fq, lds, wid, lane); S.done(cur); }
#undef PG8_SA
#undef PG8_SB
#undef PG8_STAGE
#undef PG8_LDA
#undef PG8_LDB
#undef PG8_MMA
#undef PG8_WAIT_V
#undef PG8_WAIT_L
#undef PG8_BAR
#undef PG8_SCHED
}
}
namespace attn_body {
using bf16=__hip_bfloat16;
using bf16x8=__attribute__((ext_vector_type(8)))short;
using s16x4=__attribute__((ext_vector_type(4)))short;
using f32x16=__attribute__((ext_vector_type(16)))float;
using u32x4=__attribute__((ext_vector_type(4)))unsigned;
__device__ __forceinline__ int crow(int r,int hi){return (r&3)+8*(r>>2)+4*hi;}
#define SBAR() __builtin_amdgcn_sched_barrier(0)
__device__ __forceinline__ void glds16(const void*gsrc,unsigned lds_dst){unsigned keep;
  asm volatile("s_mov_b32 %0, m0\n\ts_mov_b32 m0, %2\n\ts_nop 0\n\tglobal_load_lds_dwordx4 %1, off\n\ts_mov_b32 m0, %0":"=&s"(keep):"v"(gsrc),"s"(lds_dst):"memory");}
typedef float f32x2_t __attribute__((ext_vector_type(2))); typedef __bf16 bf16x2_t __attribute__((ext_vector_type(2)));
__device__ __forceinline__ unsigned cvtpk_s(float lo,float hi){f32x2_t v={lo,hi};bf16x2_t b=__builtin_convertvector(v,bf16x2_t);return __builtin_bit_cast(unsigned,b);}
#define WAIT_BAR(N) asm volatile("s_waitcnt vmcnt(" #N ") lgkmcnt(0)\n\ts_barrier":::"memory")
__device__ __forceinline__ void qkt(f32x16&p0,f32x16&p1,const char*Kslot,const bf16x8*qr,const f32x16&negm,int r32,int hi){
  const char*kb=Kslot+hi*1024+r32*16;
  #pragma unroll
  for(int d0=0;d0<4;++d0){
    const bf16x8 b0=*reinterpret_cast<const bf16x8*>(kb+d0*2048);
    const bf16x8 b1=*reinterpret_cast<const bf16x8*>(kb+d0*2048+512);
    if(d0==0){p0=__builtin_amdgcn_mfma_f32_32x32x16_bf16(b0,qr[0],negm,0,0,0);p1=__builtin_amdgcn_mfma_f32_32x32x16_bf16(b1,qr[0],negm,0,0,0);}
    else{p0=__builtin_amdgcn_mfma_f32_32x32x16_bf16(b0,qr[d0],p0,0,0,0);p1=__builtin_amdgcn_mfma_f32_32x32x16_bf16(b1,qr[d0],p1,0,0,0);}}
}
__device__ __forceinline__ void pv(f32x16*o,int vb,bf16x8 pa0,bf16x8 pa1,bf16x8 pa2,bf16x8 pa3){
  #pragma unroll
  for(int d0=0;d0<2;++d0){s16x4 lo[4],hi[4];
    #pragma unroll
    for(int ks=0;ks<4;++ks){
      asm volatile("ds_read_b64_tr_b16 %0,%1 offset:%c2":"=&v"(lo[ks]):"v"(vb),"i"(d0*4096+ks*1024):"memory");
      asm volatile("ds_read_b64_tr_b16 %0,%1 offset:%c2":"=&v"(hi[ks]):"v"(vb),"i"(d0*4096+ks*1024+512):"memory");}
    asm volatile("s_waitcnt lgkmcnt(0)":::"memory");SBAR();
    #define PK(k) (bf16x8){lo[k][0],lo[k][1],lo[k][2],lo[k][3],hi[k][0],hi[k][1],hi[k][2],hi[k][3]}
    o[d0]=__builtin_amdgcn_mfma_f32_32x32x16_bf16(pa0,PK(0),o[d0],0,0,0);
    o[d0]=__builtin_amdgcn_mfma_f32_32x32x16_bf16(pa1,PK(1),o[d0],0,0,0);
    o[d0]=__builtin_amdgcn_mfma_f32_32x32x16_bf16(pa2,PK(2),o[d0],0,0,0);
    o[d0]=__builtin_amdgcn_mfma_f32_32x32x16_bf16(pa3,PK(3),o[d0],0,0,0);
    #undef PK
  }
}
constexpr int QBLK=32,KVBLK=64,NW=8;
constexpr int NSLOT=3, SLOTB=8192;
constexpr int LDS_K=0, LDS_V=NSLOT*SLOTB, LDS_WS=2*NSLOT*SLOTB, LDS_OST=LDS_WS+NW*64*4, LDS_BYTES=LDS_OST+NW*4096;
__device__ __forceinline__ float max3f(float a,float b,float c){float r;asm("v_max3_f32 %0, %1, %2, %3":"=v"(r):"v"(a),"v"(b),"v"(c));return r;}
__device__ __forceinline__ float max2f(float a,float b){float r;asm("v_max_f32_e32 %0, %1, %2":"=v"(r):"v"(a),"v"(b));return r;}
__device__ __forceinline__ float fadd_s(float a,float b){float r;asm("v_add_f32_e32 %0, %1, %2":"=v"(r):"v"(a),"v"(b));return r;}
__device__ __forceinline__ float fsub_s(float a,float b){float r;asm("v_sub_f32_e32 %0, %1, %2":"=v"(r):"v"(a),"v"(b));return r;}
typedef __attribute__((address_space(3))) const char* lds_cptr;
typedef short v4i16_t __attribute__((ext_vector_type(4)));
__device__ __forceinline__ void kload8(bf16x8*kf,lds_cptr kp){
  kf[0]=*(const __attribute__((address_space(3))) bf16x8*)(kp);      kf[1]=*(const __attribute__((address_space(3))) bf16x8*)(kp+512);
  kf[2]=*(const __attribute__((address_space(3))) bf16x8*)(kp+2048); kf[3]=*(const __attribute__((address_space(3))) bf16x8*)(kp+2560);
  kf[4]=*(const __attribute__((address_space(3))) bf16x8*)(kp+4096); kf[5]=*(const __attribute__((address_space(3))) bf16x8*)(kp+4608);
  kf[6]=*(const __attribute__((address_space(3))) bf16x8*)(kp+6144); kf[7]=*(const __attribute__((address_space(3))) bf16x8*)(kp+6656);
}
__device__ __forceinline__ void kload2(bf16x8*kf,lds_cptr kp,int j){ kf[2*j]=*(const __attribute__((address_space(3))) bf16x8*)(kp+j*2048); kf[2*j+1]=*(const __attribute__((address_space(3))) bf16x8*)(kp+j*2048+512); }
__device__ __forceinline__ s16x4 vtr(lds_cptr p){ return __builtin_bit_cast(s16x4,__builtin_amdgcn_ds_read_tr16_b64_v4i16((__attribute__((address_space(3))) v4i16_t*)p)); }
__device__ __forceinline__ float rowmax(const f32x16&p0,const f32x16&p1){
  float a=max3f(p0[0],p0[1],p1[0]),b=max3f(p0[2],p0[3],p1[1]);a=max3f(a,p1[2],p1[3]);
  #pragma unroll
  for(int r=4;r<16;r+=4){a=max3f(a,p0[r],p0[r+1]);b=max3f(b,p0[r+2],p0[r+3]);a=max3f(a,p1[r],p1[r+1]);b=max3f(b,p1[r+2],p1[r+3]);}
  const float m=max2f(a,b);
  auto rr=__builtin_amdgcn_permlane32_swap(__float_as_uint(m),__float_as_uint(m),false,false);
  return max2f(__uint_as_float(rr[0]),__uint_as_float(rr[1]));
}
template<int THRL> __device__ __forceinline__ void attn_unit2(const bf16*Qu,const bf16*__restrict__ Kh,const bf16*__restrict__ Vh,bf16*Ou,const int NT,char*shm){
  constexpr int QPITCH=512,KVPITCH=128,OPITCH=1280;
  const int tid=mk_tid(),lane=tid&63,r32=lane&31,hi=lane>>5; const int wid=__builtin_amdgcn_readfirstlane(tid>>6);
  const bf16*Qw=Qu+(long)(wid*QBLK)*QPITCH;
  const unsigned lds0=(unsigned)(uintptr_t)shm;
  float*wsf=(float*)(shm+LDS_WS)+wid*64;
  const bf16*ksrc=Kh+(long)lane*KVPITCH+wid*8;
  const bf16*vsrc=Vh+(long)(16*(wid&3)+(lane>>2))*KVPITCH+(wid>>2)*32+(lane&3)*8;
  const unsigned kdst=lds0+LDS_K+wid*1024, vdst=lds0+LDS_V+wid*1024;
  #define DMA_K(t,slot) glds16(ksrc+(long)(t)*KVBLK*KVPITCH,(unsigned)__builtin_amdgcn_readfirstlane(kdst+(slot)))
  #define DMA_V(t,slot) glds16(vsrc+(long)(t)*KVBLK*KVPITCH,(unsigned)__builtin_amdgcn_readfirstlane(vdst+(slot)))
  const int vb0=(int)(lds0+LDS_V)+((lane>>4)&1)*32+(lane&3)*8+(4*hi+((lane&15)>>2))*64;
  const char*Kbase=shm+LDS_K; bf16x8 kf[8];
  const lds_cptr shm3=(lds_cptr)shm; const lds_cptr kp0=shm3+LDS_K+hi*1024+r32*16; const lds_cptr vp0=shm3+LDS_V+((lane>>4)&1)*32+(lane&3)*8+(4*hi+((lane&15)>>2))*64;
  DMA_K(0,0);DMA_V(0,0);DMA_K(1,SLOTB);
  bf16x8 qr[4];
  #pragma unroll
  for(int d0=0;d0<4;++d0)qr[d0]=*reinterpret_cast<const bf16x8*>(&Qw[(long)r32*QPITCH+d0*16+hi*8]);
  float mhat=0.f,l_reg=0.f;f32x16 o[2];o[0]=f32x16{};o[1]=f32x16{};f32x16 negm=f32x16{};asm volatile("":"+v"(negm));
  #define CMASK(P0,P1,t) do{}while(0)
  bool resc=false;
  #define START(P0,P1) do{ const float rm=rowmax(P0,P1); resc=false; \
    { const float dl=rm; mhat=fadd_s(mhat,dl); \
      _Pragma("unroll") for(int r=0;r<16;++r){P0[r]=fsub_s(P0[r],dl);P1[r]=fsub_s(P1[r],dl);} \
      _Pragma("unroll") for(int r=0;r<16;++r)negm[r]=-mhat; asm volatile("":"+v"(negm)); } \
    _Pragma("unroll") for(int r=0;r<16;++r)P0[r]=__builtin_amdgcn_exp2f(P0[r]); }while(0)
  #define RESC() do{ if(resc){ asm volatile("s_waitcnt lgkmcnt(0)":::"memory"); \
      _Pragma("unroll") for(int d_=0;d_<2;++d_) _Pragma("unroll") for(int r=0;r<16;++r)o[d_][r]*=wsf[crow(r,hi)]; } }while(0)
  f32x16 pA0,pA1,pB0,pB1;
  int sl_prev=0,sl_cur=0,sl_next=SLOTB;
  #define ROT() do{sl_prev=sl_cur;sl_cur=sl_next;sl_next=(sl_next==(NSLOT-1)*SLOTB)?0:sl_next+SLOTB;}while(0)
  DMA_K(2,2*SLOTB);
  WAIT_BAR(3);
  qkt(pA0,pA1,Kbase,qr,negm,r32,hi);asm volatile("s_nop 15\n\ts_nop 7":"+v"(pA0),"+v"(pA1));CMASK(pA0,pA1,0);
  START(pA0,pA1);
  _Pragma("unroll") for(int r=0;r<16;++r)pA1[r]=__builtin_amdgcn_exp2f(pA1[r]);
  WAIT_BAR(0);
  DMA_K(3,0);DMA_V(1,SLOTB);
  ROT();
  kload8(kf,kp0+sl_cur);
  WAIT_BAR(2);
  s16x4 vlo[8],vhi[8]; u32x4 pw0,pw1,pw2,pw3;
  #define PKW(P,B) cvtpk_s(P[B],P[B+1])
  #define PAF(k) __builtin_bit_cast(bf16x8,pw##k)
  #define VFR(i) (bf16x8){vlo[i][0],vlo[i][1],vlo[i][2],vlo[i][3],vhi[i][0],vhi[i][1],vhi[i][2],vhi[i][3]}
  #define PIN(x) asm volatile("":"+v"(x))
  #define MX3(a,b,c) __builtin_fmaxf(__builtin_fmaxf((a),(b)),(c))
  #define GAPA(MF,A0,A1,A2,A3,W0,W1,PW) do{ MF; sacc+=A0; sacc+=A1; sacc+=A2; sacc+=A3; PIN(sacc); W0; W1; PIN(PW); SBAR(); }while(0)
  #define EX(v) __builtin_amdgcn_exp2f(v)
  #define GAPB(MF,X,B) do{ MF; X[B]=EX(X[B]); X[B+1]=EX(X[B+1]); X[B+2]=EX(X[B+2]); X[B+3]=EX(X[B+3]); PIN(X); SBAR(); }while(0)
  #define VRD(i) do{ vlo[i]=vtr(vp_+(((i)>>2)*4096+((i)&3)*1024)); vhi[i]=vtr(vp_+(((i)>>2)*4096+((i)&3)*1024+512)); }while(0)
  #define KRD(G,j) do{ if(G){ kload2(kf,kp0+sl_next,j); SBAR(); } }while(0)
  #define STEP(C0,C1,P0,P1,t,GK,GV,GL) do{ SBAR(); \
    const lds_cptr vp_=vp0+sl_prev; \
    VRD(0); SBAR(); float sacc=(P0[0]+P0[1]); \
    GAPA(C0=__builtin_amdgcn_mfma_f32_32x32x16_bf16(kf[0],qr[0],negm,0,0,0), P0[2],P0[3],P0[4],P0[5],     pw0[0]=PKW(P0,0), pw0[1]=PKW(P0,2), pw0); \
    VRD(4); SBAR(); GAPA(C1=__builtin_amdgcn_mfma_f32_32x32x16_bf16(kf[1],qr[0],negm,0,0,0), P0[6],P0[7],P0[8],P0[9],     pw0[2]=PKW(P0,4), pw0[3]=PKW(P0,6), pw0); \
    VRD(1); SBAR(); GAPA(C0=__builtin_amdgcn_mfma_f32_32x32x16_bf16(kf[2],qr[1],C0,0,0,0),   P0[10],P0[11],P0[12],P0[13], pw1[0]=PKW(P0,8), pw1[1]=PKW(P0,10), pw1); \
    VRD(5); SBAR(); GAPA(C1=__builtin_amdgcn_mfma_f32_32x32x16_bf16(kf[3],qr[1],C1,0,0,0),   P0[14],P0[15],P1[0],P1[1],   pw1[2]=PKW(P0,12),pw1[3]=PKW(P0,14), pw1); \
    VRD(2); SBAR(); GAPA(C0=__builtin_amdgcn_mfma_f32_32x32x16_bf16(kf[4],qr[2],C0,0,0,0),   P1[2],P1[3],P1[4],P1[5],     pw2[0]=PKW(P1,0), pw2[1]=PKW(P1,2), pw2); \
    VRD(6); SBAR(); GAPA(C1=__builtin_amdgcn_mfma_f32_32x32x16_bf16(kf[5],qr[2],C1,0,0,0),   P1[6],P1[7],P1[8],P1[9],     pw2[2]=PKW(P1,4), pw2[3]=PKW(P1,6), pw2); \
    VRD(3); SBAR(); GAPA(C0=__builtin_amdgcn_mfma_f32_32x32x16_bf16(kf[6],qr[3],C0,0,0,0),   P1[10],P1[11],P1[12],P1[13], pw3[0]=PKW(P1,8), pw3[1]=PKW(P1,10), pw3); \
    VRD(7); SBAR(); GAPA(C1=__builtin_amdgcn_mfma_f32_32x32x16_bf16(kf[7],qr[3],C1,0,0,0),   P1[14],P1[15],0.f,0.f,       pw3[2]=PKW(P1,12),pw3[3]=PKW(P1,14), pw3); \
    l_reg+=sacc; \
    if(GK){DMA_K((t)+3,sl_cur);} if(GV){DMA_V((t)+1,sl_next);} \
    CMASK(C0,C1,t); \
    { float a=MX3(C0[0],C0[1],C1[0]),b=MX3(C0[2],C0[3],C1[1]); a=MX3(a,C1[2],C1[3]); \
      _Pragma("unroll") for(int r=4;r<16;r+=4){a=MX3(a,C0[r],C0[r+1]);b=MX3(b,C0[r+2],C0[r+3]);a=MX3(a,C1[r],C1[r+1]);b=MX3(b,C1[r+2],C1[r+3]);} \
      float rm=__builtin_fmaxf(a,b); { auto rr=__builtin_amdgcn_permlane32_swap(__float_as_uint(rm),__float_as_uint(rm),false,false); rm=__builtin_fmaxf(__uint_as_float(rr[0]),__uint_as_float(rr[1])); } \
      resc=false; \
      if(__builtin_expect(__any(rm>(float)THRL),0)){ const float dl=__builtin_fmaxf(rm,0.f); mhat+=dl; \
        _Pragma("unroll") for(int r=0;r<16;++r){C0[r]-=dl;C1[r]-=dl;} \
        _Pragma("unroll") for(int r=0;r<16;++r)negm[r]=-mhat; asm volatile("":"+v"(negm)); \
        const float f=__builtin_amdgcn_exp2f(-dl); l_reg*=f; if(hi==0)wsf[r32]=f; resc=true; } } \
    SBAR(); \
    GAPB(o[0]=__builtin_amdgcn_mfma_f32_32x32x16_bf16(PAF(0),VFR(0),o[0],0,0,0), C0,0); \
    GAPB(o[1]=__builtin_amdgcn_mfma_f32_32x32x16_bf16(PAF(0),VFR(4),o[1],0,0,0), C0,4); \
    KRD(GL,0); GAPB(o[0]=__builtin_amdgcn_mfma_f32_32x32x16_bf16(PAF(1),VFR(1),o[0],0,0,0), C0,8); \
    KRD(GL,1); GAPB(o[1]=__builtin_amdgcn_mfma_f32_32x32x16_bf16(PAF(1),VFR(5),o[1],0,0,0), C0,12); \
    KRD(GL,2); GAPB(o[0]=__builtin_amdgcn_mfma_f32_32x32x16_bf16(PAF(2),VFR(2),o[0],0,0,0), C1,0); \
    KRD(GL,3); GAPB(o[1]=__builtin_amdgcn_mfma_f32_32x32x16_bf16(PAF(2),VFR(6),o[1],0,0,0), C1,4); \
    GAPB(o[0]=__builtin_amdgcn_mfma_f32_32x32x16_bf16(PAF(3),VFR(3),o[0],0,0,0), C1,8); \
    GAPB(o[1]=__builtin_amdgcn_mfma_f32_32x32x16_bf16(PAF(3),VFR(7),o[1],0,0,0), C1,12); \
    }while(0)
  int t=1;
  #undef CMASK
  #define CMASK(P0,P1,t) do{}while(0)
  for(;t+5<NT;t+=2){
    STEP(pB0,pB1,pA0,pA1,t,true,true,true);     WAIT_BAR(2); RESC(); ROT();
    STEP(pA0,pA1,pB0,pB1,t+1,true,true,true);   WAIT_BAR(2); RESC(); ROT();
  }
  #undef CMASK
  #define CMASK(P0,P1,t) do{}while(0)
  #define ENDW(tt) do{ if((tt)+3<NT){WAIT_BAR(2);} else if((tt)+2<NT){WAIT_BAR(1);} else {WAIT_BAR(0);} }while(0)
  for(;t+1<NT;t+=2){
    STEP(pB0,pB1,pA0,pA1,t,(t+3<NT),(t+1<NT),(t+1<NT));       ENDW(t);   RESC(); ROT();
    STEP(pA0,pA1,pB0,pB1,t+1,(t+4<NT),(t+2<NT),(t+2<NT));     ENDW(t+1); RESC(); ROT();
  }
  STEP(pB0,pB1,pA0,pA1,NT-1,false,false,false); RESC();
  { float sacc=pB0[0]+pB0[1]; _Pragma("unroll") for(int r=2;r<16;++r)sacc+=pB0[r]; _Pragma("unroll") for(int r=0;r<16;++r)sacc+=pB1[r]; l_reg+=sacc;
    pw0=(u32x4){PKW(pB0,0),PKW(pB0,2),PKW(pB0,4),PKW(pB0,6)};pw1=(u32x4){PKW(pB0,8),PKW(pB0,10),PKW(pB0,12),PKW(pB0,14)};pw2=(u32x4){PKW(pB1,0),PKW(pB1,2),PKW(pB1,4),PKW(pB1,6)};pw3=(u32x4){PKW(pB1,8),PKW(pB1,10),PKW(pB1,12),PKW(pB1,14)};
    SBAR(); pv(o,vb0+sl_cur,PAF(0),PAF(1),PAF(2),PAF(3)); }
  #undef PKW
  #undef PAF
  #undef VFR
  #undef PIN
  #undef MX3
  #undef GAPA
  #undef GAPB
  #undef EX
  #undef VRD
  #undef KRD
  #undef STEP
  #undef ENDW
  {auto rr=__builtin_amdgcn_permlane32_swap(__float_as_uint(l_reg),__float_as_uint(l_reg),false,false);l_reg=__uint_as_float(rr[0])+__uint_as_float(rr[1]);}
  if(hi==0)wsf[32+r32]=l_reg;asm volatile("s_waitcnt lgkmcnt(0)":::"memory");
  float rli[16];
  #pragma unroll
  for(int r=0;r<16;++r)rli[r]=__builtin_amdgcn_rcpf(wsf[32+crow(r,hi)]);
  bf16*Ow=Ou+(long)(wid*QBLK)*OPITCH;
  { bf16*stg=(bf16*)(shm+LDS_OST)+wid*2048;
    #pragma unroll
    for(int r=0;r<16;++r){const int orow=crow(r,hi);
      #pragma unroll
      for(int d0=0;d0<2;++d0)stg[orow*64+d0*32+r32]=__float2bfloat16(o[d0][r]*rli[r]);}
    asm volatile("s_waitcnt lgkmcnt(0)":::"memory");
    #pragma unroll
    for(int i=0;i<4;++i){const int row=i*8+(lane>>3),ch=lane&7; const u32x4 v=*(const u32x4*)(stg+row*64+ch*8); *(u32x4*)(Ow+(long)row*OPITCH+ch*8)=v;} }
  asm volatile("s_waitcnt lgkmcnt(0)\n\ts_barrier":::"memory");
  #undef DMA_K
  #undef DMA_V
  #undef CMASK
  #undef START
  #undef RESC
  #undef ROT
}
#undef SBAR
#undef WAIT_BAR
}

namespace mk {
using pg8::bf16_t; using pg8::f32x4; using pg8::Unit; using pg8::cvt_pk_bf16;
#define LAS __attribute__((address_space(3)))
typedef unsigned u32x2 __attribute__((ext_vector_type(2)));
typedef unsigned u32x4 __attribute__((ext_vector_type(4)));
typedef float f32x2 __attribute__((ext_vector_type(2)));
typedef short bf16x8 __attribute__((ext_vector_type(8)));
typedef float f32x16 __attribute__((ext_vector_type(16)));

constexpr int DM = 1024, NB = 8, SL = 4096, CL = 256, ML = NB * SL, MC = NB * CL, MT = ML + MC;
constexpr int INW = 1792, DFF = 2816, UPW = 5632, MIXK = 1280, KVP = 128, QP = 512, KVB = SL + CL;
constexpr int HALF_A = 16384;
constexpr float EPS = 1e-6f;
constexpr float QSCALE = 0.125f * 1.4426950408889634f;

constexpr size_t MiB = 1u << 20;
constexpr size_t WS_CTL = 0;
constexpr size_t WS_MODP = 1 * MiB;
constexpr size_t WS_MOD = 5 * MiB;
constexpr size_t WS_T = 6 * MiB;
constexpr size_t WS_TW = 7 * MiB;
constexpr size_t WS_W = 8 * MiB;
constexpr size_t W_LAYER = 24 * MiB;
constexpr size_t WS_ADFT = 56 * MiB;
constexpr size_t WS_ADFTC = 88 * MiB;
constexpr size_t WS_KF = 89 * MiB;
constexpr size_t WS_KFC = 121 * MiB;
constexpr size_t WS_CX = 122 * MiB;
constexpr size_t WS_XN = 130 * MiB;
constexpr size_t WS_TMP = 198 * MiB;
constexpr size_t WS_Q = WS_TMP;
constexpr size_t WS_K = WS_TMP + 34 * MiB;
constexpr size_t WS_V = WS_TMP + 43 * MiB;
constexpr size_t WS_FT = WS_TMP + 52 * MiB;
constexpr size_t WS_FTC = WS_TMP + 68 * MiB;
constexpr size_t WS_PT = WS_TMP + 69 * MiB;
constexpr size_t WS_PTC = WS_TMP + 117 * MiB;
constexpr size_t WS_MIX = WS_TMP + 120 * MiB;
constexpr size_t WS_HRAW = WS_TMP + 206 * MiB;
constexpr size_t WS_U = WS_TMP;
constexpr size_t WS_G = WS_TMP;
constexpr size_t WS_SB = WS_TMP + 190 * MiB;
constexpr size_t WS_XB = WS_TMP + 224 * MiB;
constexpr size_t WS_END = WS_TMP + 297 * MiB;

struct Params { const float* in[29]; float* out; unsigned char* ws; int ph_lo, ph_hi; };
enum { I_X = 0, I_C, I_CTX, I_CCTX, I_WMOD, I_BMOD, I_GPREMIX, I_GPOSTMIX, I_GPREFFN, I_GPOSTFFN, I_WIN, I_GQ, I_GK, I_WF, I_WHC, I_BHC,
       I_HW1, I_HB1, I_HFR1, I_HW2, I_HB2, I_HFR2, I_HW3, I_HBIAS, I_WOUT, I_WUP, I_WFC, I_BFC, I_WDOWN };

__device__ __forceinline__ unsigned f2bf(float f) { unsigned u = __builtin_bit_cast(unsigned, f); return (u + 0x7fffu + ((u >> 16) & 1u)) >> 16; }
__device__ __forceinline__ unsigned pk2(float lo, float hi) { return f2bf(lo) | (f2bf(hi) << 16); }
__device__ __forceinline__ float bflo(unsigned w) { return __uint_as_float(w << 16); }
__device__ __forceinline__ float bfhi(unsigned w) { return __uint_as_float(w & 0xffff0000u); }
__device__ __forceinline__ float bf2f(bf16_t h) { return __uint_as_float((unsigned)h << 16); }
__device__ __forceinline__ float wave_sum(float v) {
#pragma unroll
    for (int o = 1; o < 64; o <<= 1) v += __shfl_xor(v, o);
    return v;
}

struct EpiPlain {
    static constexpr bool PERM = true, AFTER_DRAIN = false, APERM = false;
    bf16_t* O; int ldc;
    __device__ __forceinline__ void operator()(const f32x4 (&acc)[2][2][4][2], const Unit& u, int wr, int wc, int fr, int fq) const {
        const int row0 = u.pm * 256 + wr * 64 + fr; const int col0 = u.pn * 256 + wc * 32 + 8 * fq;
#pragma unroll
        for (int ai = 0; ai < 2; ++ai)
#pragma unroll
            for (int m = 0; m < 4; ++m) { bf16_t* rowp = O + (size_t)(row0 + ai * 128 + m * 16) * ldc + col0;
#pragma unroll
                for (int bj = 0; bj < 2; ++bj) { const f32x4 v0 = acc[ai][bj][m][0], v1 = acc[ai][bj][m][1];
                    u32x4 w; w.x = cvt_pk_bf16(v0[0], v0[1]); w.y = cvt_pk_bf16(v0[2], v0[3]); w.z = cvt_pk_bf16(v1[0], v1[1]); w.w = cvt_pk_bf16(v1[2], v1[3]);
                    *(u32x4*)(rowp + bj * 128) = w; } }
    }
};

struct EpiFourier {
    static constexpr bool PERM = true, AFTER_DRAIN = false, APERM = false;
    bf16_t* MIXp; int Lh; int rowbase0; int rowstride;
    __device__ __forceinline__ void operator()(const f32x4 (&acc)[2][2][4][2], const Unit& u, int wr, int wc, int fr, int fq) const {
        asm volatile("" : "+v"(fr), "+v"(fq), "+s"(wr), "+s"(wc));
        const int b = u.pn; const int len = 2 * Lh; const int rb = rowbase0 + b * rowstride;
#pragma unroll
        for (int ai = 0; ai < 2; ++ai)
#pragma unroll
            for (int m = 0; m < 4; ++m) {
                const int r = u.pm * 256 + ai * 128 + wr * 64 + m * 16 + fr;
                const bool isS = r > Lh; const int k = isS ? r - Lh : r;
                const bool edge = (k == 0) || (k == Lh);
#pragma unroll
                for (int bj = 0; bj < 2; ++bj) { const f32x4 v0 = acc[ai][bj][m][0], v1 = acc[ai][bj][m][1];
                    const int ch = bj * 128 + wc * 32 + 8 * fq;
                    u32x4 w; w.x = cvt_pk_bf16(v0[0], v0[1]); w.y = cvt_pk_bf16(v0[2], v0[3]); w.z = cvt_pk_bf16(v1[0], v1[1]); w.w = cvt_pk_bf16(v1[2], v1[3]);
                    const int col = 512 + (isS ? 256 : 0) + ch;
                    *(u32x4*)(MIXp + (size_t)(rb + k) * MIXK + col) = w;
                    if (!edge) { u32x4 wm = w; if (isS) { wm.x ^= 0x80008000u; wm.y ^= 0x80008000u; wm.z ^= 0x80008000u; wm.w ^= 0x80008000u; }
                        *(u32x4*)(MIXp + (size_t)(rb + len - k) * MIXK + col) = wm; }
                    else if (!isS) { *(u32x4*)(MIXp + (size_t)(rb + k) * MIXK + col + 256) = (u32x4){0u, 0u, 0u, 0u}; }
                }
            }
    }
};

struct EpiInProj {
    static constexpr bool PERM = false, AFTER_DRAIN = false, APERM = false;
    bf16_t *Q, *K, *V, *fT, *fTc, *PT, *PTc; const float *gq, *gk, *rope; LAS float* xch;
    __device__ __forceinline__ void operator()(const f32x4 (&acc)[2][2][4][2], const Unit& u, int wr, int wc, int fr, int fq) const {
        asm volatile("" : "+v"(fr), "+v"(fq), "+s"(wr), "+s"(wc));
        const int pn = u.pn, pm = u.pm; const bool isctx = pm >= 128;
        const int b = isctx ? pm - 128 : pm >> 4;
        const int tbase = isctx ? 0 : (pm & 15) * 256;
#ifdef T_NOQK
        if (false) {
#else
        if (pn <= 2) {
#endif
#pragma unroll
            for (int ai = 0; ai < 2; ++ai)
#pragma unroll
                for (int m = 0; m < 4; ++m)
#pragma unroll
                    for (int bj = 0; bj < 2; ++bj) {
                        float s = 0.f;
#pragma unroll
                        for (int n = 0; n < 2; ++n) { const f32x4 x = acc[ai][bj][m][n]; s += (x[0] * x[0] + x[1] * x[1]) + (x[2] * x[2] + x[3] * x[3]); }
                        s += __shfl_xor(s, 16); s += __shfl_xor(s, 32);
                        if (fq == 0) xch[((ai * 128 + wr * 64 + m * 16 + fr) * 2 + bj) * 4 + wc] = s;
                    }
            asm volatile("s_waitcnt lgkmcnt(0)\n\ts_barrier" ::: "memory");
            const float* gg = (pn == 2) ? gk : gq;
            const int dbase = (wc & 1) * 32 + 4 * fq;
            const f32x4 g1 = *(const f32x4*)(gg + dbase), g2 = *(const f32x4*)(gg + dbase + 16);
            const float osc = (pn == 2) ? 1.0f : QSCALE;
#pragma unroll
            for (int ai = 0; ai < 2; ++ai)
#pragma unroll
                for (int m = 0; m < 4; ++m) {
                    const int rl = ai * 128 + wr * 64 + m * 16 + fr; const int t = tbase + rl;
                    const int p = (wc & 1) ? (t & 63) : (t >> 6);
                    f32x4 cs = (f32x4){1.f, 1.f, 1.f, 1.f}, sn = (f32x4){0.f, 0.f, 0.f, 0.f};
                    if (!isctx) { cs = *(const f32x4*)(rope + p * 16 + 4 * fq); sn = *(const f32x4*)(rope + 1024 + p * 16 + 4 * fq); }
                    const size_t qrow = (size_t)pm * 256 + rl;
                    const size_t kvrow = isctx ? (size_t)b * KVB + rl : (size_t)b * KVB + CL + t;
#pragma unroll
                    for (int bj = 0; bj < 2; ++bj) {
                        if (pn == 2 && bj == 1) {
#pragma unroll
                            for (int n = 0; n < 2; ++n) { const f32x4 x = acc[ai][bj][m][n]; u32x2 w; w.x = cvt_pk_bf16(x[0], x[1]); w.y = cvt_pk_bf16(x[2], x[3]);
                                *(u32x2*)(V + kvrow * KVP + wc * 32 + 16 * n + 4 * fq) = w; }
                        } else {
                            const float ssq = xch[(rl * 2 + bj) * 4 + wc] + xch[(rl * 2 + bj) * 4 + (wc ^ 1)];
                            const float rstd = rsqrtf(ssq * (1.0f / 64.0f) + EPS) * osc;
                            const f32x4 y1 = acc[ai][bj][m][0] * rstd * g1, y2 = acc[ai][bj][m][1] * rstd * g2;
                            const f32x4 o1 = y1 * cs - y2 * sn, o2 = y2 * cs + y1 * sn;
                            u32x2 w1, w2; w1.x = cvt_pk_bf16(o1[0], o1[1]); w1.y = cvt_pk_bf16(o1[2], o1[3]); w2.x = cvt_pk_bf16(o2[0], o2[1]); w2.y = cvt_pk_bf16(o2[2], o2[3]);
                            bf16_t* dst = (pn == 2) ? (K + kvrow * KVP + wc * 32 + 4 * fq) : (Q + qrow * QP + pn * 256 + bj * 128 + wc * 32 + 4 * fq);
                            *(u32x2*)dst = w1; *(u32x2*)(dst + 16) = w2;
                        }
                    }
                }
        }
#ifndef T_NOTR
        else {
            const int NC = (pn == 3) ? 256 : 768; const int cb = (pn == 3) ? 0 : (pn - 4) * 256;
            bf16_t* base; int tl;
            if (isctx) { base = ((pn == 3) ? fTc : PTc) + (size_t)b * NC * CL; tl = CL; }
            else { base = ((pn == 3) ? fT : PT) + (size_t)b * NC * SL + tbase; tl = SL; }
            const int lane = fq * 16 + fr;
            LAS bf16_t* stg = (LAS bf16_t*)((LAS unsigned char*)xch + 8192) + (wr * 4 + wc) * 1152;
#pragma unroll
            for (int ai = 0; ai < 2; ++ai)
#pragma unroll
                for (int bj = 0; bj < 2; ++bj)
#pragma unroll
                    for (int n = 0; n < 2; ++n) {
#pragma unroll
                        for (int m = 0; m < 4; ++m) { const f32x4 x = acc[ai][bj][m][n];
#pragma unroll
                            for (int j = 0; j < 4; ++j) stg[(4 * fq + j) * 72 + m * 16 + fr] = (bf16_t)f2bf(x[j]); }
                        asm volatile("s_waitcnt lgkmcnt(0)" ::: "memory");
                        bf16_t* dst = base + (size_t)(cb + bj * 128 + wc * 32 + 16 * n) * tl + ai * 128 + wr * 64;
#pragma unroll
                        for (int i = 0; i < 2; ++i) { const int v = lane + 64 * i, col = v >> 3, k = v & 7;
                            const u32x4 w = *(const LAS u32x4*)(stg + col * 72 + k * 8);
                            *(u32x4*)(dst + (size_t)col * tl + 8 * k) = w; }
                        asm volatile("s_waitcnt lgkmcnt(0)" ::: "memory");
                    }
        }
#endif
    }
};


__device__ __forceinline__ float dppf(float old, float src, int ctrl_sel) {
    const int o = __builtin_bit_cast(int, old), s = __builtin_bit_cast(int, src); int r;
    if (ctrl_sel == 0) r = __builtin_amdgcn_update_dpp(o, s, 0x111, 0xf, 0xf, false);
    else if (ctrl_sel == 1) r = __builtin_amdgcn_update_dpp(o, s, 0x101, 0xf, 0xf, false);
    else if (ctrl_sel == 2) r = __builtin_amdgcn_update_dpp(o, s, 0x121, 0xf, 0xf, false);
    else r = __builtin_amdgcn_update_dpp(o, s, 0x12F, 0xf, 0xf, false);
    return __builtin_bit_cast(float, r);
}
__device__ __forceinline__ float silu_mul(float cg, float cv) { return cg * cv * __builtin_amdgcn_rcpf(1.0f + __builtin_amdgcn_exp2f(-1.4426950408889634f * cg)); }

struct EpiGlu {
    static constexpr bool PERM = true, AFTER_DRAIN = false, APERM = true;
    bf16_t* G; bf16_t* SB; const float* wcv; const float* bcv; LAS float* xb;
    __device__ __forceinline__ void operator()(const f32x4 (&acc)[2][2][4][2], const Unit& u, int wr, int wc, int fr, int fq) const {
        asm volatile("" : "+v"(fr), "+v"(fq), "+s"(wr), "+s"(wc));
        const int c0 = 128 * u.pn + 32 * wc + 8 * fq;
        f32x4 wgn[3], wvn[3], bgn, bvn;
#pragma unroll
        for (int d = 0; d < 3; ++d) { wgn[d] = *(const f32x4*)(wcv + d * UPW + c0); wvn[d] = *(const f32x4*)(wcv + d * UPW + DFF + c0); }
        bgn = *(const f32x4*)(bcv + c0); bvn = *(const f32x4*)(bcv + DFF + c0);
#pragma unroll
        for (int ai = 0; ai < 2; ++ai) {
            if (fr == 0 || fr == 15) {
                const int which = fr == 0 ? 0 : 1; LAS float* dst = xb + ((((ai * 2 + wr) * 2 + which) * 4 + wc) * 4 + fq) * 16;
#pragma unroll
                for (int bj = 0; bj < 2; ++bj)
#pragma unroll
                    for (int n = 0; n < 2; ++n) { const f32x4 x = fr == 0 ? acc[ai][bj][0][n] : acc[ai][bj][3][n]; *(LAS f32x4*)(dst + bj * 8 + n * 4) = x; }
            }
        }
        asm volatile("s_waitcnt lgkmcnt(0)\n\ts_barrier" ::: "memory");
#pragma unroll
        for (int n = 0; n < 2; ++n) {
            f32x4 wg[3], wv[3], bg, bv;
#pragma unroll
            for (int d = 0; d < 3; ++d) { wg[d] = n == 0 ? wgn[d] : *(const f32x4*)(wcv + d * UPW + c0 + 4); wv[d] = n == 0 ? wvn[d] : *(const f32x4*)(wcv + d * UPW + DFF + c0 + 4); }
            bg = n == 0 ? bgn : *(const f32x4*)(bcv + c0 + 4); bv = n == 0 ? bvn : *(const f32x4*)(bcv + DFF + c0 + 4);

#pragma unroll
            for (int ai = 0; ai < 2; ++ai) {
                int pblk = -1, nblk = -1;
                if (wr == 1) pblk = ai * 2 + 0; else if (ai == 1) pblk = 0 * 2 + 1;
                if (wr == 0) nblk = ai * 2 + 1; else if (ai == 0) nblk = 1 * 2 + 0;
                f32x4 pg = (f32x4){0.f, 0.f, 0.f, 0.f}, pv = pg, ng = pg, nv = pg;
                if (pblk >= 0) { const LAS float* s = xb + (((pblk * 2 + 1) * 4 + wc) * 4 + fq) * 16; pg = *(const LAS f32x4*)(s + n * 4); pv = *(const LAS f32x4*)(s + 8 + n * 4); }
                if (nblk >= 0) { const LAS float* s = xb + (((nblk * 2 + 0) * 4 + wc) * 4 + fq) * 16; ng = *(const LAS f32x4*)(s + n * 4); nv = *(const LAS f32x4*)(s + 8 + n * 4); }
                f32x4 upg, upv, dng, dnv;
#pragma unroll
                for (int j = 0; j < 4; ++j) { upg[j] = dppf(pg[j], acc[ai][0][3][n][j], 0); upv[j] = dppf(pv[j], acc[ai][1][3][n][j], 0);
                                              dng[j] = dppf(ng[j], acc[ai][0][0][n][j], 1); dnv[j] = dppf(nv[j], acc[ai][1][0][n][j], 1); }
#pragma unroll
                for (int m = 0; m < 4; ++m) {
                    const f32x4 cg = acc[ai][0][m][n], cv = acc[ai][1][m][n];
                    const f32x4 prg = m > 0 ? acc[ai][0][m - 1][n] : upg, prv = m > 0 ? acc[ai][1][m - 1][n] : upv;
                    const f32x4 nxg = m < 3 ? acc[ai][0][m + 1][n] : dng, nxv = m < 3 ? acc[ai][1][m + 1][n] : dnv;
                    const f32x4 sg = prg * wg[0] + cg * wg[1] + nxg * wg[2] + bg;
                    const f32x4 sv = prv * wv[0] + cv * wv[1] + nxv * wv[2] + bv;
                    float res[4];
#pragma unroll
                    for (int j = 0; j < 4; ++j) res[j] = silu_mul(sg[j], sv[j]);
                    const int rl = ai * 128 + wr * 64 + 4 * fr + m;
                    u32x2 w; w.x = cvt_pk_bf16(res[0], res[1]); w.y = cvt_pk_bf16(res[2], res[3]);
                    *(u32x2*)(G + (size_t)(u.pm * 256 + rl) * DFF + c0 + 4 * n) = w;
                    if (rl < 2 || rl >= 254) {
                        const int which = rl < 2 ? rl : rl - 252; bf16_t* sb = SB + ((size_t)u.pm * 4 + which) * UPW + c0 + 4 * n;
                        u32x2 a; a.x = cvt_pk_bf16(cg[0], cg[1]); a.y = cvt_pk_bf16(cg[2], cg[3]);
                        u32x2 b; b.x = cvt_pk_bf16(cv[0], cv[1]); b.y = cvt_pk_bf16(cv[2], cv[3]);
                        *(u32x2*)sb = a; *(u32x2*)(sb + DFF) = b;
                    }
                }
            }
            asm volatile("" ::: "memory");
        }
    }
};

__device__ __forceinline__ void glu_fixup(int blk, int nblk, int tid, int ntiles, const bf16_t* SB, bf16_t* G, const float* wc, const float* bc) {
    for (int it = blk; it < 2 * ntiles; it += nblk) {
        const int pm = it >> 1, b = it & 1;
        const bool isctx = pm >= 128; const bool has_prev = !isctx && (pm & 15) != 0, has_next = !isctx && (pm & 15) != 15;
        const bf16_t* rp; const bf16_t* rc; const bf16_t* rn; bool hp, hn;
        if (b == 0) { rp = SB + ((size_t)(pm - 1) * 4 + 3) * UPW; rc = SB + ((size_t)pm * 4 + 0) * UPW; rn = SB + ((size_t)pm * 4 + 1) * UPW; hp = has_prev; hn = true; }
        else { rp = SB + ((size_t)pm * 4 + 2) * UPW; rc = SB + ((size_t)pm * 4 + 3) * UPW; rn = SB + ((size_t)(pm + 1) * 4 + 0) * UPW; hp = true; hn = has_next; }
        bf16_t* grow = G + (size_t)(pm * 256 + (b ? 255 : 0)) * DFF;
        float val[6][14];
#pragma unroll
        for (int q = 0; q < 6; ++q) { const int c = tid + 512 * q; const bool in = c < DFF; const int cc = in ? c : 0;
            val[q][0] = hp ? bf2f(rp[cc]) : 0.f; val[q][1] = bf2f(rc[cc]); val[q][2] = hn ? bf2f(rn[cc]) : 0.f;
            val[q][3] = hp ? bf2f(rp[DFF + cc]) : 0.f; val[q][4] = bf2f(rc[DFF + cc]); val[q][5] = hn ? bf2f(rn[DFF + cc]) : 0.f;
            val[q][6] = wc[cc]; val[q][7] = wc[UPW + cc]; val[q][8] = wc[2 * UPW + cc]; val[q][9] = bc[cc];
            val[q][10] = wc[DFF + cc]; val[q][11] = wc[UPW + DFF + cc]; val[q][12] = wc[2 * UPW + DFF + cc]; val[q][13] = bc[DFF + cc]; }
#pragma unroll
        for (int q = 0; q < 6; ++q) { const int c = tid + 512 * q;
            const float sg = val[q][0] * val[q][6] + val[q][1] * val[q][7] + val[q][2] * val[q][8] + val[q][9];
            const float sv = val[q][3] * val[q][10] + val[q][4] * val[q][11] + val[q][5] * val[q][12] + val[q][13];
            if (c < DFF) grow[c] = (bf16_t)f2bf(silu_mul(sg, sv)); }
    }
}

struct OneUnit { int pm, pn;
    __device__ __forceinline__ bool next(int i, Unit& u) const { if (i > 0) return false; u.pm = pm; u.pn = pn; return true; }
    __device__ __forceinline__ void a_ready(const Unit&) const {}
    __device__ __forceinline__ void done(const Unit&) const {}
};

constexpr int AT_K = 0, AT_V = 16384, AT_WS = 32768, AT_OST = 32768 + 2048;
__device__ __forceinline__ void attn_unit(const bf16_t* Qu, const bf16_t* Kh, const bf16_t* Vh, bf16_t* Ou, int NT, char* shm) {
    using namespace attn_body;
    const int tid = mk_tid(), lane = tid & 63, r32 = lane & 31, hi = lane >> 5; const int wid = __builtin_amdgcn_readfirstlane(tid >> 6);
    const unsigned lds0 = (unsigned)(uintptr_t)shm;
    float* wsf = (float*)(shm + AT_WS) + wid * 64;
    const bf16_t* ksrc = Kh + (size_t)lane * KVP + wid * 8;
    const bf16_t* vsrc = Vh + (size_t)(16 * (wid & 3) + (lane >> 2)) * KVP + (wid >> 2) * 32 + (lane & 3) * 8;
    const unsigned kdst = lds0 + AT_K + wid * 1024, vdst = lds0 + AT_V + wid * 1024;
#define DMA_K(t, slot) glds16(ksrc + (size_t)(t) * 64 * KVP, (unsigned)__builtin_amdgcn_readfirstlane(kdst + (slot)))
#define DMA_V(t, slot) glds16(vsrc + (size_t)(t) * 64 * KVP, (unsigned)__builtin_amdgcn_readfirstlane(vdst + (slot)))
    const int vb0 = (int)(lds0 + AT_V) + ((lane >> 4) & 1) * 32 + (lane & 3) * 8 + (4 * hi + ((lane & 15) >> 2)) * 64;
    DMA_K(0, 0); DMA_V(0, 0);
    const bf16_t* Qw = Qu + (size_t)(wid * 32) * QP;
    bf16x8 qr[4];
#pragma unroll
    for (int d0 = 0; d0 < 4; ++d0) qr[d0] = *reinterpret_cast<const bf16x8*>(&Qw[(size_t)r32 * QP + d0 * 16 + hi * 8]);
    float mrun = -INFINITY, l_reg = 0.f; f32x16 o[2]; o[0] = f32x16{}; o[1] = f32x16{};
    f32x16 zero16 = f32x16{};
    for (int t = 0; t < NT; ++t) {
        const int buf = (t & 1) * 8192;
        if (t + 1 < NT) { DMA_K(t + 1, buf ^ 8192); DMA_V(t + 1, buf ^ 8192); asm volatile("s_waitcnt vmcnt(2)\n\ts_barrier" ::: "memory"); }
        else { asm volatile("s_waitcnt vmcnt(0)\n\ts_barrier" ::: "memory"); }
        f32x16 p0, p1;
        qkt(p0, p1, shm + AT_K + buf, qr, zero16, r32, hi);
        float rm = p0[0];
#pragma unroll
        for (int r = 1; r < 16; ++r) rm = fmaxf(rm, p0[r]);
#pragma unroll
        for (int r = 0; r < 16; ++r) rm = fmaxf(rm, p1[r]);
        rm = fmaxf(rm, __shfl_xor(rm, 32));
        const float mnew = fmaxf(mrun, rm);
        const float f = __builtin_amdgcn_exp2f(mrun - mnew);
        mrun = mnew;
        float sacc = 0.f;
#pragma unroll
        for (int r = 0; r < 16; ++r) { p0[r] = __builtin_amdgcn_exp2f(p0[r] - mnew); p1[r] = __builtin_amdgcn_exp2f(p1[r] - mnew); sacc += p0[r] + p1[r]; }
        l_reg = l_reg * f + sacc;
        if (hi == 0) wsf[r32] = f;
        asm volatile("s_waitcnt lgkmcnt(0)" ::: "memory");
#pragma unroll
        for (int r = 0; r < 16; ++r) { const float fr_ = wsf[crow(r, hi)]; o[0][r] *= fr_; o[1][r] *= fr_; }
        u32x4 pw0, pw1, pw2, pw3;
        pw0 = (u32x4){cvtpk_s(p0[0], p0[1]), cvtpk_s(p0[2], p0[3]), cvtpk_s(p0[4], p0[5]), cvtpk_s(p0[6], p0[7])};
        pw1 = (u32x4){cvtpk_s(p0[8], p0[9]), cvtpk_s(p0[10], p0[11]), cvtpk_s(p0[12], p0[13]), cvtpk_s(p0[14], p0[15])};
        pw2 = (u32x4){cvtpk_s(p1[0], p1[1]), cvtpk_s(p1[2], p1[3]), cvtpk_s(p1[4], p1[5]), cvtpk_s(p1[6], p1[7])};
        pw3 = (u32x4){cvtpk_s(p1[8], p1[9]), cvtpk_s(p1[10], p1[11]), cvtpk_s(p1[12], p1[13]), cvtpk_s(p1[14], p1[15])};
        pv(o, vb0 + buf, __builtin_bit_cast(bf16x8, pw0), __builtin_bit_cast(bf16x8, pw1), __builtin_bit_cast(bf16x8, pw2), __builtin_bit_cast(bf16x8, pw3));
        asm volatile("s_waitcnt lgkmcnt(0)\n\ts_barrier" ::: "memory");
    }
    l_reg += __shfl_xor(l_reg, 32);
    if (hi == 0) wsf[32 + r32] = l_reg;
    asm volatile("s_waitcnt lgkmcnt(0)" ::: "memory");
    float rli[16];
#pragma unroll
    for (int r = 0; r < 16; ++r) rli[r] = 1.0f / wsf[32 + crow(r, hi)];
    bf16_t* Ow = Ou + (size_t)(wid * 32) * MIXK;
    { bf16_t* stg = (bf16_t*)(shm + AT_OST) + wid * 2048;
#pragma unroll
      for (int r = 0; r < 16; ++r) { const int orow = crow(r, hi);
#pragma unroll
        for (int d0 = 0; d0 < 2; ++d0) stg[orow * 64 + d0 * 32 + r32] = (bf16_t)f2bf(o[d0][r] * rli[r]); }
      asm volatile("s_waitcnt lgkmcnt(0)" ::: "memory");
#pragma unroll
      for (int i = 0; i < 4; ++i) { const int row = i * 8 + (lane >> 3), ch = lane & 7; const u32x4 v = *(const u32x4*)(stg + row * 64 + ch * 8); *(u32x4*)(Ow + (size_t)row * MIXK + ch * 8) = v; } }
    asm volatile("s_waitcnt vmcnt(0) lgkmcnt(0)\n\ts_barrier" ::: "memory");
#undef DMA_K
#undef DMA_V
}

__device__ __forceinline__ int PADI(int i) { return i + (i >> 5); }
constexpr int FFT_TW_OFF = 69632, FFT_RED_OFF = 69632 + 32768;
template <int LOGN, int R, bool INV>
__device__ __forceinline__ void fft_pass(LAS f32x2* d, const LAS f32x2* tw, int s, int tid) {
    constexpr int N = 1 << LOGN, RR = 1 << R;
    const int lgs = LOGN - s - R; const int stride = 1 << lgs;
    constexpr float C16[8] = {1.0f, 0.9238795325112867f, 0.7071067811865476f, 0.3826834323650898f, 0.0f, -0.3826834323650898f, -0.7071067811865476f, -0.9238795325112867f};
    constexpr float S16[8] = {0.0f, 0.3826834323650898f, 0.7071067811865476f, 0.9238795325112867f, 1.0f, 0.9238795325112867f, 0.7071067811865476f, 0.3826834323650898f};
    for (int g = tid; g < (N >> R); g += 512) {
        const int lo = g & (stride - 1), hi = g >> lgs; const int base = (hi << (lgs + R)) + lo;
        f32x2 v[RR];
#pragma unroll
        for (int e = 0; e < RR; ++e) v[e] = d[PADI(base + e * stride)];
        if constexpr (R == 1) { const f32x2 a = v[0], b = v[1]; v[0] = a + b; v[1] = a - b; }
        else {
            static_assert(R == 4 || R == 1, "radix");
            f32x2 Wb[4];
            Wb[0] = tw[lo << s];
#pragma unroll
            for (int j = 1; j < 4; ++j) Wb[j] = (f32x2){Wb[j - 1].x * Wb[j - 1].x - Wb[j - 1].y * Wb[j - 1].y, 2.0f * Wb[j - 1].x * Wb[j - 1].y};
#pragma unroll
            for (int jj = 0; jj < 4; ++jj) {
                const int j = INV ? (3 - jj) : jj;
                const int he = 8 >> j;
#pragma unroll
                for (int q = 0; q < 8; ++q) if (q < he) {
                    const int k = q << j;
                    const f32x2 w = (f32x2){Wb[j].x * C16[k] + Wb[j].y * S16[k], Wb[j].y * C16[k] - Wb[j].x * S16[k]};
#pragma unroll
                    for (int e = 0; e < 16; ++e) if ((e & he) == 0 && (e & (he - 1)) == q) {
                        const f32x2 a = v[e], b = v[e + he];
                        if (!INV) { const f32x2 dl = a - b; v[e] = a + b; v[e + he] = (f32x2){dl.x * w.x - dl.y * w.y, dl.x * w.y + dl.y * w.x}; }
                        else { const f32x2 bw = (f32x2){b.x * w.x + b.y * w.y, b.y * w.x - b.x * w.y}; v[e] = a + bw; v[e + he] = a - bw; }
                    }
                }
            }
        }
#pragma unroll
        for (int e = 0; e < RR; ++e) d[PADI(base + e * stride)] = v[e];
    }
    __syncthreads();
}
template <int LOGN> __device__ __forceinline__ void fft_fwd(LAS f32x2* d, const LAS f32x2* tw, int tid) {
    if constexpr (LOGN == 13) { fft_pass<13, 4, false>(d, tw, 0, tid); fft_pass<13, 4, false>(d, tw, 4, tid); fft_pass<13, 4, false>(d, tw, 8, tid); fft_pass<13, 1, false>(d, tw, 12, tid); }
    else { fft_pass<9, 4, false>(d, tw, 0, tid); fft_pass<9, 4, false>(d, tw, 4, tid); fft_pass<9, 1, false>(d, tw, 8, tid); }
}
template <int LOGN> __device__ __forceinline__ void fft_inv(LAS f32x2* d, const LAS f32x2* tw, int tid) {
    if constexpr (LOGN == 13) { fft_pass<13, 1, true>(d, tw, 12, tid); fft_pass<13, 4, true>(d, tw, 8, tid); fft_pass<13, 4, true>(d, tw, 4, tid); fft_pass<13, 4, true>(d, tw, 0, tid); }
    else { fft_pass<9, 1, true>(d, tw, 8, tid); fft_pass<9, 4, true>(d, tw, 4, tid); fft_pass<9, 4, true>(d, tw, 0, tid); }
}
template <int LOGN> __device__ __forceinline__ void fft_fwd_head(LAS f32x2* d, const LAS f32x2* tw, int tid) {
    if constexpr (LOGN == 13) { fft_pass<13, 4, false>(d, tw, 0, tid); fft_pass<13, 4, false>(d, tw, 4, tid); fft_pass<13, 4, false>(d, tw, 8, tid); }
    else { fft_pass<9, 4, false>(d, tw, 0, tid); fft_pass<9, 4, false>(d, tw, 4, tid); }
}
template <int LOGN> __device__ __forceinline__ void fft_inv_tail(LAS f32x2* d, const LAS f32x2* tw, int tid) {
    if constexpr (LOGN == 13) { fft_pass<13, 4, true>(d, tw, 8, tid); fft_pass<13, 4, true>(d, tw, 4, tid); fft_pass<13, 4, true>(d, tw, 0, tid); }
    else { fft_pass<9, 4, true>(d, tw, 4, tid); fft_pass<9, 4, true>(d, tw, 0, tid); }
}
template <int LOGN> __device__ __forceinline__ void load_tw(LAS f32x2* tw, const f32x2* g, int tid) {
    for (int i = tid; i < (1 << (LOGN - 1)); i += 512) tw[i] = g[i];
}

template <int LOGN> __device__ __forceinline__ void kf_job(LAS unsigned char* lds, const float* hrawT, const f32x2* twg, f32x2* kf, int ch, int tid) {
    constexpr int N = 1 << LOGN, T = N / 2;
    LAS f32x2* d = (LAS f32x2*)lds; LAS f32x2* tw = (LAS f32x2*)(lds + FFT_TW_OFF); LAS float* red = (LAS float*)(lds + FFT_RED_OFF);
    float s = 0.f;
    { constexpr int NI = (N + 511) / 512; float hv[NI];
#pragma unroll
      for (int i = 0; i < NI; ++i) { const int n = tid + 512 * i; float v = 0.f;
          if (n < N) { if (n < T) v = hrawT[(size_t)ch * T + n]; else if (n > T) v = hrawT[(size_t)(256 + ch) * T + (N - n)]; }
          hv[i] = v; }
      load_tw<LOGN>(tw, twg, tid);
#pragma unroll
      for (int i = 0; i < NI; ++i) { const int n = tid + 512 * i; if (n < N) { d[PADI(n)] = (f32x2){hv[i], 0.f}; s += fabsf(hv[i]); } } }
    s = wave_sum(s);
    if ((tid & 63) == 0) red[tid >> 6] = s;
    __syncthreads();
    float tot = 0.f;
#pragma unroll
    for (int i = 0; i < 8; ++i) tot += red[i];
    const float inv = 1.0f / tot;
    for (int n = tid; n < N; n += 512) { f32x2 v = d[PADI(n)]; v.x *= inv; d[PADI(n)] = v; }
    __syncthreads();
    fft_fwd<LOGN>(d, tw, tid);
    for (int n = tid; n < N; n += 512) kf[(size_t)ch * N + n] = d[PADI(n)];
    __syncthreads();
}

template <int LOGN> __device__ __forceinline__ void hyena_job(LAS unsigned char* lds, const bf16_t* PTall, const f32x2* twg, const f32x2* kf, const float* wc, const float* bc, const float* hbias,
                                                            bf16_t* MIXp, int rowbase, int bp, int ch, int tid) {
    constexpr int N = 1 << LOGN, T = N / 2;
    constexpr int VEC = (T >= 4096) ? 8 : 1;
    constexpr int NKF = (N / 2 + 511) / 512;
    LAS f32x2* d = (LAS f32x2*)lds; LAS f32x2* tw = (LAS f32x2*)(lds + FFT_TW_OFF);
    f32x4 kfr[NKF];
#pragma unroll
    for (int i = 0; i < NKF; ++i) { const int g = tid + 512 * i; kfr[i] = (g < N / 2) ? *(const f32x4*)(kf + (size_t)ch * N + 2 * g) : (f32x4){0.f, 0.f, 0.f, 0.f}; }
    const float w10 = wc[256 + ch], w11 = wc[768 + 256 + ch], w12 = wc[1536 + 256 + ch], b1 = bc[256 + ch];
    const float w20 = wc[512 + ch], w21 = wc[768 + 512 + ch], w22 = wc[1536 + 512 + ch], b2 = bc[512 + ch];
    const float w00 = wc[ch], w01 = wc[768 + ch], w02 = wc[1536 + ch], b0 = bc[ch];
    const float hb = hbias[ch];
    const int t0 = tid * VEC; const bool act = t0 < T;
    float raw[2][3][VEC + 2];
#pragma unroll
    for (int bb = 0; bb < 2; ++bb)
#pragma unroll
        for (int st = 0; st < 3; ++st) {
            const bf16_t* p = PTall + ((size_t)(2 * bp + bb) * 768 + st * 256 + ch) * T;
            if (act) {
                if constexpr (VEC == 8) { const u32x4 w = *(const u32x4*)(p + t0);
                    raw[bb][st][1] = bflo(w.x); raw[bb][st][2] = bfhi(w.x); raw[bb][st][3] = bflo(w.y); raw[bb][st][4] = bfhi(w.y);
                    raw[bb][st][5] = bflo(w.z); raw[bb][st][6] = bfhi(w.z); raw[bb][st][7] = bflo(w.w); raw[bb][st][8] = bfhi(w.w); }
                else raw[bb][st][1] = bf2f(p[t0]);
                raw[bb][st][0] = t0 > 0 ? bf2f(p[t0 - 1]) : 0.f;
                raw[bb][st][VEC + 1] = (t0 + VEC < T) ? bf2f(p[t0 + VEC]) : 0.f;
            } else {
#pragma unroll
                for (int i = 0; i < VEC + 2; ++i) raw[bb][st][i] = 0.f;
            }
        }
    load_tw<LOGN>(tw, twg, tid);
    f32x2 ukeep[VEC]; float x0k[2][VEC];
#pragma unroll
    for (int i = 0; i < VEC; ++i) {
        f32x2 u;
#pragma unroll
        for (int bb = 0; bb < 2; ++bb) {
            const float x1 = raw[bb][1][i] * w10 + raw[bb][1][i + 1] * w11 + raw[bb][1][i + 2] * w12 + b1;
            const float vv = raw[bb][2][i] * w20 + raw[bb][2][i + 1] * w21 + raw[bb][2][i + 2] * w22 + b2;
            x0k[bb][i] = raw[bb][0][i] * w00 + raw[bb][0][i + 1] * w01 + raw[bb][0][i + 2] * w02 + b0;
            if (bb == 0) u.x = x1 * vv; else u.y = x1 * vv;
        }
        ukeep[i] = u;
        if (act) { d[PADI(t0 + i)] = u; d[PADI(t0 + i + T)] = (f32x2){0.f, 0.f}; }
    }
    __syncthreads();
    fft_fwd_head<LOGN>(d, tw, tid);
#pragma unroll
    for (int i = 0; i < NKF; ++i) { const int g = tid + 512 * i; if (g < N / 2) {
        const f32x2 a = d[PADI(2 * g)], b = d[PADI(2 * g + 1)]; const f32x2 fa = a + b, fb = a - b; const f32x4 k = kfr[i];
        const f32x2 ma = (f32x2){fa.x * k.x - fa.y * k.y, fa.x * k.y + fa.y * k.x}, mb = (f32x2){fb.x * k.z - fb.y * k.w, fb.x * k.w + fb.y * k.z};
        d[PADI(2 * g)] = ma + mb; d[PADI(2 * g + 1)] = ma - mb; } }
    __syncthreads();
    fft_inv_tail<LOGN>(d, tw, tid);
    const float sc = 1.0f / (float)N;
    if (act) {
#pragma unroll
        for (int i = 0; i < VEC; ++i) {
            const f32x2 y = d[PADI(t0 + i)] * sc; const f32x2 u = ukeep[i];
#pragma unroll
            for (int bb = 0; bb < 2; ++bb) {
                const float yy = bb == 0 ? y.x : y.y, uu = bb == 0 ? u.x : u.y;
                MIXp[(size_t)(rowbase + (2 * bp + bb) * T + t0 + i) * MIXK + 1024 + ch] = (bf16_t)f2bf(x0k[bb][i] * (yy + uu * hb));
            }
        }
    }
    __syncthreads();
}

__device__ __forceinline__ void norm_rows(int gw, int NGW, int lane, int nrows, const float* xl_in, const float* xc_in, float* xl_out, float* xc_out,
                                          const bf16_t* Y, const float* gpost, const float* modA, int ga_off,
                                          bf16_t* XN, const float* gpre, const float* modB, int sc_off, int sh_off, const bf16_t* xb_in, bf16_t* xb_out) {
    constexpr int NR = 2;
    const int per = (nrows + NGW - 1) / NGW; const int rbeg = gw * per; int rend = rbeg + per; if (rend > nrows) rend = nrows;
    f32x4 gpo[4], gpr[4];
#pragma unroll
    for (int j = 0; j < 4; ++j) { gpo[j] = Y ? *(const f32x4*)(gpost + 4 * lane + 256 * j) : (f32x4){0.f, 0.f, 0.f, 0.f}; gpr[j] = XN ? *(const f32x4*)(gpre + 4 * lane + 256 * j) : (f32x4){0.f, 0.f, 0.f, 0.f}; }
    int cur_mb = -1; f32x4 mga[4], msc[4], msh[4];
    for (int row0 = rbeg; row0 < rend; row0 += NR) {
        f32x4 v[NR][4]; u32x2 yw[NR][4]; bool ok[NR]; bool isc[NR]; int rowi[NR];
#pragma unroll
        for (int q = 0; q < NR; ++q) {
            const int row = row0 + q; ok[q] = row < rend; rowi[q] = ok[q] ? row : row0;
            isc[q] = rowi[q] >= ML;
            if (xb_in) {
#pragma unroll
                for (int j = 0; j < 4; ++j) { const u32x2 w = *(const u32x2*)(xb_in + (size_t)rowi[q] * DM + 4 * lane + 256 * j); v[q][j] = (f32x4){bflo(w.x), bfhi(w.x), bflo(w.y), bfhi(w.y)}; }
            } else {
                const float* xin = isc[q] ? xc_in + (size_t)(rowi[q] - ML) * DM : xl_in + (size_t)rowi[q] * DM;
#pragma unroll
                for (int j = 0; j < 4; ++j) v[q][j] = *(const f32x4*)(xin + 4 * lane + 256 * j);
            }
            if (Y) {
#pragma unroll
                for (int j = 0; j < 4; ++j) yw[q][j] = *(const u32x2*)(Y + (size_t)rowi[q] * DM + 4 * lane + 256 * j);
            }
        }
#pragma unroll
        for (int q = 0; q < NR; ++q) {
            const int mb = isc[q] ? 8 : (rowi[q] >> 12);
            if (mb != cur_mb) { cur_mb = mb;
#pragma unroll
                for (int j = 0; j < 4; ++j) { mga[j] = Y ? *(const f32x4*)(modA + (size_t)mb * 6144 + ga_off + 4 * lane + 256 * j) : (f32x4){0.f, 0.f, 0.f, 0.f};
                    msc[j] = XN ? *(const f32x4*)(modB + (size_t)mb * 6144 + sc_off + 4 * lane + 256 * j) : (f32x4){0.f, 0.f, 0.f, 0.f};
                    msh[j] = XN ? *(const f32x4*)(modB + (size_t)mb * 6144 + sh_off + 4 * lane + 256 * j) : (f32x4){0.f, 0.f, 0.f, 0.f}; } }
            if (Y) {
                float s = 0.f;
#pragma unroll
                for (int j = 0; j < 4; ++j) { const float a = bflo(yw[q][j].x), b = bfhi(yw[q][j].x), c = bflo(yw[q][j].y), d = bfhi(yw[q][j].y); s += (a * a + b * b) + (c * c + d * d); }
                const float rstd = rsqrtf(wave_sum(s) * (1.0f / DM) + EPS);
                float* xo = isc[q] ? xc_out + (size_t)(rowi[q] - ML) * DM : xl_out + (size_t)rowi[q] * DM;
#pragma unroll
                for (int j = 0; j < 4; ++j) { const f32x4 y = (f32x4){bflo(yw[q][j].x), bfhi(yw[q][j].x), bflo(yw[q][j].y), bfhi(yw[q][j].y)};
                    v[q][j] = v[q][j] + mga[j] * (y * rstd * gpo[j]);
                    if (ok[q]) { if (xb_out) { u32x2 w; w.x = pk2(v[q][j].x, v[q][j].y); w.y = pk2(v[q][j].z, v[q][j].w); *(u32x2*)(xb_out + (size_t)rowi[q] * DM + 4 * lane + 256 * j) = w; }
                                 else *(f32x4*)(xo + 4 * lane + 256 * j) = v[q][j]; } }
            }
            if (XN) {
                float s = 0.f;
#pragma unroll
                for (int j = 0; j < 4; ++j) s += (v[q][j].x * v[q][j].x + v[q][j].y * v[q][j].y) + (v[q][j].z * v[q][j].z + v[q][j].w * v[q][j].w);
                const float rstd = rsqrtf(wave_sum(s) * (1.0f / DM) + EPS);
#pragma unroll
                for (int j = 0; j < 4; ++j) { const f32x4 o = (v[q][j] * rstd * gpr[j]) * (1.0f + msc[j]) + msh[j]; u32x2 w; w.x = pk2(o.x, o.y); w.y = pk2(o.z, o.w);
                    if (ok[q]) *(u32x2*)(XN + (size_t)rowi[q] * DM + 4 * lane + 256 * j) = w; }
            }
        }
    }
}

__device__ __forceinline__ void glu_pass(int blk, int nblk, int tid, int r0, int nrows, const bf16_t* U, bf16_t* G, const float* wc, const float* bc) {
    const int nitems = nrows / 8;
    for (int it = blk; it < nitems; it += nblk) {
        for (int p = tid; p < 8 * 352; p += 512) {
            const int rl = it * 8 + p / 352, vc = p % 352, j0 = vc * 8; const int r = r0 + rl;
            int t, len; if (r >= ML) { t = (r - ML) & (CL - 1); len = CL; } else { t = r & (SL - 1); len = SL; }
            const bool hm = t > 0, hp = t < len - 1;
            const bf16_t* ur = U + (size_t)rl * UPW + j0;
            const u32x4 z4 = (u32x4){0u, 0u, 0u, 0u};
            const u32x4 g0 = *(const u32x4*)ur, gm = hm ? *(const u32x4*)(ur - UPW) : z4, gp = hp ? *(const u32x4*)(ur + UPW) : z4;
            const u32x4 v0 = *(const u32x4*)(ur + DFF), vm = hm ? *(const u32x4*)(ur + DFF - UPW) : z4, vp = hp ? *(const u32x4*)(ur + DFF + UPW) : z4;
            unsigned outw[4];
#pragma unroll
            for (int q = 0; q < 4; ++q) {
                float res[2];
#pragma unroll
                for (int h = 0; h < 2; ++h) {
                    const int j = j0 + 2 * q + h;
                    const float a_m = h ? bfhi(gm[q]) : bflo(gm[q]), a_0 = h ? bfhi(g0[q]) : bflo(g0[q]), a_p = h ? bfhi(gp[q]) : bflo(gp[q]);
                    const float c_m = h ? bfhi(vm[q]) : bflo(vm[q]), c_0 = h ? bfhi(v0[q]) : bflo(v0[q]), c_p = h ? bfhi(vp[q]) : bflo(vp[q]);
                    const float cg = a_m * wc[j] + a_0 * wc[UPW + j] + a_p * wc[2 * UPW + j] + bc[j];
                    const float cv = c_m * wc[DFF + j] + c_0 * wc[UPW + DFF + j] + c_p * wc[2 * UPW + DFF + j] + bc[DFF + j];
                    const float sg = cg / (1.0f + __expf(-cg));
                    res[h] = sg * cv;
                }
                outw[q] = pk2(res[0], res[1]);
            }
            *(u32x4*)(G + (size_t)rl * DFF + j0) = (u32x4){outw[0], outw[1], outw[2], outw[3]};
        }
    }
}

__device__ __forceinline__ void transpose_item(const float* W, int ldw, bf16_t* WT, int ldt, int nblk, int item, LAS float* scr, int lane, bool remap = false) {
    const int kb = item / nblk, nb = item % nblk, k0 = 64 * kb, n0 = 32 * nb;
    int n0d = n0;
    if (remap) { if (n0 < DFF) n0d = 256 * (n0 >> 7) + (n0 & 127); else { const int c = n0 - DFF; n0d = 256 * (c >> 7) + 128 + (c & 127); } }
    float tv[32];
#pragma unroll
    for (int i = 0; i < 32; ++i) tv[i] = W[(size_t)(k0 + 2 * i + (lane >> 5)) * ldw + n0 + (lane & 31)];
#pragma unroll
    for (int i = 0; i < 32; ++i) scr[(2 * i + (lane >> 5)) * 33 + (lane & 31)] = tv[i];
    asm volatile("s_waitcnt lgkmcnt(0)" ::: "memory");
    const int c = lane & 7;
#pragma unroll
    for (int j = 0; j < 4; ++j) { const int n = (lane >> 3) + 8 * j; const LAS float* s = scr + (8 * c) * 33 + n;
        u32x4 o; o.x = pk2(s[0 * 33], s[1 * 33]); o.y = pk2(s[2 * 33], s[3 * 33]); o.z = pk2(s[4 * 33], s[5 * 33]); o.w = pk2(s[6 * 33], s[7 * 33]);
        *(u32x4*)(WT + (size_t)(n0d + n) * ldt + k0 + 8 * c) = o; }
    asm volatile("s_waitcnt lgkmcnt(0)" ::: "memory");
}
}

using namespace mk;
#ifndef MK_TMASK
#define MK_TMASK 0
#endif
#define TSTART() unsigned long long tts_ = 0; if (MK_TMASK) tts_ = __builtin_amdgcn_s_memrealtime();
#define TSTOP(c) if (MK_TMASK && ((MK_TMASK >> (c)) & 1)) tacc_ += __builtin_amdgcn_s_memrealtime() - tts_;
typedef const __attribute__((address_space(4))) Params* KP;
__device__ __forceinline__ KP kp_get() { KP p = (KP)__builtin_amdgcn_kernarg_segment_ptr(); asm volatile("" : "+s"(p)); return p; }
#ifndef MK_REP
#define MK_REP 0
#endif
#define REP(k) for (int rep_ = 0; rep_ < 1 + ((MK_REP >> (k)) & 1); ++rep_)
#ifndef MK_EN
#define MK_EN 0xffff
#endif
#define EN(k) if constexpr ((MK_EN >> (k)) & 1)
constexpr int LDS_BYTES = 159744;
constexpr int XCH_OFF = 131072;
constexpr int MISC_OFF = 131072 + 8192 + 18432;

#define RLX_AGENT __ATOMIC_RELAXED, __HIP_MEMORY_SCOPE_AGENT
#define XB_TMO      128
#define XB_XCNT(j)  (256  + 64 * (j))
#define XB_XSUB(j)  (1280 + 64 * (j))
#define XB_XGEN(j)  (2304 + 64 * (j))
#define XB_TOP      3328
#define XB_TOPGEN   3392
#define XCD_BAR_WORDS 3456
#define XB_SPIN_CAP (1u << 18)

__device__ __forceinline__ unsigned xb_ld(unsigned* p)              { return __hip_atomic_load(p, __ATOMIC_RELAXED, __HIP_MEMORY_SCOPE_AGENT); }
__device__ __forceinline__ unsigned xb_add(unsigned* p, unsigned v) { return __hip_atomic_fetch_add(p, v, __ATOMIC_RELAXED, __HIP_MEMORY_SCOPE_AGENT); }
__device__ __forceinline__ unsigned xb_xcc_id() { return (unsigned)__builtin_amdgcn_s_getreg((3 << 11) | 20) & 0xFu; }
#define XB_SPIN(cond, bar) do { unsigned _sp = 0; while (cond) { __builtin_amdgcn_s_sleep(1); \
    if ((++_sp & 255u) == 0u) { if (xb_ld(&(bar)[XB_TMO])) break; if (_sp > XB_SPIN_CAP) { atomicAdd(&(bar)[XB_TMO], 1u); break; } } } } while (0)

struct XcdBarrier {
    unsigned* bar; unsigned x;
    volatile LAS unsigned* st;
};

__device__ __forceinline__ XcdBarrier xcd_barrier_post(unsigned* bar, volatile LAS unsigned* st) {
    XcdBarrier b; b.bar = bar; b.x = xb_xcc_id(); b.st = st;
    if (threadIdx.x == 0) (void)xb_add(&bar[XB_XCNT(b.x)], 1u);
    return b;
}
__device__ __forceinline__ void xcd_barrier_complete(unsigned* bar, unsigned x, unsigned& nloc, unsigned& nx) {
    const unsigned G = gridDim.x * gridDim.y * gridDim.z;
    unsigned sum, cnt, mine, sp = 0u;
    for (;;) {
        sum = 0u; cnt = 0u; mine = 0u;
#pragma unroll
        for (unsigned j = 0; j < 16; ++j) { const unsigned c = xb_ld(&bar[XB_XCNT(j)]); sum += c; cnt += (c > 0u) ? 1u : 0u; mine = (j == x) ? c : mine; }
        if (sum == G) break;
        __builtin_amdgcn_s_sleep(1);
        if ((++sp & 255u) == 0u) { if (xb_ld(&bar[XB_TMO])) break; if (sp > XB_SPIN_CAP) { atomicAdd(&bar[XB_TMO], 1u); break; } }
    }
    nloc = mine > 0u ? mine : 1u; nx = cnt > 0u ? cnt : 1u;
}

__device__ __forceinline__ void xcd_barrier(const XcdBarrier& b) {
    asm volatile("s_waitcnt vmcnt(0)" ::: "memory");
    __syncthreads();
    if (threadIdx.x == 0) {
        unsigned* bar = b.bar;
        __builtin_amdgcn_s_waitcnt(0);
        unsigned nloc = b.st[0], nx = b.st[1];
        if (nloc == 0u) { xcd_barrier_complete(bar, b.x, nloc, nx); b.st[0] = nloc; b.st[1] = nx; }
        const unsigned old = xb_add(&bar[XB_XSUB(b.x)], 1u);
        const unsigned gen = old / nloc;
        if (old + 1u == (gen + 1u) * nloc) {
            __builtin_amdgcn_fence(__ATOMIC_RELEASE, "agent");
            asm volatile("s_waitcnt vmcnt(0)" ::: "memory");
            const unsigned og = xb_add(&bar[XB_TOP], 1u);
            const unsigned tg = og / nx;
            if (og + 1u == (tg + 1u) * nx) xb_add(&bar[XB_TOPGEN], 1u);
            else XB_SPIN(xb_ld(&bar[XB_TOPGEN]) == tg, bar);
            __builtin_amdgcn_fence(__ATOMIC_ACQUIRE, "agent");
            xb_add(&bar[XB_XGEN(b.x)], 1u);
            asm volatile("s_waitcnt vmcnt(0)" ::: "memory");
        } else {
            XB_SPIN(xb_ld(&bar[XB_XGEN(b.x)]) == gen, bar);
            __builtin_amdgcn_fence(__ATOMIC_ACQUIRE, "agent");
            asm volatile("s_waitcnt vmcnt(0)" ::: "memory");
        }
    }
    __syncthreads();
}

__device__ __forceinline__ bf16_t* wlayer(unsigned char* ws, int l, size_t off) { return (bf16_t*)(ws + WS_W + (size_t)l * W_LAYER + off); }
constexpr size_t OFF_WIN = 0, OFF_WOUT = 4 * MiB, OFF_WUP = 7 * MiB, OFF_WDOWN = 18 * MiB;

__device__ __forceinline__ void setup0(KP pp, LAS unsigned char* lds, int tid, int lane, int wave, unsigned long long& tacc_) {
    unsigned char* ws = pp->ws;
    { TSTART()
        LAS float* scr = (LAS float*)(lds + wave * 16384);
        const int gw = blockIdx.x * 8 + wave, NGW = gridDim.x * 8;
        constexpr int I_IN = 16 * 56, I_UP = 16 * 176, I_DN = 44 * 32, I_OA = 8 * 32, I_OH = 4 * 32, I_L = I_IN + I_UP + I_DN + I_OA + I_OH;
        for (int it = gw; it < 2 * I_L; it += NGW) {
            const int l = it / I_L; int r = it % I_L;
            if (r < I_IN) { transpose_item(pp->in[I_WIN] + (size_t)l * DM * INW, INW, wlayer(ws, l, OFF_WIN), DM, 56, r, scr, lane); continue; } r -= I_IN;
            if (r < I_UP) { transpose_item(pp->in[I_WUP] + (size_t)l * DM * UPW, UPW, wlayer(ws, l, OFF_WUP), DM, 176, r, scr, lane, true); continue; } r -= I_UP;
            if (r < I_DN) { transpose_item(pp->in[I_WDOWN] + (size_t)l * DFF * DM, DM, wlayer(ws, l, OFF_WDOWN), DFF, 32, r, scr, lane); continue; } r -= I_DN;
            if (r < I_OA) { transpose_item(pp->in[I_WOUT] + (size_t)l * DM * DM, DM, wlayer(ws, l, OFF_WOUT), MIXK, 32, r, scr, lane); continue; } r -= I_OA;
            transpose_item(pp->in[I_WOUT] + (size_t)l * DM * DM + (size_t)768 * DM, DM, wlayer(ws, l, OFF_WOUT) + 1024, MIXK, 32, r, scr, lane);
        }
    __syncthreads(); TSTOP(9) }
    constexpr int N_MOD = 192, N_MLP = 512 + 32 + 512, N_DFT = 4096 + 256, N_T = 512, N_TAB = 1;
    constexpr int NIT = N_MOD + N_MLP + N_DFT + N_T + N_TAB;
    LAS float* fl = (LAS float*)lds; bool tab_ready = false;
    for (int it = blockIdx.x; it < NIT; it += gridDim.x) {
        int r = it; TSTART()
        if (r < N_MOD) {
            const int l = r / 96, cb = (r % 96) / 8, kc = r % 8;
            for (int idx = tid; idx < 9 * 128; idx += 512) { const int rr = idx / 128, k = idx % 128; const float cv = rr < 8 ? pp->in[I_C][rr * DM + kc * 128 + k] : pp->in[I_CCTX][kc * 128 + k];
                fl[idx] = cv / (1.0f + __expf(-cv)); }
            __syncthreads();
            const int j = cb * 512 + tid; float acc[9];
#pragma unroll
            for (int rr = 0; rr < 9; ++rr) acc[rr] = 0.f;
            const float* wm = pp->in[I_WMOD] + (size_t)l * DM * 6144 + (size_t)(kc * 128) * 6144 + j;
            for (int k0 = 0; k0 < 128; k0 += 32) { float wv_[32];
#pragma unroll
              for (int kk = 0; kk < 32; ++kk) wv_[kk] = wm[(size_t)(k0 + kk) * 6144];
#pragma unroll
              for (int kk = 0; kk < 32; ++kk) {
#pragma unroll
                for (int rr = 0; rr < 9; ++rr) acc[rr] += fl[rr * 128 + k0 + kk] * wv_[kk]; } }
            float* mp = (float*)(ws + WS_MODP) + ((size_t)(l * 8 + kc) * 9) * 6144 + j;
#pragma unroll
            for (int rr = 0; rr < 9; ++rr) mp[(size_t)rr * 6144] = acc[rr];
            __syncthreads(); TSTOP(10)
            continue;
        }
        r -= N_MOD;
        if (r < N_MLP) {
            int l, which, t0;
            if (r < 512) { l = 0; which = 0; t0 = r * 8; } else if (r < 544) { l = 0; which = 1; t0 = (r - 512) * 8; } else { l = 1; which = 0; t0 = (r - 544) * 8; }
            const int T = which ? CL : SL;
            LAS float* Z = fl; LAS float* H1 = fl + 8 * 36; LAS float* H2 = H1 + 512;
            if (tid < 128) { const int p = tid >> 4, i = tid & 15; const int t = t0 + p; const float band = 1e-4f + (float)i * ((15.0f - 1e-4f) / 15.0f);
                const float ang = ((6.2831855f * (float)t) / (float)T) * band; Z[p * 36 + 1 + i] = cosf(ang); Z[p * 36 + 17 + i] = -sinf(ang);
                if (i == 0) Z[p * 36] = (float)t / (float)(T - 1); }
            __syncthreads();
            { const int p = tid >> 6, j = tid & 63; const float* w1 = pp->in[I_HW1] + (size_t)l * 33 * 64; float s = pp->in[I_HB1][l * 64 + j];
              float wr_[33];
#pragma unroll
              for (int i = 0; i < 33; ++i) wr_[i] = w1[i * 64 + j];
#pragma unroll
              for (int i = 0; i < 33; ++i) s += Z[p * 36 + i] * wr_[i];
              H1[p * 64 + j] = sinf(pp->in[I_HFR1][l * 64 + j] * s); }
            __syncthreads();
            { const int p = tid >> 6, j = tid & 63; const float* w2 = pp->in[I_HW2] + (size_t)l * 64 * 64; float s = pp->in[I_HB2][l * 64 + j];
              float wr_[64];
#pragma unroll
              for (int i = 0; i < 64; ++i) wr_[i] = w2[i * 64 + j];
#pragma unroll
              for (int i = 0; i < 64; ++i) s += H1[p * 64 + i] * wr_[i];
              H2[p * 64 + j] = sinf(pp->in[I_HFR2][l * 64 + j] * s); }
            __syncthreads();
            { const int j = tid; const float* w3 = pp->in[I_HW3] + (size_t)l * 64 * 512 + j; float acc[8];
#pragma unroll
              for (int p = 0; p < 8; ++p) acc[p] = 0.f;
              float wr_[64];
#pragma unroll
              for (int i = 0; i < 64; ++i) wr_[i] = w3[(size_t)i * 512];
#pragma unroll
              for (int i = 0; i < 64; ++i) {
#pragma unroll
                  for (int p = 0; p < 8; ++p) acc[p] += H2[p * 64 + i] * wr_[i]; }
              const float da = -3.0701134573253944f, db = -15.350567286626972f;
              const float delta = fabsf(da + (float)(j & 255) * ((db - da) / 255.0f));
              float* hr = (float*)(ws + WS_HRAW) + (which ? (size_t)2 * 512 * SL : (size_t)l * 512 * SL) + (size_t)j * T + t0;
#pragma unroll
              for (int p = 0; p < 8; ++p) hr[p] = acc[p] * expf(-Z[p * 36] * delta); }
            __syncthreads(); TSTOP(11)
            continue;
        }
        r -= N_MLP;
        if (r < N_DFT) {
            LAS float* ctab = (LAS float*)(lds + 65536);
            if (!tab_ready) { for (int q = tid; q < 4096; q += 512) ctab[q] = cospif((float)q * (1.0f / 2048.0f)) * (1.0f / 512.0f); tab_ready = true; __syncthreads(); }
            if (r < 4096) { bf16_t* row = (bf16_t*)(ws + WS_ADFT) + (size_t)r * 4096; const bool isS = r > 2048; const int k = isS ? r - 2048 : r; const int sh = isS ? 3072 : 0;
                for (int t = tid * 2; t < 4096; t += 1024) { const float v0 = ctab[((k * t) + sh) & 4095], v1 = ctab[((k * (t + 1)) + sh) & 4095]; *(unsigned*)(row + t) = pk2(v0, v1); } }
            else { const int rr = r - 4096; bf16_t* row = (bf16_t*)(ws + WS_ADFTC) + (size_t)rr * 256; const bool isS = rr > 128; const int k = isS ? rr - 128 : rr; const int sh = isS ? 3072 : 0;
                if (tid < 256) { const float v = ctab[(((k * tid) & 255) * 16 + sh) & 4095] * 4.0f; row[tid] = (bf16_t)f2bf(v); } }
            TSTOP(12) continue;
        }
        r -= N_DFT;
        if (r < N_T) {
            LAS float* ctab = (LAS float*)(lds + 65536);
            if (!tab_ready) { for (int q = tid; q < 4096; q += 512) ctab[q] = cospif((float)q * (1.0f / 2048.0f)) * (1.0f / 512.0f); tab_ready = true; __syncthreads(); }
            const int rr2 = 2 * r + (tid >> 8); const int l = rr2 >> 9, kk = rr2 & 511; const bool isS = kk >= 256; const int gc = kk & 255, g = gc >> 6, c = gc & 63; const int j = tid & 255;
            const float* wf = pp->in[I_WF] + (size_t)l * 256 * 256 + (size_t)(g * 64) * 256 + j; float s = 0.f;
#pragma unroll 16
            for (int m = 0; m < 64; ++m) { const int q = ((m * c) & 63) * 64; const float tr = isS ? -ctab[(q + 3072) & 4095] : ctab[q]; s += tr * wf[(size_t)m * 256]; }
            ((float*)(ws + WS_T))[((size_t)l * 512 + kk) * 256 + j] = s * 512.0f;
            TSTOP(13) continue;
        }
        { f32x2* tw = (f32x2*)(ws + WS_TW);
          for (int i = tid; i < 4096; i += 512) { const float x = (float)i * (1.0f / 4096.0f); tw[i] = (f32x2){cospif(x), -sinpif(x)}; }
          f32x2* tw2 = (f32x2*)(ws + WS_TW + 65536);
          if (tid < 256) { const float x = (float)tid * (1.0f / 256.0f); tw2[tid] = (f32x2){cospif(x), -sinpif(x)}; }
          float* rope = (float*)(ws + WS_TW + 131072);
          for (int i = tid; i < 1024; i += 512) { const int p = i >> 4, q = i & 15; const float inv = powf(10000.0f, -(float)q / 16.0f); const float a = (float)p * inv; rope[i] = cosf(a); rope[1024 + i] = sinf(a); } }
    }
}

__device__ __forceinline__ void setup1(KP pp, LAS unsigned char* lds, int tid, unsigned long long& tacc_) {
    unsigned char* ws = pp->ws;
    { const int gt = blockIdx.x * 512 + tid, NGT = gridDim.x * 512;
      for (int idx = gt; idx < 2 * 9 * 6144; idx += NGT) { const int l = idx / (9 * 6144), rj = idx % (9 * 6144), j = rj % 6144; float s = pp->in[I_BMOD][l * 6144 + j];
#pragma unroll
          for (int kc = 0; kc < 8; ++kc) s += ((const float*)(ws + WS_MODP))[((size_t)(l * 8 + kc) * 9) * 6144 + rj];
          ((float*)(ws + WS_MOD))[idx] = s; } }
    constexpr int N_KF = 768, N_W2 = 256;
    LAS float* fl = (LAS float*)lds;
    for (int it = blockIdx.x; it < N_KF + N_W2; it += gridDim.x) { TSTART()
        if (it < N_KF) {
            if (it < 512) { const int l = it >> 8, ch = it & 255;
                kf_job<13>(lds, (const float*)(ws + WS_HRAW) + (size_t)l * 512 * SL, (const f32x2*)(ws + WS_TW), (f32x2*)(ws + WS_KF) + (size_t)l * 256 * 8192, ch, tid); }
            else { const int ch = it - 512;
                kf_job<9>(lds, (const float*)(ws + WS_HRAW) + (size_t)2 * 512 * SL, (const f32x2*)(ws + WS_TW + 65536), (f32x2*)(ws + WS_KFC), ch, tid); }
            TSTOP(14) continue;
        }
        const int r = it - N_KF; const int l = r >> 7, nh = (r >> 6) & 1, kb = r & 63;
        for (int idx = tid; idx < 8 * 256; idx += 512) fl[idx] = ((const float*)(ws + WS_T))[((size_t)l * 512 + 8 * kb) * 256 + idx];
        __syncthreads();
        { const int n = nh * 512 + tid; const float* wo = pp->in[I_WOUT] + (size_t)l * DM * DM + (size_t)512 * DM + n; float s[8];
#pragma unroll
          for (int q = 0; q < 8; ++q) s[q] = 0.f;
          for (int j0 = 0; j0 < 256; j0 += 32) { float wv_[32];
#pragma unroll
            for (int jj = 0; jj < 32; ++jj) wv_[jj] = wo[(size_t)(j0 + jj) * DM];
#pragma unroll
            for (int jj = 0; jj < 32; ++jj) { const int j = j0 + jj; const float w = wv_[jj];
#pragma unroll
              for (int q = 0; q < 8; ++q) s[q] += fl[q * 256 + j] * w; } }
          bf16_t* dst = wlayer(ws, l, OFF_WOUT) + (size_t)n * MIXK + 512 + 8 * kb;
          u32x4 o; o.x = pk2(s[0], s[1]); o.y = pk2(s[2], s[3]); o.z = pk2(s[4], s[5]); o.w = pk2(s[6], s[7]);
          *(u32x4*)dst = o; }
        __syncthreads(); TSTOP(15)
    }
}


__device__ __forceinline__ int ph_class(int ph) {
    if (ph < 2) return 0; if (ph == 2) return 1;
    const int r = (ph - 3) & 7;
    return r == 0 ? 2 : r == 1 ? 3 : r == 2 ? 4 : r == 3 ? 5 : r == 4 ? 6 : r == 5 ? 7 : r == 6 ? 8 : 5;
}
__global__ void __launch_bounds__(512, 2) mega_fwd(Params P) {
    extern __shared__ __attribute__((aligned(16))) unsigned char lds_raw[];
    LAS unsigned char* lds = (LAS unsigned char*)lds_raw;
    { volatile LAS unsigned* m0 = (volatile LAS unsigned*)(lds + MISC_OFF); if (threadIdx.x < 32) m0[threadIdx.x] = 0u; }
    __syncthreads();
    XcdBarrier xbar;
    { KP pb = kp_get(); xbar = xcd_barrier_post((unsigned*)(pb->ws + WS_CTL) + 4096, (volatile LAS unsigned*)(lds + MISC_OFF) + 8);
      if (pb->ph_lo < 0) cg::this_grid().sync(); }
    int ph = 0; unsigned long long tacc_ = 0;
#define PH_BEGIN { unsigned long long tph0_ = 0; if (MK_TMASK) tph0_ = __builtin_amdgcn_s_memrealtime(); KP pp = kp_get(); const int lo = pp->ph_lo, hi = pp->ph_hi; if (ph >= lo && ph < hi) { unsigned char* ws = pp->ws; const int tid = mk_tid(), lane = tid & 63, wave = __builtin_amdgcn_readfirstlane(tid >> 6); const int G = gridDim.x, gw = blockIdx.x * 8 + wave, NGW = G * 8; (void)lane; (void)gw; (void)NGW; PTRS
#define PH_END   if (ph + 1 < hi) xcd_barrier(xbar); } if (MK_TMASK && ((MK_TMASK >> ph_class(ph)) & 1)) tacc_ += __builtin_amdgcn_s_memrealtime() - tph0_; } ++ph;
#define PTRS \
    bf16_t* XN = (bf16_t*)(ws + WS_XN); bf16_t* Qb = (bf16_t*)(ws + WS_Q); bf16_t* Kb = (bf16_t*)(ws + WS_K); bf16_t* Vb = (bf16_t*)(ws + WS_V); \
    bf16_t* fT = (bf16_t*)(ws + WS_FT); bf16_t* fTc = (bf16_t*)(ws + WS_FTC); bf16_t* PT = (bf16_t*)(ws + WS_PT); bf16_t* PTc = (bf16_t*)(ws + WS_PTC); \
    bf16_t* MIXb = (bf16_t*)(ws + WS_MIX); bf16_t* Ub = (bf16_t*)(ws + WS_U); bf16_t* Gb = (bf16_t*)(ws + WS_G); \
    float* CX = (float*)(ws + WS_CX); const float* MOD = (const float*)(ws + WS_MOD); \
    const float* rope = (const float*)(ws + WS_TW + 131072); \
    volatile LAS int* misc = (volatile LAS int*)(lds + MISC_OFF); \
    (void)XN; (void)Qb; (void)Kb; (void)Vb; (void)fT; (void)fTc; (void)PT; (void)PTc; (void)MIXb; (void)Ub; (void)Gb; (void)CX; (void)MOD; (void)rope; (void)misc;

    REP(6) { PH_BEGIN EN(0) setup0(pp, lds, tid, lane, wave, tacc_); PH_END --ph; } ++ph;
    REP(8) { PH_BEGIN EN(1) setup1(pp, lds, tid, tacc_); PH_END --ph; } ++ph;
    PH_BEGIN REP(9) EN(2) norm_rows(gw, NGW, lane, MT, pp->in[I_X], pp->in[I_CTX], pp->out, CX, nullptr, nullptr, nullptr, 0, XN, pp->in[I_GPREMIX], MOD, 1024, 0, nullptr, nullptr); PH_END

    for (int l = 0; l < 2; ++l) {
        const bool last = (l == 1);
        const int MR = last ? ML : MT;
        PH_BEGIN {
            pg8::Gemm g{XN, wlayer(ws, l, OFF_WIN), MT, INW, DM}; pg8::StaticOrder S; S.init(MT, INW, G, (int)blockIdx.x);
            EpiInProj E{Qb, Kb, Vb, fT, fTc, PT, PTc, pp->in[I_GQ] + l * 64, pp->in[I_GK] + l * 64, rope, (LAS float*)(lds + XCH_OFF)};
            REP(0) EN(3) pg8::gemm_phase<EpiInProj, pg8::StaticOrder, true, true>(lds, g, S, E);
        } PH_END
        PH_BEGIN {
            const int nF = last ? 128 : 136, nA = last ? 1024 : 1088, nH1 = last ? 1024 : 2048, nH = nH1 * (1 + ((MK_REP >> 7) & 1));
            const int nFx = last ? 16 : 17, nAx = last ? 128 : 136, nHx = last ? 128 : 256, cntq = nFx + nAx + nHx;
            int nxt_ = 0, q0_ = (int)(xb_xcc_id() & 7u), tried_ = 0;
            if (mk_tid() == 0) nxt_ = (int)atomicAdd((unsigned*)(ws + WS_CTL) + 64 * (8 + 16 * l + q0_), 1u);
            for (;;) {
                KP pq = kp_get(); unsigned char* wq = pq->ws; const int tq = mk_tid(); TSTART()
                if (tq == 0) {
                    int t_ = nxt_;
                    while (t_ >= cntq && tried_ < 7) { q0_ = (q0_ + 1) & 7; ++tried_; t_ = (int)atomicAdd((unsigned*)(wq + WS_CTL) + 64 * (8 + 16 * l + q0_), 1u); }
                    misc[0] = (t_ >= cntq) ? -1 : t_; misc[2] = q0_;
                    if (t_ < cntq) nxt_ = (int)atomicAdd((unsigned*)(wq + WS_CTL) + 64 * (8 + 16 * l + q0_), 1u);
                }
                __syncthreads();
                int jt = misc[0]; const int qx = misc[2];
                __syncthreads();
                if (jt < 0) break;
                int it;
                if (jt < nFx) it = jt < 16 ? jt * 8 + qx : 128 + qx;
                else { jt -= nFx;
                    if (jt < nAx) it = nF + (jt < 128 ? qx * 128 + jt : 1024 + qx * 8 + (jt - 128));
                    else { jt -= nAx; const int hb_ = (qx >> 1) * 256 + (qx & 1) * 128; it = nF + nA + (jt < 128 ? hb_ + jt : 1024 + hb_ + (jt - 128)); } }
                TSTOP(19) if (MK_TMASK) tts_ = __builtin_amdgcn_s_memrealtime();
                bf16_t* MIXq = (bf16_t*)(wq + WS_MIX);
                if (it < nF) {
                    if (it < 128) { pg8::Gemm g{(const bf16_t*)(wq + WS_ADFT), (const bf16_t*)(wq + WS_FT), 4096, 2048, 4096}; OneUnit S{it >> 3, it & 7}; EpiFourier E{MIXq, 2048, 0, SL};
                        REP(3) EN(4) pg8::gemm_phase<EpiFourier, OneUnit, false, true>(lds, g, S, E); }
                    else { pg8::Gemm g{(const bf16_t*)(wq + WS_ADFTC), (const bf16_t*)(wq + WS_FTC), 256, 2048, 256}; OneUnit S{0, it - 128}; EpiFourier E{MIXq, 128, ML, CL};
                        REP(3) EN(4) pg8::gemm_phase<EpiFourier, OneUnit, false, true>(lds, g, S, E); }
                    TSTOP(16) continue;
                }
                it -= nF;
                if (it < nA) {
                    const bf16_t* Qq = (const bf16_t*)(wq + WS_Q); const bf16_t* Kq = (const bf16_t*)(wq + WS_K); const bf16_t* Vq = (const bf16_t*)(wq + WS_V);
                    int b, h, NT; size_t qrow;
                    if (it < 1024) { b = it >> 7; h = (it >> 4) & 7; qrow = (size_t)b * SL + (it & 15) * 256; NT = KVB / 64; }
                    else { const int r = it - 1024; b = r >> 3; h = r & 7; qrow = (size_t)ML + b * CL; NT = CL / 64; }
                    const size_t kv0 = (size_t)b * KVB;
                    REP(1) EN(5) attn_body::attn_unit2<8>((const attn_body::bf16*)(Qq + qrow * QP + h * 64), (const attn_body::bf16*)(Kq + kv0 * KVP + (h >> 2) * 64), (const attn_body::bf16*)(Vq + kv0 * KVP + (h >> 2) * 64), (attn_body::bf16*)(MIXq + qrow * MIXK + h * 64), NT, (char*)lds_raw);
                    TSTOP(17) continue;
                }
                it -= nA; if (it >= nH1) it -= nH1;
                const float* wc = pq->in[I_WHC] + (size_t)l * 3 * 768; const float* bc = pq->in[I_BHC] + (size_t)l * 768; const float* hb = pq->in[I_HBIAS] + (size_t)l * 256;
                REP(2) EN(6) { if (it < 1024) hyena_job<13>(lds, (const bf16_t*)(wq + WS_PT), (const f32x2*)(wq + WS_TW), (const f32x2*)(wq + WS_KF) + (size_t)l * 256 * 8192, wc, bc, hb, MIXq, 0, it >> 8, it & 255, tq);
                else { const int r = it - 1024; hyena_job<9>(lds, (const bf16_t*)(wq + WS_PTC), (const f32x2*)(wq + WS_TW + 65536), (const f32x2*)(wq + WS_KFC), wc, bc, hb, MIXq, ML, r >> 8, r & 255, tq); } }
                TSTOP(18)
            }
        } PH_END
        PH_BEGIN {
            pg8::Gemm g{MIXb, wlayer(ws, l, OFF_WOUT), MR, DM, MIXK}; pg8::StaticOrder S; S.init(MR, DM, G, (int)blockIdx.x);
            EpiPlain E{XN, DM};
            REP(5) EN(7) pg8::gemm_phase<EpiPlain, pg8::StaticOrder, false, true>(lds, g, S, E);
        } PH_END
        PH_BEGIN EN(2) norm_rows(gw, NGW, lane, MR, pp->in[I_X], pp->in[I_CTX], pp->out, CX, XN, pp->in[I_GPOSTMIX] + l * DM, (MOD + (size_t)l * 9 * 6144), 2048,
                           XN, pp->in[I_GPREFFN] + l * DM, (MOD + (size_t)l * 9 * 6144), 4096, 3072, l == 0 ? nullptr : (const bf16_t*)(ws + WS_XB), (bf16_t*)(ws + WS_XB)); PH_END
        PH_BEGIN {
            pg8::Gemm g{XN, wlayer(ws, l, OFF_WUP), MR, UPW, DM}; pg8::StaticOrder S; S.init(MR, UPW, G, (int)blockIdx.x);
            EpiGlu E{Gb, (bf16_t*)(ws + WS_SB), pp->in[I_WFC] + (size_t)l * 3 * UPW, pp->in[I_BFC] + (size_t)l * UPW, (LAS float*)(lds + XCH_OFF)};
            REP(4) EN(8) pg8::gemm_phase<EpiGlu, pg8::StaticOrder, true, true>(lds, g, S, E);
        } PH_END
        PH_BEGIN EN(9) glu_fixup((int)blockIdx.x, G, tid, MR / 256, (const bf16_t*)(ws + WS_SB), Gb, pp->in[I_WFC] + (size_t)l * 3 * UPW, pp->in[I_BFC] + (size_t)l * UPW); PH_END
        PH_BEGIN {
            pg8::Gemm g{Gb, wlayer(ws, l, OFF_WDOWN), MR, DM, DFF}; pg8::StaticOrder S; S.init(MR, DM, G, (int)blockIdx.x);
            EpiPlain E{XN, DM};
            REP(4) EN(10) pg8::gemm_phase<EpiPlain, pg8::StaticOrder, false, true>(lds, g, S, E);
        } PH_END
        PH_BEGIN EN(2) norm_rows(gw, NGW, lane, MR, pp->in[I_X], pp->in[I_CTX], pp->out, CX, XN, pp->in[I_GPOSTFFN] + l * DM, (MOD + (size_t)l * 9 * 6144), 5120,
                           last ? nullptr : XN, pp->in[I_GPREMIX] + (last ? 0 : (l + 1) * DM), MOD + (size_t)(last ? 0 : (l + 1)) * 9 * 6144, 1024, 0,
                           (const bf16_t*)(ws + WS_XB), last ? nullptr : (bf16_t*)(ws + WS_XB)); PH_END
    }
    if (MK_TMASK) { if (blockIdx.x == 0 && threadIdx.x == 0) { const unsigned long long t0_ = __builtin_amdgcn_s_memrealtime(); while (__builtin_amdgcn_s_memrealtime() - t0_ < 4ull * tacc_) __builtin_amdgcn_s_sleep(8); } }
}

constexpr int N_PHASES = 3 + 2 * 8;
#ifndef MK_MULTI
#define MK_MULTI 0
#endif
extern "C" void kernel_launch(void* const* d_in, const int* in_sizes, int n_in, void* d_out, int out_size, void* d_ws, size_t ws_size, hipStream_t stream) {
    static int grid = 0;
    if (grid == 0) {
        if (n_in != 29 || ws_size < WS_END) { fprintf(stderr, "kernel_launch: bad args n_in %d ws %zu (need %zu)\n", n_in, ws_size, (size_t)WS_END); grid = -1; return; }
        int dev = 0, cus = 0, per_cu = 0;
        (void)hipGetDevice(&dev); (void)hipDeviceGetAttribute(&cus, hipDeviceAttributeMultiprocessorCount, dev);
        if (hipFuncSetAttribute((const void*)mega_fwd, hipFuncAttributeMaxDynamicSharedMemorySize, LDS_BYTES) != hipSuccess) { fprintf(stderr, "hipFuncSetAttribute failed\n"); grid = -1; return; }
        if (hipOccupancyMaxActiveBlocksPerMultiprocessor(&per_cu, (const void*)mega_fwd, 512, LDS_BYTES) != hipSuccess || per_cu < 1) { fprintf(stderr, "occupancy query: %d\n", per_cu); per_cu = 1; }
        (void)hipGetLastError();
        grid = cus * 1;
    }
    if (grid < 0) return;
    (void)hipMemsetAsync((char*)d_ws + WS_CTL, 0, 32768, stream);
    Params p{};
    for (int i = 0; i < 29; ++i) p.in[i] = (const float*)d_in[i];
    p.out = (float*)d_out; p.ws = (unsigned char*)d_ws;
#if MK_MULTI
    for (int k = 0; k < N_PHASES; ++k) { p.ph_lo = k; p.ph_hi = k + 1; hipLaunchKernelGGL(mega_fwd, dim3(grid), dim3(512), LDS_BYTES, stream, p); }
#else
    p.ph_lo = 0; p.ph_hi = N_PHASES;
    void* args[] = {&p};
    hipError_t e = hipLaunchCooperativeKernel((const void*)mega_fwd, dim3(grid), dim3(512), args, LDS_BYTES, stream);
    if (e != hipSuccess) fprintf(stderr, "cooperative launch failed: %s (grid %d)\n", hipGetErrorString(e), grid);
#endif
}
```

```cpp
#define MK_REP 0
#define MK_TMASK 0
#include <hip/hip_runtime.h>
#include <hip/hip_cooperative_groups.h>
#include <hip/hip_bf16.h>
#include <cstdio>
#include <cstdint>
#include <cmath>
namespace cg = cooperative_groups;
__device__ __forceinline__ int mk_tid() { int t = threadIdx.x; asm volatile("" : "+v"(t)); return t; }
namespace pg8 {
#define PG8_LAS __attribute__((address_space(3)))
typedef unsigned short bf16_t;
typedef short bf16x8 __attribute__((ext_vector_type(8)));
typedef float f32x4 __attribute__((ext_vector_type(4)));
typedef unsigned u32x4 __attribute__((ext_vector_type(4)));
constexpr int BM = 256, BK = 64, HALF = 128, HTB = HALF * BK * 2  , STAGE_BYTES = 8 * HTB, NXCD = 8, WGM = 8;

__host__ __device__ __forceinline__ int lds_byte(int r, int c) { const int st = (r >> 4) * 2 + (c >> 5), rr = r & 15, cc = c & 31, ob = rr * 64 + cc * 2; return st * 1024 + (ob ^ (((ob >> 9) & 1) << 5)); }
__host__ __device__ __forceinline__ void stage_rc(int b, int& R, int& C) { const int st = b / 1024, sb = b % 1024, swz = sb ^ (((sb >> 9) & 1) << 5); R = (st >> 1) * 16 + swz / 64; C = (st & 1) * 32 + (swz % 64) / 2; }
__host__ __device__ __forceinline__ int perm32(int rho) { const int n = rho >> 4, i = rho & 15; return 8 * (i >> 2) + 4 * n + (i & 3); }

struct Unit { int pm, pn; };
struct Gemm { const bf16_t* A; const bf16_t* Bt; int M, N, K; };

struct StaticOrder {
    int nM, nN, nwg, G, c;
    __host__ __device__ void init(int M, int N, int G_, int c_) { nM = M / BM; nN = N / BM; nwg = nM * nN; G = G_; c = c_; }
    __host__ __device__ bool next(int i, Unit& u) const {
        const long L = (long)i * G + c; if (L >= nwg) return false;
        int wgid = (int)L; { const int q = nwg / NXCD, r = nwg % NXCD, xcd = wgid % NXCD, off = wgid / NXCD; wgid = (xcd < r ? xcd * (q + 1) : r * (q + 1) + (xcd - r) * q) + off; }
        const int nig = WGM * nN, gid = wgid / nig, fm = gid * WGM, gsz = (nM - fm) < WGM ? (nM - fm) : WGM;
        u.pm = fm + ((wgid % nig) % gsz); u.pn = (wgid % nig) / gsz; return true;
    }
    __device__ __forceinline__ void a_ready(const Unit&) const {}
    __device__ __forceinline__ void done(const Unit&) const {}
};
__device__ __forceinline__ unsigned cvt_pk_bf16(float lo, float hi) { unsigned r; asm volatile("v_cvt_pk_bf16_f32 %0, %1, %2" : "=v"(r) : "v"(lo), "v"(hi)); return r; }
typedef float f32x2 __attribute__((ext_vector_type(2)));
template <class Epi, class Sched, bool ALIGN_EPI = false, bool SP2 = false>
__device__ __forceinline__ void gemm_phase(PG8_LAS unsigned char* lds, const Gemm g, const Sched& S, const Epi& E) {
    const int tid = mk_tid(), wid = __builtin_amdgcn_readfirstlane(tid >> 6), lane = tid & 63, wr = wid >> 2, wc = wid & 3, fr = lane & 15, fq = lane >> 4;
    const int K = g.K, nt = K / BK;
    unsigned voffA[2], voffB[2];
#pragma unroll
    for (int i = 0; i < 2; ++i) { int R, C; stage_rc(tid * 16 + i * 8192, R, C); const int Rb = Epi::PERM ? ((R & ~31) + perm32(R & 31)) : R;
        const int Ra = Epi::APERM ? ((R & ~63) + 4 * (R & 15) + ((R >> 4) & 3)) : R;
        voffA[i] = (unsigned)(Ra * K + C) * 2u; voffB[i] = (unsigned)(Rb * K + C) * 2u; }
    const size_t kstep = (size_t)(BK * 2);
    const size_t hstep = (size_t)HALF * K * 2;
    const size_t tstep = 2 * hstep;
    const unsigned ldsw = (unsigned)wid * 1024u;
    const int aoff = lds_byte(wr * 64 + fr, fq * 8), boff = lds_byte(wc * 32 + fr, fq * 8);
#define PG8_SA(b, h) (((b) * 2 + (h)) * HTB)
#define PG8_SB(b, h) ((4 + (b) * 2 + (h)) * HTB)
#define PG8_STAGE(bufoff, gbase, voff) do { _Pragma("unroll") for (int _i = 0; _i < 2; ++_i) \
        __builtin_amdgcn_global_load_lds((const unsigned*)((const char*)(gbase) + (voff)[_i]), (PG8_LAS unsigned*)(lds + (bufoff) + ldsw + _i * 8192), 16, 0, 0); } while (0)
#define PG8_LDA(dst, b, h) do { _Pragma("unroll") for (int m = 0; m < 4; ++m) _Pragma("unroll") for (int k = 0; k < 2; ++k) dst[m][k] = *(const PG8_LAS bf16x8*)(lds + PG8_SA(b, h) + aoff + m * 2048 + k * 1024); } while (0)
#define PG8_LDB(dst, b, h) do { _Pragma("unroll") for (int n = 0; n < 2; ++n) _Pragma("unroll") for (int k = 0; k < 2; ++k) dst[n][k] = *(const PG8_LAS bf16x8*)(lds + PG8_SB(b, h) + boff + n * 2048 + k * 1024); } while (0)
#define PG8_MMA(ai, bj, At, Bt) do { __builtin_amdgcn_s_setprio(1); _Pragma("unroll") for (int m = 0; m < 4; ++m) _Pragma("unroll") for (int n = 0; n < 2; ++n) _Pragma("unroll") for (int k = 0; k < 2; ++k) \
        acc[ai][bj][m][n] = __builtin_amdgcn_mfma_f32_16x16x32_bf16(Bt[n][k], At[m][k], acc[ai][bj][m][n], 0, 0, 0); __builtin_amdgcn_s_setprio(0); } while (0)
#define PG8_WAIT_V(n) asm volatile("s_waitcnt vmcnt(" #n ")" ::: "memory")
#define PG8_WAIT_L(n) asm volatile("s_waitcnt lgkmcnt(" #n ")" ::: "memory")
#define PG8_BAR __builtin_amdgcn_s_barrier()
#define PG8_SCHED __builtin_amdgcn_sched_barrier(0)
    Unit cur, nxt; int ui = 0;
    if (!S.next(0, cur)) return;
    f32x4 acc[2][2][4][2];
#pragma unroll
    for (int a = 0; a < 2; ++a)
#pragma unroll
        for (int b = 0; b < 2; ++b)
#pragma unroll
            for (int m = 0; m < 4; ++m)
#pragma unroll
                for (int n = 0; n < 2; ++n) acc[a][b][m][n] = (f32x4){0.f, 0.f, 0.f, 0.f};
    bf16x8 At[4][2], B0[2][2], B1[2][2];
    const char* cA = (const char*)g.A + (size_t)cur.pm * tstep; const char* cB = (const char*)g.Bt + (size_t)cur.pn * tstep;
    S.a_ready(cur);
    if constexpr (SP2) {
        PG8_STAGE(PG8_SB(0, 0), cB, voffB); PG8_STAGE(PG8_SB(0, 1), cB + hstep, voffB); PG8_STAGE(PG8_SA(0, 0), cA, voffA); PG8_STAGE(PG8_SA(0, 1), cA + hstep, voffA);
        if (wr == 1) PG8_BAR;
        PG8_WAIT_V(2); PG8_BAR;
        PG8_STAGE(PG8_SB(1, 0), cB + kstep, voffB); PG8_STAGE(PG8_SA(1, 0), cA + kstep, voffA); PG8_STAGE(PG8_SB(1, 1), cB + hstep + kstep, voffB);
        PG8_WAIT_V(6); PG8_BAR;
    } else {
        PG8_STAGE(PG8_SB(0, 0), cB, voffB); PG8_STAGE(PG8_SA(0, 0), cA, voffA); PG8_STAGE(PG8_SB(0, 1), cB + hstep, voffB); PG8_STAGE(PG8_SA(0, 1), cA + hstep, voffA);
        if (wr == 1) PG8_BAR;
        PG8_WAIT_V(4); PG8_BAR;
        PG8_STAGE(PG8_SB(1, 0), cB + kstep, voffB); PG8_STAGE(PG8_SA(1, 0), cA + kstep, voffA); PG8_STAGE(PG8_SB(1, 1), cB + hstep + kstep, voffB);
        PG8_WAIT_V(6); PG8_BAR;
    }
    for (;;) {
        const bool has_next = S.next(ui + 1, nxt);
        const char* nA = has_next ? (const char*)g.A + (size_t)nxt.pm * tstep : cA; const char* nB = has_next ? (const char*)g.Bt + (size_t)nxt.pn * tstep : cB;
        for (int t = 0; t < nt; t += 2) {
            const bool last = (t == nt - 2);
            const char* a1 = cA + (size_t)(t + 1) * kstep;
            const char* a2 = last ? nA : cA + (size_t)(t + 2) * kstep; const char* b2 = last ? nB : cB + (size_t)(t + 2) * kstep;
            const char* a3 = a2 + kstep; const char* b3 = b2 + kstep;
            if (last && has_next) S.a_ready(nxt);
            if constexpr (SP2) {
            PG8_LDB(B0, 0, 0); PG8_LDB(B1, 0, 1); PG8_SCHED; PG8_LDA(At, 0, 0); PG8_STAGE(PG8_SA(1, 1), a1 + hstep, voffA);
            PG8_WAIT_V(8); PG8_WAIT_L(0); PG8_BAR; PG8_MMA(0, 0, At, B0); PG8_MMA(0, 1, At, B1); PG8_BAR; PG8_SCHED;
            PG8_LDA(At, 0, 1); PG8_STAGE(PG8_SB(0, 0), b2, voffB); PG8_STAGE(PG8_SB(0, 1), b2 + hstep, voffB); PG8_STAGE(PG8_SA(0, 0), a2, voffA);
            PG8_WAIT_V(8); PG8_WAIT_L(0); PG8_BAR; PG8_MMA(1, 0, At, B0); PG8_MMA(1, 1, At, B1); PG8_BAR; PG8_SCHED;
            PG8_LDB(B0, 1, 0); PG8_LDB(B1, 1, 1); PG8_SCHED; PG8_LDA(At, 1, 0); PG8_STAGE(PG8_SA(0, 1), a2 + hstep, voffA);
            PG8_WAIT_V(8); PG8_WAIT_L(0); PG8_BAR; PG8_MMA(0, 0, At, B0); PG8_MMA(0, 1, At, B1); PG8_BAR; PG8_SCHED;
            PG8_LDA(At, 1, 1); PG8_STAGE(PG8_SB(1, 0), b3, voffB); PG8_STAGE(PG8_SB(1, 1), b3 + hstep, voffB); PG8_STAGE(PG8_SA(1, 0), a3, voffA);
            PG8_WAIT_V(8); PG8_WAIT_L(0); PG8_BAR; PG8_MMA(1, 0, At, B0); PG8_MMA(1, 1, At, B1); PG8_BAR; PG8_SCHED;
            } else {
            PG8_LDB(B0, 0, 0); PG8_SCHED; PG8_LDA(At, 0, 0); PG8_STAGE(PG8_SA(1, 1), a1 + hstep, voffA);
            PG8_WAIT_L(8); PG8_BAR; PG8_WAIT_L(0); PG8_MMA(0, 0, At, B0); PG8_BAR; PG8_SCHED;
            PG8_LDB(B1, 0, 1); PG8_STAGE(PG8_SB(0, 0), b2, voffB);
            PG8_BAR; PG8_WAIT_L(0); PG8_MMA(0, 1, At, B1); PG8_BAR;
            PG8_LDA(At, 0, 1); PG8_STAGE(PG8_SA(0, 0), a2, voffA);
            PG8_BAR; PG8_WAIT_L(0); PG8_MMA(1, 0, At, B0); PG8_BAR; PG8_SCHED;
            PG8_STAGE(PG8_SB(0, 1), b2 + hstep, voffB);
            PG8_WAIT_V(6); PG8_BAR; PG8_MMA(1, 1, At, B1); PG8_BAR;
            PG8_LDB(B0, 1, 0); PG8_SCHED; PG8_LDA(At, 1, 0); PG8_STAGE(PG8_SA(0, 1), a2 + hstep, voffA);
            PG8_WAIT_L(8); PG8_BAR; PG8_WAIT_L(0); PG8_MMA(0, 0, At, B0); PG8_BAR; PG8_SCHED;
            PG8_LDB(B1, 1, 1); PG8_STAGE(PG8_SB(1, 0), b3, voffB);
            PG8_BAR; PG8_WAIT_L(0); PG8_MMA(0, 1, At, B1); PG8_BAR;
            PG8_LDA(At, 1, 1); PG8_STAGE(PG8_SA(1, 0), a3, voffA);
            PG8_BAR; PG8_WAIT_L(0); PG8_MMA(1, 0, At, B0); PG8_BAR; PG8_SCHED;
            PG8_STAGE(PG8_SB(1, 1), b3 + hstep, voffB);
            PG8_WAIT_V(6); PG8_BAR; PG8_MMA(1, 1, At, B1); PG8_BAR;
            }
        }
        if constexpr (ALIGN_EPI) { if (wr == 0) PG8_BAR; }
        if constexpr (!Epi::AFTER_DRAIN) { E(acc, cur, wr, wc, fr, fq); S.done(cur); }
        if (!has_next) break;
#pragma unroll
        for (int a = 0; a < 2; ++a)
#pragma unroll
            for (int b = 0; b < 2; ++b)
#pragma unroll
                for (int m = 0; m < 4; ++m)
#pragma unroll
                    for (int n = 0; n < 2; ++n) acc[a][b][m][n] = (f32x4){0.f, 0.f, 0.f, 0.f};
        cur = nxt; cA = nA; cB = nB; ++ui;
        if constexpr (ALIGN_EPI) { if (wr == 1) PG8_BAR; }
    }
    PG8_WAIT_V(0);
    if constexpr (!ALIGN_EPI) { if (wr == 0) PG8_BAR; }
    PG8_BAR;
    if constexpr (Epi::AFTER_DRAIN) { E.fused(acc, cur, wr, wc, fr, fq, lds, wid, lane); S.done(cur); }
#undef PG8_SA
#undef PG8_SB
#undef PG8_STAGE
#undef PG8_LDA
#undef PG8_LDB
#undef PG8_MMA
#undef PG8_WAIT_V
#undef PG8_WAIT_L
#undef PG8_BAR
#undef PG8_SCHED
}
}
namespace attn_body {
using bf16=__hip_bfloat16;
using bf16x8=__attribute__((ext_vector_type(8)))short;
using s16x4=__attribute__((ext_vector_type(4)))short;
using f32x16=__attribute__((ext_vector_type(16)))float;
using u32x4=__attribute__((ext_vector_type(4)))unsigned;
__device__ __forceinline__ int crow(int r,int hi){return (r&3)+8*(r>>2)+4*hi;}
#define SBAR() __builtin_amdgcn_sched_barrier(0)
__device__ __forceinline__ void glds16(const void*gsrc,unsigned lds_dst){unsigned keep;
  asm volatile("s_mov_b32 %0, m0\n\ts_mov_b32 m0, %2\n\ts_nop 0\n\tglobal_load_lds_dwordx4 %1, off\n\ts_mov_b32 m0, %0":"=&s"(keep):"v"(gsrc),"s"(lds_dst):"memory");}
typedef float f32x2_t __attribute__((ext_vector_type(2))); typedef __bf16 bf16x2_t __attribute__((ext_vector_type(2)));
__device__ __forceinline__ unsigned cvtpk_s(float lo,float hi){f32x2_t v={lo,hi};bf16x2_t b=__builtin_convertvector(v,bf16x2_t);return __builtin_bit_cast(unsigned,b);}
#define WAIT_BAR(N) asm volatile("s_waitcnt vmcnt(" #N ") lgkmcnt(0)\n\ts_barrier":::"memory")
__device__ __forceinline__ void qkt(f32x16&p0,f32x16&p1,const char*Kslot,const bf16x8*qr,const f32x16&negm,int r32,int hi){
  const char*kb=Kslot+hi*1024+r32*16;
  #pragma unroll
  for(int d0=0;d0<4;++d0){
    const bf16x8 b0=*reinterpret_cast<const bf16x8*>(kb+d0*2048);
    const bf16x8 b1=*reinterpret_cast<const bf16x8*>(kb+d0*2048+512);
    if(d0==0){p0=__builtin_amdgcn_mfma_f32_32x32x16_bf16(b0,qr[0],negm,0,0,0);p1=__builtin_amdgcn_mfma_f32_32x32x16_bf16(b1,qr[0],negm,0,0,0);}
    else{p0=__builtin_amdgcn_mfma_f32_32x32x16_bf16(b0,qr[d0],p0,0,0,0);p1=__builtin_amdgcn_mfma_f32_32x32x16_bf16(b1,qr[d0],p1,0,0,0);}}
}
__device__ __forceinline__ void pv(f32x16*o,int vb,bf16x8 pa0,bf16x8 pa1,bf16x8 pa2,bf16x8 pa3){
  #pragma unroll
  for(int d0=0;d0<2;++d0){s16x4 lo[4],hi[4];
    #pragma unroll
    for(int ks=0;ks<4;++ks){
      asm volatile("ds_read_b64_tr_b16 %0,%1 offset:%c2":"=&v"(lo[ks]):"v"(vb),"i"(d0*4096+ks*1024):"memory");
      asm volatile("ds_read_b64_tr_b16 %0,%1 offset:%c2":"=&v"(hi[ks]):"v"(vb),"i"(d0*4096+ks*1024+512):"memory");}
    asm volatile("s_waitcnt lgkmcnt(0)":::"memory");SBAR();
    #define PK(k) (bf16x8){lo[k][0],lo[k][1],lo[k][2],lo[k][3],hi[k][0],hi[k][1],hi[k][2],hi[k][3]}
    o[d0]=__builtin_amdgcn_mfma_f32_32x32x16_bf16(pa0,PK(0),o[d0],0,0,0);
    o[d0]=__builtin_amdgcn_mfma_f32_32x32x16_bf16(pa1,PK(1),o[d0],0,0,0);
    o[d0]=__builtin_amdgcn_mfma_f32_32x32x16_bf16(pa2,PK(2),o[d0],0,0,0);
    o[d0]=__builtin_amdgcn_mfma_f32_32x32x16_bf16(pa3,PK(3),o[d0],0,0,0);
    #undef PK
  }
}
constexpr int QBLK=32,KVBLK=64,NW=8;
constexpr int NSLOT=3, SLOTB=8192;
constexpr int LDS_K=0, LDS_V=NSLOT*SLOTB, LDS_WS=2*NSLOT*SLOTB, LDS_OST=LDS_WS+NW*64*4, LDS_BYTES=LDS_OST+NW*4096;
__device__ __forceinline__ float max3f(float a,float b,float c){float r;asm("v_max3_f32 %0, %1, %2, %3":"=v"(r):"v"(a),"v"(b),"v"(c));return r;}
__device__ __forceinline__ float max2f(float a,float b){float r;asm("v_max_f32_e32 %0, %1, %2":"=v"(r):"v"(a),"v"(b));return r;}
__device__ __forceinline__ float fadd_s(float a,float b){float r;asm("v_add_f32_e32 %0, %1, %2":"=v"(r):"v"(a),"v"(b));return r;}
__device__ __forceinline__ float fsub_s(float a,float b){float r;asm("v_sub_f32_e32 %0, %1, %2":"=v"(r):"v"(a),"v"(b));return r;}
typedef __attribute__((address_space(3))) const char* lds_cptr;
typedef short v4i16_t __attribute__((ext_vector_type(4)));
__device__ __forceinline__ void kload8(bf16x8*kf,lds_cptr kp){
  kf[0]=*(const __attribute__((address_space(3))) bf16x8*)(kp);      kf[1]=*(const __attribute__((address_space(3))) bf16x8*)(kp+512);
  kf[2]=*(const __attribute__((address_space(3))) bf16x8*)(kp+2048); kf[3]=*(const __attribute__((address_space(3))) bf16x8*)(kp+2560);
  kf[4]=*(const __attribute__((address_space(3))) bf16x8*)(kp+4096); kf[5]=*(const __attribute__((address_space(3))) bf16x8*)(kp+4608);
  kf[6]=*(const __attribute__((address_space(3))) bf16x8*)(kp+6144); kf[7]=*(const __attribute__((address_space(3))) bf16x8*)(kp+6656);
}
__device__ __forceinline__ void kload2(bf16x8*kf,lds_cptr kp,int j){ kf[2*j]=*(const __attribute__((address_space(3))) bf16x8*)(kp+j*2048); kf[2*j+1]=*(const __attribute__((address_space(3))) bf16x8*)(kp+j*2048+512); }
__device__ __forceinline__ s16x4 vtr(lds_cptr p){ return __builtin_bit_cast(s16x4,__builtin_amdgcn_ds_read_tr16_b64_v4i16((__attribute__((address_space(3))) v4i16_t*)p)); }
__device__ __forceinline__ float rowmax(const f32x16&p0,const f32x16&p1){
  float a=max3f(p0[0],p0[1],p1[0]),b=max3f(p0[2],p0[3],p1[1]);a=max3f(a,p1[2],p1[3]);
  #pragma unroll
  for(int r=4;r<16;r+=4){a=max3f(a,p0[r],p0[r+1]);b=max3f(b,p0[r+2],p0[r+3]);a=max3f(a,p1[r],p1[r+1]);b=max3f(b,p1[r+2],p1[r+3]);}
  const float m=max2f(a,b);
  auto rr=__builtin_amdgcn_permlane32_swap(__float_as_uint(m),__float_as_uint(m),false,false);
  return max2f(__uint_as_float(rr[0]),__uint_as_float(rr[1]));
}
template<int THRL> __device__ __forceinline__ void attn_unit2(const bf16*Qu,const bf16*__restrict__ Kh,const bf16*__restrict__ Vh,bf16*Ou,const int NT,char*shm){
  constexpr int QPITCH=512,KVPITCH=128,OPITCH=1280;
  const int tid=mk_tid(),lane=tid&63,r32=lane&31,hi=lane>>5; const int wid=__builtin_amdgcn_readfirstlane(tid>>6);
  const bf16*Qw=Qu+(long)(wid*QBLK)*QPITCH;
  const unsigned lds0=(unsigned)(uintptr_t)shm;
  float*wsf=(float*)(shm+LDS_WS)+wid*64;
  const bf16*ksrc=Kh+(long)lane*KVPITCH+wid*8;
  const bf16*vsrc=Vh+(long)(16*(wid&3)+(lane>>2))*KVPITCH+(wid>>2)*32+(lane&3)*8;
  const unsigned kdst=lds0+LDS_K+wid*1024, vdst=lds0+LDS_V+wid*1024;
  #define DMA_K(t,slot) glds16(ksrc+(long)(t)*KVBLK*KVPITCH,(unsigned)__builtin_amdgcn_readfirstlane(kdst+(slot)))
  #define DMA_V(t,slot) glds16(vsrc+(long)(t)*KVBLK*KVPITCH,(unsigned)__builtin_amdgcn_readfirstlane(vdst+(slot)))
  const int vb0=(int)(lds0+LDS_V)+((lane>>4)&1)*32+(lane&3)*8+(4*hi+((lane&15)>>2))*64;
  const char*Kbase=shm+LDS_K; bf16x8 kf[8];
  const lds_cptr shm3=(lds_cptr)shm; const lds_cptr kp0=shm3+LDS_K+hi*1024+r32*16; const lds_cptr vp0=shm3+LDS_V+((lane>>4)&1)*32+(lane&3)*8+(4*hi+((lane&15)>>2))*64;
  DMA_K(0,0);DMA_V(0,0);DMA_K(1,SLOTB);
  bf16x8 qr[4];
  #pragma unroll
  for(int d0=0;d0<4;++d0)qr[d0]=*reinterpret_cast<const bf16x8*>(&Qw[(long)r32*QPITCH+d0*16+hi*8]);
  float mhat=0.f,l_reg=0.f;f32x16 o[2];o[0]=f32x16{};o[1]=f32x16{};f32x16 negm=f32x16{};asm volatile("":"+v"(negm));
  #define CMASK(P0,P1,t) do{}while(0)
  bool resc=false;
  #define START(P0,P1) do{ const float rm=rowmax(P0,P1); resc=false; \
    { const float dl=rm; mhat=fadd_s(mhat,dl); \
      _Pragma("unroll") for(int r=0;r<16;++r){P0[r]=fsub_s(P0[r],dl);P1[r]=fsub_s(P1[r],dl);} \
      _Pragma("unroll") for(int r=0;r<16;++r)negm[r]=-mhat; asm volatile("":"+v"(negm)); } \
    _Pragma("unroll") for(int r=0;r<16;++r)P0[r]=__builtin_amdgcn_exp2f(P0[r]); }while(0)
  #define RESC() do{ if(resc){ asm volatile("s_waitcnt lgkmcnt(0)":::"memory"); \
      _Pragma("unroll") for(int d_=0;d_<2;++d_) _Pragma("unroll") for(int r=0;r<16;++r)o[d_][r]*=wsf[crow(r,hi)]; } }while(0)
  f32x16 pA0,pA1,pB0,pB1;
  int sl_prev=0,sl_cur=0,sl_next=SLOTB;
  #define ROT() do{sl_prev=sl_cur;sl_cur=sl_next;sl_next=(sl_next==(NSLOT-1)*SLOTB)?0:sl_next+SLOTB;}while(0)
  DMA_K(2,2*SLOTB);
  WAIT_BAR(3);
  qkt(pA0,pA1,Kbase,qr,negm,r32,hi);asm volatile("s_nop 15\n\ts_nop 7":"+v"(pA0),"+v"(pA1));CMASK(pA0,pA1,0);
  START(pA0,pA1);
  _Pragma("unroll") for(int r=0;r<16;++r)pA1[r]=__builtin_amdgcn_exp2f(pA1[r]);
  WAIT_BAR(0);
  DMA_K(3,0);DMA_V(1,SLOTB);
  ROT();
  kload8(kf,kp0+sl_cur);
  WAIT_BAR(2);
  s16x4 vlo[8],vhi[8]; u32x4 pw0,pw1,pw2,pw3;
  #define PKW(P,B) cvtpk_s(P[B],P[B+1])
  #define PAF(k) __builtin_bit_cast(bf16x8,pw##k)
  #define VFR(i) (bf16x8){vlo[i][0],vlo[i][1],vlo[i][2],vlo[i][3],vhi[i][0],vhi[i][1],vhi[i][2],vhi[i][3]}
  #define PIN(x) asm volatile("":"+v"(x))
  #define MX3(a,b,c) __builtin_fmaxf(__builtin_fmaxf((a),(b)),(c))
  #define GAPA(MF,A0,A1,A2,A3,W0,W1,PW) do{ MF; sacc+=A0; sacc+=A1; sacc+=A2; sacc+=A3; PIN(sacc); W0; W1; PIN(PW); SBAR(); }while(0)
  #define EX(v) __builtin_amdgcn_exp2f(v)
  #define GAPB(MF,X,B) do{ MF; X[B]=EX(X[B]); X[B+1]=EX(X[B+1]); X[B+2]=EX(X[B+2]); X[B+3]=EX(X[B+3]); PIN(X); SBAR(); }while(0)
  #define VRD(i) do{ vlo[i]=vtr(vp_+(((i)>>2)*4096+((i)&3)*1024)); vhi[i]=vtr(vp_+(((i)>>2)*4096+((i)&3)*1024+512)); }while(0)
  #define KRD(G,j) do{ if(G){ kload2(kf,kp0+sl_next,j); SBAR(); } }while(0)
  #define STEP(C0,C1,P0,P1,t,GK,GV,GL) do{ SBAR(); \
    const lds_cptr vp_=vp0+sl_prev; \
    VRD(0); SBAR(); float sacc=(P0[0]+P0[1]); \
    GAPA(C0=__builtin_amdgcn_mfma_f32_32x32x16_bf16(kf[0],qr[0],negm,0,0,0), P0[2],P0[3],P0[4],P0[5],     pw0[0]=PKW(P0,0), pw0[1]=PKW(P0,2), pw0); \
    VRD(4); SBAR(); GAPA(C1=__builtin_amdgcn_mfma_f32_32x32x16_bf16(kf[1],qr[0],negm,0,0,0), P0[6],P0[7],P0[8],P0[9],     pw0[2]=PKW(P0,4), pw0[3]=PKW(P0,6), pw0); \
    VRD(1); SBAR(); GAPA(C0=__builtin_amdgcn_mfma_f32_32x32x16_bf16(kf[2],qr[1],C0,0,0,0),   P0[10],P0[11],P0[12],P0[13], pw1[0]=PKW(P0,8), pw1[1]=PKW(P0,10), pw1); \
    VRD(5); SBAR(); GAPA(C1=__builtin_amdgcn_mfma_f32_32x32x16_bf16(kf[3],qr[1],C1,0,0,0),   P0[14],P0[15],P1[0],P1[1],   pw1[2]=PKW(P0,12),pw1[3]=PKW(P0,14), pw1); \
    VRD(2); SBAR(); GAPA(C0=__builtin_amdgcn_mfma_f32_32x32x16_bf16(kf[4],qr[2],C0,0,0,0),   P1[2],P1[3],P1[4],P1[5],     pw2[0]=PKW(P1,0), pw2[1]=PKW(P1,2), pw2); \
    VRD(6); SBAR(); GAPA(C1=__builtin_amdgcn_mfma_f32_32x32x16_bf16(kf[5],qr[2],C1,0,0,0),   P1[6],P1[7],P1[8],P1[9],     pw2[2]=PKW(P1,4), pw2[3]=PKW(P1,6), pw2); \
    VRD(3); SBAR(); GAPA(C0=__builtin_amdgcn_mfma_f32_32x32x16_bf16(kf[6],qr[3],C0,0,0,0),   P1[10],P1[11],P1[12],P1[13], pw3[0]=PKW(P1,8), pw3[1]=PKW(P1,10), pw3); \
    VRD(7); SBAR(); GAPA(C1=__builtin_amdgcn_mfma_f32_32x32x16_bf16(kf[7],qr[3],C1,0,0,0),   P1[14],P1[15],0.f,0.f,       pw3[2]=PKW(P1,12),pw3[3]=PKW(P1,14), pw3); \
    l_reg+=sacc; \
    if(GK){DMA_K((t)+3,sl_cur);} if(GV){DMA_V((t)+1,sl_next);} \
    CMASK(C0,C1,t); \
    { float a=MX3(C0[0],C0[1],C1[0]),b=MX3(C0[2],C0[3],C1[1]); a=MX3(a,C1[2],C1[3]); \
      _Pragma("unroll") for(int r=4;r<16;r+=4){a=MX3(a,C0[r],C0[r+1]);b=MX3(b,C0[r+2],C0[r+3]);a=MX3(a,C1[r],C1[r+1]);b=MX3(b,C1[r+2],C1[r+3]);} \
      float rm=__builtin_fmaxf(a,b); { auto rr=__builtin_amdgcn_permlane32_swap(__float_as_uint(rm),__float_as_uint(rm),false,false); rm=__builtin_fmaxf(__uint_as_float(rr[0]),__uint_as_float(rr[1])); } \
      resc=false; \
      if(__builtin_expect(__any(rm>(float)THRL),0)){ const float dl=__builtin_fmaxf(rm,0.f); mhat+=dl; \
        _Pragma("unroll") for(int r=0;r<16;++r){C0[r]-=dl;C1[r]-=dl;} \
        _Pragma("unroll") for(int r=0;r<16;++r)negm[r]=-mhat; asm volatile("":"+v"(negm)); \
        const float f=__builtin_amdgcn_exp2f(-dl); l_reg*=f; if(hi==0)wsf[r32]=f; resc=true; } } \
    SBAR(); \
    GAPB(o[0]=__builtin_amdgcn_mfma_f32_32x32x16_bf16(PAF(0),VFR(0),o[0],0,0,0), C0,0); \
    GAPB(o[1]=__builtin_amdgcn_mfma_f32_32x32x16_bf16(PAF(0),VFR(4),o[1],0,0,0), C0,4); \
    KRD(GL,0); GAPB(o[0]=__builtin_amdgcn_mfma_f32_32x32x16_bf16(PAF(1),VFR(1),o[0],0,0,0), C0,8); \
    KRD(GL,1); GAPB(o[1]=__builtin_amdgcn_mfma_f32_32x32x16_bf16(PAF(1),VFR(5),o[1],0,0,0), C0,12); \
    KRD(GL,2); GAPB(o[0]=__builtin_amdgcn_mfma_f32_32x32x16_bf16(PAF(2),VFR(2),o[0],0,0,0), C1,0); \
    KRD(GL,3); GAPB(o[1]=__builtin_amdgcn_mfma_f32_32x32x16_bf16(PAF(2),VFR(6),o[1],0,0,0), C1,4); \
    GAPB(o[0]=__builtin_amdgcn_mfma_f32_32x32x16_bf16(PAF(3),VFR(3),o[0],0,0,0), C1,8); \
    GAPB(o[1]=__builtin_amdgcn_mfma_f32_32x32x16_bf16(PAF(3),VFR(7),o[1],0,0,0), C1,12); \
    }while(0)
  int t=1;
  #undef CMASK
  #define CMASK(P0,P1,t) do{}while(0)
  for(;t+5<NT;t+=2){
    STEP(pB0,pB1,pA0,pA1,t,true,true,true);     WAIT_BAR(2); RESC(); ROT();
    STEP(pA0,pA1,pB0,pB1,t+1,true,true,true);   WAIT_BAR(2); RESC(); ROT();
  }
  #undef CMASK
  #define CMASK(P0,P1,t) do{}while(0)
  #define ENDW(tt) do{ if((tt)+3<NT){WAIT_BAR(2);} else if((tt)+2<NT){WAIT_BAR(1);} else {WAIT_BAR(0);} }while(0)
  for(;t+1<NT;t+=2){
    STEP(pB0,pB1,pA0,pA1,t,(t+3<NT),(t+1<NT),(t+1<NT));       ENDW(t);   RESC(); ROT();
    STEP(pA0,pA1,pB0,pB1,t+1,(t+4<NT),(t+2<NT),(t+2<NT));     ENDW(t+1); RESC(); ROT();
  }
  STEP(pB0,pB1,pA0,pA1,NT-1,false,false,false); RESC();
  { float sacc=pB0[0]+pB0[1]; _Pragma("unroll") for(int r=2;r<16;++r)sacc+=pB0[r]; _Pragma("unroll") for(int r=0;r<16;++r)sacc+=pB1[r]; l_reg+=sacc;
    pw0=(u32x4){PKW(pB0,0),PKW(pB0,2),PKW(pB0,4),PKW(pB0,6)};pw1=(u32x4){PKW(pB0,8),PKW(pB0,10),PKW(pB0,12),PKW(pB0,14)};pw2=(u32x4){PKW(pB1,0),PKW(pB1,2),PKW(pB1,4),PKW(pB1,6)};pw3=(u32x4){PKW(pB1,8),PKW(pB1,10),PKW(pB1,12),PKW(pB1,14)};
    SBAR(); pv(o,vb0+sl_cur,PAF(0),PAF(1),PAF(2),PAF(3)); }
  #undef PKW
  #undef PAF
  #undef VFR
  #undef PIN
  #undef MX3
  #undef GAPA
  #undef GAPB
  #undef EX
  #undef VRD
  #undef KRD
  #undef STEP
  #undef ENDW
  {auto rr=__builtin_amdgcn_permlane32_swap(__float_as_uint(l_reg),__float_as_uint(l_reg),false,false);l_reg=__uint_as_float(rr[0])+__uint_as_float(rr[1]);}
  if(hi==0)wsf[32+r32]=l_reg;asm volatile("s_waitcnt lgkmcnt(0)":::"memory");
  float rli[16];
  #pragma unroll
  for(int r=0;r<16;++r)rli[r]=__builtin_amdgcn_rcpf(wsf[32+crow(r,hi)]);
  bf16*Ow=Ou+(long)(wid*QBLK)*OPITCH;
  { bf16*stg=(bf16*)(shm+LDS_OST)+wid*2048;
    #pragma unroll
    for(int r=0;r<16;++r){const int orow=crow(r,hi);
      #pragma unroll
      for(int d0=0;d0<2;++d0)stg[orow*64+d0*32+r32]=__float2bfloat16(o[d0][r]*rli[r]);}
    asm volatile("s_waitcnt lgkmcnt(0)":::"memory");
    #pragma unroll
    for(int i=0;i<4;++i){const int row=i*8+(lane>>3),ch=lane&7; const u32x4 v=*(const u32x4*)(stg+row*64+ch*8); *(u32x4*)(Ow+(long)row*OPITCH+ch*8)=v;} }
  asm volatile("s_waitcnt lgkmcnt(0)\n\ts_barrier":::"memory");
  #undef DMA_K
  #undef DMA_V
  #undef CMASK
  #undef START
  #undef RESC
  #undef ROT
}
#undef SBAR
#undef WAIT_BAR
}

namespace mk {
using pg8::bf16_t; using pg8::f32x4; using pg8::Unit; using pg8::cvt_pk_bf16;
#define LAS __attribute__((address_space(3)))
typedef unsigned u32x2 __attribute__((ext_vector_type(2)));
typedef unsigned u32x4 __attribute__((ext_vector_type(4)));
typedef float f32x2 __attribute__((ext_vector_type(2)));
typedef short bf16x8 __attribute__((ext_vector_type(8)));
typedef float f32x16 __attribute__((ext_vector_type(16)));

constexpr int DM = 1024, NB = 8, SL = 4096, CL = 256, ML = NB * SL, MC = NB * CL, MT = ML + MC;
constexpr int INW = 1792, DFF = 2816, UPW = 5632, MIXK = 1280, KVP = 128, QP = 512, KVB = SL + CL;
constexpr int HALF_A = 16384;
constexpr float EPS = 1e-6f;
constexpr float QSCALE = 0.125f * 1.4426950408889634f;

constexpr size_t MiB = 1u << 20;
constexpr size_t WS_CTL = 0;
constexpr size_t WS_MODP = 1 * MiB;
constexpr size_t WS_MOD = 5 * MiB;
constexpr size_t WS_WCP = 5 * MiB + 512 * 1024;
constexpr size_t WS_T = 6 * MiB;
constexpr size_t WS_TW = 7 * MiB;
constexpr size_t WS_W = 8 * MiB;
constexpr size_t W_LAYER = 24 * MiB;
constexpr size_t WS_ADFT = 56 * MiB;
constexpr size_t WS_ADFTC = 88 * MiB;
constexpr size_t WS_KF = 89 * MiB;
constexpr size_t WS_KFC = 121 * MiB;
constexpr size_t WS_CX = 122 * MiB;
constexpr size_t WS_XN = 130 * MiB;
constexpr size_t WS_TMP = 198 * MiB;
constexpr size_t WS_Q = WS_TMP;
constexpr size_t WS_K = WS_TMP + 34 * MiB;
constexpr size_t WS_V = WS_TMP + 43 * MiB;
constexpr size_t WS_FT = WS_TMP + 52 * MiB;
constexpr size_t WS_FTC = WS_TMP + 68 * MiB;
constexpr size_t WS_PT = WS_TMP + 69 * MiB;
constexpr size_t WS_PTC = WS_TMP + 117 * MiB;
constexpr size_t WS_MIX = WS_TMP + 120 * MiB;
constexpr size_t WS_HRAW = WS_TMP + 206 * MiB;
constexpr size_t WS_U = WS_TMP;
constexpr size_t WS_G = WS_TMP;
constexpr size_t WS_SB = WS_TMP + 190 * MiB;
constexpr size_t WS_XB = WS_TMP + 224 * MiB;
constexpr size_t WS_END = WS_TMP + 297 * MiB;

struct Params { const float* in[29]; float* out; unsigned char* ws; int ph_lo, ph_hi; };
enum { I_X = 0, I_C, I_CTX, I_CCTX, I_WMOD, I_BMOD, I_GPREMIX, I_GPOSTMIX, I_GPREFFN, I_GPOSTFFN, I_WIN, I_GQ, I_GK, I_WF, I_WHC, I_BHC,
       I_HW1, I_HB1, I_HFR1, I_HW2, I_HB2, I_HFR2, I_HW3, I_HBIAS, I_WOUT, I_WUP, I_WFC, I_BFC, I_WDOWN };

__device__ __forceinline__ unsigned f2bf(float f) { unsigned u = __builtin_bit_cast(unsigned, f); return (u + 0x7fffu + ((u >> 16) & 1u)) >> 16; }
__device__ __forceinline__ unsigned pk2(float lo, float hi) { return f2bf(lo) | (f2bf(hi) << 16); }
__device__ __forceinline__ float bflo(unsigned w) { return __uint_as_float(w << 16); }
__device__ __forceinline__ float bfhi(unsigned w) { return __uint_as_float(w & 0xffff0000u); }
__device__ __forceinline__ float bf2f(bf16_t h) { return __uint_as_float((unsigned)h << 16); }
__device__ __forceinline__ float wave_sum(float v) {
#pragma unroll
    for (int o = 1; o < 64; o <<= 1) v += __shfl_xor(v, o);
    return v;
}

struct EpiPlain {
    static constexpr bool PERM = true, AFTER_DRAIN = false, APERM = false;
    bf16_t* O; int ldc;
    __device__ __forceinline__ void operator()(const f32x4 (&acc)[2][2][4][2], const Unit& u, int wr, int wc, int fr, int fq) const {
        const int row0 = u.pm * 256 + wr * 64 + fr; const int col0 = u.pn * 256 + wc * 32 + 8 * fq;
#pragma unroll
        for (int ai = 0; ai < 2; ++ai)
#pragma unroll
            for (int m = 0; m < 4; ++m) { bf16_t* rowp = O + (size_t)(row0 + ai * 128 + m * 16) * ldc + col0;
#pragma unroll
                for (int bj = 0; bj < 2; ++bj) { const f32x4 v0 = acc[ai][bj][m][0], v1 = acc[ai][bj][m][1];
                    u32x4 w; w.x = cvt_pk_bf16(v0[0], v0[1]); w.y = cvt_pk_bf16(v0[2], v0[3]); w.z = cvt_pk_bf16(v1[0], v1[1]); w.w = cvt_pk_bf16(v1[2], v1[3]);
                    *(u32x4*)(rowp + bj * 128) = w; } }
    }
};

struct EpiFourier {
    static constexpr bool PERM = true, AFTER_DRAIN = false, APERM = false;
    bf16_t* MIXp; int Lh; int rowbase0; int rowstride;
    __device__ __forceinline__ void operator()(const f32x4 (&acc)[2][2][4][2], const Unit& u, int wr, int wc, int fr, int fq) const {
        asm volatile("" : "+v"(fr), "+v"(fq), "+s"(wr), "+s"(wc));
        const int b = u.pn; const int len = 2 * Lh; const int rb = rowbase0 + b * rowstride;
#pragma unroll
        for (int ai = 0; ai < 2; ++ai)
#pragma unroll
            for (int m = 0; m < 4; ++m) {
                const int r = u.pm * 256 + ai * 128 + wr * 64 + m * 16 + fr;
                const bool isS = r > Lh; const int k = isS ? r - Lh : r;
                const bool edge = (k == 0) || (k == Lh);
#pragma unroll
                for (int bj = 0; bj < 2; ++bj) { const f32x4 v0 = acc[ai][bj][m][0], v1 = acc[ai][bj][m][1];
                    const int ch = bj * 128 + wc * 32 + 8 * fq;
                    u32x4 w; w.x = cvt_pk_bf16(v0[0], v0[1]); w.y = cvt_pk_bf16(v0[2], v0[3]); w.z = cvt_pk_bf16(v1[0], v1[1]); w.w = cvt_pk_bf16(v1[2], v1[3]);
                    const int col = 512 + (isS ? 256 : 0) + ch;
                    *(u32x4*)(MIXp + (size_t)(rb + k) * MIXK + col) = w;
                    if (!edge) { u32x4 wm = w; if (isS) { wm.x ^= 0x80008000u; wm.y ^= 0x80008000u; wm.z ^= 0x80008000u; wm.w ^= 0x80008000u; }
                        *(u32x4*)(MIXp + (size_t)(rb + len - k) * MIXK + col) = wm; }
                    else if (!isS) { *(u32x4*)(MIXp + (size_t)(rb + k) * MIXK + col + 256) = (u32x4){0u, 0u, 0u, 0u}; }
                }
            }
    }
};

struct EpiInProj {
    static constexpr bool PERM = false, AFTER_DRAIN = false, APERM = false;
    bf16_t *Q, *K, *V, *fT, *fTc, *PT, *PTc; const float *gq, *gk, *rope; LAS float* xch;
    __device__ __forceinline__ void operator()(const f32x4 (&acc)[2][2][4][2], const Unit& u, int wr, int wc, int fr, int fq) const {
        asm volatile("" : "+v"(fr), "+v"(fq), "+s"(wr), "+s"(wc));
        const int pn = u.pn, pm = u.pm; const bool isctx = pm >= 128;
        const int b = isctx ? pm - 128 : pm >> 4;
        const int tbase = isctx ? 0 : (pm & 15) * 256;
#ifdef T_NOQK
        if (false) {
#else
        if (pn <= 2) {
#endif
#pragma unroll
            for (int ai = 0; ai < 2; ++ai)
#pragma unroll
                for (int m = 0; m < 4; ++m)
#pragma unroll
                    for (int bj = 0; bj < 2; ++bj) {
                        float s = 0.f;
#pragma unroll
                        for (int n = 0; n < 2; ++n) { const f32x4 x = acc[ai][bj][m][n]; s += (x[0] * x[0] + x[1] * x[1]) + (x[2] * x[2] + x[3] * x[3]); }
                        s += __shfl_xor(s, 16); s += __shfl_xor(s, 32);
                        if (fq == 0) xch[((ai * 128 + wr * 64 + m * 16 + fr) * 2 + bj) * 4 + wc] = s;
                    }
            asm volatile("s_waitcnt lgkmcnt(0)\n\ts_barrier" ::: "memory");
            const float* gg = (pn == 2) ? gk : gq;
            const int dbase = (wc & 1) * 32 + 4 * fq;
            const f32x4 g1 = *(const f32x4*)(gg + dbase), g2 = *(const f32x4*)(gg + dbase + 16);
            const float osc = (pn == 2) ? 1.0f : QSCALE;
#pragma unroll
            for (int ai = 0; ai < 2; ++ai)
#pragma unroll
                for (int m = 0; m < 4; ++m) {
                    const int rl = ai * 128 + wr * 64 + m * 16 + fr; const int t = tbase + rl;
                    const int p = (wc & 1) ? (t & 63) : (t >> 6);
                    f32x4 cs = (f32x4){1.f, 1.f, 1.f, 1.f}, sn = (f32x4){0.f, 0.f, 0.f, 0.f};
                    if (!isctx) { cs = *(const f32x4*)(rope + p * 16 + 4 * fq); sn = *(const f32x4*)(rope + 1024 + p * 16 + 4 * fq); }
                    const size_t qrow = (size_t)pm * 256 + rl;
                    const size_t kvrow = isctx ? (size_t)b * KVB + rl : (size_t)b * KVB + CL + t;
#pragma unroll
                    for (int bj = 0; bj < 2; ++bj) {
                        if (pn == 2 && bj == 1) {
#pragma unroll
                            for (int n = 0; n < 2; ++n) { const f32x4 x = acc[ai][bj][m][n]; u32x2 w; w.x = cvt_pk_bf16(x[0], x[1]); w.y = cvt_pk_bf16(x[2], x[3]);
                                *(u32x2*)(V + kvrow * KVP + wc * 32 + 16 * n + 4 * fq) = w; }
                        } else {
                            const float ssq = xch[(rl * 2 + bj) * 4 + wc] + xch[(rl * 2 + bj) * 4 + (wc ^ 1)];
                            const float rstd = rsqrtf(ssq * (1.0f / 64.0f) + EPS) * osc;
                            const f32x4 y1 = acc[ai][bj][m][0] * rstd * g1, y2 = acc[ai][bj][m][1] * rstd * g2;
                            const f32x4 o1 = y1 * cs - y2 * sn, o2 = y2 * cs + y1 * sn;
                            u32x2 w1, w2; w1.x = cvt_pk_bf16(o1[0], o1[1]); w1.y = cvt_pk_bf16(o1[2], o1[3]); w2.x = cvt_pk_bf16(o2[0], o2[1]); w2.y = cvt_pk_bf16(o2[2], o2[3]);
                            bf16_t* dst = (pn == 2) ? (K + kvrow * KVP + wc * 32 + 4 * fq) : (Q + qrow * QP + pn * 256 + bj * 128 + wc * 32 + 4 * fq);
                            *(u32x2*)dst = w1; *(u32x2*)(dst + 16) = w2;
                        }
                    }
                }
        }
#ifndef T_NOTR
        else {
            const int NC = (pn == 3) ? 256 : 768; const int cb = (pn == 3) ? 0 : (pn - 4) * 256;
            bf16_t* base; int tl;
            if (isctx) { base = ((pn == 3) ? fTc : PTc) + (size_t)b * NC * CL; tl = CL; }
            else { base = ((pn == 3) ? fT : PT) + (size_t)b * NC * SL + tbase; tl = SL; }
            const int lane = fq * 16 + fr;
            LAS bf16_t* stg = (LAS bf16_t*)((LAS unsigned char*)xch + 8192) + (wr * 4 + wc) * 1152;
#pragma unroll
            for (int ai = 0; ai < 2; ++ai)
#pragma unroll
                for (int bj = 0; bj < 2; ++bj)
#pragma unroll
                    for (int n = 0; n < 2; ++n) {
#pragma unroll
                        for (int m = 0; m < 4; ++m) { const f32x4 x = acc[ai][bj][m][n];
#pragma unroll
                            for (int j = 0; j < 4; ++j) stg[(4 * fq + j) * 72 + m * 16 + fr] = (bf16_t)f2bf(x[j]); }
                        asm volatile("s_waitcnt lgkmcnt(0)" ::: "memory");
                        bf16_t* dst = base + (size_t)(cb + bj * 128 + wc * 32 + 16 * n) * tl + ai * 128 + wr * 64;
#pragma unroll
                        for (int i = 0; i < 2; ++i) { const int v = lane + 64 * i, col = v >> 3, k = v & 7;
                            const u32x4 w = *(const LAS u32x4*)(stg + col * 72 + k * 8);
                            *(u32x4*)(dst + (size_t)col * tl + 8 * k) = w; }
                        asm volatile("s_waitcnt lgkmcnt(0)" ::: "memory");
                    }
        }
#endif
    }
};


__device__ __forceinline__ float dppf(float old, float src, int ctrl_sel) {
    const int o = __builtin_bit_cast(int, old), s = __builtin_bit_cast(int, src); int r;
    if (ctrl_sel == 0) r = __builtin_amdgcn_update_dpp(o, s, 0x111, 0xf, 0xf, false);
    else if (ctrl_sel == 1) r = __builtin_amdgcn_update_dpp(o, s, 0x101, 0xf, 0xf, false);
    else if (ctrl_sel == 2) r = __builtin_amdgcn_update_dpp(o, s, 0x121, 0xf, 0xf, false);
    else r = __builtin_amdgcn_update_dpp(o, s, 0x12F, 0xf, 0xf, false);
    return __builtin_bit_cast(float, r);
}
__device__ __forceinline__ float silu_mul(float cg, float cv) { return cg * cv * __builtin_amdgcn_rcpf(1.0f + __builtin_amdgcn_exp2f(-1.4426950408889634f * cg)); }

struct EpiGlu {
    static constexpr bool PERM = true, AFTER_DRAIN = false, APERM = true;
    bf16_t* G; bf16_t* SB; const u32x4* wcp; LAS float* xb;
    __device__ __forceinline__ void operator()(const f32x4 (&acc)[2][2][4][2], const Unit& u, int wr, int wc, int fr, int fq) const {
        asm volatile("" : "+v"(fr), "+v"(fq), "+s"(wr), "+s"(wc));
        const int c0 = 128 * u.pn + 32 * wc + 8 * fq;
        u32x4 wq[8];
#pragma unroll
        for (int k = 0; k < 8; ++k) wq[k] = wcp[c0 + k];
#pragma unroll
        for (int ai = 0; ai < 2; ++ai) {
            if (fr == 0 || fr == 15) {
                const int which = fr == 0 ? 0 : 1; LAS float* dst = xb + ((((ai * 2 + wr) * 2 + which) * 4 + wc) * 4 + fq) * 16;
#pragma unroll
                for (int bj = 0; bj < 2; ++bj)
#pragma unroll
                    for (int n = 0; n < 2; ++n) { const f32x4 x = fr == 0 ? acc[ai][bj][0][n] : acc[ai][bj][3][n]; *(LAS f32x4*)(dst + bj * 8 + n * 4) = x; }
            }
        }
        asm volatile("s_waitcnt lgkmcnt(0)\n\ts_barrier" ::: "memory");
#pragma unroll
        for (int ai = 0; ai < 2; ++ai) {
            int pblk = -1, nblk = -1;
            if (wr == 1) pblk = ai * 2 + 0; else if (ai == 1) pblk = 0 * 2 + 1;
            if (wr == 0) nblk = ai * 2 + 1; else if (ai == 0) nblk = 1 * 2 + 0;
#pragma unroll
            for (int n = 0; n < 2; ++n) {
#pragma unroll
                for (int j = 0; j < 4; ++j) asm volatile("" : "+v"(wq[4 * n + j]));
                f32x4 wg[3], wv[3], bg, bv;
#pragma unroll
                for (int j = 0; j < 4; ++j) { const u32x4 w = wq[4 * n + j];
                    wg[0][j] = bflo(w.x); wg[1][j] = bfhi(w.x); wg[2][j] = bflo(w.y); bg[j] = bfhi(w.y);
                    wv[0][j] = bflo(w.z); wv[1][j] = bfhi(w.z); wv[2][j] = bflo(w.w); bv[j] = bfhi(w.w); }
                f32x4 pg = (f32x4){0.f, 0.f, 0.f, 0.f}, pv = pg, ng = pg, nv = pg;
                if (pblk >= 0) { const LAS float* s = xb + (((pblk * 2 + 1) * 4 + wc) * 4 + fq) * 16; pg = *(const LAS f32x4*)(s + n * 4); pv = *(const LAS f32x4*)(s + 8 + n * 4); }
                if (nblk >= 0) { const LAS float* s = xb + (((nblk * 2 + 0) * 4 + wc) * 4 + fq) * 16; ng = *(const LAS f32x4*)(s + n * 4); nv = *(const LAS f32x4*)(s + 8 + n * 4); }
                f32x4 upg, upv, dng, dnv;
#pragma unroll
                for (int j = 0; j < 4; ++j) { upg[j] = dppf(pg[j], acc[ai][0][3][n][j], 0); upv[j] = dppf(pv[j], acc[ai][1][3][n][j], 0);
                                              dng[j] = dppf(ng[j], acc[ai][0][0][n][j], 1); dnv[j] = dppf(nv[j], acc[ai][1][0][n][j], 1); }
#pragma unroll
                for (int m = 0; m < 4; ++m) {
                    const f32x4 cg = acc[ai][0][m][n], cv = acc[ai][1][m][n];
                    const f32x4 prg = m > 0 ? acc[ai][0][m - 1][n] : upg, prv = m > 0 ? acc[ai][1][m - 1][n] : upv;
                    const f32x4 nxg = m < 3 ? acc[ai][0][m + 1][n] : dng, nxv = m < 3 ? acc[ai][1][m + 1][n] : dnv;
                    const f32x4 sg = prg * wg[0] + cg * wg[1] + nxg * wg[2] + bg;
                    const f32x4 sv = prv * wv[0] + cv * wv[1] + nxv * wv[2] + bv;
                    float res[4];
#pragma unroll
                    for (int j = 0; j < 4; ++j) res[j] = silu_mul(sg[j], sv[j]);
                    u32x2 pk; pk.x = cvt_pk_bf16(res[0], res[1]); pk.y = cvt_pk_bf16(res[2], res[3]);
                    const int rl = ai * 128 + wr * 64 + 4 * fr + m;
                    *(u32x2*)(G + (size_t)(u.pm * 256 + rl) * DFF + c0 + 4 * n) = pk;
                    if (rl < 2 || rl >= 254) {
                        const int which = rl < 2 ? rl : rl - 252; bf16_t* sb = SB + ((size_t)u.pm * 4 + which) * UPW + c0 + 4 * n;
                        u32x2 a; a.x = cvt_pk_bf16(cg[0], cg[1]); a.y = cvt_pk_bf16(cg[2], cg[3]);
                        u32x2 bq; bq.x = cvt_pk_bf16(cv[0], cv[1]); bq.y = cvt_pk_bf16(cv[2], cv[3]);
                        *(u32x2*)sb = a; *(u32x2*)(sb + DFF) = bq;
                    }
                }
            }
        }
    }
};

__device__ __forceinline__ void glu_fixup(int blk, int nblk, int tid, int ntiles, const bf16_t* SB, bf16_t* G, const float* wc, const float* bc) {
    for (int it = blk; it < 2 * ntiles; it += nblk) {
        const int pm = it >> 1, b = it & 1;
        const bool isctx = pm >= 128; const bool has_prev = !isctx && (pm & 15) != 0, has_next = !isctx && (pm & 15) != 15;
        const bf16_t* rp; const bf16_t* rc; const bf16_t* rn; bool hp, hn;
        if (b == 0) { rp = SB + ((size_t)(pm - 1) * 4 + 3) * UPW; rc = SB + ((size_t)pm * 4 + 0) * UPW; rn = SB + ((size_t)pm * 4 + 1) * UPW; hp = has_prev; hn = true; }
        else { rp = SB + ((size_t)pm * 4 + 2) * UPW; rc = SB + ((size_t)pm * 4 + 3) * UPW; rn = SB + ((size_t)(pm + 1) * 4 + 0) * UPW; hp = true; hn = has_next; }
        bf16_t* grow = G + (size_t)(pm * 256 + (b ? 255 : 0)) * DFF;
        float val[6][14];
#pragma unroll
        for (int q = 0; q < 6; ++q) { const int c = tid + 512 * q; const bool in = c < DFF; const int cc = in ? c : 0;
            val[q][0] = hp ? bf2f(rp[cc]) : 0.f; val[q][1] = bf2f(rc[cc]); val[q][2] = hn ? bf2f(rn[cc]) : 0.f;
            val[q][3] = hp ? bf2f(rp[DFF + cc]) : 0.f; val[q][4] = bf2f(rc[DFF + cc]); val[q][5] = hn ? bf2f(rn[DFF + cc]) : 0.f;
            val[q][6] = wc[cc]; val[q][7] = wc[UPW + cc]; val[q][8] = wc[2 * UPW + cc]; val[q][9] = bc[cc];
            val[q][10] = wc[DFF + cc]; val[q][11] = wc[UPW + DFF + cc]; val[q][12] = wc[2 * UPW + DFF + cc]; val[q][13] = bc[DFF + cc]; }
#pragma unroll
        for (int q = 0; q < 6; ++q) { const int c = tid + 512 * q;
            const float sg = val[q][0] * val[q][6] + val[q][1] * val[q][7] + val[q][2] * val[q][8] + val[q][9];
            const float sv = val[q][3] * val[q][10] + val[q][4] * val[q][11] + val[q][5] * val[q][12] + val[q][13];
            if (c < DFF) grow[c] = (bf16_t)f2bf(silu_mul(sg, sv)); }
    }
}

struct OneUnit { int pm, pn;
    __device__ __forceinline__ bool next(int i, Unit& u) const { if (i > 0) return false; u.pm = pm; u.pn = pn; return true; }
    __device__ __forceinline__ void a_ready(const Unit&) const {}
    __device__ __forceinline__ void done(const Unit&) const {}
};

constexpr int AT_K = 0, AT_V = 16384, AT_WS = 32768, AT_OST = 32768 + 2048;
__device__ __forceinline__ void attn_unit(const bf16_t* Qu, const bf16_t* Kh, const bf16_t* Vh, bf16_t* Ou, int NT, char* shm) {
    using namespace attn_body;
    const int tid = mk_tid(), lane = tid & 63, r32 = lane & 31, hi = lane >> 5; const int wid = __builtin_amdgcn_readfirstlane(tid >> 6);
    const unsigned lds0 = (unsigned)(uintptr_t)shm;
    float* wsf = (float*)(shm + AT_WS) + wid * 64;
    const bf16_t* ksrc = Kh + (size_t)lane * KVP + wid * 8;
    const bf16_t* vsrc = Vh + (size_t)(16 * (wid & 3) + (lane >> 2)) * KVP + (wid >> 2) * 32 + (lane & 3) * 8;
    const unsigned kdst = lds0 + AT_K + wid * 1024, vdst = lds0 + AT_V + wid * 1024;
#define DMA_K(t, slot) glds16(ksrc + (size_t)(t) * 64 * KVP, (unsigned)__builtin_amdgcn_readfirstlane(kdst + (slot)))
#define DMA_V(t, slot) glds16(vsrc + (size_t)(t) * 64 * KVP, (unsigned)__builtin_amdgcn_readfirstlane(vdst + (slot)))
    const int vb0 = (int)(lds0 + AT_V) + ((lane >> 4) & 1) * 32 + (lane & 3) * 8 + (4 * hi + ((lane & 15) >> 2)) * 64;
    DMA_K(0, 0); DMA_V(0, 0);
    const bf16_t* Qw = Qu + (size_t)(wid * 32) * QP;
    bf16x8 qr[4];
#pragma unroll
    for (int d0 = 0; d0 < 4; ++d0) qr[d0] = *reinterpret_cast<const bf16x8*>(&Qw[(size_t)r32 * QP + d0 * 16 + hi * 8]);
    float mrun = -INFINITY, l_reg = 0.f; f32x16 o[2]; o[0] = f32x16{}; o[1] = f32x16{};
    f32x16 zero16 = f32x16{};
    for (int t = 0; t < NT; ++t) {
        const int buf = (t & 1) * 8192;
        if (t + 1 < NT) { DMA_K(t + 1, buf ^ 8192); DMA_V(t + 1, buf ^ 8192); asm volatile("s_waitcnt vmcnt(2)\n\ts_barrier" ::: "memory"); }
        else { asm volatile("s_waitcnt vmcnt(0)\n\ts_barrier" ::: "memory"); }
        f32x16 p0, p1;
        qkt(p0, p1, shm + AT_K + buf, qr, zero16, r32, hi);
        float rm = p0[0];
#pragma unroll
        for (int r = 1; r < 16; ++r) rm = fmaxf(rm, p0[r]);
#pragma unroll
        for (int r = 0; r < 16; ++r) rm = fmaxf(rm, p1[r]);
        rm = fmaxf(rm, __shfl_xor(rm, 32));
        const float mnew = fmaxf(mrun, rm);
        const float f = __builtin_amdgcn_exp2f(mrun - mnew);
        mrun = mnew;
        float sacc = 0.f;
#pragma unroll
        for (int r = 0; r < 16; ++r) { p0[r] = __builtin_amdgcn_exp2f(p0[r] - mnew); p1[r] = __builtin_amdgcn_exp2f(p1[r] - mnew); sacc += p0[r] + p1[r]; }
        l_reg = l_reg * f + sacc;
        if (hi == 0) wsf[r32] = f;
        asm volatile("s_waitcnt lgkmcnt(0)" ::: "memory");
#pragma unroll
        for (int r = 0; r < 16; ++r) { const float fr_ = wsf[crow(r, hi)]; o[0][r] *= fr_; o[1][r] *= fr_; }
        u32x4 pw0, pw1, pw2, pw3;
        pw0 = (u32x4){cvtpk_s(p0[0], p0[1]), cvtpk_s(p0[2], p0[3]), cvtpk_s(p0[4], p0[5]), cvtpk_s(p0[6], p0[7])};
        pw1 = (u32x4){cvtpk_s(p0[8], p0[9]), cvtpk_s(p0[10], p0[11]), cvtpk_s(p0[12], p0[13]), cvtpk_s(p0[14], p0[15])};
        pw2 = (u32x4){cvtpk_s(p1[0], p1[1]), cvtpk_s(p1[2], p1[3]), cvtpk_s(p1[4], p1[5]), cvtpk_s(p1[6], p1[7])};
        pw3 = (u32x4){cvtpk_s(p1[8], p1[9]), cvtpk_s(p1[10], p1[11]), cvtpk_s(p1[12], p1[13]), cvtpk_s(p1[14], p1[15])};
        pv(o, vb0 + buf, __builtin_bit_cast(bf16x8, pw0), __builtin_bit_cast(bf16x8, pw1), __builtin_bit_cast(bf16x8, pw2), __builtin_bit_cast(bf16x8, pw3));
        asm volatile("s_waitcnt lgkmcnt(0)\n\ts_barrier" ::: "memory");
    }
    l_reg += __shfl_xor(l_reg, 32);
    if (hi == 0) wsf[32 + r32] = l_reg;
    asm volatile("s_waitcnt lgkmcnt(0)" ::: "memory");
    float rli[16];
#pragma unroll
    for (int r = 0; r < 16; ++r) rli[r] = 1.0f / wsf[32 + crow(r, hi)];
    bf16_t* Ow = Ou + (size_t)(wid * 32) * MIXK;
    { bf16_t* stg = (bf16_t*)(shm + AT_OST) + wid * 2048;
#pragma unroll
      for (int r = 0; r < 16; ++r) { const int orow = crow(r, hi);
#pragma unroll
        for (int d0 = 0; d0 < 2; ++d0) stg[orow * 64 + d0 * 32 + r32] = (bf16_t)f2bf(o[d0][r] * rli[r]); }
      asm volatile("s_waitcnt lgkmcnt(0)" ::: "memory");
#pragma unroll
      for (int i = 0; i < 4; ++i) { const int row = i * 8 + (lane >> 3), ch = lane & 7; const u32x4 v = *(const u32x4*)(stg + row * 64 + ch * 8); *(u32x4*)(Ow + (size_t)row * MIXK + ch * 8) = v; } }
    asm volatile("s_waitcnt vmcnt(0) lgkmcnt(0)\n\ts_barrier" ::: "memory");
#undef DMA_K
#undef DMA_V
}

__device__ __forceinline__ int PADI(int i) { return i + (i >> 5); }
constexpr int FFT_TW_OFF = 69632, FFT_RED_OFF = 69632 + 32768;
template <int LOGN, int R, bool INV>
__device__ __forceinline__ void fft_pass(LAS f32x2* d, const LAS f32x2* tw, int s, int tid) {
    constexpr int N = 1 << LOGN, RR = 1 << R;
    const int lgs = LOGN - s - R; const int stride = 1 << lgs;
    constexpr float C16[8] = {1.0f, 0.9238795325112867f, 0.7071067811865476f, 0.3826834323650898f, 0.0f, -0.3826834323650898f, -0.7071067811865476f, -0.9238795325112867f};
    constexpr float S16[8] = {0.0f, 0.3826834323650898f, 0.7071067811865476f, 0.9238795325112867f, 1.0f, 0.9238795325112867f, 0.7071067811865476f, 0.3826834323650898f};
    for (int g = tid; g < (N >> R); g += 512) {
        const int lo = g & (stride - 1), hi = g >> lgs; const int base = (hi << (lgs + R)) + lo;
        f32x2 v[RR];
#pragma unroll
        for (int e = 0; e < RR; ++e) v[e] = d[PADI(base + e * stride)];
        if constexpr (R == 1) { const f32x2 a = v[0], b = v[1]; v[0] = a + b; v[1] = a - b; }
        else {
            static_assert(R == 4 || R == 1, "radix");
            f32x2 Wb[4];
            Wb[0] = tw[lo << s];
#pragma unroll
            for (int j = 1; j < 4; ++j) Wb[j] = (f32x2){Wb[j - 1].x * Wb[j - 1].x - Wb[j - 1].y * Wb[j - 1].y, 2.0f * Wb[j - 1].x * Wb[j - 1].y};
#pragma unroll
            for (int jj = 0; jj < 4; ++jj) {
                const int j = INV ? (3 - jj) : jj;
                const int he = 8 >> j;
#pragma unroll
                for (int q = 0; q < 8; ++q) if (q < he) {
                    const int k = q << j;
                    const f32x2 w = (f32x2){Wb[j].x * C16[k] + Wb[j].y * S16[k], Wb[j].y * C16[k] - Wb[j].x * S16[k]};
#pragma unroll
                    for (int e = 0; e < 16; ++e) if ((e & he) == 0 && (e & (he - 1)) == q) {
                        const f32x2 a = v[e], b = v[e + he];
                        if (!INV) { const f32x2 dl = a - b; v[e] = a + b; v[e + he] = (f32x2){dl.x * w.x - dl.y * w.y, dl.x * w.y + dl.y * w.x}; }
                        else { const f32x2 bw = (f32x2){b.x * w.x + b.y * w.y, b.y * w.x - b.x * w.y}; v[e] = a + bw; v[e + he] = a - bw; }
                    }
                }
            }
        }
#pragma unroll
        for (int e = 0; e < RR; ++e) d[PADI(base + e * stride)] = v[e];
    }
    __syncthreads();
}
template <int LOGN> __device__ __forceinline__ void fft_fwd(LAS f32x2* d, const LAS f32x2* tw, int tid) {
    if constexpr (LOGN == 13) { fft_pass<13, 4, false>(d, tw, 0, tid); fft_pass<13, 4, false>(d, tw, 4, tid); fft_pass<13, 4, false>(d, tw, 8, tid); fft_pass<13, 1, false>(d, tw, 12, tid); }
    else { fft_pass<9, 4, false>(d, tw, 0, tid); fft_pass<9, 4, false>(d, tw, 4, tid); fft_pass<9, 1, false>(d, tw, 8, tid); }
}
template <int LOGN> __device__ __forceinline__ void fft_inv(LAS f32x2* d, const LAS f32x2* tw, int tid) {
    if constexpr (LOGN == 13) { fft_pass<13, 1, true>(d, tw, 12, tid); fft_pass<13, 4, true>(d, tw, 8, tid); fft_pass<13, 4, true>(d, tw, 4, tid); fft_pass<13, 4, true>(d, tw, 0, tid); }
    else { fft_pass<9, 1, true>(d, tw, 8, tid); fft_pass<9, 4, true>(d, tw, 4, tid); fft_pass<9, 4, true>(d, tw, 0, tid); }
}
template <int LOGN> __device__ __forceinline__ void fft_fwd_head(LAS f32x2* d, const LAS f32x2* tw, int tid) {
    if constexpr (LOGN == 13) { fft_pass<13, 4, false>(d, tw, 0, tid); fft_pass<13, 4, false>(d, tw, 4, tid); fft_pass<13, 4, false>(d, tw, 8, tid); }
    else { fft_pass<9, 4, false>(d, tw, 0, tid); fft_pass<9, 4, false>(d, tw, 4, tid); }
}
template <int LOGN> __device__ __forceinline__ void fft_inv_tail(LAS f32x2* d, const LAS f32x2* tw, int tid) {
    if constexpr (LOGN == 13) { fft_pass<13, 4, true>(d, tw, 8, tid); fft_pass<13, 4, true>(d, tw, 4, tid); fft_pass<13, 4, true>(d, tw, 0, tid); }
    else { fft_pass<9, 4, true>(d, tw, 4, tid); fft_pass<9, 4, true>(d, tw, 0, tid); }
}
template <int LOGN> __device__ __forceinline__ void load_tw(LAS f32x2* tw, const f32x2* g, int tid) {
    for (int i = tid; i < (1 << (LOGN - 1)); i += 512) tw[i] = g[i];
}

template <int LOGN> __device__ __forceinline__ void kf_job(LAS unsigned char* lds, const float* hrawT, const f32x2* twg, f32x2* kf, int ch, int tid) {
    constexpr int N = 1 << LOGN, T = N / 2;
    LAS f32x2* d = (LAS f32x2*)lds; LAS f32x2* tw = (LAS f32x2*)(lds + FFT_TW_OFF); LAS float* red = (LAS float*)(lds + FFT_RED_OFF);
    float s = 0.f;
    { constexpr int NI = (N + 511) / 512; float hv[NI];
#pragma unroll
      for (int i = 0; i < NI; ++i) { const int n = tid + 512 * i; float v = 0.f;
          if (n < N) { if (n < T) v = hrawT[(size_t)ch * T + n]; else if (n > T) v = hrawT[(size_t)(256 + ch) * T + (N - n)]; }
          hv[i] = v; }
      load_tw<LOGN>(tw, twg, tid);
#pragma unroll
      for (int i = 0; i < NI; ++i) { const int n = tid + 512 * i; if (n < N) { d[PADI(n)] = (f32x2){hv[i], 0.f}; s += fabsf(hv[i]); } } }
    s = wave_sum(s);
    if ((tid & 63) == 0) red[tid >> 6] = s;
    __syncthreads();
    float tot = 0.f;
#pragma unroll
    for (int i = 0; i < 8; ++i) tot += red[i];
    const float inv = 1.0f / tot;
    for (int n = tid; n < N; n += 512) { f32x2 v = d[PADI(n)]; v.x *= inv; d[PADI(n)] = v; }
    __syncthreads();
    fft_fwd<LOGN>(d, tw, tid);
    for (int n = tid; n < N; n += 512) kf[(size_t)ch * N + n] = d[PADI(n)];
    __syncthreads();
}

template <int LOGN> __device__ __forceinline__ void hyena_job(LAS unsigned char* lds, const bf16_t* PTall, const f32x2* twg, const f32x2* kf, const float* wc, const float* bc, const float* hbias,
                                                            bf16_t* MIXp, int rowbase, int bp, int ch, int tid) {
    constexpr int N = 1 << LOGN, T = N / 2;
    constexpr int VEC = (T >= 4096) ? 8 : 1;
    constexpr int NKF = (N / 2 + 511) / 512;
    LAS f32x2* d = (LAS f32x2*)lds; LAS f32x2* tw = (LAS f32x2*)(lds + FFT_TW_OFF);
    f32x4 kfr[NKF];
#pragma unroll
    for (int i = 0; i < NKF; ++i) { const int g = tid + 512 * i; kfr[i] = (g < N / 2) ? *(const f32x4*)(kf + (size_t)ch * N + 2 * g) : (f32x4){0.f, 0.f, 0.f, 0.f}; }
    const float w10 = wc[256 + ch], w11 = wc[768 + 256 + ch], w12 = wc[1536 + 256 + ch], b1 = bc[256 + ch];
    const float w20 = wc[512 + ch], w21 = wc[768 + 512 + ch], w22 = wc[1536 + 512 + ch], b2 = bc[512 + ch];
    const float w00 = wc[ch], w01 = wc[768 + ch], w02 = wc[1536 + ch], b0 = bc[ch];
    const float hb = hbias[ch];
    const int t0 = tid * VEC; const bool act = t0 < T;
    float raw[2][3][VEC + 2];
#pragma unroll
    for (int bb = 0; bb < 2; ++bb)
#pragma unroll
        for (int st = 0; st < 3; ++st) {
            const bf16_t* p = PTall + ((size_t)(2 * bp + bb) * 768 + st * 256 + ch) * T;
            if (act) {
                if constexpr (VEC == 8) { const u32x4 w = *(const u32x4*)(p + t0);
                    raw[bb][st][1] = bflo(w.x); raw[bb][st][2] = bfhi(w.x); raw[bb][st][3] = bflo(w.y); raw[bb][st][4] = bfhi(w.y);
                    raw[bb][st][5] = bflo(w.z); raw[bb][st][6] = bfhi(w.z); raw[bb][st][7] = bflo(w.w); raw[bb][st][8] = bfhi(w.w); }
                else raw[bb][st][1] = bf2f(p[t0]);
                raw[bb][st][0] = t0 > 0 ? bf2f(p[t0 - 1]) : 0.f;
                raw[bb][st][VEC + 1] = (t0 + VEC < T) ? bf2f(p[t0 + VEC]) : 0.f;
            } else {
#pragma unroll
                for (int i = 0; i < VEC + 2; ++i) raw[bb][st][i] = 0.f;
            }
        }
    load_tw<LOGN>(tw, twg, tid);
    f32x2 ukeep[VEC]; float x0k[2][VEC];
#pragma unroll
    for (int i = 0; i < VEC; ++i) {
        f32x2 u;
#pragma unroll
        for (int bb = 0; bb < 2; ++bb) {
            const float x1 = raw[bb][1][i] * w10 + raw[bb][1][i + 1] * w11 + raw[bb][1][i + 2] * w12 + b1;
            const float vv = raw[bb][2][i] * w20 + raw[bb][2][i + 1] * w21 + raw[bb][2][i + 2] * w22 + b2;
            x0k[bb][i] = raw[bb][0][i] * w00 + raw[bb][0][i + 1] * w01 + raw[bb][0][i + 2] * w02 + b0;
            if (bb == 0) u.x = x1 * vv; else u.y = x1 * vv;
        }
        ukeep[i] = u;
        if (act) { d[PADI(t0 + i)] = u; d[PADI(t0 + i + T)] = (f32x2){0.f, 0.f}; }
    }
    __syncthreads();
    fft_fwd_head<LOGN>(d, tw, tid);
#pragma unroll
    for (int i = 0; i < NKF; ++i) { const int g = tid + 512 * i; if (g < N / 2) {
        const f32x2 a = d[PADI(2 * g)], b = d[PADI(2 * g + 1)]; const f32x2 fa = a + b, fb = a - b; const f32x4 k = kfr[i];
        const f32x2 ma = (f32x2){fa.x * k.x - fa.y * k.y, fa.x * k.y + fa.y * k.x}, mb = (f32x2){fb.x * k.z - fb.y * k.w, fb.x * k.w + fb.y * k.z};
        d[PADI(2 * g)] = ma + mb; d[PADI(2 * g + 1)] = ma - mb; } }
    __syncthreads();
    fft_inv_tail<LOGN>(d, tw, tid);
    const float sc = 1.0f / (float)N;
    if (act) {
#pragma unroll
        for (int i = 0; i < VEC; ++i) {
            const f32x2 y = d[PADI(t0 + i)] * sc; const f32x2 u = ukeep[i];
#pragma unroll
            for (int bb = 0; bb < 2; ++bb) {
                const float yy = bb == 0 ? y.x : y.y, uu = bb == 0 ? u.x : u.y;
                MIXp[(size_t)(rowbase + (2 * bp + bb) * T + t0 + i) * MIXK + 1024 + ch] = (bf16_t)f2bf(x0k[bb][i] * (yy + uu * hb));
            }
        }
    }
    __syncthreads();
}

__device__ __forceinline__ void norm_rows(int gw, int NGW, int lane, int nrows, const float* xl_in, const float* xc_in, float* xl_out, float* xc_out,
                                          const bf16_t* Y, const float* gpost, const float* modA, int ga_off,
                                          bf16_t* XN, const float* gpre, const float* modB, int sc_off, int sh_off, const bf16_t* xb_in, bf16_t* xb_out) {
    constexpr int NR = 2;
    const int per = (nrows + NGW - 1) / NGW; const int rbeg = gw * per; int rend = rbeg + per; if (rend > nrows) rend = nrows;
    f32x4 gpo[4], gpr[4];
#pragma unroll
    for (int j = 0; j < 4; ++j) { gpo[j] = Y ? *(const f32x4*)(gpost + 4 * lane + 256 * j) : (f32x4){0.f, 0.f, 0.f, 0.f}; gpr[j] = XN ? *(const f32x4*)(gpre + 4 * lane + 256 * j) : (f32x4){0.f, 0.f, 0.f, 0.f}; }
    int cur_mb = -1; f32x4 mga[4], msc[4], msh[4];
    for (int row0 = rbeg; row0 < rend; row0 += NR) {
        f32x4 v[NR][4]; u32x2 yw[NR][4]; bool ok[NR]; bool isc[NR]; int rowi[NR];
#pragma unroll
        for (int q = 0; q < NR; ++q) {
            const int row = row0 + q; ok[q] = row < rend; rowi[q] = ok[q] ? row : row0;
            isc[q] = rowi[q] >= ML;
            if (xb_in) {
#pragma unroll
                for (int j = 0; j < 4; ++j) { const u32x2 w = *(const u32x2*)(xb_in + (size_t)rowi[q] * DM + 4 * lane + 256 * j); v[q][j] = (f32x4){bflo(w.x), bfhi(w.x), bflo(w.y), bfhi(w.y)}; }
            } else {
                const float* xin = isc[q] ? xc_in + (size_t)(rowi[q] - ML) * DM : xl_in + (size_t)rowi[q] * DM;
#pragma unroll
                for (int j = 0; j < 4; ++j) v[q][j] = *(const f32x4*)(xin + 4 * lane + 256 * j);
            }
            if (Y) {
#pragma unroll
                for (int j = 0; j < 4; ++j) yw[q][j] = *(const u32x2*)(Y + (size_t)rowi[q] * DM + 4 * lane + 256 * j);
            }
        }
#pragma unroll
        for (int q = 0; q < NR; ++q) {
            const int mb = isc[q] ? 8 : (rowi[q] >> 12);
            if (mb != cur_mb) { cur_mb = mb;
#pragma unroll
                for (int j = 0; j < 4; ++j) { mga[j] = Y ? *(const f32x4*)(modA + (size_t)mb * 6144 + ga_off + 4 * lane + 256 * j) : (f32x4){0.f, 0.f, 0.f, 0.f};
                    msc[j] = XN ? *(const f32x4*)(modB + (size_t)mb * 6144 + sc_off + 4 * lane + 256 * j) : (f32x4){0.f, 0.f, 0.f, 0.f};
                    msh[j] = XN ? *(const f32x4*)(modB + (size_t)mb * 6144 + sh_off + 4 * lane + 256 * j) : (f32x4){0.f, 0.f, 0.f, 0.f}; } }
            if (Y) {
                float s = 0.f;
#pragma unroll
                for (int j = 0; j < 4; ++j) { const float a = bflo(yw[q][j].x), b = bfhi(yw[q][j].x), c = bflo(yw[q][j].y), d = bfhi(yw[q][j].y); s += (a * a + b * b) + (c * c + d * d); }
                const float rstd = rsqrtf(wave_sum(s) * (1.0f / DM) + EPS);
                float* xo = isc[q] ? xc_out + (size_t)(rowi[q] - ML) * DM : xl_out + (size_t)rowi[q] * DM;
#pragma unroll
                for (int j = 0; j < 4; ++j) { const f32x4 y = (f32x4){bflo(yw[q][j].x), bfhi(yw[q][j].x), bflo(yw[q][j].y), bfhi(yw[q][j].y)};
                    v[q][j] = v[q][j] + mga[j] * (y * rstd * gpo[j]);
                    if (ok[q]) { if (xb_out) { u32x2 w; w.x = pk2(v[q][j].x, v[q][j].y); w.y = pk2(v[q][j].z, v[q][j].w); *(u32x2*)(xb_out + (size_t)rowi[q] * DM + 4 * lane + 256 * j) = w; }
                                 else *(f32x4*)(xo + 4 * lane + 256 * j) = v[q][j]; } }
            }
            if (XN) {
                float s = 0.f;
#pragma unroll
                for (int j = 0; j < 4; ++j) s += (v[q][j].x * v[q][j].x + v[q][j].y * v[q][j].y) + (v[q][j].z * v[q][j].z + v[q][j].w * v[q][j].w);
                const float rstd = rsqrtf(wave_sum(s) * (1.0f / DM) + EPS);
#pragma unroll
                for (int j = 0; j < 4; ++j) { const f32x4 o = (v[q][j] * rstd * gpr[j]) * (1.0f + msc[j]) + msh[j]; u32x2 w; w.x = pk2(o.x, o.y); w.y = pk2(o.z, o.w);
                    if (ok[q]) *(u32x2*)(XN + (size_t)rowi[q] * DM + 4 * lane + 256 * j) = w; }
            }
        }
    }
}

__device__ __forceinline__ void glu_pass(int blk, int nblk, int tid, int r0, int nrows, const bf16_t* U, bf16_t* G, const float* wc, const float* bc) {
    const int nitems = nrows / 8;
    for (int it = blk; it < nitems; it += nblk) {
        for (int p = tid; p < 8 * 352; p += 512) {
            const int rl = it * 8 + p / 352, vc = p % 352, j0 = vc * 8; const int r = r0 + rl;
            int t, len; if (r >= ML) { t = (r - ML) & (CL - 1); len = CL; } else { t = r & (SL - 1); len = SL; }
            const bool hm = t > 0, hp = t < len - 1;
            const bf16_t* ur = U + (size_t)rl * UPW + j0;
            const u32x4 z4 = (u32x4){0u, 0u, 0u, 0u};
            const u32x4 g0 = *(const u32x4*)ur, gm = hm ? *(const u32x4*)(ur - UPW) : z4, gp = hp ? *(const u32x4*)(ur + UPW) : z4;
            const u32x4 v0 = *(const u32x4*)(ur + DFF), vm = hm ? *(const u32x4*)(ur + DFF - UPW) : z4, vp = hp ? *(const u32x4*)(ur + DFF + UPW) : z4;
            unsigned outw[4];
#pragma unroll
            for (int q = 0; q < 4; ++q) {
                float res[2];
#pragma unroll
                for (int h = 0; h < 2; ++h) {
                    const int j = j0 + 2 * q + h;
                    const float a_m = h ? bfhi(gm[q]) : bflo(gm[q]), a_0 = h ? bfhi(g0[q]) : bflo(g0[q]), a_p = h ? bfhi(gp[q]) : bflo(gp[q]);
                    const float c_m = h ? bfhi(vm[q]) : bflo(vm[q]), c_0 = h ? bfhi(v0[q]) : bflo(v0[q]), c_p = h ? bfhi(vp[q]) : bflo(vp[q]);
                    const float cg = a_m * wc[j] + a_0 * wc[UPW + j] + a_p * wc[2 * UPW + j] + bc[j];
                    const float cv = c_m * wc[DFF + j] + c_0 * wc[UPW + DFF + j] + c_p * wc[2 * UPW + DFF + j] + bc[DFF + j];
                    const float sg = cg / (1.0f + __expf(-cg));
                    res[h] = sg * cv;
                }
                outw[q] = pk2(res[0], res[1]);
            }
            *(u32x4*)(G + (size_t)rl * DFF + j0) = (u32x4){outw[0], outw[1], outw[2], outw[3]};
        }
    }
}

__device__ __forceinline__ void transpose_item(const float* W, int ldw, bf16_t* WT, int ldt, int nblk, int item, LAS float* scr, int lane, bool remap = false) {
    const int kb = item / nblk, nb = item % nblk, k0 = 64 * kb, n0 = 32 * nb;
    int n0d = n0;
    if (remap) { if (n0 < DFF) n0d = 256 * (n0 >> 7) + (n0 & 127); else { const int c = n0 - DFF; n0d = 256 * (c >> 7) + 128 + (c & 127); } }
    float tv[32];
#pragma unroll
    for (int i = 0; i < 32; ++i) tv[i] = W[(size_t)(k0 + 2 * i + (lane >> 5)) * ldw + n0 + (lane & 31)];
#pragma unroll
    for (int i = 0; i < 32; ++i) scr[(2 * i + (lane >> 5)) * 33 + (lane & 31)] = tv[i];
    asm volatile("s_waitcnt lgkmcnt(0)" ::: "memory");
    const int c = lane & 7;
#pragma unroll
    for (int j = 0; j < 4; ++j) { const int n = (lane >> 3) + 8 * j; const LAS float* s = scr + (8 * c) * 33 + n;
        u32x4 o; o.x = pk2(s[0 * 33], s[1 * 33]); o.y = pk2(s[2 * 33], s[3 * 33]); o.z = pk2(s[4 * 33], s[5 * 33]); o.w = pk2(s[6 * 33], s[7 * 33]);
        *(u32x4*)(WT + (size_t)(n0d + n) * ldt + k0 + 8 * c) = o; }
    asm volatile("s_waitcnt lgkmcnt(0)" ::: "memory");
}
}

using namespace mk;
#ifndef MK_TMASK
#define MK_TMASK 0
#endif
#define TSTART() unsigned long long tts_ = 0; if (MK_TMASK) tts_ = __builtin_amdgcn_s_memrealtime();
#define TSTOP(c) if (MK_TMASK && ((MK_TMASK >> (c)) & 1)) tacc_ += __builtin_amdgcn_s_memrealtime() - tts_;
typedef const __attribute__((address_space(4))) Params* KP;
__device__ __forceinline__ KP kp_get() { KP p = (KP)__builtin_amdgcn_kernarg_segment_ptr(); asm volatile("" : "+s"(p)); return p; }
#ifndef MK_REP
#define MK_REP 0
#endif
#define REP(k) for (int rep_ = 0; rep_ < 1 + ((MK_REP >> (k)) & 1); ++rep_)
#ifndef MK_EN
#define MK_EN 0xffff
#endif
#define EN(k) if constexpr ((MK_EN >> (k)) & 1)
constexpr int LDS_BYTES = 159744;
constexpr int XCH_OFF = 131072;
constexpr int MISC_OFF = 131072 + 8192 + 18432;

#define RLX_AGENT __ATOMIC_RELAXED, __HIP_MEMORY_SCOPE_AGENT
#define XB_TMO      128
#define XB_XCNT(j)  (256  + 64 * (j))
#define XB_XSUB(j)  (1280 + 64 * (j))
#define XB_XGEN(j)  (2304 + 64 * (j))
#define XB_TOP      3328
#define XB_TOPGEN   3392
#define XCD_BAR_WORDS 3456
#define XB_SPIN_CAP (1u << 18)

__device__ __forceinline__ unsigned xb_ld(unsigned* p)              { return __hip_atomic_load(p, __ATOMIC_RELAXED, __HIP_MEMORY_SCOPE_AGENT); }
__device__ __forceinline__ unsigned xb_add(unsigned* p, unsigned v) { return __hip_atomic_fetch_add(p, v, __ATOMIC_RELAXED, __HIP_MEMORY_SCOPE_AGENT); }
__device__ __forceinline__ unsigned xb_xcc_id() { return (unsigned)__builtin_amdgcn_s_getreg((3 << 11) | 20) & 0xFu; }
#define XB_SPIN(cond, bar) do { unsigned _sp = 0; while (cond) { __builtin_amdgcn_s_sleep(1); \
    if ((++_sp & 255u) == 0u) { if (xb_ld(&(bar)[XB_TMO])) break; if (_sp > XB_SPIN_CAP) { atomicAdd(&(bar)[XB_TMO], 1u); break; } } } } while (0)

struct XcdBarrier {
    unsigned* bar; unsigned x;
    volatile LAS unsigned* st;
};

__device__ __forceinline__ XcdBarrier xcd_barrier_post(unsigned* bar, volatile LAS unsigned* st) {
    XcdBarrier b; b.bar = bar; b.x = xb_xcc_id(); b.st = st;
    if (threadIdx.x == 0) (void)xb_add(&bar[XB_XCNT(b.x)], 1u);
    return b;
}
__device__ __forceinline__ void xcd_barrier_complete(unsigned* bar, unsigned x, unsigned& nloc, unsigned& nx) {
    const unsigned G = gridDim.x * gridDim.y * gridDim.z;
    unsigned sum, cnt, mine, sp = 0u;
    for (;;) {
        sum = 0u; cnt = 0u; mine = 0u;
#pragma unroll
        for (unsigned j = 0; j < 16; ++j) { const unsigned c = xb_ld(&bar[XB_XCNT(j)]); sum += c; cnt += (c > 0u) ? 1u : 0u; mine = (j == x) ? c : mine; }
        if (sum == G) break;
        __builtin_amdgcn_s_sleep(1);
        if ((++sp & 255u) == 0u) { if (xb_ld(&bar[XB_TMO])) break; if (sp > XB_SPIN_CAP) { atomicAdd(&bar[XB_TMO], 1u); break; } }
    }
    nloc = mine > 0u ? mine : 1u; nx = cnt > 0u ? cnt : 1u;
}

__device__ __forceinline__ void xcd_barrier(const XcdBarrier& b) {
    asm volatile("s_waitcnt vmcnt(0)" ::: "memory");
    __syncthreads();
    if (threadIdx.x == 0) {
        unsigned* bar = b.bar;
        __builtin_amdgcn_s_waitcnt(0);
        unsigned nloc = b.st[0], nx = b.st[1];
        if (nloc == 0u) { xcd_barrier_complete(bar, b.x, nloc, nx); b.st[0] = nloc; b.st[1] = nx; }
        const unsigned old = xb_add(&bar[XB_XSUB(b.x)], 1u);
        const unsigned gen = old / nloc;
        if (old + 1u == (gen + 1u) * nloc) {
            __builtin_amdgcn_fence(__ATOMIC_RELEASE, "agent");
            asm volatile("s_waitcnt vmcnt(0)" ::: "memory");
            const unsigned og = xb_add(&bar[XB_TOP], 1u);
            const unsigned tg = og / nx;
            if (og + 1u == (tg + 1u) * nx) xb_add(&bar[XB_TOPGEN], 1u);
            else XB_SPIN(xb_ld(&bar[XB_TOPGEN]) == tg, bar);
            __builtin_amdgcn_fence(__ATOMIC_ACQUIRE, "agent");
            xb_add(&bar[XB_XGEN(b.x)], 1u);
            asm volatile("s_waitcnt vmcnt(0)" ::: "memory");
        } else {
            XB_SPIN(xb_ld(&bar[XB_XGEN(b.x)]) == gen, bar);
            __builtin_amdgcn_fence(__ATOMIC_ACQUIRE, "agent");
            asm volatile("s_waitcnt vmcnt(0)" ::: "memory");
        }
    }
    __syncthreads();
}

__device__ __forceinline__ bf16_t* wlayer(unsigned char* ws, int l, size_t off) { return (bf16_t*)(ws + WS_W + (size_t)l * W_LAYER + off); }
constexpr size_t OFF_WIN = 0, OFF_WOUT = 4 * MiB, OFF_WUP = 7 * MiB, OFF_WDOWN = 18 * MiB;

__device__ __forceinline__ void setup0(KP pp, LAS unsigned char* lds, int tid, int lane, int wave, unsigned long long& tacc_) {
    unsigned char* ws = pp->ws;
    { TSTART()
        LAS float* scr = (LAS float*)(lds + wave * 16384);
        const int gw = blockIdx.x * 8 + wave, NGW = gridDim.x * 8;
        constexpr int I_IN = 16 * 56, I_UP = 16 * 176, I_DN = 44 * 32, I_OA = 8 * 32, I_OH = 4 * 32, I_L = I_IN + I_UP + I_DN + I_OA + I_OH;
        for (int it = gw; it < 2 * I_L; it += NGW) {
            const int l = it / I_L; int r = it % I_L;
            if (r < I_IN) { transpose_item(pp->in[I_WIN] + (size_t)l * DM * INW, INW, wlayer(ws, l, OFF_WIN), DM, 56, r, scr, lane); continue; } r -= I_IN;
            if (r < I_UP) { transpose_item(pp->in[I_WUP] + (size_t)l * DM * UPW, UPW, wlayer(ws, l, OFF_WUP), DM, 176, r, scr, lane, true); continue; } r -= I_UP;
            if (r < I_DN) { transpose_item(pp->in[I_WDOWN] + (size_t)l * DFF * DM, DM, wlayer(ws, l, OFF_WDOWN), DFF, 32, r, scr, lane); continue; } r -= I_DN;
            if (r < I_OA) { transpose_item(pp->in[I_WOUT] + (size_t)l * DM * DM, DM, wlayer(ws, l, OFF_WOUT), MIXK, 32, r, scr, lane); continue; } r -= I_OA;
            transpose_item(pp->in[I_WOUT] + (size_t)l * DM * DM + (size_t)768 * DM, DM, wlayer(ws, l, OFF_WOUT) + 1024, MIXK, 32, r, scr, lane);
        }
    __syncthreads(); TSTOP(9) }
    constexpr int N_MOD = 192, N_MLP = 512 + 32 + 512, N_DFT = 4096 + 256, N_T = 512, N_TAB = 1;
    constexpr int NIT = N_MOD + N_MLP + N_DFT + N_T + N_TAB;
    if (blockIdx.x < 11) {
        const int idx = (int)blockIdx.x * 512 + tid;
        if (idx < 2 * DFF) { const int l = idx / DFF, c = idx % DFF; const float* w = pp->in[I_WFC] + (size_t)l * 3 * UPW; const float* b = pp->in[I_BFC] + (size_t)l * UPW;
            u32x4 o; o.x = pk2(w[c], w[UPW + c]); o.y = pk2(w[2 * UPW + c], b[c]); o.z = pk2(w[DFF + c], w[UPW + DFF + c]); o.w = pk2(w[2 * UPW + DFF + c], b[DFF + c]);
            ((u32x4*)(ws + WS_WCP))[idx] = o; }
    }
    LAS float* fl = (LAS float*)lds; bool tab_ready = false;
    for (int it = blockIdx.x; it < NIT; it += gridDim.x) {
        int r = it; TSTART()
        if (r < N_MOD) {
            const int l = r / 96, cb = (r % 96) / 8, kc = r % 8;
            for (int idx = tid; idx < 9 * 128; idx += 512) { const int rr = idx / 128, k = idx % 128; const float cv = rr < 8 ? pp->in[I_C][rr * DM + kc * 128 + k] : pp->in[I_CCTX][kc * 128 + k];
                fl[idx] = cv / (1.0f + __expf(-cv)); }
            __syncthreads();
            const int j = cb * 512 + tid; float acc[9];
#pragma unroll
            for (int rr = 0; rr < 9; ++rr) acc[rr] = 0.f;
            const float* wm = pp->in[I_WMOD] + (size_t)l * DM * 6144 + (size_t)(kc * 128) * 6144 + j;
            for (int k0 = 0; k0 < 128; k0 += 32) { float wv_[32];
#pragma unroll
              for (int kk = 0; kk < 32; ++kk) wv_[kk] = wm[(size_t)(k0 + kk) * 6144];
#pragma unroll
              for (int kk = 0; kk < 32; ++kk) {
#pragma unroll
                for (int rr = 0; rr < 9; ++rr) acc[rr] += fl[rr * 128 + k0 + kk] * wv_[kk]; } }
            float* mp = (float*)(ws + WS_MODP) + ((size_t)(l * 8 + kc) * 9) * 6144 + j;
#pragma unroll
            for (int rr = 0; rr < 9; ++rr) mp[(size_t)rr * 6144] = acc[rr];
            __syncthreads(); TSTOP(10)
            continue;
        }
        r -= N_MOD;
        if (r < N_MLP) {
            int l, which, t0;
            if (r < 512) { l = 0; which = 0; t0 = r * 8; } else if (r < 544) { l = 0; which = 1; t0 = (r - 512) * 8; } else { l = 1; which = 0; t0 = (r - 544) * 8; }
            const int T = which ? CL : SL;
            LAS float* Z = fl; LAS float* H1 = fl + 8 * 36; LAS float* H2 = H1 + 512;
            if (tid < 128) { const int p = tid >> 4, i = tid & 15; const int t = t0 + p; const float band = 1e-4f + (float)i * ((15.0f - 1e-4f) / 15.0f);
                const float ang = ((6.2831855f * (float)t) / (float)T) * band; Z[p * 36 + 1 + i] = cosf(ang); Z[p * 36 + 17 + i] = -sinf(ang);
                if (i == 0) Z[p * 36] = (float)t / (float)(T - 1); }
            __syncthreads();
            { const int p = tid >> 6, j = tid & 63; const float* w1 = pp->in[I_HW1] + (size_t)l * 33 * 64; float s = pp->in[I_HB1][l * 64 + j];
              float wr_[33];
#pragma unroll
              for (int i = 0; i < 33; ++i) wr_[i] = w1[i * 64 + j];
#pragma unroll
              for (int i = 0; i < 33; ++i) s += Z[p * 36 + i] * wr_[i];
              H1[p * 64 + j] = sinf(pp->in[I_HFR1][l * 64 + j] * s); }
            __syncthreads();
            { const int p = tid >> 6, j = tid & 63; const float* w2 = pp->in[I_HW2] + (size_t)l * 64 * 64; float s = pp->in[I_HB2][l * 64 + j];
              float wr_[64];
#pragma unroll
              for (int i = 0; i < 64; ++i) wr_[i] = w2[i * 64 + j];
#pragma unroll
              for (int i = 0; i < 64; ++i) s += H1[p * 64 + i] * wr_[i];
              H2[p * 64 + j] = sinf(pp->in[I_HFR2][l * 64 + j] * s); }
            __syncthreads();
            { const int j = tid; const float* w3 = pp->in[I_HW3] + (size_t)l * 64 * 512 + j; float acc[8];
#pragma unroll
              for (int p = 0; p < 8; ++p) acc[p] = 0.f;
              float wr_[64];
#pragma unroll
              for (int i = 0; i < 64; ++i) wr_[i] = w3[(size_t)i * 512];
#pragma unroll
              for (int i = 0; i < 64; ++i) {
#pragma unroll
                  for (int p = 0; p < 8; ++p) acc[p] += H2[p * 64 + i] * wr_[i]; }
              const float da = -3.0701134573253944f, db = -15.350567286626972f;
              const float delta = fabsf(da + (float)(j & 255) * ((db - da) / 255.0f));
              float* hr = (float*)(ws + WS_HRAW) + (which ? (size_t)2 * 512 * SL : (size_t)l * 512 * SL) + (size_t)j * T + t0;
#pragma unroll
              for (int p = 0; p < 8; ++p) hr[p] = acc[p] * expf(-Z[p * 36] * delta); }
            __syncthreads(); TSTOP(11)
            continue;
        }
        r -= N_MLP;
        if (r < N_DFT) {
            LAS float* ctab = (LAS float*)(lds + 65536);
            if (!tab_ready) { for (int q = tid; q < 4096; q += 512) ctab[q] = cospif((float)q * (1.0f / 2048.0f)) * (1.0f / 512.0f); tab_ready = true; __syncthreads(); }
            if (r < 4096) { bf16_t* row = (bf16_t*)(ws + WS_ADFT) + (size_t)r * 4096; const bool isS = r > 2048; const int k = isS ? r - 2048 : r; const int sh = isS ? 3072 : 0;
                for (int t = tid * 2; t < 4096; t += 1024) { const float v0 = ctab[((k * t) + sh) & 4095], v1 = ctab[((k * (t + 1)) + sh) & 4095]; *(unsigned*)(row + t) = pk2(v0, v1); } }
            else { const int rr = r - 4096; bf16_t* row = (bf16_t*)(ws + WS_ADFTC) + (size_t)rr * 256; const bool isS = rr > 128; const int k = isS ? rr - 128 : rr; const int sh = isS ? 3072 : 0;
                if (tid < 256) { const float v = ctab[(((k * tid) & 255) * 16 + sh) & 4095] * 4.0f; row[tid] = (bf16_t)f2bf(v); } }
            TSTOP(12) continue;
        }
        r -= N_DFT;
        if (r < N_T) {
            LAS float* ctab = (LAS float*)(lds + 65536);
            if (!tab_ready) { for (int q = tid; q < 4096; q += 512) ctab[q] = cospif((float)q * (1.0f / 2048.0f)) * (1.0f / 512.0f); tab_ready = true; __syncthreads(); }
            const int rr2 = 2 * r + (tid >> 8); const int l = rr2 >> 9, kk = rr2 & 511; const bool isS = kk >= 256; const int gc = kk & 255, g = gc >> 6, c = gc & 63; const int j = tid & 255;
            const float* wf = pp->in[I_WF] + (size_t)l * 256 * 256 + (size_t)(g * 64) * 256 + j; float s = 0.f;
#pragma unroll 16
            for (int m = 0; m < 64; ++m) { const int q = ((m * c) & 63) * 64; const float tr = isS ? -ctab[(q + 3072) & 4095] : ctab[q]; s += tr * wf[(size_t)m * 256]; }
            ((float*)(ws + WS_T))[((size_t)l * 512 + kk) * 256 + j] = s * 512.0f;
            TSTOP(13) continue;
        }
        { f32x2* tw = (f32x2*)(ws + WS_TW);
          for (int i = tid; i < 4096; i += 512) { const float x = (float)i * (1.0f / 4096.0f); tw[i] = (f32x2){cospif(x), -sinpif(x)}; }
          f32x2* tw2 = (f32x2*)(ws + WS_TW + 65536);
          if (tid < 256) { const float x = (float)tid * (1.0f / 256.0f); tw2[tid] = (f32x2){cospif(x), -sinpif(x)}; }
          float* rope = (float*)(ws + WS_TW + 131072);
          for (int i = tid; i < 1024; i += 512) { const int p = i >> 4, q = i & 15; const float inv = powf(10000.0f, -(float)q / 16.0f); const float a = (float)p * inv; rope[i] = cosf(a); rope[1024 + i] = sinf(a); } }
    }
}

__device__ __forceinline__ void setup1(KP pp, LAS unsigned char* lds, int tid, unsigned long long& tacc_) {
    unsigned char* ws = pp->ws;
    { const int gt = blockIdx.x * 512 + tid, NGT = gridDim.x * 512;
      for (int idx = gt; idx < 2 * 9 * 6144; idx += NGT) { const int l = idx / (9 * 6144), rj = idx % (9 * 6144), j = rj % 6144; float s = pp->in[I_BMOD][l * 6144 + j];
#pragma unroll
          for (int kc = 0; kc < 8; ++kc) s += ((const float*)(ws + WS_MODP))[((size_t)(l * 8 + kc) * 9) * 6144 + rj];
          ((float*)(ws + WS_MOD))[idx] = s; } }
    constexpr int N_KF = 768, N_W2 = 256;
    LAS float* fl = (LAS float*)lds;
    for (int it = blockIdx.x; it < N_KF + N_W2; it += gridDim.x) { TSTART()
        if (it < N_KF) {
            if (it < 512) { const int l = it >> 8, ch = it & 255;
                kf_job<13>(lds, (const float*)(ws + WS_HRAW) + (size_t)l * 512 * SL, (const f32x2*)(ws + WS_TW), (f32x2*)(ws + WS_KF) + (size_t)l * 256 * 8192, ch, tid); }
            else { const int ch = it - 512;
                kf_job<9>(lds, (const float*)(ws + WS_HRAW) + (size_t)2 * 512 * SL, (const f32x2*)(ws + WS_TW + 65536), (f32x2*)(ws + WS_KFC), ch, tid); }
            TSTOP(14) continue;
        }
        const int r = it - N_KF; const int l = r >> 7, nh = (r >> 6) & 1, kb = r & 63;
        for (int idx = tid; idx < 8 * 256; idx += 512) fl[idx] = ((const float*)(ws + WS_T))[((size_t)l * 512 + 8 * kb) * 256 + idx];
        __syncthreads();
        { const int n = nh * 512 + tid; const float* wo = pp->in[I_WOUT] + (size_t)l * DM * DM + (size_t)512 * DM + n; float s[8];
#pragma unroll
          for (int q = 0; q < 8; ++q) s[q] = 0.f;
          for (int j0 = 0; j0 < 256; j0 += 32) { float wv_[32];
#pragma unroll
            for (int jj = 0; jj < 32; ++jj) wv_[jj] = wo[(size_t)(j0 + jj) * DM];
#pragma unroll
            for (int jj = 0; jj < 32; ++jj) { const int j = j0 + jj; const float w = wv_[jj];
#pragma unroll
              for (int q = 0; q < 8; ++q) s[q] += fl[q * 256 + j] * w; } }
          bf16_t* dst = wlayer(ws, l, OFF_WOUT) + (size_t)n * MIXK + 512 + 8 * kb;
          u32x4 o; o.x = pk2(s[0], s[1]); o.y = pk2(s[2], s[3]); o.z = pk2(s[4], s[5]); o.w = pk2(s[6], s[7]);
          *(u32x4*)dst = o; }
        __syncthreads(); TSTOP(15)
    }
}


__device__ __forceinline__ int ph_class(int ph) {
    if (ph < 2) return 0; if (ph == 2) return 1;
    const int r = (ph - 3) & 7;
    return r == 0 ? 2 : r == 1 ? 3 : r == 2 ? 4 : r == 3 ? 5 : r == 4 ? 6 : r == 5 ? 7 : r == 6 ? 8 : 5;
}
__global__ void __launch_bounds__(512, 2) mega_fwd(Params P) {
    extern __shared__ __attribute__((aligned(16))) unsigned char lds_raw[];
    LAS unsigned char* lds = (LAS unsigned char*)lds_raw;
    { volatile LAS unsigned* m0 = (volatile LAS unsigned*)(lds + MISC_OFF); if (threadIdx.x < 32) m0[threadIdx.x] = 0u; }
    __syncthreads();
    XcdBarrier xbar;
    { KP pb = kp_get(); xbar = xcd_barrier_post((unsigned*)(pb->ws + WS_CTL) + 4096, (volatile LAS unsigned*)(lds + MISC_OFF) + 8);
      if (pb->ph_lo < 0) cg::this_grid().sync(); }
    int ph = 0; unsigned long long tacc_ = 0;
#define PH_BEGIN { unsigned long long tph0_ = 0; if (MK_TMASK) tph0_ = __builtin_amdgcn_s_memrealtime(); KP pp = kp_get(); const int lo = pp->ph_lo, hi = pp->ph_hi; if (ph >= lo && ph < hi) { unsigned char* ws = pp->ws; const int tid = mk_tid(), lane = tid & 63, wave = __builtin_amdgcn_readfirstlane(tid >> 6); const int G = gridDim.x, gw = blockIdx.x * 8 + wave, NGW = G * 8; (void)lane; (void)gw; (void)NGW; PTRS
#define PH_END   if (ph + 1 < hi) xcd_barrier(xbar); } if (MK_TMASK && ((MK_TMASK >> ph_class(ph)) & 1)) tacc_ += __builtin_amdgcn_s_memrealtime() - tph0_; } ++ph;
#define PTRS \
    bf16_t* XN = (bf16_t*)(ws + WS_XN); bf16_t* Qb = (bf16_t*)(ws + WS_Q); bf16_t* Kb = (bf16_t*)(ws + WS_K); bf16_t* Vb = (bf16_t*)(ws + WS_V); \
    bf16_t* fT = (bf16_t*)(ws + WS_FT); bf16_t* fTc = (bf16_t*)(ws + WS_FTC); bf16_t* PT = (bf16_t*)(ws + WS_PT); bf16_t* PTc = (bf16_t*)(ws + WS_PTC); \
    bf16_t* MIXb = (bf16_t*)(ws + WS_MIX); bf16_t* Ub = (bf16_t*)(ws + WS_U); bf16_t* Gb = (bf16_t*)(ws + WS_G); \
    float* CX = (float*)(ws + WS_CX); const float* MOD = (const float*)(ws + WS_MOD); \
    const float* rope = (const float*)(ws + WS_TW + 131072); \
    volatile LAS int* misc = (volatile LAS int*)(lds + MISC_OFF); \
    (void)XN; (void)Qb; (void)Kb; (void)Vb; (void)fT; (void)fTc; (void)PT; (void)PTc; (void)MIXb; (void)Ub; (void)Gb; (void)CX; (void)MOD; (void)rope; (void)misc;

    REP(6) { PH_BEGIN EN(0) setup0(pp, lds, tid, lane, wave, tacc_); PH_END --ph; } ++ph;
    REP(8) { PH_BEGIN EN(1) setup1(pp, lds, tid, tacc_); PH_END --ph; } ++ph;
    PH_BEGIN REP(9) EN(2) norm_rows(gw, NGW, lane, MT, pp->in[I_X], pp->in[I_CTX], pp->out, CX, nullptr, nullptr, nullptr, 0, XN, pp->in[I_GPREMIX], MOD, 1024, 0, nullptr, nullptr); PH_END

    for (int l = 0; l < 2; ++l) {
        const bool last = (l == 1);
        const int MR = last ? ML : MT;
        PH_BEGIN {
            pg8::Gemm g{XN, wlayer(ws, l, OFF_WIN), MT, INW, DM}; pg8::StaticOrder S; S.init(MT, INW, G, (int)blockIdx.x);
            EpiInProj E{Qb, Kb, Vb, fT, fTc, PT, PTc, pp->in[I_GQ] + l * 64, pp->in[I_GK] + l * 64, rope, (LAS float*)(lds + XCH_OFF)};
            REP(0) EN(3) pg8::gemm_phase<EpiInProj, pg8::StaticOrder, true, true>(lds, g, S, E);
        } PH_END
        PH_BEGIN {
            const int nF = last ? 128 : 136, nA = last ? 1024 : 1088, nH1 = last ? 1024 : 2048, nH = nH1 * (1 + ((MK_REP >> 7) & 1));
            const int nFx = last ? 16 : 17, nAx = last ? 128 : 136, nHx = last ? 128 : 256, cntq = nFx + nAx + nHx;
            int nxt_ = 0, q0_ = (int)(xb_xcc_id() & 7u), tried_ = 0;
            if (mk_tid() == 0) nxt_ = (int)atomicAdd((unsigned*)(ws + WS_CTL) + 64 * (8 + 16 * l + q0_), 1u);
            for (;;) {
                KP pq = kp_get(); unsigned char* wq = pq->ws; const int tq = mk_tid(); TSTART()
                if (tq == 0) {
                    int t_ = nxt_;
                    while (t_ >= cntq && tried_ < 7) { q0_ = (q0_ + 1) & 7; ++tried_; t_ = (int)atomicAdd((unsigned*)(wq + WS_CTL) + 64 * (8 + 16 * l + q0_), 1u); }
                    misc[0] = (t_ >= cntq) ? -1 : t_; misc[2] = q0_;
                    if (t_ < cntq) nxt_ = (int)atomicAdd((unsigned*)(wq + WS_CTL) + 64 * (8 + 16 * l + q0_), 1u);
                }
                __syncthreads();
                int jt = misc[0]; const int qx = misc[2];
                __syncthreads();
                if (jt < 0) break;
                int it;
                if (jt < nFx) it = jt < 16 ? jt * 8 + qx : 128 + qx;
                else { jt -= nFx;
                    if (jt < nAx) it = nF + (jt < 128 ? qx * 128 + jt : 1024 + qx * 8 + (jt - 128));
                    else { jt -= nAx; const int hb_ = (qx >> 1) * 256 + (qx & 1) * 128; it = nF + nA + (jt < 128 ? hb_ + jt : 1024 + hb_ + (jt - 128)); } }
                TSTOP(19) if (MK_TMASK) tts_ = __builtin_amdgcn_s_memrealtime();
                bf16_t* MIXq = (bf16_t*)(wq + WS_MIX);
                if (it < nF) {
                    if (it < 128) { pg8::Gemm g{(const bf16_t*)(wq + WS_ADFT), (const bf16_t*)(wq + WS_FT), 4096, 2048, 4096}; OneUnit S{it >> 3, it & 7}; EpiFourier E{MIXq, 2048, 0, SL};
                        REP(3) EN(4) pg8::gemm_phase<EpiFourier, OneUnit, false, true>(lds, g, S, E); }
                    else { pg8::Gemm g{(const bf16_t*)(wq + WS_ADFTC), (const bf16_t*)(wq + WS_FTC), 256, 2048, 256}; OneUnit S{0, it - 128}; EpiFourier E{MIXq, 128, ML, CL};
                        REP(3) EN(4) pg8::gemm_phase<EpiFourier, OneUnit, false, true>(lds, g, S, E); }
                    TSTOP(16) continue;
                }
                it -= nF;
                if (it < nA) {
                    const bf16_t* Qq = (const bf16_t*)(wq + WS_Q); const bf16_t* Kq = (const bf16_t*)(wq + WS_K); const bf16_t* Vq = (const bf16_t*)(wq + WS_V);
                    int b, h, NT; size_t qrow;
                    if (it < 1024) { b = it >> 7; h = (it >> 4) & 7; qrow = (size_t)b * SL + (it & 15) * 256; NT = KVB / 64; }
                    else { const int r = it - 1024; b = r >> 3; h = r & 7; qrow = (size_t)ML + b * CL; NT = CL / 64; }
                    const size_t kv0 = (size_t)b * KVB;
                    REP(1) EN(5) attn_body::attn_unit2<8>((const attn_body::bf16*)(Qq + qrow * QP + h * 64), (const attn_body::bf16*)(Kq + kv0 * KVP + (h >> 2) * 64), (const attn_body::bf16*)(Vq + kv0 * KVP + (h >> 2) * 64), (attn_body::bf16*)(MIXq + qrow * MIXK + h * 64), NT, (char*)lds_raw);
                    TSTOP(17) continue;
                }
                it -= nA; if (it >= nH1) it -= nH1;
                const float* wc = pq->in[I_WHC] + (size_t)l * 3 * 768; const float* bc = pq->in[I_BHC] + (size_t)l * 768; const float* hb = pq->in[I_HBIAS] + (size_t)l * 256;
                REP(2) EN(6) { if (it < 1024) hyena_job<13>(lds, (const bf16_t*)(wq + WS_PT), (const f32x2*)(wq + WS_TW), (const f32x2*)(wq + WS_KF) + (size_t)l * 256 * 8192, wc, bc, hb, MIXq, 0, it >> 8, it & 255, tq);
                else { const int r = it - 1024; hyena_job<9>(lds, (const bf16_t*)(wq + WS_PTC), (const f32x2*)(wq + WS_TW + 65536), (const f32x2*)(wq + WS_KFC), wc, bc, hb, MIXq, ML, r >> 8, r & 255, tq); } }
                TSTOP(18)
            }
        } PH_END
        PH_BEGIN {
            pg8::Gemm g{MIXb, wlayer(ws, l, OFF_WOUT), MR, DM, MIXK}; pg8::StaticOrder S; S.init(MR, DM, G, (int)blockIdx.x);
            EpiPlain E{XN, DM};
            REP(5) EN(7) pg8::gemm_phase<EpiPlain, pg8::StaticOrder, true, true>(lds, g, S, E);
        } PH_END
        PH_BEGIN EN(2) norm_rows(gw, NGW, lane, MR, pp->in[I_X], pp->in[I_CTX], pp->out, CX, XN, pp->in[I_GPOSTMIX] + l * DM, (MOD + (size_t)l * 9 * 6144), 2048,
                           XN, pp->in[I_GPREFFN] + l * DM, (MOD + (size_t)l * 9 * 6144), 4096, 3072, l == 0 ? nullptr : (const bf16_t*)(ws + WS_XB), (bf16_t*)(ws + WS_XB)); PH_END
        PH_BEGIN {
            pg8::Gemm g{XN, wlayer(ws, l, OFF_WUP), MR, UPW, DM}; pg8::StaticOrder S; S.init(MR, UPW, G, (int)blockIdx.x);
            EpiGlu E{Gb, (bf16_t*)(ws + WS_SB), (const u32x4*)(ws + WS_WCP) + (size_t)l * DFF, (LAS float*)(lds + XCH_OFF)};
            REP(4) EN(8) pg8::gemm_phase<EpiGlu, pg8::StaticOrder, true, true>(lds, g, S, E);
        } PH_END
        PH_BEGIN EN(9) glu_fixup((int)blockIdx.x, G, tid, MR / 256, (const bf16_t*)(ws + WS_SB), Gb, pp->in[I_WFC] + (size_t)l * 3 * UPW, pp->in[I_BFC] + (size_t)l * UPW); PH_END
        PH_BEGIN {
            pg8::Gemm g{Gb, wlayer(ws, l, OFF_WDOWN), MR, DM, DFF}; pg8::StaticOrder S; S.init(MR, DM, G, (int)blockIdx.x);
            EpiPlain E{XN, DM};
            REP(4) EN(10) pg8::gemm_phase<EpiPlain, pg8::StaticOrder, true, true>(lds, g, S, E);
        } PH_END
        PH_BEGIN EN(2) norm_rows(gw, NGW, lane, MR, pp->in[I_X], pp->in[I_CTX], pp->out, CX, XN, pp->in[I_GPOSTFFN] + l * DM, (MOD + (size_t)l * 9 * 6144), 5120,
                           last ? nullptr : XN, pp->in[I_GPREMIX] + (last ? 0 : (l + 1) * DM), MOD + (size_t)(last ? 0 : (l + 1)) * 9 * 6144, 1024, 0,
                           (const bf16_t*)(ws + WS_XB), last ? nullptr : (bf16_t*)(ws + WS_XB)); PH_END
    }
    if (MK_TMASK) { if (blockIdx.x == 0 && threadIdx.x == 0) { const unsigned long long t0_ = __builtin_amdgcn_s_memrealtime(); while (__builtin_amdgcn_s_memrealtime() - t0_ < 4ull * tacc_) __builtin_amdgcn_s_sleep(8); } }
}

constexpr int N_PHASES = 3 + 2 * 8;
#ifndef MK_MULTI
#define MK_MULTI 0
#endif
extern "C" void kernel_launch(void* const* d_in, const int* in_sizes, int n_in, void* d_out, int out_size, void* d_ws, size_t ws_size, hipStream_t stream) {
    static int grid = 0;
    if (grid == 0) {
        if (n_in != 29 || ws_size < WS_END) { fprintf(stderr, "kernel_launch: bad args n_in %d ws %zu (need %zu)\n", n_in, ws_size, (size_t)WS_END); grid = -1; return; }
        int dev = 0, cus = 0, per_cu = 0;
        (void)hipGetDevice(&dev); (void)hipDeviceGetAttribute(&cus, hipDeviceAttributeMultiprocessorCount, dev);
        if (hipFuncSetAttribute((const void*)mega_fwd, hipFuncAttributeMaxDynamicSharedMemorySize, LDS_BYTES) != hipSuccess) { fprintf(stderr, "hipFuncSetAttribute failed\n"); grid = -1; return; }
        if (hipOccupancyMaxActiveBlocksPerMultiprocessor(&per_cu, (const void*)mega_fwd, 512, LDS_BYTES) != hipSuccess || per_cu < 1) { fprintf(stderr, "occupancy query: %d\n", per_cu); per_cu = 1; }
        (void)hipGetLastError();
        grid = cus * 1;
    }
    if (grid < 0) return;
    (void)hipMemsetAsync((char*)d_ws + WS_CTL, 0, 32768, stream);
    Params p{};
    for (int i = 0; i < 29; ++i) p.in[i] = (const float*)d_in[i];
    p.out = (float*)d_out; p.ws = (unsigned char*)d_ws;
#if MK_MULTI
    for (int k = 0; k < N_PHASES; ++k) { p.ph_lo = k; p.ph_hi = k + 1; hipLaunchKernelGGL(mega_fwd, dim3(grid), dim3(512), LDS_BYTES, stream, p); }
#else
    p.ph_lo = 0; p.ph_hi = N_PHASES;
    void* args[] = {&p};
    hipError_t e = hipLaunchCooperativeKernel((const void*)mega_fwd, dim3(grid), dim3(512), args, LDS_BYTES, stream);
    if (e != hipSuccess) fprintf(stderr, "cooperative launch failed: %s (grid %d)\n", hipGetErrorString(e), grid);
#endif
}
```

```cpp
#define MK_REP 0
#define MK_TMASK 0
#include <hip/hip_runtime.h>
#include <hip/hip_cooperative_groups.h>
#include <hip/hip_bf16.h>
#include <cstdio>
#include <cstdint>
#include <cmath>
namespace cg = cooperative_groups;
__device__ __forceinline__ int mk_tid() { int t = threadIdx.x; asm volatile("" : "+v"(t)); return t; }
namespace pg8 {
#define PG8_LAS __attribute__((address_space(3)))
typedef unsigned short bf16_t;
typedef short bf16x8 __attribute__((ext_vector_type(8)));
typedef float f32x4 __attribute__((ext_vector_type(4)));
typedef unsigned u32x4 __attribute__((ext_vector_type(4)));
constexpr int BM = 256, BK = 64, HALF = 128, HTB = HALF * BK * 2  , STAGE_BYTES = 8 * HTB, NXCD = 8, WGM = 8;

__host__ __device__ __forceinline__ int lds_byte(int r, int c) { const int st = (r >> 4) * 2 + (c >> 5), rr = r & 15, cc = c & 31, ob = rr * 64 + cc * 2; return st * 1024 + (ob ^ (((ob >> 9) & 1) << 5)); }
__host__ __device__ __forceinline__ void stage_rc(int b, int& R, int& C) { const int st = b / 1024, sb = b % 1024, swz = sb ^ (((sb >> 9) & 1) << 5); R = (st >> 1) * 16 + swz / 64; C = (st & 1) * 32 + (swz % 64) / 2; }
__host__ __device__ __forceinline__ int perm32(int rho) { const int n = rho >> 4, i = rho & 15; return 8 * (i >> 2) + 4 * n + (i & 3); }

struct Unit { int pm, pn; };
struct Gemm { const bf16_t* A; const bf16_t* Bt; int M, N, K; };

struct StaticOrder {
    int nM, nN, nwg, G, c;
    __host__ __device__ void init(int M, int N, int G_, int c_) { nM = M / BM; nN = N / BM; nwg = nM * nN; G = G_; c = c_; }
    __host__ __device__ bool next(int i, Unit& u) const {
        const long L = (long)i * G + c; if (L >= nwg) return false;
        int wgid = (int)L; { const int q = nwg / NXCD, r = nwg % NXCD, xcd = wgid % NXCD, off = wgid / NXCD; wgid = (xcd < r ? xcd * (q + 1) : r * (q + 1) + (xcd - r) * q) + off; }
        const int nig = WGM * nN, gid = wgid / nig, fm = gid * WGM, gsz = (nM - fm) < WGM ? (nM - fm) : WGM;
        u.pm = fm + ((wgid % nig) % gsz); u.pn = (wgid % nig) / gsz; return true;
    }
    __device__ __forceinline__ void a_ready(const Unit&) const {}
    __device__ __forceinline__ void done(const Unit&) const {}
};
__device__ __forceinline__ unsigned cvt_pk_bf16(float lo, float hi) { unsigned r; asm volatile("v_cvt_pk_bf16_f32 %0, %1, %2" : "=v"(r) : "v"(lo), "v"(hi)); return r; }
typedef float f32x2 __attribute__((ext_vector_type(2)));
template <class Epi, class Sched, bool ALIGN_EPI = false, bool SP2 = false>
__device__ __forceinline__ void gemm_phase(PG8_LAS unsigned char* lds, const Gemm g, const Sched& S, const Epi& E) {
    const int tid = mk_tid(), wid = __builtin_amdgcn_readfirstlane(tid >> 6), lane = tid & 63, wr = wid >> 2, wc = wid & 3, fr = lane & 15, fq = lane >> 4;
    const int K = g.K, nt = K / BK;
    unsigned voffA[2], voffB[2];
#pragma unroll
    for (int i = 0; i < 2; ++i) { int R, C; stage_rc(tid * 16 + i * 8192, R, C); const int Rb = Epi::PERM ? ((R & ~31) + perm32(R & 31)) : R;
        const int Ra = Epi::APERM ? ((R & ~63) + 4 * (R & 15) + ((R >> 4) & 3)) : R;
        voffA[i] = (unsigned)(Ra * K + C) * 2u; voffB[i] = (unsigned)(Rb * K + C) * 2u; }
    const size_t kstep = (size_t)(BK * 2);
    const size_t hstep = (size_t)HALF * K * 2;
    const size_t tstep = 2 * hstep;
    const unsigned ldsw = (unsigned)wid * 1024u;
    const int aoff = lds_byte(wr * 64 + fr, fq * 8), boff = lds_byte(wc * 32 + fr, fq * 8);
#define PG8_SA(b, h) (((b) * 2 + (h)) * HTB)
#define PG8_SB(b, h) ((4 + (b) * 2 + (h)) * HTB)
#define PG8_STAGE(bufoff, gbase, voff) do { _Pragma("unroll") for (int _i = 0; _i < 2; ++_i) \
        __builtin_amdgcn_global_load_lds((const unsigned*)((const char*)(gbase) + (voff)[_i]), (PG8_LAS unsigned*)(lds + (bufoff) + ldsw + _i * 8192), 16, 0, 0); } while (0)
#define PG8_LDA(dst, b, h) do { _Pragma("unroll") for (int m = 0; m < 4; ++m) _Pragma("unroll") for (int k = 0; k < 2; ++k) dst[m][k] = *(const PG8_LAS bf16x8*)(lds + PG8_SA(b, h) + aoff + m * 2048 + k * 1024); } while (0)
#define PG8_LDB(dst, b, h) do { _Pragma("unroll") for (int n = 0; n < 2; ++n) _Pragma("unroll") for (int k = 0; k < 2; ++k) dst[n][k] = *(const PG8_LAS bf16x8*)(lds + PG8_SB(b, h) + boff + n * 2048 + k * 1024); } while (0)
#define PG8_MMA(ai, bj, At, Bt) do { __builtin_amdgcn_s_setprio(1); _Pragma("unroll") for (int m = 0; m < 4; ++m) _Pragma("unroll") for (int n = 0; n < 2; ++n) _Pragma("unroll") for (int k = 0; k < 2; ++k) \
        acc[ai][bj][m][n] = __builtin_amdgcn_mfma_f32_16x16x32_bf16(Bt[n][k], At[m][k], acc[ai][bj][m][n], 0, 0, 0); __builtin_amdgcn_s_setprio(0); } while (0)
#define PG8_WAIT_V(n) asm volatile("s_waitcnt vmcnt(" #n ")" ::: "memory")
#define PG8_WAIT_L(n) asm volatile("s_waitcnt lgkmcnt(" #n ")" ::: "memory")
#define PG8_BAR __builtin_amdgcn_s_barrier()
#define PG8_SCHED __builtin_amdgcn_sched_barrier(0)
    Unit cur, nxt; int ui = 0;
    if (!S.next(0, cur)) return;
    f32x4 acc[2][2][4][2];
#pragma unroll
    for (int a = 0; a < 2; ++a)
#pragma unroll
        for (int b = 0; b < 2; ++b)
#pragma unroll
            for (int m = 0; m < 4; ++m)
#pragma unroll
                for (int n = 0; n < 2; ++n) acc[a][b][m][n] = (f32x4){0.f, 0.f, 0.f, 0.f};
    bf16x8 At[4][2], B0[2][2], B1[2][2];
    const char* cA = (const char*)g.A + (size_t)cur.pm * tstep; const char* cB = (const char*)g.Bt + (size_t)cur.pn * tstep;
    S.a_ready(cur);
    if constexpr (SP2) {
        PG8_STAGE(PG8_SB(0, 0), cB, voffB); PG8_STAGE(PG8_SB(0, 1), cB + hstep, voffB); PG8_STAGE(PG8_SA(0, 0), cA, voffA); PG8_STAGE(PG8_SA(0, 1), cA + hstep, voffA);
        if (wr == 1) PG8_BAR;
        PG8_WAIT_V(2); PG8_BAR;
        PG8_STAGE(PG8_SB(1, 0), cB + kstep, voffB); PG8_STAGE(PG8_SA(1, 0), cA + kstep, voffA); PG8_STAGE(PG8_SB(1, 1), cB + hstep + kstep, voffB);
        PG8_WAIT_V(6); PG8_BAR;
    } else {
        PG8_STAGE(PG8_SB(0, 0), cB, voffB); PG8_STAGE(PG8_SA(0, 0), cA, voffA); PG8_STAGE(PG8_SB(0, 1), cB + hstep, voffB); PG8_STAGE(PG8_SA(0, 1), cA + hstep, voffA);
        if (wr == 1) PG8_BAR;
        PG8_WAIT_V(4); PG8_BAR;
        PG8_STAGE(PG8_SB(1, 0), cB + kstep, voffB); PG8_STAGE(PG8_SA(1, 0), cA + kstep, voffA); PG8_STAGE(PG8_SB(1, 1), cB + hstep + kstep, voffB);
        PG8_WAIT_V(6); PG8_BAR;
    }
    for (;;) {
        const bool has_next = S.next(ui + 1, nxt);
        const char* nA = has_next ? (const char*)g.A + (size_t)nxt.pm * tstep : cA; const char* nB = has_next ? (const char*)g.Bt + (size_t)nxt.pn * tstep : cB;
        for (int t = 0; t < nt; t += 2) {
            const bool last = (t == nt - 2);
            const char* a1 = cA + (size_t)(t + 1) * kstep;
            const char* a2 = last ? nA : cA + (size_t)(t + 2) * kstep; const char* b2 = last ? nB : cB + (size_t)(t + 2) * kstep;
            const char* a3 = a2 + kstep; const char* b3 = b2 + kstep;
            if (last && has_next) S.a_ready(nxt);
            if constexpr (SP2) {
            PG8_LDB(B0, 0, 0); PG8_LDB(B1, 0, 1); PG8_SCHED; PG8_LDA(At, 0, 0); PG8_STAGE(PG8_SA(1, 1), a1 + hstep, voffA);
            PG8_WAIT_V(8); PG8_WAIT_L(0); PG8_BAR; PG8_MMA(0, 0, At, B0); PG8_MMA(0, 1, At, B1); PG8_BAR; PG8_SCHED;
            PG8_LDA(At, 0, 1); PG8_STAGE(PG8_SB(0, 0), b2, voffB); PG8_STAGE(PG8_SB(0, 1), b2 + hstep, voffB); PG8_STAGE(PG8_SA(0, 0), a2, voffA);
            PG8_WAIT_V(8); PG8_WAIT_L(0); PG8_BAR; PG8_MMA(1, 0, At, B0); PG8_MMA(1, 1, At, B1); PG8_BAR; PG8_SCHED;
            PG8_LDB(B0, 1, 0); PG8_LDB(B1, 1, 1); PG8_SCHED; PG8_LDA(At, 1, 0); PG8_STAGE(PG8_SA(0, 1), a2 + hstep, voffA);
            PG8_WAIT_V(8); PG8_WAIT_L(0); PG8_BAR; PG8_MMA(0, 0, At, B0); PG8_MMA(0, 1, At, B1); PG8_BAR; PG8_SCHED;
            PG8_LDA(At, 1, 1); PG8_STAGE(PG8_SB(1, 0), b3, voffB); PG8_STAGE(PG8_SB(1, 1), b3 + hstep, voffB); PG8_STAGE(PG8_SA(1, 0), a3, voffA);
            PG8_WAIT_V(8); PG8_WAIT_L(0); PG8_BAR; PG8_MMA(1, 0, At, B0); PG8_MMA(1, 1, At, B1); PG8_BAR; PG8_SCHED;
            } else {
            PG8_LDB(B0, 0, 0); PG8_SCHED; PG8_LDA(At, 0, 0); PG8_STAGE(PG8_SA(1, 1), a1 + hstep, voffA);
            PG8_WAIT_L(8); PG8_BAR; PG8_WAIT_L(0); PG8_MMA(0, 0, At, B0); PG8_BAR; PG8_SCHED;
            PG8_LDB(B1, 0, 1); PG8_STAGE(PG8_SB(0, 0), b2, voffB);
            PG8_BAR; PG8_WAIT_L(0); PG8_MMA(0, 1, At, B1); PG8_BAR;
            PG8_LDA(At, 0, 1); PG8_STAGE(PG8_SA(0, 0), a2, voffA);
            PG8_BAR; PG8_WAIT_L(0); PG8_MMA(1, 0, At, B0); PG8_BAR; PG8_SCHED;
            PG8_STAGE(PG8_SB(0, 1), b2 + hstep, voffB);
            PG8_WAIT_V(6); PG8_BAR; PG8_MMA(1, 1, At, B1); PG8_BAR;
            PG8_LDB(B0, 1, 0); PG8_SCHED; PG8_LDA(At, 1, 0); PG8_STAGE(PG8_SA(0, 1), a2 + hstep, voffA);
            PG8_WAIT_L(8); PG8_BAR; PG8_WAIT_L(0); PG8_MMA(0, 0, At, B0); PG8_BAR; PG8_SCHED;
            PG8_LDB(B1, 1, 1); PG8_STAGE(PG8_SB(1, 0), b3, voffB);
            PG8_BAR; PG8_WAIT_L(0); PG8_MMA(0, 1, At, B1); PG8_BAR;
            PG8_LDA(At, 1, 1); PG8_STAGE(PG8_SA(1, 0), a3, voffA);
            PG8_BAR; PG8_WAIT_L(0); PG8_MMA(1, 0, At, B0); PG8_BAR; PG8_SCHED;
            PG8_STAGE(PG8_SB(1, 1), b3 + hstep, voffB);
            PG8_WAIT_V(6); PG8_BAR; PG8_MMA(1, 1, At, B1); PG8_BAR;
            }
        }
        if constexpr (ALIGN_EPI) { if (wr == 0) PG8_BAR; }
        if constexpr (!Epi::AFTER_DRAIN) { E(acc, cur, wr, wc, fr, fq); S.done(cur); }
        if (!has_next) break;
#pragma unroll
        for (int a = 0; a < 2; ++a)
#pragma unroll
            for (int b = 0; b < 2; ++b)
#pragma unroll
                for (int m = 0; m < 4; ++m)
#pragma unroll
                    for (int n = 0; n < 2; ++n) acc[a][b][m][n] = (f32x4){0.f, 0.f, 0.f, 0.f};
        cur = nxt; cA = nA; cB = nB; ++ui;
        if constexpr (ALIGN_EPI) { if (wr == 1) PG8_BAR; }
    }
    PG8_WAIT_V(0);
    if constexpr (!ALIGN_EPI) { if (wr == 0) PG8_BAR; }
    PG8_BAR;
    if constexpr (Epi::AFTER_DRAIN) { E.fused(acc, cur, wr, wc, fr, fq, lds, wid, lane); S.done(cur); }
#undef PG8_SA
#undef PG8_SB
#undef PG8_STAGE
#undef PG8_LDA
#undef PG8_LDB
#undef PG8_MMA
#undef PG8_WAIT_V
#undef PG8_WAIT_L
#undef PG8_BAR
#undef PG8_SCHED
}
}
namespace attn_body {
using bf16=__hip_bfloat16;
using bf16x8=__attribute__((ext_vector_type(8)))short;
using s16x4=__attribute__((ext_vector_type(4)))short;
using f32x16=__attribute__((ext_vector_type(16)))float;
using u32x4=__attribute__((ext_vector_type(4)))unsigned;
__device__ __forceinline__ int crow(int r,int hi){return (r&3)+8*(r>>2)+4*hi;}
#define SBAR() __builtin_amdgcn_sched_barrier(0)
__device__ __forceinline__ void glds16(const void*gsrc,unsigned lds_dst){unsigned keep;
  asm volatile("s_mov_b32 %0, m0\n\ts_mov_b32 m0, %2\n\ts_nop 0\n\tglobal_load_lds_dwordx4 %1, off\n\ts_mov_b32 m0, %0":"=&s"(keep):"v"(gsrc),"s"(lds_dst):"memory");}
typedef float f32x2_t __attribute__((ext_vector_type(2))); typedef __bf16 bf16x2_t __attribute__((ext_vector_type(2)));
__device__ __forceinline__ unsigned cvtpk_s(float lo,float hi){f32x2_t v={lo,hi};bf16x2_t b=__builtin_convertvector(v,bf16x2_t);return __builtin_bit_cast(unsigned,b);}
#define WAIT_BAR(N) asm volatile("s_waitcnt vmcnt(" #N ") lgkmcnt(0)\n\ts_barrier":::"memory")
__device__ __forceinline__ void qkt(f32x16&p0,f32x16&p1,const char*Kslot,const bf16x8*qr,const f32x16&negm,int r32,int hi){
  const char*kb=Kslot+hi*1024+r32*16;
  #pragma unroll
  for(int d0=0;d0<4;++d0){
    const bf16x8 b0=*reinterpret_cast<const bf16x8*>(kb+d0*2048);
    const bf16x8 b1=*reinterpret_cast<const bf16x8*>(kb+d0*2048+512);
    if(d0==0){p0=__builtin_amdgcn_mfma_f32_32x32x16_bf16(b0,qr[0],negm,0,0,0);p1=__builtin_amdgcn_mfma_f32_32x32x16_bf16(b1,qr[0],negm,0,0,0);}
    else{p0=__builtin_amdgcn_mfma_f32_32x32x16_bf16(b0,qr[d0],p0,0,0,0);p1=__builtin_amdgcn_mfma_f32_32x32x16_bf16(b1,qr[d0],p1,0,0,0);}}
}
__device__ __forceinline__ void pv(f32x16*o,int vb,bf16x8 pa0,bf16x8 pa1,bf16x8 pa2,bf16x8 pa3){
  #pragma unroll
  for(int d0=0;d0<2;++d0){s16x4 lo[4],hi[4];
    #pragma unroll
    for(int ks=0;ks<4;++ks){
      asm volatile("ds_read_b64_tr_b16 %0,%1 offset:%c2":"=&v"(lo[ks]):"v"(vb),"i"(d0*4096+ks*1024):"memory");
      asm volatile("ds_read_b64_tr_b16 %0,%1 offset:%c2":"=&v"(hi[ks]):"v"(vb),"i"(d0*4096+ks*1024+512):"memory");}
    asm volatile("s_waitcnt lgkmcnt(0)":::"memory");SBAR();
    #define PK(k) (bf16x8){lo[k][0],lo[k][1],lo[k][2],lo[k][3],hi[k][0],hi[k][1],hi[k][2],hi[k][3]}
    o[d0]=__builtin_amdgcn_mfma_f32_32x32x16_bf16(pa0,PK(0),o[d0],0,0,0);
    o[d0]=__builtin_amdgcn_mfma_f32_32x32x16_bf16(pa1,PK(1),o[d0],0,0,0);
    o[d0]=__builtin_amdgcn_mfma_f32_32x32x16_bf16(pa2,PK(2),o[d0],0,0,0);
    o[d0]=__builtin_amdgcn_mfma_f32_32x32x16_bf16(pa3,PK(3),o[d0],0,0,0);
    #undef PK
  }
}
constexpr int QBLK=32,KVBLK=64,NW=8;
constexpr int NSLOT=3, SLOTB=8192;
constexpr int LDS_K=0, LDS_V=NSLOT*SLOTB, LDS_WS=2*NSLOT*SLOTB, LDS_OST=LDS_WS+NW*64*4, LDS_BYTES=LDS_OST+NW*4096;
__device__ __forceinline__ float max3f(float a,float b,float c){float r;asm("v_max3_f32 %0, %1, %2, %3":"=v"(r):"v"(a),"v"(b),"v"(c));return r;}
__device__ __forceinline__ float max2f(float a,float b){float r;asm("v_max_f32_e32 %0, %1, %2":"=v"(r):"v"(a),"v"(b));return r;}
__device__ __forceinline__ float fadd_s(float a,float b){float r;asm("v_add_f32_e32 %0, %1, %2":"=v"(r):"v"(a),"v"(b));return r;}
__device__ __forceinline__ float fsub_s(float a,float b){float r;asm("v_sub_f32_e32 %0, %1, %2":"=v"(r):"v"(a),"v"(b));return r;}
typedef __attribute__((address_space(3))) const char* lds_cptr;
typedef short v4i16_t __attribute__((ext_vector_type(4)));
__device__ __forceinline__ void kload8(bf16x8*kf,lds_cptr kp){
  kf[0]=*(const __attribute__((address_space(3))) bf16x8*)(kp);      kf[1]=*(const __attribute__((address_space(3))) bf16x8*)(kp+512);
  kf[2]=*(const __attribute__((address_space(3))) bf16x8*)(kp+2048); kf[3]=*(const __attribute__((address_space(3))) bf16x8*)(kp+2560);
  kf[4]=*(const __attribute__((address_space(3))) bf16x8*)(kp+4096); kf[5]=*(const __attribute__((address_space(3))) bf16x8*)(kp+4608);
  kf[6]=*(const __attribute__((address_space(3))) bf16x8*)(kp+6144); kf[7]=*(const __attribute__((address_space(3))) bf16x8*)(kp+6656);
}
__device__ __forceinline__ void kload2(bf16x8*kf,lds_cptr kp,int j){ kf[2*j]=*(const __attribute__((address_space(3))) bf16x8*)(kp+j*2048); kf[2*j+1]=*(const __attribute__((address_space(3))) bf16x8*)(kp+j*2048+512); }
__device__ __forceinline__ s16x4 vtr(lds_cptr p){ return __builtin_bit_cast(s16x4,__builtin_amdgcn_ds_read_tr16_b64_v4i16((__attribute__((address_space(3))) v4i16_t*)p)); }
__device__ __forceinline__ float rowmax(const f32x16&p0,const f32x16&p1){
  float a=max3f(p0[0],p0[1],p1[0]),b=max3f(p0[2],p0[3],p1[1]);a=max3f(a,p1[2],p1[3]);
  #pragma unroll
  for(int r=4;r<16;r+=4){a=max3f(a,p0[r],p0[r+1]);b=max3f(b,p0[r+2],p0[r+3]);a=max3f(a,p1[r],p1[r+1]);b=max3f(b,p1[r+2],p1[r+3]);}
  const float m=max2f(a,b);
  auto rr=__builtin_amdgcn_permlane32_swap(__float_as_uint(m),__float_as_uint(m),false,false);
  return max2f(__uint_as_float(rr[0]),__uint_as_float(rr[1]));
}
template<int THRL> __device__ __forceinline__ void attn_unit2(const bf16*Qu,const bf16*__restrict__ Kh,const bf16*__restrict__ Vh,bf16*Ou,const int NT,char*shm){
  constexpr int QPITCH=512,KVPITCH=128,OPITCH=1280;
  const int tid=mk_tid(),lane=tid&63,r32=lane&31,hi=lane>>5; const int wid=__builtin_amdgcn_readfirstlane(tid>>6);
  const bf16*Qw=Qu+(long)(wid*QBLK)*QPITCH;
  const unsigned lds0=(unsigned)(uintptr_t)shm;
  float*wsf=(float*)(shm+LDS_WS)+wid*64;
  const bf16*ksrc=Kh+(long)lane*KVPITCH+wid*8;
  const bf16*vsrc=Vh+(long)(16*(wid&3)+(lane>>2))*KVPITCH+(wid>>2)*32+(lane&3)*8;
  const unsigned kdst=lds0+LDS_K+wid*1024, vdst=lds0+LDS_V+wid*1024;
  #define DMA_K(t,slot) glds16(ksrc+(long)(t)*KVBLK*KVPITCH,(unsigned)__builtin_amdgcn_readfirstlane(kdst+(slot)))
  #define DMA_V(t,slot) glds16(vsrc+(long)(t)*KVBLK*KVPITCH,(unsigned)__builtin_amdgcn_readfirstlane(vdst+(slot)))
  const int vb0=(int)(lds0+LDS_V)+((lane>>4)&1)*32+(lane&3)*8+(4*hi+((lane&15)>>2))*64;
  const char*Kbase=shm+LDS_K; bf16x8 kf[8];
  const lds_cptr shm3=(lds_cptr)shm; const lds_cptr kp0=shm3+LDS_K+hi*1024+r32*16; const lds_cptr vp0=shm3+LDS_V+((lane>>4)&1)*32+(lane&3)*8+(4*hi+((lane&15)>>2))*64;
  DMA_K(0,0);DMA_V(0,0);DMA_K(1,SLOTB);
  bf16x8 qr[4];
  #pragma unroll
  for(int d0=0;d0<4;++d0)qr[d0]=*reinterpret_cast<const bf16x8*>(&Qw[(long)r32*QPITCH+d0*16+hi*8]);
  float mhat=0.f,l_reg=0.f;f32x16 o[2];o[0]=f32x16{};o[1]=f32x16{};f32x16 negm=f32x16{};asm volatile("":"+v"(negm));
  #define CMASK(P0,P1,t) do{}while(0)
  bool resc=false;
  #define START(P0,P1) do{ const float rm=rowmax(P0,P1); resc=false; \
    { const float dl=rm; mhat=fadd_s(mhat,dl); \
      _Pragma("unroll") for(int r=0;r<16;++r){P0[r]=fsub_s(P0[r],dl);P1[r]=fsub_s(P1[r],dl);} \
      _Pragma("unroll") for(int r=0;r<16;++r)negm[r]=-mhat; asm volatile("":"+v"(negm)); } \
    _Pragma("unroll") for(int r=0;r<16;++r)P0[r]=__builtin_amdgcn_exp2f(P0[r]); }while(0)
  #define RESC() do{ if(resc){ asm volatile("s_waitcnt lgkmcnt(0)":::"memory"); \
      _Pragma("unroll") for(int d_=0;d_<2;++d_) _Pragma("unroll") for(int r=0;r<16;++r)o[d_][r]*=wsf[crow(r,hi)]; } }while(0)
  f32x16 pA0,pA1,pB0,pB1;
  int sl_prev=0,sl_cur=0,sl_next=SLOTB;
  #define ROT() do{sl_prev=sl_cur;sl_cur=sl_next;sl_next=(sl_next==(NSLOT-1)*SLOTB)?0:sl_next+SLOTB;}while(0)
  DMA_K(2,2*SLOTB);
  WAIT_BAR(3);
  qkt(pA0,pA1,Kbase,qr,negm,r32,hi);asm volatile("s_nop 15\n\ts_nop 7":"+v"(pA0),"+v"(pA1));CMASK(pA0,pA1,0);
  START(pA0,pA1);
  _Pragma("unroll") for(int r=0;r<16;++r)pA1[r]=__builtin_amdgcn_exp2f(pA1[r]);
  WAIT_BAR(0);
  DMA_K(3,0);DMA_V(1,SLOTB);
  ROT();
  kload8(kf,kp0+sl_cur);
  WAIT_BAR(2);
  s16x4 vlo[8],vhi[8]; u32x4 pw0,pw1,pw2,pw3;
  #define PKW(P,B) cvtpk_s(P[B],P[B+1])
  #define PAF(k) __builtin_bit_cast(bf16x8,pw##k)
  #define VFR(i) (bf16x8){vlo[i][0],vlo[i][1],vlo[i][2],vlo[i][3],vhi[i][0],vhi[i][1],vhi[i][2],vhi[i][3]}
  #define PIN(x) asm volatile("":"+v"(x))
  #define MX3(a,b,c) __builtin_fmaxf(__builtin_fmaxf((a),(b)),(c))
  #define GAPA(MF,A0,A1,A2,A3,W0,W1,PW) do{ MF; sacc+=A0; sacc+=A1; sacc+=A2; sacc+=A3; PIN(sacc); W0; W1; PIN(PW); SBAR(); }while(0)
  #define EX(v) __builtin_amdgcn_exp2f(v)
  #define GAPB(MF,X,B) do{ MF; X[B]=EX(X[B]); X[B+1]=EX(X[B+1]); X[B+2]=EX(X[B+2]); X[B+3]=EX(X[B+3]); PIN(X); SBAR(); }while(0)
  #define VRD(i) do{ vlo[i]=vtr(vp_+(((i)>>2)*4096+((i)&3)*1024)); vhi[i]=vtr(vp_+(((i)>>2)*4096+((i)&3)*1024+512)); }while(0)
  #define KRD(G,j) do{ if(G){ kload2(kf,kp0+sl_next,j); SBAR(); } }while(0)
  #define STEP(C0,C1,P0,P1,t,GK,GV,GL) do{ SBAR(); \
    const lds_cptr vp_=vp0+sl_prev; \
    VRD(0); SBAR(); float sacc=(P0[0]+P0[1]); \
    GAPA(C0=__builtin_amdgcn_mfma_f32_32x32x16_bf16(kf[0],qr[0],negm,0,0,0), P0[2],P0[3],P0[4],P0[5],     pw0[0]=PKW(P0,0), pw0[1]=PKW(P0,2), pw0); \
    VRD(4); SBAR(); GAPA(C1=__builtin_amdgcn_mfma_f32_32x32x16_bf16(kf[1],qr[0],negm,0,0,0), P0[6],P0[7],P0[8],P0[9],     pw0[2]=PKW(P0,4), pw0[3]=PKW(P0,6), pw0); \
    VRD(1); SBAR(); GAPA(C0=__builtin_amdgcn_mfma_f32_32x32x16_bf16(kf[2],qr[1],C0,0,0,0),   P0[10],P0[11],P0[12],P0[13], pw1[0]=PKW(P0,8), pw1[1]=PKW(P0,10), pw1); \
    VRD(5); SBAR(); GAPA(C1=__builtin_amdgcn_mfma_f32_32x32x16_bf16(kf[3],qr[1],C1,0,0,0),   P0[14],P0[15],P1[0],P1[1],   pw1[2]=PKW(P0,12),pw1[3]=PKW(P0,14), pw1); \
    VRD(2); SBAR(); GAPA(C0=__builtin_amdgcn_mfma_f32_32x32x16_bf16(kf[4],qr[2],C0,0,0,0),   P1[2],P1[3],P1[4],P1[5],     pw2[0]=PKW(P1,0), pw2[1]=PKW(P1,2), pw2); \
    VRD(6); SBAR(); GAPA(C1=__builtin_amdgcn_mfma_f32_32x32x16_bf16(kf[5],qr[2],C1,0,0,0),   P1[6],P1[7],P1[8],P1[9],     pw2[2]=PKW(P1,4), pw2[3]=PKW(P1,6), pw2); \
    VRD(3); SBAR(); GAPA(C0=__builtin_amdgcn_mfma_f32_32x32x16_bf16(kf[6],qr[3],C0,0,0,0),   P1[10],P1[11],P1[12],P1[13], pw3[0]=PKW(P1,8), pw3[1]=PKW(P1,10), pw3); \
    VRD(7); SBAR(); GAPA(C1=__builtin_amdgcn_mfma_f32_32x32x16_bf16(kf[7],qr[3],C1,0,0,0),   P1[14],P1[15],0.f,0.f,       pw3[2]=PKW(P1,12),pw3[3]=PKW(P1,14), pw3); \
    l_reg+=sacc; \
    if(GK){DMA_K((t)+3,sl_cur);} if(GV){DMA_V((t)+1,sl_next);} \
    CMASK(C0,C1,t); \
    { float a=MX3(C0[0],C0[1],C1[0]),b=MX3(C0[2],C0[3],C1[1]); a=MX3(a,C1[2],C1[3]); \
      _Pragma("unroll") for(int r=4;r<16;r+=4){a=MX3(a,C0[r],C0[r+1]);b=MX3(b,C0[r+2],C0[r+3]);a=MX3(a,C1[r],C1[r+1]);b=MX3(b,C1[r+2],C1[r+3]);} \
      float rm=__builtin_fmaxf(a,b); { auto rr=__builtin_amdgcn_permlane32_swap(__float_as_uint(rm),__float_as_uint(rm),false,false); rm=__builtin_fmaxf(__uint_as_float(rr[0]),__uint_as_float(rr[1])); } \
      resc=false; \
      if(__builtin_expect(__any(rm>(float)THRL),0)){ const float dl=__builtin_fmaxf(rm,0.f); mhat+=dl; \
        _Pragma("unroll") for(int r=0;r<16;++r){C0[r]-=dl;C1[r]-=dl;} \
        _Pragma("unroll") for(int r=0;r<16;++r)negm[r]=-mhat; asm volatile("":"+v"(negm)); \
        const float f=__builtin_amdgcn_exp2f(-dl); l_reg*=f; if(hi==0)wsf[r32]=f; resc=true; } } \
    SBAR(); \
    GAPB(o[0]=__builtin_amdgcn_mfma_f32_32x32x16_bf16(PAF(0),VFR(0),o[0],0,0,0), C0,0); \
    GAPB(o[1]=__builtin_amdgcn_mfma_f32_32x32x16_bf16(PAF(0),VFR(4),o[1],0,0,0), C0,4); \
    KRD(GL,0); GAPB(o[0]=__builtin_amdgcn_mfma_f32_32x32x16_bf16(PAF(1),VFR(1),o[0],0,0,0), C0,8); \
    KRD(GL,1); GAPB(o[1]=__builtin_amdgcn_mfma_f32_32x32x16_bf16(PAF(1),VFR(5),o[1],0,0,0), C0,12); \
    KRD(GL,2); GAPB(o[0]=__builtin_amdgcn_mfma_f32_32x32x16_bf16(PAF(2),VFR(2),o[0],0,0,0), C1,0); \
    KRD(GL,3); GAPB(o[1]=__builtin_amdgcn_mfma_f32_32x32x16_bf16(PAF(2),VFR(6),o[1],0,0,0), C1,4); \
    GAPB(o[0]=__builtin_amdgcn_mfma_f32_32x32x16_bf16(PAF(3),VFR(3),o[0],0,0,0), C1,8); \
    GAPB(o[1]=__builtin_amdgcn_mfma_f32_32x32x16_bf16(PAF(3),VFR(7),o[1],0,0,0), C1,12); \
    }while(0)
  int t=1;
  #undef CMASK
  #define CMASK(P0,P1,t) do{}while(0)
  for(;t+5<NT;t+=2){
    STEP(pB0,pB1,pA0,pA1,t,true,true,true);     WAIT_BAR(2); RESC(); ROT();
    STEP(pA0,pA1,pB0,pB1,t+1,true,true,true);   WAIT_BAR(2); RESC(); ROT();
  }
  #undef CMASK
  #define CMASK(P0,P1,t) do{}while(0)
  #define ENDW(tt) do{ if((tt)+3<NT){WAIT_BAR(2);} else if((tt)+2<NT){WAIT_BAR(1);} else {WAIT_BAR(0);} }while(0)
  for(;t+1<NT;t+=2){
    STEP(pB0,pB1,pA0,pA1,t,(t+3<NT),(t+1<NT),(t+1<NT));       ENDW(t);   RESC(); ROT();
    STEP(pA0,pA1,pB0,pB1,t+1,(t+4<NT),(t+2<NT),(t+2<NT));     ENDW(t+1); RESC(); ROT();
  }
  STEP(pB0,pB1,pA0,pA1,NT-1,false,false,false); RESC();
  { float sacc=pB0[0]+pB0[1]; _Pragma("unroll") for(int r=2;r<16;++r)sacc+=pB0[r]; _Pragma("unroll") for(int r=0;r<16;++r)sacc+=pB1[r]; l_reg+=sacc;
    pw0=(u32x4){PKW(pB0,0),PKW(pB0,2),PKW(pB0,4),PKW(pB0,6)};pw1=(u32x4){PKW(pB0,8),PKW(pB0,10),PKW(pB0,12),PKW(pB0,14)};pw2=(u32x4){PKW(pB1,0),PKW(pB1,2),PKW(pB1,4),PKW(pB1,6)};pw3=(u32x4){PKW(pB1,8),PKW(pB1,10),PKW(pB1,12),PKW(pB1,14)};
    SBAR(); pv(o,vb0+sl_cur,PAF(0),PAF(1),PAF(2),PAF(3)); }
  #undef PKW
  #undef PAF
  #undef VFR
  #undef PIN
  #undef MX3
  #undef GAPA
  #undef GAPB
  #undef EX
  #undef VRD
  #undef KRD
  #undef STEP
  #undef ENDW
  {auto rr=__builtin_amdgcn_permlane32_swap(__float_as_uint(l_reg),__float_as_uint(l_reg),false,false);l_reg=__uint_as_float(rr[0])+__uint_as_float(rr[1]);}
  if(hi==0)wsf[32+r32]=l_reg;asm volatile("s_waitcnt lgkmcnt(0)":::"memory");
  float rli[16];
  #pragma unroll
  for(int r=0;r<16;++r)rli[r]=__builtin_amdgcn_rcpf(wsf[32+crow(r,hi)]);
  bf16*Ow=Ou+(long)(wid*QBLK)*OPITCH;
  { bf16*stg=(bf16*)(shm+LDS_OST)+wid*2048;
    #pragma unroll
    for(int r=0;r<16;++r){const int orow=crow(r,hi);
      #pragma unroll
      for(int d0=0;d0<2;++d0)stg[orow*64+d0*32+r32]=__float2bfloat16(o[d0][r]*rli[r]);}
    asm volatile("s_waitcnt lgkmcnt(0)":::"memory");
    #pragma unroll
    for(int i=0;i<4;++i){const int row=i*8+(lane>>3),ch=lane&7; const u32x4 v=*(const u32x4*)(stg+row*64+ch*8); *(u32x4*)(Ow+(long)row*OPITCH+ch*8)=v;} }
  asm volatile("s_waitcnt lgkmcnt(0)\n\ts_barrier":::"memory");
  #undef DMA_K
  #undef DMA_V
  #undef CMASK
  #undef START
  #undef RESC
  #undef ROT
}
#undef SBAR
#undef WAIT_BAR
}

namespace mk {
using pg8::bf16_t; using pg8::f32x4; using pg8::Unit; using pg8::cvt_pk_bf16;
#define LAS __attribute__((address_space(3)))
typedef unsigned u32x2 __attribute__((ext_vector_type(2)));
typedef unsigned u32x4 __attribute__((ext_vector_type(4)));
typedef float f32x2 __attribute__((ext_vector_type(2)));
typedef short bf16x8 __attribute__((ext_vector_type(8)));
typedef float f32x16 __attribute__((ext_vector_type(16)));

constexpr int DM = 1024, NB = 8, SL = 4096, CL = 256, ML = NB * SL, MC = NB * CL, MT = ML + MC;
constexpr int INW = 1792, DFF = 2816, UPW = 5632, MIXK = 1280, KVP = 128, QP = 512, KVB = SL + CL;
constexpr int HALF_A = 16384;
constexpr float EPS = 1e-6f;
constexpr float QSCALE = 0.125f * 1.4426950408889634f;

constexpr size_t MiB = 1u << 20;
constexpr size_t WS_CTL = 0;
constexpr size_t WS_MODP = 1 * MiB;
constexpr size_t WS_MOD = 5 * MiB;
constexpr size_t WS_WCP = 5 * MiB + 512 * 1024;
constexpr size_t WS_T = 6 * MiB;
constexpr size_t WS_TW = 7 * MiB;
constexpr size_t WS_W = 8 * MiB;
constexpr size_t W_LAYER = 24 * MiB;
constexpr size_t WS_ADFT = 56 * MiB;
constexpr size_t WS_ADFTC = 88 * MiB;
constexpr size_t WS_KF = 89 * MiB;
constexpr size_t WS_KFC = 121 * MiB;
constexpr size_t WS_CX = 122 * MiB;
constexpr size_t WS_XN = 130 * MiB;
constexpr size_t WS_TMP = 198 * MiB;
constexpr size_t WS_Q = WS_TMP;
constexpr size_t WS_K = WS_TMP + 34 * MiB;
constexpr size_t WS_V = WS_TMP + 43 * MiB;
constexpr size_t WS_FT = WS_TMP + 52 * MiB;
constexpr size_t WS_FTC = WS_TMP + 68 * MiB;
constexpr size_t WS_PT = WS_TMP + 69 * MiB;
constexpr size_t WS_PTC = WS_TMP + 117 * MiB;
constexpr size_t WS_MIX = WS_TMP + 120 * MiB;
constexpr size_t WS_HRAW = WS_TMP + 206 * MiB;
constexpr size_t WS_U = WS_TMP;
constexpr size_t WS_G = WS_TMP;
constexpr size_t WS_SB = WS_TMP + 190 * MiB;
constexpr size_t WS_XB = WS_TMP + 224 * MiB;
constexpr size_t WS_END = WS_TMP + 297 * MiB;

struct Params { const float* in[29]; float* out; unsigned char* ws; int ph_lo, ph_hi; };
enum { I_X = 0, I_C, I_CTX, I_CCTX, I_WMOD, I_BMOD, I_GPREMIX, I_GPOSTMIX, I_GPREFFN, I_GPOSTFFN, I_WIN, I_GQ, I_GK, I_WF, I_WHC, I_BHC,
       I_HW1, I_HB1, I_HFR1, I_HW2, I_HB2, I_HFR2, I_HW3, I_HBIAS, I_WOUT, I_WUP, I_WFC, I_BFC, I_WDOWN };

__device__ __forceinline__ unsigned f2bf(float f) { unsigned u = __builtin_bit_cast(unsigned, f); return (u + 0x7fffu + ((u >> 16) & 1u)) >> 16; }
__device__ __forceinline__ unsigned pk2(float lo, float hi) { return f2bf(lo) | (f2bf(hi) << 16); }
__device__ __forceinline__ float bflo(unsigned w) { return __uint_as_float(w << 16); }
__device__ __forceinline__ float bfhi(unsigned w) { return __uint_as_float(w & 0xffff0000u); }
__device__ __forceinline__ float bf2f(bf16_t h) { return __uint_as_float((unsigned)h << 16); }
__device__ __forceinline__ float wave_sum(float v) {
#pragma unroll
    for (int o = 1; o < 64; o <<= 1) v += __shfl_xor(v, o);
    return v;
}

struct EpiPlain {
    static constexpr bool PERM = true, AFTER_DRAIN = false, APERM = false;
    bf16_t* O; int ldc;
    __device__ __forceinline__ void operator()(const f32x4 (&acc)[2][2][4][2], const Unit& u, int wr, int wc, int fr, int fq) const {
        const int row0 = u.pm * 256 + wr * 64 + fr; const int col0 = u.pn * 256 + wc * 32 + 8 * fq;
#pragma unroll
        for (int ai = 0; ai < 2; ++ai)
#pragma unroll
            for (int m = 0; m < 4; ++m) { bf16_t* rowp = O + (size_t)(row0 + ai * 128 + m * 16) * ldc + col0;
#pragma unroll
                for (int bj = 0; bj < 2; ++bj) { const f32x4 v0 = acc[ai][bj][m][0], v1 = acc[ai][bj][m][1];
                    u32x4 w; w.x = cvt_pk_bf16(v0[0], v0[1]); w.y = cvt_pk_bf16(v0[2], v0[3]); w.z = cvt_pk_bf16(v1[0], v1[1]); w.w = cvt_pk_bf16(v1[2], v1[3]);
                    *(u32x4*)(rowp + bj * 128) = w; } }
    }
};

struct EpiFourier {
    static constexpr bool PERM = true, AFTER_DRAIN = false, APERM = false;
    bf16_t* MIXp; int Lh; int rowbase0; int rowstride;
    __device__ __forceinline__ void operator()(const f32x4 (&acc)[2][2][4][2], const Unit& u, int wr, int wc, int fr, int fq) const {
        asm volatile("" : "+v"(fr), "+v"(fq), "+s"(wr), "+s"(wc));
        const int b = u.pn; const int len = 2 * Lh; const int rb = rowbase0 + b * rowstride;
#pragma unroll
        for (int ai = 0; ai < 2; ++ai)
#pragma unroll
            for (int m = 0; m < 4; ++m) {
                const int r = u.pm * 256 + ai * 128 + wr * 64 + m * 16 + fr;
                const bool isS = r > Lh; const int k = isS ? r - Lh : r;
                const bool edge = (k == 0) || (k == Lh);
#pragma unroll
                for (int bj = 0; bj < 2; ++bj) { const f32x4 v0 = acc[ai][bj][m][0], v1 = acc[ai][bj][m][1];
                    const int ch = bj * 128 + wc * 32 + 8 * fq;
                    u32x4 w; w.x = cvt_pk_bf16(v0[0], v0[1]); w.y = cvt_pk_bf16(v0[2], v0[3]); w.z = cvt_pk_bf16(v1[0], v1[1]); w.w = cvt_pk_bf16(v1[2], v1[3]);
                    const int col = 512 + (isS ? 256 : 0) + ch;
                    *(u32x4*)(MIXp + (size_t)(rb + k) * MIXK + col) = w;
                    if (!edge) { u32x4 wm = w; if (isS) { wm.x ^= 0x80008000u; wm.y ^= 0x80008000u; wm.z ^= 0x80008000u; wm.w ^= 0x80008000u; }
                        *(u32x4*)(MIXp + (size_t)(rb + len - k) * MIXK + col) = wm; }
                    else if (!isS) { *(u32x4*)(MIXp + (size_t)(rb + k) * MIXK + col + 256) = (u32x4){0u, 0u, 0u, 0u}; }
                }
            }
    }
};

struct EpiInProj {
    static constexpr bool PERM = false, AFTER_DRAIN = false, APERM = false;
    bf16_t *Q, *K, *V, *fT, *fTc, *PT, *PTc; const float *gq, *gk, *rope; LAS float* xch;
    __device__ __forceinline__ void operator()(const f32x4 (&acc)[2][2][4][2], const Unit& u, int wr, int wc, int fr, int fq) const {
        asm volatile("" : "+v"(fr), "+v"(fq), "+s"(wr), "+s"(wc));
        const int pn = u.pn, pm = u.pm; const bool isctx = pm >= 128;
        const int b = isctx ? pm - 128 : pm >> 4;
        const int tbase = isctx ? 0 : (pm & 15) * 256;
#ifdef T_NOQK
        if (false) {
#else
        if (pn <= 2) {
#endif
#pragma unroll
            for (int ai = 0; ai < 2; ++ai)
#pragma unroll
                for (int m = 0; m < 4; ++m)
#pragma unroll
                    for (int bj = 0; bj < 2; ++bj) {
                        float s = 0.f;
#pragma unroll
                        for (int n = 0; n < 2; ++n) { const f32x4 x = acc[ai][bj][m][n]; s += (x[0] * x[0] + x[1] * x[1]) + (x[2] * x[2] + x[3] * x[3]); }
                        s += __shfl_xor(s, 16); s += __shfl_xor(s, 32);
                        if (fq == 0) xch[((ai * 128 + wr * 64 + m * 16 + fr) * 2 + bj) * 4 + wc] = s;
                    }
            asm volatile("s_waitcnt lgkmcnt(0)\n\ts_barrier" ::: "memory");
            const float* gg = (pn == 2) ? gk : gq;
            const int dbase = (wc & 1) * 32 + 4 * fq;
            const f32x4 g1 = *(const f32x4*)(gg + dbase), g2 = *(const f32x4*)(gg + dbase + 16);
            const float osc = (pn == 2) ? 1.0f : QSCALE;
#pragma unroll
            for (int ai = 0; ai < 2; ++ai)
#pragma unroll
                for (int m = 0; m < 4; ++m) {
                    const int rl = ai * 128 + wr * 64 + m * 16 + fr; const int t = tbase + rl;
                    const int p = (wc & 1) ? (t & 63) : (t >> 6);
                    f32x4 cs = (f32x4){1.f, 1.f, 1.f, 1.f}, sn = (f32x4){0.f, 0.f, 0.f, 0.f};
                    if (!isctx) { cs = *(const f32x4*)(rope + p * 16 + 4 * fq); sn = *(const f32x4*)(rope + 1024 + p * 16 + 4 * fq); }
                    const size_t qrow = (size_t)pm * 256 + rl;
                    const size_t kvrow = isctx ? (size_t)b * KVB + rl : (size_t)b * KVB + CL + t;
#pragma unroll
                    for (int bj = 0; bj < 2; ++bj) {
                        if (pn == 2 && bj == 1) {
#pragma unroll
                            for (int n = 0; n < 2; ++n) { const f32x4 x = acc[ai][bj][m][n]; u32x2 w; w.x = cvt_pk_bf16(x[0], x[1]); w.y = cvt_pk_bf16(x[2], x[3]);
                                *(u32x2*)(V + kvrow * KVP + wc * 32 + 16 * n + 4 * fq) = w; }
                        } else {
                            const float ssq = xch[(rl * 2 + bj) * 4 + wc] + xch[(rl * 2 + bj) * 4 + (wc ^ 1)];
                            const float rstd = rsqrtf(ssq * (1.0f / 64.0f) + EPS) * osc;
                            const f32x4 y1 = acc[ai][bj][m][0] * rstd * g1, y2 = acc[ai][bj][m][1] * rstd * g2;
                            const f32x4 o1 = y1 * cs - y2 * sn, o2 = y2 * cs + y1 * sn;
                            u32x2 w1, w2; w1.x = cvt_pk_bf16(o1[0], o1[1]); w1.y = cvt_pk_bf16(o1[2], o1[3]); w2.x = cvt_pk_bf16(o2[0], o2[1]); w2.y = cvt_pk_bf16(o2[2], o2[3]);
                            bf16_t* dst = (pn == 2) ? (K + kvrow * KVP + wc * 32 + 4 * fq) : (Q + qrow * QP + pn * 256 + bj * 128 + wc * 32 + 4 * fq);
                            *(u32x2*)dst = w1; *(u32x2*)(dst + 16) = w2;
                        }
                    }
                }
        }
#ifndef T_NOTR
        else {
            const int NC = (pn == 3) ? 256 : 768; const int cb = (pn == 3) ? 0 : (pn - 4) * 256;
            bf16_t* base; int tl;
            if (isctx) { base = ((pn == 3) ? fTc : PTc) + (size_t)b * NC * CL; tl = CL; }
            else { base = ((pn == 3) ? fT : PT) + (size_t)b * NC * SL + tbase; tl = SL; }
            const int lane = fq * 16 + fr;
            LAS bf16_t* stg = (LAS bf16_t*)((LAS unsigned char*)xch + 8192) + (wr * 4 + wc) * 1152;
#pragma unroll
            for (int ai = 0; ai < 2; ++ai)
#pragma unroll
                for (int bj = 0; bj < 2; ++bj)
#pragma unroll
                    for (int n = 0; n < 2; ++n) {
#pragma unroll
                        for (int m = 0; m < 4; ++m) { const f32x4 x = acc[ai][bj][m][n];
#pragma unroll
                            for (int j = 0; j < 4; ++j) stg[(4 * fq + j) * 72 + m * 16 + fr] = (bf16_t)f2bf(x[j]); }
                        asm volatile("s_waitcnt lgkmcnt(0)" ::: "memory");
                        bf16_t* dst = base + (size_t)(cb + bj * 128 + wc * 32 + 16 * n) * tl + ai * 128 + wr * 64;
#pragma unroll
                        for (int i = 0; i < 2; ++i) { const int v = lane + 64 * i, col = v >> 3, k = v & 7;
                            const u32x4 w = *(const LAS u32x4*)(stg + col * 72 + k * 8);
                            *(u32x4*)(dst + (size_t)col * tl + 8 * k) = w; }
                        asm volatile("s_waitcnt lgkmcnt(0)" ::: "memory");
                    }
        }
#endif
    }
};


__device__ __forceinline__ float dppf(float old, float src, int ctrl_sel) {
    const int o = __builtin_bit_cast(int, old), s = __builtin_bit_cast(int, src); int r;
    if (ctrl_sel == 0) r = __builtin_amdgcn_update_dpp(o, s, 0x111, 0xf, 0xf, false);
    else if (ctrl_sel == 1) r = __builtin_amdgcn_update_dpp(o, s, 0x101, 0xf, 0xf, false);
    else if (ctrl_sel == 2) r = __builtin_amdgcn_update_dpp(o, s, 0x121, 0xf, 0xf, false);
    else r = __builtin_amdgcn_update_dpp(o, s, 0x12F, 0xf, 0xf, false);
    return __builtin_bit_cast(float, r);
}
__device__ __forceinline__ float silu_mul(float cg, float cv) { return cg * cv * __builtin_amdgcn_rcpf(1.0f + __builtin_amdgcn_exp2f(-1.4426950408889634f * cg)); }

struct EpiGlu {
    static constexpr bool PERM = true, AFTER_DRAIN = false, APERM = true;
    bf16_t* G; bf16_t* SB; const u32x4* wcp; LAS float* xb;
    __device__ __forceinline__ void operator()(const f32x4 (&acc)[2][2][4][2], const Unit& u, int wr, int wc, int fr, int fq) const {
        asm volatile("" : "+v"(fr), "+v"(fq), "+s"(wr), "+s"(wc));
        const int c0 = 128 * u.pn + 32 * wc + 8 * fq;
        u32x4 wq[8];
#pragma unroll
        for (int k = 0; k < 8; ++k) wq[k] = wcp[c0 + k];
#pragma unroll
        for (int ai = 0; ai < 2; ++ai) {
            if (fr == 0 || fr == 15) {
                const int which = fr == 0 ? 0 : 1; LAS float* dst = xb + ((((ai * 2 + wr) * 2 + which) * 4 + wc) * 4 + fq) * 16;
#pragma unroll
                for (int bj = 0; bj < 2; ++bj)
#pragma unroll
                    for (int n = 0; n < 2; ++n) { const f32x4 x = fr == 0 ? acc[ai][bj][0][n] : acc[ai][bj][3][n]; *(LAS f32x4*)(dst + bj * 8 + n * 4) = x; }
            }
        }
        asm volatile("s_waitcnt lgkmcnt(0)\n\ts_barrier" ::: "memory");
#pragma unroll
        for (int ai = 0; ai < 2; ++ai) {
            int pblk = -1, nblk = -1;
            if (wr == 1) pblk = ai * 2 + 0; else if (ai == 1) pblk = 0 * 2 + 1;
            if (wr == 0) nblk = ai * 2 + 1; else if (ai == 0) nblk = 1 * 2 + 0;
#pragma unroll
            for (int n = 0; n < 2; ++n) {
#pragma unroll
                for (int j = 0; j < 4; ++j) asm volatile("" : "+v"(wq[4 * n + j]));
                f32x4 wg[3], wv[3], bg, bv;
#pragma unroll
                for (int j = 0; j < 4; ++j) { const u32x4 w = wq[4 * n + j];
                    wg[0][j] = bflo(w.x); wg[1][j] = bfhi(w.x); wg[2][j] = bflo(w.y); bg[j] = bfhi(w.y);
                    wv[0][j] = bflo(w.z); wv[1][j] = bfhi(w.z); wv[2][j] = bflo(w.w); bv[j] = bfhi(w.w); }
                f32x4 pg = (f32x4){0.f, 0.f, 0.f, 0.f}, pv = pg, ng = pg, nv = pg;
                if (pblk >= 0) { const LAS float* s = xb + (((pblk * 2 + 1) * 4 + wc) * 4 + fq) * 16; pg = *(const LAS f32x4*)(s + n * 4); pv = *(const LAS f32x4*)(s + 8 + n * 4); }
                if (nblk >= 0) { const LAS float* s = xb + (((nblk * 2 + 0) * 4 + wc) * 4 + fq) * 16; ng = *(const LAS f32x4*)(s + n * 4); nv = *(const LAS f32x4*)(s + 8 + n * 4); }
                f32x4 upg, upv, dng, dnv;
#pragma unroll
                for (int j = 0; j < 4; ++j) { upg[j] = dppf(pg[j], acc[ai][0][3][n][j], 0); upv[j] = dppf(pv[j], acc[ai][1][3][n][j], 0);
                                              dng[j] = dppf(ng[j], acc[ai][0][0][n][j], 1); dnv[j] = dppf(nv[j], acc[ai][1][0][n][j], 1); }
#pragma unroll
                for (int m = 0; m < 4; ++m) {
                    const f32x4 cg = acc[ai][0][m][n], cv = acc[ai][1][m][n];
                    const f32x4 prg = m > 0 ? acc[ai][0][m - 1][n] : upg, prv = m > 0 ? acc[ai][1][m - 1][n] : upv;
                    const f32x4 nxg = m < 3 ? acc[ai][0][m + 1][n] : dng, nxv = m < 3 ? acc[ai][1][m + 1][n] : dnv;
                    const f32x4 sg = prg * wg[0] + cg * wg[1] + nxg * wg[2] + bg;
                    const f32x4 sv = prv * wv[0] + cv * wv[1] + nxv * wv[2] + bv;
                    float res[4];
#pragma unroll
                    for (int j = 0; j < 4; ++j) res[j] = silu_mul(sg[j], sv[j]);
                    u32x2 pk; pk.x = cvt_pk_bf16(res[0], res[1]); pk.y = cvt_pk_bf16(res[2], res[3]);
                    const int rl = ai * 128 + wr * 64 + 4 * fr + m;
                    *(u32x2*)(G + (size_t)(u.pm * 256 + rl) * DFF + c0 + 4 * n) = pk;
                    if (rl < 2 || rl >= 254) {
                        const int which = rl < 2 ? rl : rl - 252; bf16_t* sb = SB + ((size_t)u.pm * 4 + which) * UPW + c0 + 4 * n;
                        u32x2 a; a.x = cvt_pk_bf16(cg[0], cg[1]); a.y = cvt_pk_bf16(cg[2], cg[3]);
                        u32x2 bq; bq.x = cvt_pk_bf16(cv[0], cv[1]); bq.y = cvt_pk_bf16(cv[2], cv[3]);
                        *(u32x2*)sb = a; *(u32x2*)(sb + DFF) = bq;
                    }
                }
            }
        }
    }
};

__device__ __forceinline__ void glu_fixup(int blk, int nblk, int tid, int ntiles, const bf16_t* SB, bf16_t* G, const float* wc, const float* bc) {
    for (int it = blk; it < 2 * ntiles; it += nblk) {
        const int pm = it >> 1, b = it & 1;
        const bool isctx = pm >= 128; const bool has_prev = !isctx && (pm & 15) != 0, has_next = !isctx && (pm & 15) != 15;
        const bf16_t* rp; const bf16_t* rc; const bf16_t* rn; bool hp, hn;
        if (b == 0) { rp = SB + ((size_t)(pm - 1) * 4 + 3) * UPW; rc = SB + ((size_t)pm * 4 + 0) * UPW; rn = SB + ((size_t)pm * 4 + 1) * UPW; hp = has_prev; hn = true; }
        else { rp = SB + ((size_t)pm * 4 + 2) * UPW; rc = SB + ((size_t)pm * 4 + 3) * UPW; rn = SB + ((size_t)(pm + 1) * 4 + 0) * UPW; hp = true; hn = has_next; }
        bf16_t* grow = G + (size_t)(pm * 256 + (b ? 255 : 0)) * DFF;
        float val[6][14];
#pragma unroll
        for (int q = 0; q < 6; ++q) { const int c = tid + 512 * q; const bool in = c < DFF; const int cc = in ? c : 0;
            val[q][0] = hp ? bf2f(rp[cc]) : 0.f; val[q][1] = bf2f(rc[cc]); val[q][2] = hn ? bf2f(rn[cc]) : 0.f;
            val[q][3] = hp ? bf2f(rp[DFF + cc]) : 0.f; val[q][4] = bf2f(rc[DFF + cc]); val[q][5] = hn ? bf2f(rn[DFF + cc]) : 0.f;
            val[q][6] = wc[cc]; val[q][7] = wc[UPW + cc]; val[q][8] = wc[2 * UPW + cc]; val[q][9] = bc[cc];
            val[q][10] = wc[DFF + cc]; val[q][11] = wc[UPW + DFF + cc]; val[q][12] = wc[2 * UPW + DFF + cc]; val[q][13] = bc[DFF + cc]; }
#pragma unroll
        for (int q = 0; q < 6; ++q) { const int c = tid + 512 * q;
            const float sg = val[q][0] * val[q][6] + val[q][1] * val[q][7] + val[q][2] * val[q][8] + val[q][9];
            const float sv = val[q][3] * val[q][10] + val[q][4] * val[q][11] + val[q][5] * val[q][12] + val[q][13];
            if (c < DFF) grow[c] = (bf16_t)f2bf(silu_mul(sg, sv)); }
    }
}

struct OneUnit { int pm, pn;
    __device__ __forceinline__ bool next(int i, Unit& u) const { if (i > 0) return false; u.pm = pm; u.pn = pn; return true; }
    __device__ __forceinline__ void a_ready(const Unit&) const {}
    __device__ __forceinline__ void done(const Unit&) const {}
};

constexpr int AT_K = 0, AT_V = 16384, AT_WS = 32768, AT_OST = 32768 + 2048;
__device__ __forceinline__ void attn_unit(const bf16_t* Qu, const bf16_t* Kh, const bf16_t* Vh, bf16_t* Ou, int NT, char* shm) {
    using namespace attn_body;
    const int tid = mk_tid(), lane = tid & 63, r32 = lane & 31, hi = lane >> 5; const int wid = __builtin_amdgcn_readfirstlane(tid >> 6);
    const unsigned lds0 = (unsigned)(uintptr_t)shm;
    float* wsf = (float*)(shm + AT_WS) + wid * 64;
    const bf16_t* ksrc = Kh + (size_t)lane * KVP + wid * 8;
    const bf16_t* vsrc = Vh + (size_t)(16 * (wid & 3) + (lane >> 2)) * KVP + (wid >> 2) * 32 + (lane & 3) * 8;
    const unsigned kdst = lds0 + AT_K + wid * 1024, vdst = lds0 + AT_V + wid * 1024;
#define DMA_K(t, slot) glds16(ksrc + (size_t)(t) * 64 * KVP, (unsigned)__builtin_amdgcn_readfirstlane(kdst + (slot)))
#define DMA_V(t, slot) glds16(vsrc + (size_t)(t) * 64 * KVP, (unsigned)__builtin_amdgcn_readfirstlane(vdst + (slot)))
    const int vb0 = (int)(lds0 + AT_V) + ((lane >> 4) & 1) * 32 + (lane & 3) * 8 + (4 * hi + ((lane & 15) >> 2)) * 64;
    DMA_K(0, 0); DMA_V(0, 0);
    const bf16_t* Qw = Qu + (size_t)(wid * 32) * QP;
    bf16x8 qr[4];
#pragma unroll
    for (int d0 = 0; d0 < 4; ++d0) qr[d0] = *reinterpret_cast<const bf16x8*>(&Qw[(size_t)r32 * QP + d0 * 16 + hi * 8]);
    float mrun = -INFINITY, l_reg = 0.f; f32x16 o[2]; o[0] = f32x16{}; o[1] = f32x16{};
    f32x16 zero16 = f32x16{};
    for (int t = 0; t < NT; ++t) {
        const int buf = (t & 1) * 8192;
        if (t + 1 < NT) { DMA_K(t + 1, buf ^ 8192); DMA_V(t + 1, buf ^ 8192); asm volatile("s_waitcnt vmcnt(2)\n\ts_barrier" ::: "memory"); }
        else { asm volatile("s_waitcnt vmcnt(0)\n\ts_barrier" ::: "memory"); }
        f32x16 p0, p1;
        qkt(p0, p1, shm + AT_K + buf, qr, zero16, r32, hi);
        float rm = p0[0];
#pragma unroll
        for (int r = 1; r < 16; ++r) rm = fmaxf(rm, p0[r]);
#pragma unroll
        for (int r = 0; r < 16; ++r) rm = fmaxf(rm, p1[r]);
        rm = fmaxf(rm, __shfl_xor(rm, 32));
        const float mnew = fmaxf(mrun, rm);
        const float f = __builtin_amdgcn_exp2f(mrun - mnew);
        mrun = mnew;
        float sacc = 0.f;
#pragma unroll
        for (int r = 0; r < 16; ++r) { p0[r] = __builtin_amdgcn_exp2f(p0[r] - mnew); p1[r] = __builtin_amdgcn_exp2f(p1[r] - mnew); sacc += p0[r] + p1[r]; }
        l_reg = l_reg * f + sacc;
        if (hi == 0) wsf[r32] = f;
        asm volatile("s_waitcnt lgkmcnt(0)" ::: "memory");
#pragma unroll
        for (int r = 0; r < 16; ++r) { const float fr_ = wsf[crow(r, hi)]; o[0][r] *= fr_; o[1][r] *= fr_; }
        u32x4 pw0, pw1, pw2, pw3;
        pw0 = (u32x4){cvtpk_s(p0[0], p0[1]), cvtpk_s(p0[2], p0[3]), cvtpk_s(p0[4], p0[5]), cvtpk_s(p0[6], p0[7])};
        pw1 = (u32x4){cvtpk_s(p0[8], p0[9]), cvtpk_s(p0[10], p0[11]), cvtpk_s(p0[12], p0[13]), cvtpk_s(p0[14], p0[15])};
        pw2 = (u32x4){cvtpk_s(p1[0], p1[1]), cvtpk_s(p1[2], p1[3]), cvtpk_s(p1[4], p1[5]), cvtpk_s(p1[6], p1[7])};
        pw3 = (u32x4){cvtpk_s(p1[8], p1[9]), cvtpk_s(p1[10], p1[11]), cvtpk_s(p1[12], p1[13]), cvtpk_s(p1[14], p1[15])};
        pv(o, vb0 + buf, __builtin_bit_cast(bf16x8, pw0), __builtin_bit_cast(bf16x8, pw1), __builtin_bit_cast(bf16x8, pw2), __builtin_bit_cast(bf16x8, pw3));
        asm volatile("s_waitcnt lgkmcnt(0)\n\ts_barrier" ::: "memory");
    }
    l_reg += __shfl_xor(l_reg, 32);
    if (hi == 0) wsf[32 + r32] = l_reg;
    asm volatile("s_waitcnt lgkmcnt(0)" ::: "memory");
    float rli[16];
#pragma unroll
    for (int r = 0; r < 16; ++r) rli[r] = 1.0f / wsf[32 + crow(r, hi)];
    bf16_t* Ow = Ou + (size_t)(wid * 32) * MIXK;
    { bf16_t* stg = (bf16_t*)(shm + AT_OST) + wid * 2048;
#pragma unroll
      for (int r = 0; r < 16; ++r) { const int orow = crow(r, hi);
#pragma unroll
        for (int d0 = 0; d0 < 2; ++d0) stg[orow * 64 + d0 * 32 + r32] = (bf16_t)f2bf(o[d0][r] * rli[r]); }
      asm volatile("s_waitcnt lgkmcnt(0)" ::: "memory");
#pragma unroll
      for (int i = 0; i < 4; ++i) { const int row = i * 8 + (lane >> 3), ch = lane & 7; const u32x4 v = *(const u32x4*)(stg + row * 64 + ch * 8); *(u32x4*)(Ow + (size_t)row * MIXK + ch * 8) = v; } }
    asm volatile("s_waitcnt vmcnt(0) lgkmcnt(0)\n\ts_barrier" ::: "memory");
#undef DMA_K
#undef DMA_V
}

__device__ __forceinline__ int PADI(int i) { return i + (i >> 5); }
constexpr int FFT_TW_OFF = 69632, FFT_RED_OFF = 69632 + 32768;
template <int LOGN, int R, bool INV>
__device__ __forceinline__ void fft_pass(LAS f32x2* d, const LAS f32x2* tw, int s, int tid) {
    constexpr int N = 1 << LOGN, RR = 1 << R;
    const int lgs = LOGN - s - R; const int stride = 1 << lgs;
    constexpr float C16[8] = {1.0f, 0.9238795325112867f, 0.7071067811865476f, 0.3826834323650898f, 0.0f, -0.3826834323650898f, -0.7071067811865476f, -0.9238795325112867f};
    constexpr float S16[8] = {0.0f, 0.3826834323650898f, 0.7071067811865476f, 0.9238795325112867f, 1.0f, 0.9238795325112867f, 0.7071067811865476f, 0.3826834323650898f};
    for (int g = tid; g < (N >> R); g += 512) {
        const int lo = g & (stride - 1), hi = g >> lgs; const int base = (hi << (lgs + R)) + lo;
        f32x2 v[RR];
#pragma unroll
        for (int e = 0; e < RR; ++e) v[e] = d[PADI(base + e * stride)];
        if constexpr (R == 1) { const f32x2 a = v[0], b = v[1]; v[0] = a + b; v[1] = a - b; }
        else {
            static_assert(R == 4 || R == 1, "radix");
            f32x2 Wb[4];
            Wb[0] = tw[lo << s];
#pragma unroll
            for (int j = 1; j < 4; ++j) Wb[j] = (f32x2){Wb[j - 1].x * Wb[j - 1].x - Wb[j - 1].y * Wb[j - 1].y, 2.0f * Wb[j - 1].x * Wb[j - 1].y};
#pragma unroll
            for (int jj = 0; jj < 4; ++jj) {
                const int j = INV ? (3 - jj) : jj;
                const int he = 8 >> j;
#pragma unroll
                for (int q = 0; q < 8; ++q) if (q < he) {
                    const int k = q << j;
                    const f32x2 w = (f32x2){Wb[j].x * C16[k] + Wb[j].y * S16[k], Wb[j].y * C16[k] - Wb[j].x * S16[k]};
#pragma unroll
                    for (int e = 0; e < 16; ++e) if ((e & he) == 0 && (e & (he - 1)) == q) {
                        const f32x2 a = v[e], b = v[e + he];
                        if (!INV) { const f32x2 dl = a - b; v[e] = a + b; v[e + he] = (f32x2){dl.x * w.x - dl.y * w.y, dl.x * w.y + dl.y * w.x}; }
                        else { const f32x2 bw = (f32x2){b.x * w.x + b.y * w.y, b.y * w.x - b.x * w.y}; v[e] = a + bw; v[e + he] = a - bw; }
                    }
                }
            }
        }
#pragma unroll
        for (int e = 0; e < RR; ++e) d[PADI(base + e * stride)] = v[e];
    }
    __syncthreads();
}
template <int LOGN> __device__ __forceinline__ void fft_fwd(LAS f32x2* d, const LAS f32x2* tw, int tid) {
    if constexpr (LOGN == 13) { fft_pass<13, 4, false>(d, tw, 0, tid); fft_pass<13, 4, false>(d, tw, 4, tid); fft_pass<13, 4, false>(d, tw, 8, tid); fft_pass<13, 1, false>(d, tw, 12, tid); }
    else { fft_pass<9, 4, false>(d, tw, 0, tid); fft_pass<9, 4, false>(d, tw, 4, tid); fft_pass<9, 1, false>(d, tw, 8, tid); }
}
template <int LOGN> __device__ __forceinline__ void fft_inv(LAS f32x2* d, const LAS f32x2* tw, int tid) {
    if constexpr (LOGN == 13) { fft_pass<13, 1, true>(d, tw, 12, tid); fft_pass<13, 4, true>(d, tw, 8, tid); fft_pass<13, 4, true>(d, tw, 4, tid); fft_pass<13, 4, true>(d, tw, 0, tid); }
    else { fft_pass<9, 1, true>(d, tw, 8, tid); fft_pass<9, 4, true>(d, tw, 4, tid); fft_pass<9, 4, true>(d, tw, 0, tid); }
}
template <int LOGN> __device__ __forceinline__ void fft_fwd_head(LAS f32x2* d, const LAS f32x2* tw, int tid) {
    if constexpr (LOGN == 13) { fft_pass<13, 4, false>(d, tw, 0, tid); fft_pass<13, 4, false>(d, tw, 4, tid); fft_pass<13, 4, false>(d, tw, 8, tid); }
    else { fft_pass<9, 4, false>(d, tw, 0, tid); fft_pass<9, 4, false>(d, tw, 4, tid); }
}
template <int LOGN> __device__ __forceinline__ void fft_inv_tail(LAS f32x2* d, const LAS f32x2* tw, int tid) {
    if constexpr (LOGN == 13) { fft_pass<13, 4, true>(d, tw, 8, tid); fft_pass<13, 4, true>(d, tw, 4, tid); fft_pass<13, 4, true>(d, tw, 0, tid); }
    else { fft_pass<9, 4, true>(d, tw, 4, tid); fft_pass<9, 4, true>(d, tw, 0, tid); }
}
template <int LOGN> __device__ __forceinline__ void load_tw(LAS f32x2* tw, const f32x2* g, int tid) {
    for (int i = tid; i < (1 << (LOGN - 1)); i += 512) tw[i] = g[i];
}

template <int LOGN> __device__ __forceinline__ void kf_job(LAS unsigned char* lds, const float* hrawT, const f32x2* twg, f32x2* kf, int ch, int tid) {
    constexpr int N = 1 << LOGN, T = N / 2;
    LAS f32x2* d = (LAS f32x2*)lds; LAS f32x2* tw = (LAS f32x2*)(lds + FFT_TW_OFF); LAS float* red = (LAS float*)(lds + FFT_RED_OFF);
    float s = 0.f;
    { constexpr int NI = (N + 511) / 512; float hv[NI];
#pragma unroll
      for (int i = 0; i < NI; ++i) { const int n = tid + 512 * i; float v = 0.f;
          if (n < N) { if (n < T) v = hrawT[(size_t)ch * T + n]; else if (n > T) v = hrawT[(size_t)(256 + ch) * T + (N - n)]; }
          hv[i] = v; }
      load_tw<LOGN>(tw, twg, tid);
#pragma unroll
      for (int i = 0; i < NI; ++i) { const int n = tid + 512 * i; if (n < N) { d[PADI(n)] = (f32x2){hv[i], 0.f}; s += fabsf(hv[i]); } } }
    s = wave_sum(s);
    if ((tid & 63) == 0) red[tid >> 6] = s;
    __syncthreads();
    float tot = 0.f;
#pragma unroll
    for (int i = 0; i < 8; ++i) tot += red[i];
    const float inv = 1.0f / tot;
    for (int n = tid; n < N; n += 512) { f32x2 v = d[PADI(n)]; v.x *= inv; d[PADI(n)] = v; }
    __syncthreads();
    fft_fwd<LOGN>(d, tw, tid);
    for (int n = tid; n < N; n += 512) kf[(size_t)ch * N + n] = d[PADI(n)];
    __syncthreads();
}

template <int LOGN> __device__ __forceinline__ void hyena_job(LAS unsigned char* lds, const bf16_t* PTall, const f32x2* twg, const f32x2* kf, const float* wc, const float* bc, const float* hbias,
                                                            bf16_t* MIXp, int rowbase, int bp, int ch, int tid) {
    constexpr int N = 1 << LOGN, T = N / 2;
    constexpr int VEC = (T >= 4096) ? 8 : 1;
    constexpr int NKF = (N / 2 + 511) / 512;
    LAS f32x2* d = (LAS f32x2*)lds; LAS f32x2* tw = (LAS f32x2*)(lds + FFT_TW_OFF);
    f32x4 kfr[NKF];
#pragma unroll
    for (int i = 0; i < NKF; ++i) { const int g = tid + 512 * i; kfr[i] = (g < N / 2) ? *(const f32x4*)(kf + (size_t)ch * N + 2 * g) : (f32x4){0.f, 0.f, 0.f, 0.f}; }
    const float w10 = wc[256 + ch], w11 = wc[768 + 256 + ch], w12 = wc[1536 + 256 + ch], b1 = bc[256 + ch];
    const float w20 = wc[512 + ch], w21 = wc[768 + 512 + ch], w22 = wc[1536 + 512 + ch], b2 = bc[512 + ch];
    const float w00 = wc[ch], w01 = wc[768 + ch], w02 = wc[1536 + ch], b0 = bc[ch];
    const float hb = hbias[ch];
    const int t0 = tid * VEC; const bool act = t0 < T;
    float raw[2][3][VEC + 2];
#pragma unroll
    for (int bb = 0; bb < 2; ++bb)
#pragma unroll
        for (int st = 0; st < 3; ++st) {
            const bf16_t* p = PTall + ((size_t)(2 * bp + bb) * 768 + st * 256 + ch) * T;
            if (act) {
                if constexpr (VEC == 8) { const u32x4 w = *(const u32x4*)(p + t0);
                    raw[bb][st][1] = bflo(w.x); raw[bb][st][2] = bfhi(w.x); raw[bb][st][3] = bflo(w.y); raw[bb][st][4] = bfhi(w.y);
                    raw[bb][st][5] = bflo(w.z); raw[bb][st][6] = bfhi(w.z); raw[bb][st][7] = bflo(w.w); raw[bb][st][8] = bfhi(w.w); }
                else raw[bb][st][1] = bf2f(p[t0]);
                raw[bb][st][0] = t0 > 0 ? bf2f(p[t0 - 1]) : 0.f;
                raw[bb][st][VEC + 1] = (t0 + VEC < T) ? bf2f(p[t0 + VEC]) : 0.f;
            } else {
#pragma unroll
                for (int i = 0; i < VEC + 2; ++i) raw[bb][st][i] = 0.f;
            }
        }
    load_tw<LOGN>(tw, twg, tid);
    f32x2 ukeep[VEC]; float x0k[2][VEC];
#pragma unroll
    for (int i = 0; i < VEC; ++i) {
        f32x2 u;
#pragma unroll
        for (int bb = 0; bb < 2; ++bb) {
            const float x1 = raw[bb][1][i] * w10 + raw[bb][1][i + 1] * w11 + raw[bb][1][i + 2] * w12 + b1;
            const float vv = raw[bb][2][i] * w20 + raw[bb][2][i + 1] * w21 + raw[bb][2][i + 2] * w22 + b2;
            x0k[bb][i] = raw[bb][0][i] * w00 + raw[bb][0][i + 1] * w01 + raw[bb][0][i + 2] * w02 + b0;
            if (bb == 0) u.x = x1 * vv; else u.y = x1 * vv;
        }
        ukeep[i] = u;
        if (act) { d[PADI(t0 + i)] = u; d[PADI(t0 + i + T)] = (f32x2){0.f, 0.f}; }
    }
    __syncthreads();
    fft_fwd_head<LOGN>(d, tw, tid);
#pragma unroll
    for (int i = 0; i < NKF; ++i) { const int g = tid + 512 * i; if (g < N / 2) {
        const f32x2 a = d[PADI(2 * g)], b = d[PADI(2 * g + 1)]; const f32x2 fa = a + b, fb = a - b; const f32x4 k = kfr[i];
        const f32x2 ma = (f32x2){fa.x * k.x - fa.y * k.y, fa.x * k.y + fa.y * k.x}, mb = (f32x2){fb.x * k.z - fb.y * k.w, fb.x * k.w + fb.y * k.z};
        d[PADI(2 * g)] = ma + mb; d[PADI(2 * g + 1)] = ma - mb; } }
    __syncthreads();
    fft_inv_tail<LOGN>(d, tw, tid);
    const float sc = 1.0f / (float)N;
    if (act) {
#pragma unroll
        for (int i = 0; i < VEC; ++i) {
            const f32x2 y = d[PADI(t0 + i)] * sc; const f32x2 u = ukeep[i];
#pragma unroll
            for (int bb = 0; bb < 2; ++bb) {
                const float yy = bb == 0 ? y.x : y.y, uu = bb == 0 ? u.x : u.y;
                MIXp[(size_t)(rowbase + (2 * bp + bb) * T + t0 + i) * MIXK + 1024 + ch] = (bf16_t)f2bf(x0k[bb][i] * (yy + uu * hb));
            }
        }
    }
    __syncthreads();
}

__device__ __forceinline__ void norm_rows(int gw, int NGW, int lane, int nrows, const float* xl_in, const float* xc_in, float* xl_out, float* xc_out,
                                          const bf16_t* Y, const float* gpost, const float* modA, int ga_off,
                                          bf16_t* XN, const float* gpre, const float* modB, int sc_off, int sh_off, const bf16_t* xb_in, bf16_t* xb_out) {
    constexpr int NR = 2;
    const int per = (nrows + NGW - 1) / NGW; const int rbeg = gw * per; int rend = rbeg + per; if (rend > nrows) rend = nrows;
    f32x4 gpo[4], gpr[4];
#pragma unroll
    for (int j = 0; j < 4; ++j) { gpo[j] = Y ? *(const f32x4*)(gpost + 4 * lane + 256 * j) : (f32x4){0.f, 0.f, 0.f, 0.f}; gpr[j] = XN ? *(const f32x4*)(gpre + 4 * lane + 256 * j) : (f32x4){0.f, 0.f, 0.f, 0.f}; }
    int cur_mb = -1; f32x4 mga[4], msc[4], msh[4];
    for (int row0 = rbeg; row0 < rend; row0 += NR) {
        f32x4 v[NR][4]; u32x2 yw[NR][4]; bool ok[NR]; bool isc[NR]; int rowi[NR];
#pragma unroll
        for (int q = 0; q < NR; ++q) {
            const int row = row0 + q; ok[q] = row < rend; rowi[q] = ok[q] ? row : row0;
            isc[q] = rowi[q] >= ML;
            if (xb_in) {
#pragma unroll
                for (int j = 0; j < 4; ++j) { const u32x2 w = *(const u32x2*)(xb_in + (size_t)rowi[q] * DM + 4 * lane + 256 * j); v[q][j] = (f32x4){bflo(w.x), bfhi(w.x), bflo(w.y), bfhi(w.y)}; }
            } else {
                const float* xin = isc[q] ? xc_in + (size_t)(rowi[q] - ML) * DM : xl_in + (size_t)rowi[q] * DM;
#pragma unroll
                for (int j = 0; j < 4; ++j) v[q][j] = *(const f32x4*)(xin + 4 * lane + 256 * j);
            }
            if (Y) {
#pragma unroll
                for (int j = 0; j < 4; ++j) yw[q][j] = *(const u32x2*)(Y + (size_t)rowi[q] * DM + 4 * lane + 256 * j);
            }
        }
#pragma unroll
        for (int q = 0; q < NR; ++q) {
            const int mb = isc[q] ? 8 : (rowi[q] >> 12);
            if (mb != cur_mb) { cur_mb = mb;
#pragma unroll
                for (int j = 0; j < 4; ++j) { mga[j] = Y ? *(const f32x4*)(modA + (size_t)mb * 6144 + ga_off + 4 * lane + 256 * j) : (f32x4){0.f, 0.f, 0.f, 0.f};
                    msc[j] = XN ? *(const f32x4*)(modB + (size_t)mb * 6144 + sc_off + 4 * lane + 256 * j) : (f32x4){0.f, 0.f, 0.f, 0.f};
                    msh[j] = XN ? *(const f32x4*)(modB + (size_t)mb * 6144 + sh_off + 4 * lane + 256 * j) : (f32x4){0.f, 0.f, 0.f, 0.f}; } }
            if (Y) {
                float s = 0.f;
#pragma unroll
                for (int j = 0; j < 4; ++j) { const float a = bflo(yw[q][j].x), b = bfhi(yw[q][j].x), c = bflo(yw[q][j].y), d = bfhi(yw[q][j].y); s += (a * a + b * b) + (c * c + d * d); }
                const float rstd = rsqrtf(wave_sum(s) * (1.0f / DM) + EPS);
                float* xo = isc[q] ? xc_out + (size_t)(rowi[q] - ML) * DM : xl_out + (size_t)rowi[q] * DM;
#pragma unroll
                for (int j = 0; j < 4; ++j) { const f32x4 y = (f32x4){bflo(yw[q][j].x), bfhi(yw[q][j].x), bflo(yw[q][j].y), bfhi(yw[q][j].y)};
                    v[q][j] = v[q][j] + mga[j] * (y * rstd * gpo[j]);
                    if (ok[q]) { if (xb_out) { u32x2 w; w.x = pk2(v[q][j].x, v[q][j].y); w.y = pk2(v[q][j].z, v[q][j].w); *(u32x2*)(xb_out + (size_t)rowi[q] * DM + 4 * lane + 256 * j) = w; }
                                 else *(f32x4*)(xo + 4 * lane + 256 * j) = v[q][j]; } }
            }
            if (XN) {
                float s = 0.f;
#pragma unroll
                for (int j = 0; j < 4; ++j) s += (v[q][j].x * v[q][j].x + v[q][j].y * v[q][j].y) + (v[q][j].z * v[q][j].z + v[q][j].w * v[q][j].w);
                const float rstd = rsqrtf(wave_sum(s) * (1.0f / DM) + EPS);
#pragma unroll
                for (int j = 0; j < 4; ++j) { const f32x4 o = (v[q][j] * rstd * gpr[j]) * (1.0f + msc[j]) + msh[j]; u32x2 w; w.x = pk2(o.x, o.y); w.y = pk2(o.z, o.w);
                    if (ok[q]) *(u32x2*)(XN + (size_t)rowi[q] * DM + 4 * lane + 256 * j) = w; }
            }
        }
    }
}

__device__ __forceinline__ void glu_pass(int blk, int nblk, int tid, int r0, int nrows, const bf16_t* U, bf16_t* G, const float* wc, const float* bc) {
    const int nitems = nrows / 8;
    for (int it = blk; it < nitems; it += nblk) {
        for (int p = tid; p < 8 * 352; p += 512) {
            const int rl = it * 8 + p / 352, vc = p % 352, j0 = vc * 8; const int r = r0 + rl;
            int t, len; if (r >= ML) { t = (r - ML) & (CL - 1); len = CL; } else { t = r & (SL - 1); len = SL; }
            const bool hm = t > 0, hp = t < len - 1;
            const bf16_t* ur = U + (size_t)rl * UPW + j0;
            const u32x4 z4 = (u32x4){0u, 0u, 0u, 0u};
            const u32x4 g0 = *(const u32x4*)ur, gm = hm ? *(const u32x4*)(ur - UPW) : z4, gp = hp ? *(const u32x4*)(ur + UPW) : z4;
            const u32x4 v0 = *(const u32x4*)(ur + DFF), vm = hm ? *(const u32x4*)(ur + DFF - UPW) : z4, vp = hp ? *(const u32x4*)(ur + DFF + UPW) : z4;
            unsigned outw[4];
#pragma unroll
            for (int q = 0; q < 4; ++q) {
                float res[2];
#pragma unroll
                for (int h = 0; h < 2; ++h) {
                    const int j = j0 + 2 * q + h;
                    const float a_m = h ? bfhi(gm[q]) : bflo(gm[q]), a_0 = h ? bfhi(g0[q]) : bflo(g0[q]), a_p = h ? bfhi(gp[q]) : bflo(gp[q]);
                    const float c_m = h ? bfhi(vm[q]) : bflo(vm[q]), c_0 = h ? bfhi(v0[q]) : bflo(v0[q]), c_p = h ? bfhi(vp[q]) : bflo(vp[q]);
                    const float cg = a_m * wc[j] + a_0 * wc[UPW + j] + a_p * wc[2 * UPW + j] + bc[j];
                    const float cv = c_m * wc[DFF + j] + c_0 * wc[UPW + DFF + j] + c_p * wc[2 * UPW + DFF + j] + bc[DFF + j];
                    const float sg = cg / (1.0f + __expf(-cg));
                    res[h] = sg * cv;
                }
                outw[q] = pk2(res[0], res[1]);
            }
            *(u32x4*)(G + (size_t)rl * DFF + j0) = (u32x4){outw[0], outw[1], outw[2], outw[3]};
        }
    }
}

__device__ __forceinline__ void transpose_item(const float* W, int ldw, bf16_t* WT, int ldt, int nblk, int item, LAS float* scr, int lane, bool remap = false) {
    const int kb = item / nblk, nb = item % nblk, k0 = 64 * kb, n0 = 32 * nb;
    int n0d = n0;
    if (remap) { if (n0 < DFF) n0d = 256 * (n0 >> 7) + (n0 & 127); else { const int c = n0 - DFF; n0d = 256 * (c >> 7) + 128 + (c & 127); } }
    float tv[32];
#pragma unroll
    for (int i = 0; i < 32; ++i) tv[i] = W[(size_t)(k0 + 2 * i + (lane >> 5)) * ldw + n0 + (lane & 31)];
#pragma unroll
    for (int i = 0; i < 32; ++i) scr[(2 * i + (lane >> 5)) * 33 + (lane & 31)] = tv[i];
    asm volatile("s_waitcnt lgkmcnt(0)" ::: "memory");
    const int c = lane & 7;
#pragma unroll
    for (int j = 0; j < 4; ++j) { const int n = (lane >> 3) + 8 * j; const LAS float* s = scr + (8 * c) * 33 + n;
        u32x4 o; o.x = pk2(s[0 * 33], s[1 * 33]); o.y = pk2(s[2 * 33], s[3 * 33]); o.z = pk2(s[4 * 33], s[5 * 33]); o.w = pk2(s[6 * 33], s[7 * 33]);
        *(u32x4*)(WT + (size_t)(n0d + n) * ldt + k0 + 8 * c) = o; }
    asm volatile("s_waitcnt lgkmcnt(0)" ::: "memory");
}
}

using namespace mk;
#ifndef MK_TMASK
#define MK_TMASK 0
#endif
#define TSTART() unsigned long long tts_ = 0; if (MK_TMASK) tts_ = __builtin_amdgcn_s_memrealtime();
#define TSTOP(c) if (MK_TMASK && ((MK_TMASK >> (c)) & 1)) tacc_ += __builtin_amdgcn_s_memrealtime() - tts_;
typedef const __attribute__((address_space(4))) Params* KP;
__device__ __forceinline__ KP kp_get() { KP p = (KP)__builtin_amdgcn_kernarg_segment_ptr(); asm volatile("" : "+s"(p)); return p; }
#ifndef MK_REP
#define MK_REP 0
#endif
#define REP(k) for (int rep_ = 0; rep_ < 1 + ((MK_REP >> (k)) & 1); ++rep_)
#ifndef MK_EN
#define MK_EN 0xffff
#endif
#define EN(k) if constexpr ((MK_EN >> (k)) & 1)
constexpr int LDS_BYTES = 159744;
constexpr int XCH_OFF = 131072;
constexpr int MISC_OFF = 131072 + 8192 + 18432;

#define RLX_AGENT __ATOMIC_RELAXED, __HIP_MEMORY_SCOPE_AGENT
#define XB_TMO      128
#define XB_XCNT(j)  (256  + 64 * (j))
#define XB_XSUB(j)  (1280 + 64 * (j))
#define XB_XGEN(j)  (2304 + 64 * (j))
#define XB_TOP      3328
#define XB_TOPGEN   3392
#define XCD_BAR_WORDS 3456
#define XB_SPIN_CAP (1u << 18)

__device__ __forceinline__ unsigned xb_ld(unsigned* p)              { return __hip_atomic_load(p, __ATOMIC_RELAXED, __HIP_MEMORY_SCOPE_AGENT); }
__device__ __forceinline__ unsigned xb_add(unsigned* p, unsigned v) { return __hip_atomic_fetch_add(p, v, __ATOMIC_RELAXED, __HIP_MEMORY_SCOPE_AGENT); }
__device__ __forceinline__ unsigned xb_xcc_id() { return (unsigned)__builtin_amdgcn_s_getreg((3 << 11) | 20) & 0xFu; }
#define XB_SPIN(cond, bar) do { unsigned _sp = 0; while (cond) { __builtin_amdgcn_s_sleep(1); \
    if ((++_sp & 255u) == 0u) { if (xb_ld(&(bar)[XB_TMO])) break; if (_sp > XB_SPIN_CAP) { atomicAdd(&(bar)[XB_TMO], 1u); break; } } } } while (0)

struct XcdBarrier {
    unsigned* bar; unsigned x;
    volatile LAS unsigned* st;
};

__device__ __forceinline__ XcdBarrier xcd_barrier_post(unsigned* bar, volatile LAS unsigned* st) {
    XcdBarrier b; b.bar = bar; b.x = xb_xcc_id(); b.st = st;
    if (threadIdx.x == 0) (void)xb_add(&bar[XB_XCNT(b.x)], 1u);
    return b;
}
__device__ __forceinline__ void xcd_barrier_complete(unsigned* bar, unsigned x, unsigned& nloc, unsigned& nx) {
    const unsigned G = gridDim.x * gridDim.y * gridDim.z;
    unsigned sum, cnt, mine, sp = 0u;
    for (;;) {
        sum = 0u; cnt = 0u; mine = 0u;
#pragma unroll
        for (unsigned j = 0; j < 16; ++j) { const unsigned c = xb_ld(&bar[XB_XCNT(j)]); sum += c; cnt += (c > 0u) ? 1u : 0u; mine = (j == x) ? c : mine; }
        if (sum == G) break;
        __builtin_amdgcn_s_sleep(1);
        if ((++sp & 255u) == 0u) { if (xb_ld(&bar[XB_TMO])) break; if (sp > XB_SPIN_CAP) { atomicAdd(&bar[XB_TMO], 1u); break; } }
    }
    nloc = mine > 0u ? mine : 1u; nx = cnt > 0u ? cnt : 1u;
}

__device__ __forceinline__ void xcd_barrier(const XcdBarrier& b) {
    asm volatile("s_waitcnt vmcnt(0)" ::: "memory");
    __syncthreads();
    if (threadIdx.x == 0) {
        unsigned* bar = b.bar;
        __builtin_amdgcn_s_waitcnt(0);
        unsigned nloc = b.st[0], nx = b.st[1];
        if (nloc == 0u) { xcd_barrier_complete(bar, b.x, nloc, nx); b.st[0] = nloc; b.st[1] = nx; }
        const unsigned old = xb_add(&bar[XB_XSUB(b.x)], 1u);
        const unsigned gen = old / nloc;
        if (old + 1u == (gen + 1u) * nloc) {
            __builtin_amdgcn_fence(__ATOMIC_RELEASE, "agent");
            asm volatile("s_waitcnt vmcnt(0)" ::: "memory");
            const unsigned og = xb_add(&bar[XB_TOP], 1u);
            const unsigned tg = og / nx;
            if (og + 1u == (tg + 1u) * nx) xb_add(&bar[XB_TOPGEN], 1u);
            else XB_SPIN(xb_ld(&bar[XB_TOPGEN]) == tg, bar);
            __builtin_amdgcn_fence(__ATOMIC_ACQUIRE, "agent");
            xb_add(&bar[XB_XGEN(b.x)], 1u);
            asm volatile("s_waitcnt vmcnt(0)" ::: "memory");
        } else {
            XB_SPIN(xb_ld(&bar[XB_XGEN(b.x)]) == gen, bar);
            __builtin_amdgcn_fence(__ATOMIC_ACQUIRE, "agent");
            asm volatile("s_waitcnt vmcnt(0)" ::: "memory");
        }
    }
    __syncthreads();
}

__device__ __forceinline__ bf16_t* wlayer(unsigned char* ws, int l, size_t off) { return (bf16_t*)(ws + WS_W + (size_t)l * W_LAYER + off); }
constexpr size_t OFF_WIN = 0, OFF_WOUT = 4 * MiB, OFF_WUP = 7 * MiB, OFF_WDOWN = 18 * MiB;

__device__ __forceinline__ void setup0(KP pp, LAS unsigned char* lds, int tid, int lane, int wave, unsigned long long& tacc_) {
    unsigned char* ws = pp->ws;
    { TSTART()
        LAS float* scr = (LAS float*)(lds + wave * 16384);
        const int gw = blockIdx.x * 8 + wave, NGW = gridDim.x * 8;
        constexpr int I_IN = 16 * 56, I_UP = 16 * 176, I_DN = 44 * 32, I_OA = 8 * 32, I_OH = 4 * 32, I_L = I_IN + I_UP + I_DN + I_OA + I_OH;
        for (int it = gw; it < 2 * I_L; it += NGW) {
            const int l = it / I_L; int r = it % I_L;
            if (r < I_IN) { transpose_item(pp->in[I_WIN] + (size_t)l * DM * INW, INW, wlayer(ws, l, OFF_WIN), DM, 56, r, scr, lane); continue; } r -= I_IN;
            if (r < I_UP) { transpose_item(pp->in[I_WUP] + (size_t)l * DM * UPW, UPW, wlayer(ws, l, OFF_WUP), DM, 176, r, scr, lane, true); continue; } r -= I_UP;
            if (r < I_DN) { transpose_item(pp->in[I_WDOWN] + (size_t)l * DFF * DM, DM, wlayer(ws, l, OFF_WDOWN), DFF, 32, r, scr, lane); continue; } r -= I_DN;
            if (r < I_OA) { transpose_item(pp->in[I_WOUT] + (size_t)l * DM * DM, DM, wlayer(ws, l, OFF_WOUT), MIXK, 32, r, scr, lane); continue; } r -= I_OA;
            transpose_item(pp->in[I_WOUT] + (size_t)l * DM * DM + (size_t)768 * DM, DM, wlayer(ws, l, OFF_WOUT) + 1024, MIXK, 32, r, scr, lane);
        }
    __syncthreads(); TSTOP(9) }
    constexpr int N_MOD = 192, N_MLP = 512 + 32 + 512, N_DFT = 4096 + 256, N_T = 512, N_TAB = 1;
    constexpr int NIT = N_MOD + N_MLP + N_DFT + N_T + N_TAB;
    if (blockIdx.x < 11) {
        const int idx = (int)blockIdx.x * 512 + tid;
        if (idx < 2 * DFF) { const int l = idx / DFF, c = idx % DFF; const float* w = pp->in[I_WFC] + (size_t)l * 3 * UPW; const float* b = pp->in[I_BFC] + (size_t)l * UPW;
            u32x4 o; o.x = pk2(w[c], w[UPW + c]); o.y = pk2(w[2 * UPW + c], b[c]); o.z = pk2(w[DFF + c], w[UPW + DFF + c]); o.w = pk2(w[2 * UPW + DFF + c], b[DFF + c]);
            ((u32x4*)(ws + WS_WCP))[idx] = o; }
    }
    LAS float* fl = (LAS float*)lds; bool tab_ready = false;
    for (int it = blockIdx.x; it < NIT; it += gridDim.x) {
        int r = it; TSTART()
        if (r < N_MOD) {
            const int l = r / 96, cb = (r % 96) / 8, kc = r % 8;
            for (int idx = tid; idx < 9 * 128; idx += 512) { const int rr = idx / 128, k = idx % 128; const float cv = rr < 8 ? pp->in[I_C][rr * DM + kc * 128 + k] : pp->in[I_CCTX][kc * 128 + k];
                fl[idx] = cv / (1.0f + __expf(-cv)); }
            __syncthreads();
            const int j = cb * 512 + tid; float acc[9];
#pragma unroll
            for (int rr = 0; rr < 9; ++rr) acc[rr] = 0.f;
            const float* wm = pp->in[I_WMOD] + (size_t)l * DM * 6144 + (size_t)(kc * 128) * 6144 + j;
            for (int k0 = 0; k0 < 128; k0 += 32) { float wv_[32];
#pragma unroll
              for (int kk = 0; kk < 32; ++kk) wv_[kk] = wm[(size_t)(k0 + kk) * 6144];
#pragma unroll
              for (int kk = 0; kk < 32; ++kk) {
#pragma unroll
                for (int rr = 0; rr < 9; ++rr) acc[rr] += fl[rr * 128 + k0 + kk] * wv_[kk]; } }
            float* mp = (float*)(ws + WS_MODP) + ((size_t)(l * 8 + kc) * 9) * 6144 + j;
#pragma unroll
            for (int rr = 0; rr < 9; ++rr) mp[(size_t)rr * 6144] = acc[rr];
            __syncthreads(); TSTOP(10)
            continue;
        }
        r -= N_MOD;
        if (r < N_MLP) {
            int l, which, t0;
            if (r < 512) { l = 0; which = 0; t0 = r * 8; } else if (r < 544) { l = 0; which = 1; t0 = (r - 512) * 8; } else { l = 1; which = 0; t0 = (r - 544) * 8; }
            const int T = which ? CL : SL;
            LAS float* Z = fl; LAS float* H1 = fl + 8 * 36; LAS float* H2 = H1 + 512;
            if (tid < 128) { const int p = tid >> 4, i = tid & 15; const int t = t0 + p; const float band = 1e-4f + (float)i * ((15.0f - 1e-4f) / 15.0f);
                const float ang = ((6.2831855f * (float)t) / (float)T) * band; Z[p * 36 + 1 + i] = cosf(ang); Z[p * 36 + 17 + i] = -sinf(ang);
                if (i == 0) Z[p * 36] = (float)t / (float)(T - 1); }
            __syncthreads();
            { const int p = tid >> 6, j = tid & 63; const float* w1 = pp->in[I_HW1] + (size_t)l * 33 * 64; float s = pp->in[I_HB1][l * 64 + j];
              float wr_[33];
#pragma unroll
              for (int i = 0; i < 33; ++i) wr_[i] = w1[i * 64 + j];
#pragma unroll
              for (int i = 0; i < 33; ++i) s += Z[p * 36 + i] * wr_[i];
              H1[p * 64 + j] = sinf(pp->in[I_HFR1][l * 64 + j] * s); }
            __syncthreads();
            { const int p = tid >> 6, j = tid & 63; const float* w2 = pp->in[I_HW2] + (size_t)l * 64 * 64; float s = pp->in[I_HB2][l * 64 + j];
              float wr_[64];
#pragma unroll
              for (int i = 0; i < 64; ++i) wr_[i] = w2[i * 64 + j];
#pragma unroll
              for (int i = 0; i < 64; ++i) s += H1[p * 64 + i] * wr_[i];
              H2[p * 64 + j] = sinf(pp->in[I_HFR2][l * 64 + j] * s); }
            __syncthreads();
            { const int j = tid; const float* w3 = pp->in[I_HW3] + (size_t)l * 64 * 512 + j; float acc[8];
#pragma unroll
              for (int p = 0; p < 8; ++p) acc[p] = 0.f;
              float wr_[64];
#pragma unroll
              for (int i = 0; i < 64; ++i) wr_[i] = w3[(size_t)i * 512];
#pragma unroll
              for (int i = 0; i < 64; ++i) {
#pragma unroll
                  for (int p = 0; p < 8; ++p) acc[p] += H2[p * 64 + i] * wr_[i]; }
              const float da = -3.0701134573253944f, db = -15.350567286626972f;
              const float delta = fabsf(da + (float)(j & 255) * ((db - da) / 255.0f));
              float* hr = (float*)(ws + WS_HRAW) + (which ? (size_t)2 * 512 * SL : (size_t)l * 512 * SL) + (size_t)j * T + t0;
#pragma unroll
              for (int p = 0; p < 8; ++p) hr[p] = acc[p] * expf(-Z[p * 36] * delta); }
            __syncthreads(); TSTOP(11)
            continue;
        }
        r -= N_MLP;
        if (r < N_DFT) {
            LAS float* ctab = (LAS float*)(lds + 65536);
            if (!tab_ready) { for (int q = tid; q < 4096; q += 512) ctab[q] = cospif((float)q * (1.0f / 2048.0f)) * (1.0f / 512.0f); tab_ready = true; __syncthreads(); }
            if (r < 4096) { bf16_t* row = (bf16_t*)(ws + WS_ADFT) + (size_t)r * 4096; const bool isS = r > 2048; const int k = isS ? r - 2048 : r; const int sh = isS ? 3072 : 0;
                for (int t = tid * 2; t < 4096; t += 1024) { const float v0 = ctab[((k * t) + sh) & 4095], v1 = ctab[((k * (t + 1)) + sh) & 4095]; *(unsigned*)(row + t) = pk2(v0, v1); } }
            else { const int rr = r - 4096; bf16_t* row = (bf16_t*)(ws + WS_ADFTC) + (size_t)rr * 256; const bool isS = rr > 128; const int k = isS ? rr - 128 : rr; const int sh = isS ? 3072 : 0;
                if (tid < 256) { const float v = ctab[(((k * tid) & 255) * 16 + sh) & 4095] * 4.0f; row[tid] = (bf16_t)f2bf(v); } }
            TSTOP(12) continue;
        }
        r -= N_DFT;
        if (r < N_T) {
            LAS float* ctab = (LAS float*)(lds + 65536);
            if (!tab_ready) { for (int q = tid; q < 4096; q += 512) ctab[q] = cospif((float)q * (1.0f / 2048.0f)) * (1.0f / 512.0f); tab_ready = true; __syncthreads(); }
            const int rr2 = 2 * r + (tid >> 8); const int l = rr2 >> 9, kk = rr2 & 511; const bool isS = kk >= 256; const int gc = kk & 255, g = gc >> 6, c = gc & 63; const int j = tid & 255;
            const float* wf = pp->in[I_WF] + (size_t)l * 256 * 256 + (size_t)(g * 64) * 256 + j; float s = 0.f;
#pragma unroll 16
            for (int m = 0; m < 64; ++m) { const int q = ((m * c) & 63) * 64; const float tr = isS ? -ctab[(q + 3072) & 4095] : ctab[q]; s += tr * wf[(size_t)m * 256]; }
            ((float*)(ws + WS_T))[((size_t)l * 512 + kk) * 256 + j] = s * 512.0f;
            TSTOP(13) continue;
        }
        { f32x2* tw = (f32x2*)(ws + WS_TW);
          for (int i = tid; i < 4096; i += 512) { const float x = (float)i * (1.0f / 4096.0f); tw[i] = (f32x2){cospif(x), -sinpif(x)}; }
          f32x2* tw2 = (f32x2*)(ws + WS_TW + 65536);
          if (tid < 256) { const float x = (float)tid * (1.0f / 256.0f); tw2[tid] = (f32x2){cospif(x), -sinpif(x)}; }
          float* rope = (float*)(ws + WS_TW + 131072);
          for (int i = tid; i < 1024; i += 512) { const int p = i >> 4, q = i & 15; const float inv = powf(10000.0f, -(float)q / 16.0f); const float a = (float)p * inv; rope[i] = cosf(a); rope[1024 + i] = sinf(a); } }
    }
}

__device__ __forceinline__ void setup1(KP pp, LAS unsigned char* lds, int tid, unsigned long long& tacc_) {
    unsigned char* ws = pp->ws;
    { const int gt = blockIdx.x * 512 + tid, NGT = gridDim.x * 512;
      for (int idx = gt; idx < 2 * 9 * 6144; idx += NGT) { const int l = idx / (9 * 6144), rj = idx % (9 * 6144), j = rj % 6144; float s = pp->in[I_BMOD][l * 6144 + j];
#pragma unroll
          for (int kc = 0; kc < 8; ++kc) s += ((const float*)(ws + WS_MODP))[((size_t)(l * 8 + kc) * 9) * 6144 + rj];
          ((float*)(ws + WS_MOD))[idx] = s; } }
    constexpr int N_KF = 768, N_W2 = 256;
    LAS float* fl = (LAS float*)lds;
    for (int it = blockIdx.x; it < N_KF + N_W2; it += gridDim.x) { TSTART()
        if (it < N_KF) {
            if (it < 512) { const int l = it >> 8, ch = it & 255;
                kf_job<13>(lds, (const float*)(ws + WS_HRAW) + (size_t)l * 512 * SL, (const f32x2*)(ws + WS_TW), (f32x2*)(ws + WS_KF) + (size_t)l * 256 * 8192, ch, tid); }
            else { const int ch = it - 512;
                kf_job<9>(lds, (const float*)(ws + WS_HRAW) + (size_t)2 * 512 * SL, (const f32x2*)(ws + WS_TW + 65536), (f32x2*)(ws + WS_KFC), ch, tid); }
            TSTOP(14) continue;
        }
        const int r = it - N_KF; const int l = r >> 7, nh = (r >> 6) & 1, kb = r & 63;
        for (int idx = tid; idx < 8 * 256; idx += 512) fl[idx] = ((const float*)(ws + WS_T))[((size_t)l * 512 + 8 * kb) * 256 + idx];
        __syncthreads();
        { const int n = nh * 512 + tid; const float* wo = pp->in[I_WOUT] + (size_t)l * DM * DM + (size_t)512 * DM + n; float s[8];
#pragma unroll
          for (int q = 0; q < 8; ++q) s[q] = 0.f;
          for (int j0 = 0; j0 < 256; j0 += 32) { float wv_[32];
#pragma unroll
            for (int jj = 0; jj < 32; ++jj) wv_[jj] = wo[(size_t)(j0 + jj) * DM];
#pragma unroll
            for (int jj = 0; jj < 32; ++jj) { const int j = j0 + jj; const float w = wv_[jj];
#pragma unroll
              for (int q = 0; q < 8; ++q) s[q] += fl[q * 256 + j] * w; } }
          bf16_t* dst = wlayer(ws, l, OFF_WOUT) + (size_t)n * MIXK + 512 + 8 * kb;
          u32x4 o; o.x = pk2(s[0], s[1]); o.y = pk2(s[2], s[3]); o.z = pk2(s[4], s[5]); o.w = pk2(s[6], s[7]);
          *(u32x4*)dst = o; }
        __syncthreads(); TSTOP(15)
    }
}


__device__ __forceinline__ int ph_class(int ph) {
    if (ph < 2) return 0; if (ph == 2) return 1;
    const int r = (ph - 3) & 7;
    return r == 0 ? 2 : r == 1 ? 3 : r == 2 ? 4 : r == 3 ? 5 : r == 4 ? 6 : r == 5 ? 7 : r == 6 ? 8 : 5;
}
__global__ void __launch_bounds__(512, 2) mega_fwd(Params P) {
    extern __shared__ __attribute__((aligned(16))) unsigned char lds_raw[];
    LAS unsigned char* lds = (LAS unsigned char*)lds_raw;
    { volatile LAS unsigned* m0 = (volatile LAS unsigned*)(lds + MISC_OFF); if (threadIdx.x < 32) m0[threadIdx.x] = 0u; }
    __syncthreads();
    XcdBarrier xbar;
    { KP pb = kp_get(); xbar = xcd_barrier_post((unsigned*)(pb->ws + WS_CTL) + 4096, (volatile LAS unsigned*)(lds + MISC_OFF) + 8);
      if (pb->ph_lo < 0) cg::this_grid().sync(); }
    int ph = 0; unsigned long long tacc_ = 0;
#define PH_BEGIN { unsigned long long tph0_ = 0; if (MK_TMASK) tph0_ = __builtin_amdgcn_s_memrealtime(); KP pp = kp_get(); const int lo = pp->ph_lo, hi = pp->ph_hi; if (ph >= lo && ph < hi) { unsigned char* ws = pp->ws; const int tid = mk_tid(), lane = tid & 63, wave = __builtin_amdgcn_readfirstlane(tid >> 6); const int G = gridDim.x, vcu_ = (G % 8 == 0) ? ((int)blockIdx.x % 8) * (G / 8) + (int)blockIdx.x / 8 : (int)blockIdx.x, gw = vcu_ * 8 + wave, NGW = G * 8;     (void)lane; (void)gw; (void)NGW; PTRS
#define PH_END   if (ph + 1 < hi) xcd_barrier(xbar); } if (MK_TMASK && ((MK_TMASK >> ph_class(ph)) & 1)) tacc_ += __builtin_amdgcn_s_memrealtime() - tph0_; } ++ph;
#define PTRS \
    bf16_t* XN = (bf16_t*)(ws + WS_XN); bf16_t* Qb = (bf16_t*)(ws + WS_Q); bf16_t* Kb = (bf16_t*)(ws + WS_K); bf16_t* Vb = (bf16_t*)(ws + WS_V); \
    bf16_t* fT = (bf16_t*)(ws + WS_FT); bf16_t* fTc = (bf16_t*)(ws + WS_FTC); bf16_t* PT = (bf16_t*)(ws + WS_PT); bf16_t* PTc = (bf16_t*)(ws + WS_PTC); \
    bf16_t* MIXb = (bf16_t*)(ws + WS_MIX); bf16_t* Ub = (bf16_t*)(ws + WS_U); bf16_t* Gb = (bf16_t*)(ws + WS_G); \
    float* CX = (float*)(ws + WS_CX); const float* MOD = (const float*)(ws + WS_MOD); \
    const float* rope = (const float*)(ws + WS_TW + 131072); \
    volatile LAS int* misc = (volatile LAS int*)(lds + MISC_OFF); \
    (void)XN; (void)Qb; (void)Kb; (void)Vb; (void)fT; (void)fTc; (void)PT; (void)PTc; (void)MIXb; (void)Ub; (void)Gb; (void)CX; (void)MOD; (void)rope; (void)misc;

    REP(6) { PH_BEGIN EN(0) setup0(pp, lds, tid, lane, wave, tacc_); PH_END --ph; } ++ph;
    REP(8) { PH_BEGIN EN(1) setup1(pp, lds, tid, tacc_); PH_END --ph; } ++ph;
    PH_BEGIN REP(9) EN(2) norm_rows(gw, NGW, lane, MT, pp->in[I_X], pp->in[I_CTX], pp->out, CX, nullptr, nullptr, nullptr, 0, XN, pp->in[I_GPREMIX], MOD, 1024, 0, nullptr, nullptr); PH_END

    for (int l = 0; l < 2; ++l) {
        const bool last = (l == 1);
        const int MR = last ? ML : MT;
        PH_BEGIN {
            pg8::Gemm g{XN, wlayer(ws, l, OFF_WIN), MT, INW, DM}; pg8::StaticOrder S; S.init(MT, INW, G, (int)blockIdx.x);
            EpiInProj E{Qb, Kb, Vb, fT, fTc, PT, PTc, pp->in[I_GQ] + l * 64, pp->in[I_GK] + l * 64, rope, (LAS float*)(lds + XCH_OFF)};
            REP(0) EN(3) pg8::gemm_phase<EpiInProj, pg8::StaticOrder, true, true>(lds, g, S, E);
        } PH_END
        PH_BEGIN {
            const int nF = last ? 128 : 136, nA = last ? 1024 : 1088, nH1 = last ? 1024 : 2048, nH = nH1 * (1 + ((MK_REP >> 7) & 1));
            const int nFx = last ? 16 : 17, nAx = last ? 128 : 136, nHx = last ? 128 : 256, cntq = nFx + nAx + nHx;
            int nxt_ = 0, q0_ = (int)(xb_xcc_id() & 7u), tried_ = 0;
            if (mk_tid() == 0) nxt_ = (int)atomicAdd((unsigned*)(ws + WS_CTL) + 64 * (8 + 16 * l + q0_), 1u);
            for (;;) {
                KP pq = kp_get(); unsigned char* wq = pq->ws; const int tq = mk_tid(); TSTART()
                if (tq == 0) {
                    int t_ = nxt_;
                    while (t_ >= cntq && tried_ < 7) { q0_ = (q0_ + 1) & 7; ++tried_; t_ = (int)atomicAdd((unsigned*)(wq + WS_CTL) + 64 * (8 + 16 * l + q0_), 1u); }
                    misc[0] = (t_ >= cntq) ? -1 : t_; misc[2] = q0_;
                    if (t_ < cntq) nxt_ = (int)atomicAdd((unsigned*)(wq + WS_CTL) + 64 * (8 + 16 * l + q0_), 1u);
                }
                __syncthreads();
                int jt = misc[0]; const int qx = misc[2];
                __syncthreads();
                if (jt < 0) break;
                int it;
                if (jt < nFx) it = jt < 16 ? jt * 8 + qx : 128 + qx;
                else { jt -= nFx;
                    if (jt < nAx) it = nF + (jt < 128 ? qx * 128 + jt : 1024 + qx * 8 + (jt - 128));
                    else { jt -= nAx; const int hb_ = (qx >> 1) * 256 + (qx & 1) * 128; it = nF + nA + (jt < 128 ? hb_ + jt : 1024 + hb_ + (jt - 128)); } }
                TSTOP(19) if (MK_TMASK) tts_ = __builtin_amdgcn_s_memrealtime();
                bf16_t* MIXq = (bf16_t*)(wq + WS_MIX);
                if (it < nF) {
                    if (it < 128) { pg8::Gemm g{(const bf16_t*)(wq + WS_ADFT), (const bf16_t*)(wq + WS_FT), 4096, 2048, 4096}; OneUnit S{it >> 3, it & 7}; EpiFourier E{MIXq, 2048, 0, SL};
                        REP(3) EN(4) pg8::gemm_phase<EpiFourier, OneUnit, false, true>(lds, g, S, E); }
                    else { pg8::Gemm g{(const bf16_t*)(wq + WS_ADFTC), (const bf16_t*)(wq + WS_FTC), 256, 2048, 256}; OneUnit S{0, it - 128}; EpiFourier E{MIXq, 128, ML, CL};
                        REP(3) EN(4) pg8::gemm_phase<EpiFourier, OneUnit, false, true>(lds, g, S, E); }
                    TSTOP(16) continue;
                }
                it -= nF;
                if (it < nA) {
                    const bf16_t* Qq = (const bf16_t*)(wq + WS_Q); const bf16_t* Kq = (const bf16_t*)(wq + WS_K); const bf16_t* Vq = (const bf16_t*)(wq + WS_V);
                    int b, h, NT; size_t qrow;
                    if (it < 1024) { b = it >> 7; h = (it >> 4) & 7; qrow = (size_t)b * SL + (it & 15) * 256; NT = KVB / 64; }
                    else { const int r = it - 1024; b = r >> 3; h = r & 7; qrow = (size_t)ML + b * CL; NT = CL / 64; }
                    const size_t kv0 = (size_t)b * KVB;
                    REP(1) EN(5) attn_body::attn_unit2<8>((const attn_body::bf16*)(Qq + qrow * QP + h * 64), (const attn_body::bf16*)(Kq + kv0 * KVP + (h >> 2) * 64), (const attn_body::bf16*)(Vq + kv0 * KVP + (h >> 2) * 64), (attn_body::bf16*)(MIXq + qrow * MIXK + h * 64), NT, (char*)lds_raw);
                    TSTOP(17) continue;
                }
                it -= nA; if (it >= nH1) it -= nH1;
                const float* wc = pq->in[I_WHC] + (size_t)l * 3 * 768; const float* bc = pq->in[I_BHC] + (size_t)l * 768; const float* hb = pq->in[I_HBIAS] + (size_t)l * 256;
                REP(2) EN(6) { if (it < 1024) hyena_job<13>(lds, (const bf16_t*)(wq + WS_PT), (const f32x2*)(wq + WS_TW), (const f32x2*)(wq + WS_KF) + (size_t)l * 256 * 8192, wc, bc, hb, MIXq, 0, it >> 8, it & 255, tq);
                else { const int r = it - 1024; hyena_job<9>(lds, (const bf16_t*)(wq + WS_PTC), (const f32x2*)(wq + WS_TW + 65536), (const f32x2*)(wq + WS_KFC), wc, bc, hb, MIXq, ML, r >> 8, r & 255, tq); } }
                TSTOP(18)
            }
        } PH_END
        PH_BEGIN {
            pg8::Gemm g{MIXb, wlayer(ws, l, OFF_WOUT), MR, DM, MIXK}; pg8::StaticOrder S; S.init(MR, DM, G, (int)blockIdx.x);
            EpiPlain E{XN, DM};
            REP(5) EN(7) pg8::gemm_phase<EpiPlain, pg8::StaticOrder, true, true>(lds, g, S, E);
        } PH_END
        PH_BEGIN EN(2) norm_rows(gw, NGW, lane, MR, pp->in[I_X], pp->in[I_CTX], pp->out, CX, XN, pp->in[I_GPOSTMIX] + l * DM, (MOD + (size_t)l * 9 * 6144), 2048,
                           XN, pp->in[I_GPREFFN] + l * DM, (MOD + (size_t)l * 9 * 6144), 4096, 3072, l == 0 ? nullptr : (const bf16_t*)(ws + WS_XB), (bf16_t*)(ws + WS_XB)); PH_END
        PH_BEGIN {
            pg8::Gemm g{XN, wlayer(ws, l, OFF_WUP), MR, UPW, DM}; pg8::StaticOrder S; S.init(MR, UPW, G, (int)blockIdx.x);
            EpiGlu E{Gb, (bf16_t*)(ws + WS_SB), (const u32x4*)(ws + WS_WCP) + (size_t)l * DFF, (LAS float*)(lds + XCH_OFF)};
            REP(4) EN(8) pg8::gemm_phase<EpiGlu, pg8::StaticOrder, true, true>(lds, g, S, E);
        } PH_END
        PH_BEGIN EN(9) glu_fixup((int)blockIdx.x, G, tid, MR / 256, (const bf16_t*)(ws + WS_SB), Gb, pp->in[I_WFC] + (size_t)l * 3 * UPW, pp->in[I_BFC] + (size_t)l * UPW); PH_END
        PH_BEGIN {
            pg8::Gemm g{Gb, wlayer(ws, l, OFF_WDOWN), MR, DM, DFF}; pg8::StaticOrder S; S.init(MR, DM, G, (int)blockIdx.x);
            EpiPlain E{XN, DM};
            REP(4) EN(10) pg8::gemm_phase<EpiPlain, pg8::StaticOrder, true, true>(lds, g, S, E);
        } PH_END
        PH_BEGIN EN(2) norm_rows(gw, NGW, lane, MR, pp->in[I_X], pp->in[I_CTX], pp->out, CX, XN, pp->in[I_GPOSTFFN] + l * DM, (MOD + (size_t)l * 9 * 6144), 5120,
                           last ? nullptr : XN, pp->in[I_GPREMIX] + (last ? 0 : (l + 1) * DM), MOD + (size_t)(last ? 0 : (l + 1)) * 9 * 6144, 1024, 0,
                           (const bf16_t*)(ws + WS_XB), last ? nullptr : (bf16_t*)(ws + WS_XB)); PH_END
    }
    if (MK_TMASK) { if (blockIdx.x == 0 && threadIdx.x == 0) { const unsigned long long t0_ = __builtin_amdgcn_s_memrealtime(); while (__builtin_amdgcn_s_memrealtime() - t0_ < 4ull * tacc_) __builtin_amdgcn_s_sleep(8); } }
}

constexpr int N_PHASES = 3 + 2 * 8;
#ifndef MK_MULTI
#define MK_MULTI 0
#endif
extern "C" void kernel_launch(void* const* d_in, const int* in_sizes, int n_in, void* d_out, int out_size, void* d_ws, size_t ws_size, hipStream_t stream) {
    static int grid = 0;
    if (grid == 0) {
        if (n_in != 29 || ws_size < WS_END) { fprintf(stderr, "kernel_launch: bad args n_in %d ws %zu (need %zu)\n", n_in, ws_size, (size_t)WS_END); grid = -1; return; }
        int dev = 0, cus = 0, per_cu = 0;
        (void)hipGetDevice(&dev); (void)hipDeviceGetAttribute(&cus, hipDeviceAttributeMultiprocessorCount, dev);
        if (hipFuncSetAttribute((const void*)mega_fwd, hipFuncAttributeMaxDynamicSharedMemorySize, LDS_BYTES) != hipSuccess) { fprintf(stderr, "hipFuncSetAttribute failed\n"); grid = -1; return; }
        if (hipOccupancyMaxActiveBlocksPerMultiprocessor(&per_cu, (const void*)mega_fwd, 512, LDS_BYTES) != hipSuccess || per_cu < 1) { fprintf(stderr, "occupancy query: %d\n", per_cu); per_cu = 1; }
        (void)hipGetLastError();
        grid = cus * 1;
    }
    if (grid < 0) return;
    (void)hipMemsetAsync((char*)d_ws + WS_CTL, 0, 32768, stream);
    Params p{};
    for (int i = 0; i < 29; ++i) p.in[i] = (const float*)d_in[i];
    p.out = (float*)d_out; p.ws = (unsigned char*)d_ws;
#if MK_MULTI
    for (int k = 0; k < N_PHASES; ++k) { p.ph_lo = k; p.ph_hi = k + 1; hipLaunchKernelGGL(mega_fwd, dim3(grid), dim3(512), LDS_BYTES, stream, p); }
#else
    p.ph_lo = 0; p.ph_hi = N_PHASES;
    void* args[] = {&p};
    hipError_t e = hipLaunchCooperativeKernel((const void*)mega_fwd, dim3(grid), dim3(512), args, LDS_BYTES, stream);
    if (e != hipSuccess) fprintf(stderr, "cooperative launch failed: %s (grid %d)\n", hipGetErrorString(e), grid);
#endif
}
```
